# Optimizing an MI355X kernel written in HIP

```python
import itertools
import jax, jax.numpy as jnp
from jax import lax
import numpy as np

D_MODEL = 2048
BATCH = 2
SEQ = 16384
DEPTH = 2
DEC_BATCH = 8
DEC_SEQ = 4096
PAST_LEN = 128

A_HEADS = 8
Q_LORA = 512
KV_LORA = 512
QK_NOPE = 128
QK_ROPE = 64
V_HEAD = 128
ROPE_THETA = 10000.0
Q_BLOCK = 128
A_WIDTH = A_HEADS * V_HEAD
M_HEADS = 8
M_QK = 128
M_V = 128
CHUNK = 64
M_QK_WIDTH = M_HEADS * M_QK
M_WIDTH = M_HEADS * M_V
N_GATES = 4 * M_HEADS
EPS = 1e-6
SPLIT_SIZES = (Q_LORA, KV_LORA, QK_ROPE, A_WIDTH,
               M_QK_WIDTH, M_QK_WIDTH, M_WIDTH, M_WIDTH, M_WIDTH, N_GATES,
               D_MODEL, D_MODEL)
IN_COLS = Q_LORA + KV_LORA + QK_ROPE + A_WIDTH + 2 * M_QK_WIDTH + 3 * M_WIDTH + N_GATES + 2 * D_MODEL

kernel_name = "hybrid_mla_mlstm_bidir_encoder"


def rms_norm(x, g):
    xf = x.astype(jnp.float32)
    y = xf * lax.rsqrt(jnp.mean(xf * xf, axis=-1, keepdims=True) + EPS)
    return (y * g.astype(jnp.float32)).astype(x.dtype)


def split_cols(t):
    offs = list(itertools.accumulate(SPLIT_SIZES))[:-1]
    return jnp.split(t, offs, axis=-1)


def rope_tables(seq_len):
    inv = ROPE_THETA ** (-jnp.arange(0, QK_ROPE, 2, dtype=jnp.float32) / QK_ROPE)
    ang = jnp.arange(seq_len, dtype=jnp.float32)[:, None] * inv[None, :]
    return jnp.cos(ang), jnp.sin(ang)


def apply_rope(x, cos, sin):
    extra = x.ndim - 3
    c = cos.reshape(cos.shape[0], *([1] * extra), cos.shape[1])
    s = sin.reshape(sin.shape[0], *([1] * extra), sin.shape[1])
    xf = x.astype(jnp.float32)
    x1, x2 = xf[..., :QK_ROPE // 2], xf[..., QK_ROPE // 2:]
    out = jnp.concatenate([x1 * c - x2 * s, x2 * c + x1 * s], axis=-1)
    return out.astype(x.dtype)


def mla_branch(c_q, c_kv, k_rope, q_a_norm, w_uq, kv_a_norm, w_ukv, cos, sin):
    B, S, _ = c_q.shape
    q = (rms_norm(c_q, q_a_norm) @ w_uq).reshape(B, S, A_HEADS, QK_NOPE + QK_ROPE)
    q_nope = q[..., :QK_NOPE]
    q_rope = apply_rope(q[..., QK_NOPE:], cos, sin)
    kv = (rms_norm(c_kv, kv_a_norm) @ w_ukv).reshape(B, S, A_HEADS, QK_NOPE + V_HEAD)
    k_nope, v = kv[..., :QK_NOPE], kv[..., QK_NOPE:]
    k_r = apply_rope(k_rope, cos, sin)
    scale = (QK_NOPE + QK_ROPE) ** -0.5
    nb = S // Q_BLOCK

    def to_blocks(t):
        return t.reshape(B, nb, Q_BLOCK, *t.shape[2:]).swapaxes(0, 1)

    def attend(blk):
        qn, qr = blk
        s = (jnp.einsum('bqhd,bkhd->bhqk', qn, k_nope, preferred_element_type=jnp.float32)
             + jnp.einsum('bqhd,bkd->bhqk', qr, k_r, preferred_element_type=jnp.float32))
        p = jax.nn.softmax(s * scale, axis=-1)
        return jnp.einsum('bhqk,bkhd->bqhd', p.astype(v.dtype), v)

    o = lax.map(attend, (to_blocks(q_nope), to_blocks(q_rope)))
    return o.swapaxes(0, 1).reshape(B, S, A_WIDTH)


def mlstm_chunkwise(q, k, v, i_pre, f_pre):
    B, S, H, DK = q.shape
    DV = v.shape[-1]
    L = CHUNK
    NC = S // L
    f32 = jnp.float32
    q = q.astype(f32).reshape(B, NC, L, H, DK) * (DK ** -0.5)
    k = k.astype(f32).reshape(B, NC, L, H, DK)
    v = v.astype(f32).reshape(B, NC, L, H, DV)
    log_f = jax.nn.log_sigmoid(f_pre.astype(f32)).reshape(B, NC, L, H).transpose(0, 1, 3, 2)
    log_i = i_pre.astype(f32).reshape(B, NC, L, H).transpose(0, 1, 3, 2)
    b = jnp.cumsum(log_f, axis=-1)
    g = b[..., -1]
    a = g[..., None] - b + log_i
    m_loc = a.max(axis=-1)
    w = jnp.exp(a - m_loc[..., None])
    kw = k * w.transpose(0, 1, 3, 2)[..., None]
    C_loc = jnp.einsum('bclhk,bclhv->bchkv', kw, v)
    n_loc = kw.sum(axis=2)

    def step(carry, xs):
        C, n, m = carry
        Cl, nl, ml, gl = xs
        m_new = jnp.maximum(gl + m, ml)
        a_old = jnp.exp(gl + m - m_new)
        a_new = jnp.exp(ml - m_new)
        C_new = a_old[..., None, None] * C + a_new[..., None, None] * Cl
        n_new = a_old[..., None] * n + a_new[..., None] * nl
        return (C_new, n_new, m_new), (C, n, m)

    init = (jnp.zeros((B, H, DK, DV), f32), jnp.zeros((B, H, DK), f32), jnp.zeros((B, H), f32))
    xs = tuple(jnp.moveaxis(t, 1, 0) for t in (C_loc, n_loc, m_loc, g))
    _, (C_prev, n_prev, m_prev) = lax.scan(step, init, xs)
    C_prev = jnp.moveaxis(C_prev, 0, 1)
    n_prev = jnp.moveaxis(n_prev, 0, 1)
    m_prev = jnp.moveaxis(m_prev, 0, 1)

    lower = jnp.tril(jnp.ones((L, L), dtype=bool))
    Dm = jnp.where(lower, b[..., :, None] - b[..., None, :] + log_i[..., None, :], -jnp.inf)
    e = b + m_prev[..., None]
    m_t = jnp.maximum(e, Dm.max(axis=-1))
    P = jnp.exp(Dm - m_t[..., None]) * jnp.einsum('bcjhd,bclhd->bchjl', q, k)
    w_inter = jnp.exp(e - m_t)
    num = (jnp.einsum('bchjl,bclhv->bchjv', P, v)
           + w_inter[..., None] * jnp.einsum('bcjhd,bchdv->bchjv', q, C_prev))
    den = P.sum(axis=-1) + w_inter * jnp.einsum('bcjhd,bchd->bchj', q, n_prev)
    h = num / jnp.maximum(jnp.abs(den), jnp.exp(-m_t))[..., None]
    return h.transpose(0, 1, 3, 2, 4).reshape(B, S, H, DV)


def mlstm_bidir(q, k, v, gates):
    i_fw, i_bw, f_fw, f_bw = jnp.split(gates, 4, axis=-1)
    h_fw = mlstm_chunkwise(q, k, v, i_fw, f_fw)
    flip = lambda t: jnp.flip(t, axis=1)
    h_bw = flip(mlstm_chunkwise(flip(q), flip(k), flip(v), flip(i_bw), flip(f_bw)))
    return h_fw + h_bw


def encoder_layer(x, cos, sin, norm_in, w_in, b_gates, q_a_norm, w_uq, kv_a_norm, w_ukv,
                  w_oa, m_head_norm, w_ob, w_out):
    B, S, _ = x.shape
    h = rms_norm(x, norm_in)
    (c_q, c_kv, k_rope, z_a, q_m, k_m, v_m, o_m, z_m, gates, g_a, g_b) = split_cols(h @ w_in)
    y_a = mla_branch(c_q, c_kv, k_rope, q_a_norm, w_uq, kv_a_norm, w_ukv, cos, sin) * jax.nn.silu(z_a)
    hm = mlstm_bidir(q_m.reshape(B, S, M_HEADS, M_QK), k_m.reshape(B, S, M_HEADS, M_QK),
                     v_m.reshape(B, S, M_HEADS, M_V), gates.astype(jnp.float32) + b_gates.astype(jnp.float32))
    hm = hm * lax.rsqrt(jnp.mean(hm * hm, axis=-1, keepdims=True) + EPS)
    hm = (hm * m_head_norm.astype(jnp.float32).reshape(M_HEADS, M_V)).reshape(B, S, M_WIDTH).astype(x.dtype)
    y_b = hm * jax.nn.sigmoid(o_m) * jax.nn.silu(z_m)
    merged = jax.nn.sigmoid(g_a) * (y_a @ w_oa) + jax.nn.sigmoid(g_b) * (y_b @ w_ob)
    return x + merged @ w_out


def trunk(x, norm_in, w_in, b_gates, q_a_norm, w_uq, kv_a_norm, w_ukv, w_oa, m_head_norm,
          w_ob, w_out, norm_f):
    cos, sin = rope_tables(x.shape[1])
    for l in range(DEPTH):
        x = encoder_layer(x, cos, sin, norm_in[l], w_in[l], b_gates[l], q_a_norm[l], w_uq[l],
                          kv_a_norm[l], w_ukv[l], w_oa[l], m_head_norm[l], w_ob[l], w_out[l])
    return rms_norm(x, norm_f)


def setup_inputs(seed: int = 0) -> dict:
    key = jax.random.key(seed)
    ks = jax.random.split(key, 16)
    f32 = jnp.float32
    nrm = lambda k, shape: jax.random.normal(k, shape, f32)
    gain = lambda k, shape: 1.0 + 0.02 * nrm(k, shape)
    b_i = 0.1 * nrm(ks[2], (DEPTH, 2 * M_HEADS))
    b_f = 3.0 + 0.5 * nrm(ks[3], (DEPTH, 2 * M_HEADS))
    return {
        "x_prompt": nrm(ks[0], (BATCH, SEQ, D_MODEL)),
        "x_sample": nrm(ks[1], (DEC_BATCH, DEC_SEQ, D_MODEL)),
        "norm_in": gain(ks[4], (DEPTH, D_MODEL)),
        "w_in": nrm(ks[5], (DEPTH, D_MODEL, IN_COLS)) * D_MODEL ** -0.5,
        "b_gates": jnp.concatenate([b_i, b_f], axis=-1),
        "q_a_norm": gain(ks[6], (DEPTH, Q_LORA)),
        "w_uq": nrm(ks[7], (DEPTH, Q_LORA, A_HEADS * (QK_NOPE + QK_ROPE))) * Q_LORA ** -0.5,
        "kv_a_norm": gain(ks[8], (DEPTH, KV_LORA)),
        "w_ukv": nrm(ks[9], (DEPTH, KV_LORA, A_HEADS * (QK_NOPE + V_HEAD))) * KV_LORA ** -0.5,
        "w_oa": nrm(ks[10], (DEPTH, A_WIDTH, D_MODEL)) * A_WIDTH ** -0.5,
        "m_head_norm": gain(ks[11], (DEPTH, M_WIDTH)),
        "w_ob": nrm(ks[12], (DEPTH, M_WIDTH, D_MODEL)) * M_WIDTH ** -0.5,
        "w_out": nrm(ks[13], (DEPTH, D_MODEL, D_MODEL)) * D_MODEL ** -0.5,
        "norm_f": gain(ks[14], (D_MODEL,)),
    }


def reference(x_prompt, x_sample, norm_in, w_in, b_gates, q_a_norm, w_uq, kv_a_norm, w_ukv,
              w_oa, m_head_norm, w_ob, w_out, norm_f):
    y_prompt = trunk(x_prompt, norm_in, w_in, b_gates, q_a_norm, w_uq, kv_a_norm, w_ukv,
                     w_oa, m_head_norm, w_ob, w_out, norm_f)
    y_sample = trunk(x_sample, norm_in, w_in, b_gates, q_a_norm, w_uq, kv_a_norm, w_ukv,
                     w_oa, m_head_norm, w_ob, w_out, norm_f)
    return (y_prompt, y_sample)
```

```cpp
#include <hip/hip_runtime.h>
#include <hip/hip_bf16.h>
#include <cstdio>
#include <cstdint>

#ifndef MK_PER_PHASE
#define MK_PER_PHASE 1
#endif
#ifndef ML_FAST_TR
#define ML_FAST_TR 1
#endif

namespace pg8 {
#define PG8_LAS __attribute__((address_space(3)))
typedef unsigned short bf16_t;
typedef short bf16x8 __attribute__((ext_vector_type(8)));
typedef float f32x4 __attribute__((ext_vector_type(4)));
typedef unsigned u32x4 __attribute__((ext_vector_type(4)));
constexpr int BM = 256, BK = 64, HALF = 128, HTB = HALF * BK * 2  , STAGE_BYTES = 8 * HTB, NXCD = 8, WGM = 8;

__host__ __device__ __forceinline__ int lds_byte(int r, int c) { const int st = (r >> 4) * 2 + (c >> 5), rr = r & 15, cc = c & 31, ob = rr * 64 + cc * 2; return st * 1024 + (ob ^ (((ob >> 9) & 1) << 5)); }
__host__ __device__ __forceinline__ void stage_rc(int b, int& R, int& C) { const int st = b / 1024, sb = b % 1024, swz = sb ^ (((sb >> 9) & 1) << 5); R = (st >> 1) * 16 + swz / 64; C = (st & 1) * 32 + (swz % 64) / 2; }
__host__ __device__ __forceinline__ int perm32(int rho) { const int n = rho >> 4, i = rho & 15; return 8 * (i >> 2) + 4 * n + (i & 3); }

struct Unit { int pm, pn; };
struct Gemm { const bf16_t* A; const bf16_t* Bt; int M, N, K, lda; };

struct StaticOrder {
    int nM, nN, nwg, G, c;
    __host__ __device__ void init(int M, int N, int G_, int c_) { nM = M / BM; nN = N / BM; nwg = nM * nN; G = G_; c = c_; }
    __host__ __device__ bool next(int i, Unit& u) const {
        const long L = (long)i * G + c; if (L >= nwg) return false;
        int wgid = (int)L; { const int q = nwg / NXCD, r = nwg % NXCD, xcd = wgid % NXCD, off = wgid / NXCD; wgid = (xcd < r ? xcd * (q + 1) : r * (q + 1) + (xcd - r) * q) + off; }
        const int nig = WGM * nN, gid = wgid / nig, fm = gid * WGM, gsz = (nM - fm) < WGM ? (nM - fm) : WGM;
        u.pm = fm + ((wgid % nig) % gsz); u.pn = (wgid % nig) / gsz; return true;
    }
    __device__ __forceinline__ void a_ready(const Unit&) const {}
    __device__ __forceinline__ void done(const Unit&) const {}
};

__device__ __forceinline__ unsigned cvt_pk_bf16(float lo, float hi) { unsigned r; asm volatile("v_cvt_pk_bf16_f32 %0, %1, %2" : "=v"(r) : "v"(lo), "v"(hi)); return r; }
typedef float f32x2 __attribute__((ext_vector_type(2)));
template <class Epi, class Sched, bool ALIGN_EPI = false, bool SP2 = false>
__device__ __forceinline__ void gemm_phase(PG8_LAS unsigned char* lds, const Gemm g, const Sched& S, const Epi& E) {
    int tid = threadIdx.x; asm volatile("" : "+v"(tid));
    const int wid = __builtin_amdgcn_readfirstlane(tid >> 6), lane = tid & 63, wr = wid >> 2, wc = wid & 3, fr = lane & 15, fq = lane >> 4;
    const int K = g.K, nt = K / BK;
    unsigned voffA[2], voffB[2];
#pragma unroll
    for (int i = 0; i < 2; ++i) { int R, C; stage_rc(tid * 16 + i * 8192, R, C); const int Rb = Epi::PERM ? ((R & ~31) + perm32(R & 31)) : R;
        voffA[i] = (unsigned)(R * g.lda + C) * 2u; voffB[i] = (unsigned)(Rb * K + C) * 2u; }
    const size_t kstep = (size_t)(BK * 2);
    const size_t hstepA = (size_t)HALF * g.lda * 2, hstepB = (size_t)HALF * K * 2;
    const size_t tstepA = 2 * hstepA, tstepB = 2 * hstepB;
    const unsigned ldsw = (unsigned)wid * 1024u;
    const int aoff = lds_byte(wr * 64 + fr, fq * 8), boff = lds_byte(wc * 32 + fr, fq * 8);
#define PG8_SA(b, h) (((b) * 2 + (h)) * HTB)
#define PG8_SB(b, h) ((4 + (b) * 2 + (h)) * HTB)
#define PG8_STAGE(bufoff, gbase, voff) do { _Pragma("unroll") for (int _i = 0; _i < 2; ++_i) \
        __builtin_amdgcn_global_load_lds((const unsigned*)((const char*)(gbase) + (voff)[_i]), (PG8_LAS unsigned*)(lds + (bufoff) + ldsw + _i * 8192), 16, 0, 0); } while (0)
#define PG8_LDA(dst, b, h) do { _Pragma("unroll") for (int m = 0; m < 4; ++m) _Pragma("unroll") for (int k = 0; k < 2; ++k) dst[m][k] = *(const PG8_LAS bf16x8*)(lds + PG8_SA(b, h) + aoff + m * 2048 + k * 1024); } while (0)
#define PG8_LDB(dst, b, h) do { _Pragma("unroll") for (int n = 0; n < 2; ++n) _Pragma("unroll") for (int k = 0; k < 2; ++k) dst[n][k] = *(const PG8_LAS bf16x8*)(lds + PG8_SB(b, h) + boff + n * 2048 + k * 1024); } while (0)
#define PG8_MMA(ai, bj, At, Bt) do { __builtin_amdgcn_s_setprio(1); _Pragma("unroll") for (int m = 0; m < 4; ++m) _Pragma("unroll") for (int n = 0; n < 2; ++n) _Pragma("unroll") for (int k = 0; k < 2; ++k) \
        acc[ai][bj][m][n] = __builtin_amdgcn_mfma_f32_16x16x32_bf16(Bt[n][k], At[m][k], acc[ai][bj][m][n], 0, 0, 0); __builtin_amdgcn_s_setprio(0); } while (0)
#define PG8_WAIT_V(n) asm volatile("s_waitcnt vmcnt(" #n ")" ::: "memory")
#define PG8_WAIT_L(n) asm volatile("s_waitcnt lgkmcnt(" #n ")" ::: "memory")
#define PG8_BAR __builtin_amdgcn_s_barrier()
#define PG8_SCHED __builtin_amdgcn_sched_barrier(0)
    Unit cur, nxt; int ui = 0;
    if (!S.next(0, cur)) return;
    f32x4 acc[2][2][4][2];
#pragma unroll
    for (int a = 0; a < 2; ++a)
#pragma unroll
        for (int b = 0; b < 2; ++b)
#pragma unroll
            for (int m = 0; m < 4; ++m)
#pragma unroll
                for (int n = 0; n < 2; ++n) acc[a][b][m][n] = (f32x4){0.f, 0.f, 0.f, 0.f};
    bf16x8 At[4][2], B0[2][2], B1[2][2];
    const char* cA = (const char*)g.A + (size_t)cur.pm * tstepA; const char* cB = (const char*)g.Bt + (size_t)cur.pn * tstepB;
    S.a_ready(cur);
    if constexpr (SP2) {
        PG8_STAGE(PG8_SB(0, 0), cB, voffB); PG8_STAGE(PG8_SB(0, 1), cB + hstepB, voffB); PG8_STAGE(PG8_SA(0, 0), cA, voffA); PG8_STAGE(PG8_SA(0, 1), cA + hstepA, voffA);
        if (wr == 1) PG8_BAR;
        PG8_WAIT_V(2); PG8_BAR;
        PG8_STAGE(PG8_SB(1, 0), cB + kstep, voffB); PG8_STAGE(PG8_SA(1, 0), cA + kstep, voffA); PG8_STAGE(PG8_SB(1, 1), cB + hstepB + kstep, voffB);
        PG8_WAIT_V(6); PG8_BAR;
    } else {
        PG8_STAGE(PG8_SB(0, 0), cB, voffB); PG8_STAGE(PG8_SA(0, 0), cA, voffA); PG8_STAGE(PG8_SB(0, 1), cB + hstepB, voffB); PG8_STAGE(PG8_SA(0, 1), cA + hstepA, voffA);
        if (wr == 1) PG8_BAR;
        PG8_WAIT_V(4); PG8_BAR;
        PG8_STAGE(PG8_SB(1, 0), cB + kstep, voffB); PG8_STAGE(PG8_SA(1, 0), cA + kstep, voffA); PG8_STAGE(PG8_SB(1, 1), cB + hstepB + kstep, voffB);
        PG8_WAIT_V(6); PG8_BAR;
    }
    for (;;) {
        const bool has_next = S.next(ui + 1, nxt);
        const char* nA = has_next ? (const char*)g.A + (size_t)nxt.pm * tstepA : cA; const char* nB = has_next ? (const char*)g.Bt + (size_t)nxt.pn * tstepB : cB;
        for (int t = 0; t < nt; t += 2) {
            const bool last = (t == nt - 2);
            const char* a1 = cA + (size_t)(t + 1) * kstep;
            const char* a2 = last ? nA : cA + (size_t)(t + 2) * kstep; const char* b2 = last ? nB : cB + (size_t)(t + 2) * kstep;
            const char* a3 = a2 + kstep; const char* b3 = b2 + kstep;
            if (last && has_next) S.a_ready(nxt);
            if constexpr (SP2) {
            PG8_LDB(B0, 0, 0); PG8_LDB(B1, 0, 1); PG8_SCHED; PG8_LDA(At, 0, 0); PG8_STAGE(PG8_SA(1, 1), a1 + hstepA, voffA);
            PG8_WAIT_V(8); PG8_WAIT_L(0); PG8_BAR; PG8_MMA(0, 0, At, B0); PG8_MMA(0, 1, At, B1); PG8_BAR; PG8_SCHED;
            PG8_LDA(At, 0, 1); PG8_STAGE(PG8_SB(0, 0), b2, voffB); PG8_STAGE(PG8_SB(0, 1), b2 + hstepB, voffB); PG8_STAGE(PG8_SA(0, 0), a2, voffA);
            PG8_WAIT_V(8); PG8_WAIT_L(0); PG8_BAR; PG8_MMA(1, 0, At, B0); PG8_MMA(1, 1, At, B1); PG8_BAR; PG8_SCHED;
            PG8_LDB(B0, 1, 0); PG8_LDB(B1, 1, 1); PG8_SCHED; PG8_LDA(At, 1, 0); PG8_STAGE(PG8_SA(0, 1), a2 + hstepA, voffA);
            PG8_WAIT_V(8); PG8_WAIT_L(0); PG8_BAR; PG8_MMA(0, 0, At, B0); PG8_MMA(0, 1, At, B1); PG8_BAR; PG8_SCHED;
            PG8_LDA(At, 1, 1); PG8_STAGE(PG8_SB(1, 0), b3, voffB); PG8_STAGE(PG8_SB(1, 1), b3 + hstepB, voffB); PG8_STAGE(PG8_SA(1, 0), a3, voffA);
            PG8_WAIT_V(8); PG8_WAIT_L(0); PG8_BAR; PG8_MMA(1, 0, At, B0); PG8_MMA(1, 1, At, B1); PG8_BAR; PG8_SCHED;
            } else {
            PG8_LDB(B0, 0, 0); PG8_SCHED; PG8_LDA(At, 0, 0); PG8_STAGE(PG8_SA(1, 1), a1 + hstepA, voffA);
            PG8_WAIT_L(8); PG8_BAR; PG8_WAIT_L(0); PG8_MMA(0, 0, At, B0); PG8_BAR; PG8_SCHED;
            PG8_LDB(B1, 0, 1); PG8_STAGE(PG8_SB(0, 0), b2, voffB);
            PG8_BAR; PG8_WAIT_L(0); PG8_MMA(0, 1, At, B1); PG8_BAR;
            PG8_LDA(At, 0, 1); PG8_STAGE(PG8_SA(0, 0), a2, voffA);
            PG8_BAR; PG8_WAIT_L(0); PG8_MMA(1, 0, At, B0); PG8_BAR; PG8_SCHED;
            PG8_STAGE(PG8_SB(0, 1), b2 + hstepB, voffB);
            PG8_WAIT_V(6); PG8_BAR; PG8_MMA(1, 1, At, B1); PG8_BAR;
            PG8_LDB(B0, 1, 0); PG8_SCHED; PG8_LDA(At, 1, 0); PG8_STAGE(PG8_SA(0, 1), a2 + hstepA, voffA);
            PG8_WAIT_L(8); PG8_BAR; PG8_WAIT_L(0); PG8_MMA(0, 0, At, B0); PG8_BAR; PG8_SCHED;
            PG8_LDB(B1, 1, 1); PG8_STAGE(PG8_SB(1, 0), b3, voffB);
            PG8_BAR; PG8_WAIT_L(0); PG8_MMA(0, 1, At, B1); PG8_BAR;
            PG8_LDA(At, 1, 1); PG8_STAGE(PG8_SA(1, 0), a3, voffA);
            PG8_BAR; PG8_WAIT_L(0); PG8_MMA(1, 0, At, B0); PG8_BAR; PG8_SCHED;
            PG8_STAGE(PG8_SB(1, 1), b3 + hstepB, voffB);
            PG8_WAIT_V(6); PG8_BAR; PG8_MMA(1, 1, At, B1); PG8_BAR;
            }
        }
        if constexpr (ALIGN_EPI) { if (wr == 0) PG8_BAR; }
        if constexpr (!Epi::AFTER_DRAIN) { E(acc, cur, wr, wc, fr, fq); S.done(cur); }
        if (!has_next) break;
#pragma unroll
        for (int a = 0; a < 2; ++a)
#pragma unroll
            for (int b = 0; b < 2; ++b)
#pragma unroll
                for (int m = 0; m < 4; ++m)
#pragma unroll
                    for (int n = 0; n < 2; ++n) acc[a][b][m][n] = (f32x4){0.f, 0.f, 0.f, 0.f};
        cur = nxt; cA = nA; cB = nB; ++ui;
        if constexpr (ALIGN_EPI) { if (wr == 1) PG8_BAR; }
    }
    PG8_WAIT_V(0);
    if constexpr (!ALIGN_EPI) { if (wr == 0) PG8_BAR; }
    PG8_BAR;
    if constexpr (Epi::AFTER_DRAIN) { E.fused(acc, cur, wr, wc, fr, fq, lds, wid, lane); S.done(cur); }
#undef PG8_SA
#undef PG8_SB
#undef PG8_STAGE
#undef PG8_LDA
#undef PG8_LDB
#undef PG8_MMA
#undef PG8_WAIT_V
#undef PG8_WAIT_L
#undef PG8_BAR
#undef PG8_SCHED
}
}

constexpr int DM = 2048, DEPTH = 2;
constexpr int MTOK = 65536, MPROMPT = 32768, SEQ_P = 16384, SEQ_S = 4096;
constexpr int IN_COLS = 11360;
constexpr int NP1 = 4352, NP2 = 7168, NQ = 1536, NKV = 2048;
constexpr int SRC_CQ = 0, SRC_CKV = 512, SRC_KROPE = 1024, SRC_ZA = 1088, SRC_QM = 2112, SRC_KM = 3136, SRC_VM = 4160, SRC_OM = 5184, SRC_ZM = 6208, SRC_GATES = 7232, SRC_GA = 7264, SRC_GB = 9312;
constexpr float EPS = 1e-6f;
constexpr int NWAVES = 8;

constexpr size_t MiB = 1u << 20, U = 128 * MiB;
constexpr size_t WS_XN = 0;
constexpr size_t WS_CQKV = 2 * U;
constexpr size_t WS_QM = 3 * U, WS_KM = 4 * U, WS_VM = 5 * U;
constexpr size_t WS_Q = 6 * U;
constexpr size_t WS_KN = 6 * U + U / 2 * 3, WS_V = WS_KN + U;
constexpr size_t WS_KR = WS_V + U;
constexpr size_t WS_HFW = 10 * U, WS_HBW = 11 * U;
constexpr size_t WS_SO = 3 * U, WS_SZ = 4 * U, WS_SGA = 5 * U, WS_SGB = 7 * U;
constexpr size_t WS_W = 12 * U;
constexpr size_t W_P1 = 0, W_P2 = W_P1 + (size_t)NP1 * DM * 2, W_UQ = W_P2 + (size_t)NP2 * DM * 2, W_UKV = W_UQ + (size_t)NQ * 512 * 2,
                 W_OA = W_UKV + (size_t)NKV * 512 * 2, W_OB = W_OA + (size_t)DM * 1024 * 2, W_OUT = W_OB + (size_t)DM * 1024 * 2, LW = W_OUT + (size_t)DM * DM * 2;
constexpr size_t WS_ROPE = WS_W + 2 * LW;
constexpr size_t WS_GATES = WS_ROPE + 4 * MiB;
constexpr size_t WS_SSQ = WS_GATES + 8 * MiB;
constexpr size_t WS_CTL = WS_SSQ + 4 * MiB, CTL_ZERO_BYTES = 1 * MiB;
constexpr size_t WS_END = WS_CTL + CTL_ZERO_BYTES;
static_assert(LW % 256 == 0 && WS_END < 2040 * MiB, "d_ws map");
constexpr int CW_BAR = 4096;
constexpr int CW_QUEUE = 16384;

constexpr int LDS_BYTES = 163840;
constexpr int MISC_OFF = 159744;

#define GAS __attribute__((address_space(1)))
#define LAS __attribute__((address_space(3)))
typedef unsigned short bf16;
typedef unsigned v4u __attribute__((ext_vector_type(4)));
typedef float f32x4 __attribute__((ext_vector_type(4)));
typedef short bf16x8 __attribute__((ext_vector_type(8)));
typedef GAS unsigned gu32;
typedef GAS unsigned long long gu64;
#define RLX_AGENT __ATOMIC_RELAXED, __HIP_MEMORY_SCOPE_AGENT
#define LDS_WAIT() asm volatile("s_waitcnt lgkmcnt(0)" ::: "memory")
#define VM_WAIT() asm volatile("s_waitcnt vmcnt(0)" ::: "memory")
__device__ __forceinline__ unsigned long long rt() { return __builtin_amdgcn_s_memrealtime(); }
__device__ __forceinline__ unsigned f2bf(float f) { unsigned u = __builtin_bit_cast(unsigned, f); return (u + 0x7fffu + ((u >> 16) & 1u)) >> 16; }
__device__ __forceinline__ unsigned pk2(float lo, float hi) { return f2bf(lo) | (f2bf(hi) << 16); }

#define XB_TMO      128
#define XB_XCNT(j)  (256  + 64 * (j))
#define XB_XSUB(j)  (1280 + 64 * (j))
#define XB_XGEN(j)  (2304 + 64 * (j))
#define XB_TOP      3328
#define XB_TOPGEN   3392
#define XCD_BAR_WORDS 3456
#define XB_SPIN_CAP (1u << 18)

__device__ __forceinline__ unsigned xb_ld(unsigned* p)              { return __hip_atomic_load(p, __ATOMIC_RELAXED, __HIP_MEMORY_SCOPE_AGENT); }
__device__ __forceinline__ unsigned xb_add(unsigned* p, unsigned v) { return __hip_atomic_fetch_add(p, v, __ATOMIC_RELAXED, __HIP_MEMORY_SCOPE_AGENT); }
__device__ __forceinline__ unsigned xb_xcc_id() { return (unsigned)__builtin_amdgcn_s_getreg((3 << 11) | 20) & 0xFu; }
#define XB_SPIN(cond, bar) do { unsigned _sp = 0; while (cond) { __builtin_amdgcn_s_sleep(1); \
    if ((++_sp & 255u) == 0u) { if (xb_ld(&(bar)[XB_TMO])) break; if (_sp > XB_SPIN_CAP) { atomicAdd(&(bar)[XB_TMO], 1u); break; } } } } while (0)

struct XcdBarrier {
    unsigned* bar; unsigned x;
    volatile LAS unsigned* st;
};

__device__ __forceinline__ XcdBarrier xcd_barrier_post(unsigned* bar, volatile LAS unsigned* st) {
    XcdBarrier b; b.bar = bar; b.x = xb_xcc_id(); b.st = st;
    if (threadIdx.x == 0) (void)xb_add(&bar[XB_XCNT(b.x)], 1u);
    return b;
}
__device__ __forceinline__ void xcd_barrier_complete(unsigned* bar, unsigned x, unsigned& nloc, unsigned& nx) {
    const unsigned G = gridDim.x * gridDim.y * gridDim.z;
    unsigned sum, cnt, mine, sp = 0u;
    for (;;) {
        sum = 0u; cnt = 0u; mine = 0u;
#pragma unroll
        for (unsigned j = 0; j < 16; ++j) { const unsigned c = xb_ld(&bar[XB_XCNT(j)]); sum += c; cnt += (c > 0u) ? 1u : 0u; mine = (j == x) ? c : mine; }
        if (sum == G) break;
        __builtin_amdgcn_s_sleep(1);
        if ((++sp & 255u) == 0u) { if (xb_ld(&bar[XB_TMO])) break; if (sp > XB_SPIN_CAP) { atomicAdd(&bar[XB_TMO], 1u); break; } }
    }
    nloc = mine > 0u ? mine : 1u; nx = cnt > 0u ? cnt : 1u;
}

__device__ __forceinline__ void xcd_barrier(const XcdBarrier& b) {
    asm volatile("s_waitcnt vmcnt(0)" ::: "memory");
    __syncthreads();
    if (threadIdx.x == 0) {
        unsigned* bar = b.bar;
        __builtin_amdgcn_s_waitcnt(0);
        unsigned nloc = b.st[0], nx = b.st[1];
        if (nloc == 0u) { xcd_barrier_complete(bar, b.x, nloc, nx); b.st[0] = nloc; b.st[1] = nx; }
        const unsigned old = xb_add(&bar[XB_XSUB(b.x)], 1u);
        const unsigned gen = old / nloc;
        if (old + 1u == (gen + 1u) * nloc) {
            __builtin_amdgcn_fence(__ATOMIC_RELEASE, "agent");
            asm volatile("s_waitcnt vmcnt(0)" ::: "memory");
            const unsigned og = xb_add(&bar[XB_TOP], 1u);
            const unsigned tg = og / nx;
            if (og + 1u == (tg + 1u) * nx) xb_add(&bar[XB_TOPGEN], 1u);
            else XB_SPIN(xb_ld(&bar[XB_TOPGEN]) == tg, bar);
            __builtin_amdgcn_fence(__ATOMIC_ACQUIRE, "agent");
            xb_add(&bar[XB_XGEN(b.x)], 1u);
            asm volatile("s_waitcnt vmcnt(0)" ::: "memory");
        } else {
            XB_SPIN(xb_ld(&bar[XB_XGEN(b.x)]) == gen, bar);
            __builtin_amdgcn_fence(__ATOMIC_ACQUIRE, "agent");
            asm volatile("s_waitcnt vmcnt(0)" ::: "memory");
        }
    }
    __syncthreads();
}


typedef float f32x2 __attribute__((ext_vector_type(2)));
typedef float f32x8v __attribute__((ext_vector_type(8)));
typedef unsigned u32x2 __attribute__((ext_vector_type(2)));
typedef short s16x4 __attribute__((ext_vector_type(4)));
typedef float f32x16 __attribute__((ext_vector_type(16)));

__device__ __forceinline__ unsigned cvtpk(float lo, float hi) { unsigned r; asm volatile("v_cvt_pk_bf16_f32 %0, %1, %2" : "=v"(r) : "v"(lo), "v"(hi)); return r; }
__device__ __forceinline__ float bflo(unsigned w) { return __uint_as_float(w << 16); }
__device__ __forceinline__ float bfhi(unsigned w) { return __uint_as_float(w & 0xffff0000u); }
__device__ __forceinline__ float sigmoidf_(float x) { return __builtin_amdgcn_rcpf(1.0f + __expf(-x)); }
__device__ __forceinline__ float siluf_(float x) { return x * __builtin_amdgcn_rcpf(1.0f + __expf(-x)); }
__device__ __forceinline__ float wave_sum(float v) {
#pragma unroll
    for (int o = 1; o < 64; o <<= 1) v += __shfl_xor(v, o);
    return v;
}
__device__ __forceinline__ int opaque_tid() { int t = threadIdx.x; asm volatile("" : "+v"(t)); return t; }
__device__ __forceinline__ int seq_pos(int m) { return m < MPROMPT ? (m & (SEQ_P - 1)) : (m & (SEQ_S - 1)); }

struct Frame {
    LAS unsigned char* lds;
    volatile LAS unsigned* MISC;
    gu32* ctl;
    int tid, lane, wave, vcu, G;
    unsigned char* ws;
    float* out;
};
enum { IN_XP = 0, IN_XS = 1, IN_NORM_IN = 2, IN_W_IN = 3, IN_B_GATES = 4, IN_Q_A_NORM = 5, IN_W_UQ = 6, IN_KV_A_NORM = 7, IN_W_UKV = 8, IN_W_OA = 9, IN_M_HEAD_NORM = 10, IN_W_OB = 11, IN_W_OUT = 12, IN_NORM_F = 13 };
struct Args { const float* in[14]; float* out; unsigned char* ws; int ph_lo, ph_hi; };

__device__ __forceinline__ int wmap(int kind, int n) {
    if (kind == 0) {
        if (n < 1024) return n;
        if (n < 4096) return SRC_QM + (n - 1024);
        if (n < 4160) { const int j = n - 4096; return SRC_KROPE + (j >> 1) + 32 * (j & 1); }
        if (n < 4192) return SRC_GATES + (n - 4160);
        return -1;
    }
    if (kind == 1) {
        if (n < 1024) return SRC_ZA + n;
        if (n < 3072) return SRC_OM + (n - 1024);
        return SRC_GA + (n - 3072);
    }
    if (kind == 2) {
        if (n < 1024) return (n >> 7) * 192 + (n & 127);
        const int j = n - 1024, h = j >> 6, jj = j & 63; return h * 192 + 128 + (jj >> 1) + 32 * (jj & 1);
    }
    if (kind == 3) {
        if (n < 1024) return (n >> 7) * 256 + (n & 127);
        const int j = n - 1024; return (j >> 7) * 256 + 128 + (j & 127);
    }
    return n;
}
__device__ __forceinline__ void transpose_item(const float* W, int K, int srcN, bf16* WT, int Ndst, int kind, const float* kgain, LAS float* scr, int item, int lane) {
    const int nblk = Ndst / 32, kb = item / nblk, nb = item % nblk, k0 = 64 * kb, n0 = 32 * nb;
    const int n = n0 + (lane & 31); const int sc = wmap(kind, n);
    const float cs = (kind == 0 && n >= 1024 && n < 2048) ? 0.08838834764831845f : 1.0f;
#pragma unroll 8
    for (int i = 0; i < 32; ++i) { const int kk = 2 * i + (lane >> 5);
        float v = 0.f; if (sc >= 0) { v = W[(size_t)(k0 + kk) * srcN + sc] * cs; if (kgain) v *= kgain[k0 + kk]; }
        scr[kk * 33 + (lane & 31)] = v; }
    LDS_WAIT(); asm volatile("" ::: "memory");
    const int c = lane & 7;
#pragma unroll
    for (int j = 0; j < 4; ++j) { const int nn = (lane >> 3) + 8 * j; const LAS float* s = scr + (8 * c) * 33 + nn;
        v4u o; o.x = pk2(s[0 * 33], s[1 * 33]); o.y = pk2(s[2 * 33], s[3 * 33]); o.z = pk2(s[4 * 33], s[5 * 33]); o.w = pk2(s[6 * 33], s[7 * 33]);
        *(GAS v4u*)(WT + (size_t)(n0 + nn) * K + k0 + 8 * c) = o; }
    LDS_WAIT(); asm volatile("" ::: "memory");
}
__device__ __forceinline__ void p_prologue(Frame& F, const Args& A) {
    const int tid_ = opaque_tid(), lane_ = tid_ & 63, wave_ = __builtin_amdgcn_readfirstlane(tid_ >> 6);
    LAS float* scr = (LAS float*)(F.lds + wave_ * 16384);
    const int gw = F.vcu * NWAVES + wave_, NGW = F.G * NWAVES;
    constexpr int I_P1 = (DM / 64) * (NP1 / 32), I_P2 = (DM / 64) * (NP2 / 32), I_UQ = (512 / 64) * (NQ / 32), I_UKV = (512 / 64) * (NKV / 32),
                  I_OA = (1024 / 64) * (DM / 32), I_OB = I_OA, I_OUT = (DM / 64) * (DM / 32), I_LAYER = I_P1 + I_P2 + I_UQ + I_UKV + I_OA + I_OB + I_OUT;
    for (int it = gw; it < DEPTH * I_LAYER; it += NGW) {
        const int l = it / I_LAYER; int r = it - l * I_LAYER;
        bf16* wb = (bf16*)(F.ws + WS_W + (size_t)l * LW);
        if (r < I_P1) { transpose_item(A.in[IN_W_IN] + (size_t)l * DM * IN_COLS, DM, IN_COLS, (bf16*)((unsigned char*)wb + W_P1), NP1, 0, nullptr, scr, r, lane_); continue; } r -= I_P1;
        if (r < I_P2) { transpose_item(A.in[IN_W_IN] + (size_t)l * DM * IN_COLS, DM, IN_COLS, (bf16*)((unsigned char*)wb + W_P2), NP2, 1, nullptr, scr, r, lane_); continue; } r -= I_P2;
        if (r < I_UQ) { transpose_item(A.in[IN_W_UQ] + (size_t)l * 512 * NQ, 512, NQ, (bf16*)((unsigned char*)wb + W_UQ), NQ, 2, A.in[IN_Q_A_NORM] + l * 512, scr, r, lane_); continue; } r -= I_UQ;
        if (r < I_UKV) { transpose_item(A.in[IN_W_UKV] + (size_t)l * 512 * NKV, 512, NKV, (bf16*)((unsigned char*)wb + W_UKV), NKV, 3, A.in[IN_KV_A_NORM] + l * 512, scr, r, lane_); continue; } r -= I_UKV;
        if (r < I_OA) { transpose_item(A.in[IN_W_OA] + (size_t)l * 1024 * DM, 1024, DM, (bf16*)((unsigned char*)wb + W_OA), DM, 4, nullptr, scr, r, lane_); continue; } r -= I_OA;
        if (r < I_OB) { transpose_item(A.in[IN_W_OB] + (size_t)l * 1024 * DM, 1024, DM, (bf16*)((unsigned char*)wb + W_OB), DM, 4, nullptr, scr, r, lane_); continue; } r -= I_OB;
        transpose_item(A.in[IN_W_OUT] + (size_t)l * DM * DM, DM, DM, (bf16*)((unsigned char*)wb + W_OUT), DM, 4, nullptr, scr, r, lane_);
    }
    f32x2* rope = (f32x2*)(F.ws + WS_ROPE);
    for (int e = F.vcu * 512 + tid_; e < SEQ_P * 32; e += F.G * 512) {
        const int pos = e >> 5, i = e & 31;
        const float inv = powf(10000.0f, -(float)(2 * i) / 64.0f);
        const float ang = (float)pos * inv; float s, c; sincosf(ang, &s, &c);
        rope[e] = (f32x2){c, s};
    }
}

__device__ __forceinline__ const float* x_row(Frame& F, const Args& A, int layer, int m) {
    if (layer == 0) return m < MPROMPT ? A.in[IN_XP] + (size_t)m * DM : A.in[IN_XS] + (size_t)(m - MPROMPT) * DM;
    return F.out + (size_t)m * DM;
}
__device__ __forceinline__ void p_norm(Frame& F, const Args& A, int layer) {
    const int tid_ = opaque_tid(), lane_ = tid_ & 63, wave_ = __builtin_amdgcn_readfirstlane(tid_ >> 6);
    const int gw = F.vcu * NWAVES + wave_, NGW = F.G * NWAVES;
    const float* g = A.in[IN_NORM_IN] + layer * DM; bf16* XN = (bf16*)(F.ws + WS_XN);
    for (int m = gw; m < MTOK; m += NGW) {
        const GAS f32x4* xr = (const GAS f32x4*)x_row(F, A, layer, m) + lane_;
        f32x4 v[8]; float s = 0.f;
#pragma unroll
        for (int j = 0; j < 8; ++j) { v[j] = xr[64 * j]; s += (v[j].x * v[j].x + v[j].y * v[j].y) + (v[j].z * v[j].z + v[j].w * v[j].w); }
        const float rs = 1.0f / sqrtf(wave_sum(s) * (1.0f / DM) + EPS);
        GAS unsigned long long* o8 = (GAS unsigned long long*)(XN + (size_t)m * DM) + lane_;
#pragma unroll
        for (int j = 0; j < 8; ++j) { const f32x4 gg = *((const GAS f32x4*)g + lane_ + 64 * j);
            o8[64 * j] = (unsigned long long)cvtpk(v[j].x * rs * gg.x, v[j].y * rs * gg.y) | ((unsigned long long)cvtpk(v[j].z * rs * gg.z, v[j].w * rs * gg.w) << 32); }
    }
}
__device__ __forceinline__ void p_final(Frame& F, const Args& A) {
    const int tid_ = opaque_tid(), lane_ = tid_ & 63, wave_ = __builtin_amdgcn_readfirstlane(tid_ >> 6);
    const int gw = F.vcu * NWAVES + wave_, NGW = F.G * NWAVES;
    for (int m = gw; m < MTOK; m += NGW) {
        GAS f32x4* xr = (GAS f32x4*)(F.out + (size_t)m * DM) + lane_;
        f32x4 v[8]; float s = 0.f;
#pragma unroll
        for (int j = 0; j < 8; ++j) { v[j] = xr[64 * j]; s += (v[j].x * v[j].x + v[j].y * v[j].y) + (v[j].z * v[j].z + v[j].w * v[j].w); }
        const float rs = 1.0f / sqrtf(wave_sum(s) * (1.0f / DM) + EPS);
#pragma unroll
        for (int j = 0; j < 8; ++j) { const f32x4 gg = *((const GAS f32x4*)A.in[IN_NORM_F] + lane_ + 64 * j); xr[64 * j] = v[j] * rs * gg; }
    }
}
__device__ __forceinline__ void p_comb(Frame& F, const Args& A, int layer) {
    const int tid_ = opaque_tid(), lane_ = tid_ & 63, wave_ = __builtin_amdgcn_readfirstlane(tid_ >> 6);
    const int gw = F.vcu * NWAVES + wave_, NGW = F.G * NWAVES;
    const float* gain = A.in[IN_M_HEAD_NORM] + layer * 1024 + lane_ * 16;
    f32x4 gg[4];
#pragma unroll
    for (int j = 0; j < 4; ++j) gg[j] = *(const GAS f32x4*)(gain + 4 * j);
    for (int m = gw; m < MTOK; m += NGW) {
        const size_t off = (size_t)m * 1024 + lane_ * 16;
        const v4u* pf = (const v4u*)((bf16*)(F.ws + WS_HFW) + off); const v4u* pb = (const v4u*)((bf16*)(F.ws + WS_HBW) + off);
        const v4u* po = (const v4u*)((bf16*)(F.ws + WS_SO) + off); const v4u* pz = (const v4u*)((bf16*)(F.ws + WS_SZ) + off);
        v4u a[2] = {pf[0], pf[1]}, b[2] = {pb[0], pb[1]}, so[2] = {po[0], po[1]}, sz[2] = {pz[0], pz[1]};
        float h[16]; float s = 0.f;
#pragma unroll
        for (int q = 0; q < 2; ++q)
#pragma unroll
            for (int e = 0; e < 4; ++e) { const unsigned wa = a[q][e], wb = b[q][e]; const float lo = bflo(wa) + bflo(wb), hi = bfhi(wa) + bfhi(wb); h[q * 8 + e * 2] = lo; h[q * 8 + e * 2 + 1] = hi; s += lo * lo + hi * hi; }
        s += __shfl_xor(s, 1); s += __shfl_xor(s, 2); s += __shfl_xor(s, 4);
        const float rs = 1.0f / sqrtf(s * (1.0f / 128.0f) + EPS);
        v4u o[2];
#pragma unroll
        for (int q = 0; q < 2; ++q)
#pragma unroll
            for (int e = 0; e < 4; ++e) { const int c = q * 8 + e * 2; const unsigned wo = so[q][e], wz = sz[q][e];
                const float lo = h[c] * rs * gg[c >> 2][c & 3] * bflo(wo) * bflo(wz), hi = h[c + 1] * rs * gg[(c + 1) >> 2][(c + 1) & 3] * bfhi(wo) * bfhi(wz);
                o[q][e] = cvtpk(lo, hi); }
        v4u* py = (v4u*)((bf16*)(F.ws + WS_HFW) + off); py[0] = o[0]; py[1] = o[1];
    }
}

using pg8::Unit; using pg8::BM; using pg8::HALF;
#define EPI_ROWS_BEGIN  _Pragma("unroll") for (int ai = 0; ai < 2; ++ai) _Pragma("unroll") for (int m = 0; m < 4; ++m) { const int row = u.pm * BM + ai * HALF + wr * 64 + m * 16 + fr;
#define EPI_ROWS_END    asm volatile("" ::: "memory"); }

struct EpiP1 {
    static constexpr bool PERM = true, AFTER_DRAIN = false;
    unsigned char* ws; const float* bg;
    __device__ __forceinline__ void operator()(const f32x4 (&acc)[2][2][4][2], const Unit& u, int wr, int wc, int fr, int fq) const {
        const int pn = u.pn;
        if (pn < 16) {
            bf16* base; int colt;
            if (pn < 4) { base = (bf16*)(ws + WS_CQKV); colt = pn * 256; } else { base = (bf16*)(ws + WS_QM + (size_t)((pn - 4) >> 2) * U); colt = ((pn - 4) & 3) * 256; }
            const int col0 = colt + wc * 32 + 8 * fq;
            EPI_ROWS_BEGIN
                bf16* rowp = base + (size_t)row * 1024 + col0; float s = 0.f;
#pragma unroll
                for (int bj = 0; bj < 2; ++bj) { const f32x4 v0 = acc[ai][bj][m][0], v1 = acc[ai][bj][m][1];
                    s += (v0[0] * v0[0] + v0[1] * v0[1]) + (v0[2] * v0[2] + v0[3] * v0[3]) + (v1[0] * v1[0] + v1[1] * v1[1]) + (v1[2] * v1[2] + v1[3] * v1[3]);
                    v4u w; w.x = cvtpk(v0[0], v0[1]); w.y = cvtpk(v0[2], v0[3]); w.z = cvtpk(v1[0], v1[1]); w.w = cvtpk(v1[2], v1[3]);
                    *(v4u*)(rowp + bj * HALF) = w; }
                if (pn < 4) { s += __shfl_xor(s, 16); s += __shfl_xor(s, 32); if (fq == 0) ((float*)(ws + WS_SSQ))[(size_t)row * 16 + pn * 4 + wc] = s; }
            EPI_ROWS_END
        } else {
            if (wc < 2) {
                const f32x2* rope = (const f32x2*)(ws + WS_ROPE);
                EPI_ROWS_BEGIN
                    const int pos = seq_pos(row); const f32x2* rp = rope + pos * 32 + 16 * wc + 4 * fq;
                    const f32x4 cs01 = *(const f32x4*)rp, cs23 = *(const f32x4*)(rp + 2);
                    const f32x4 v0 = acc[ai][0][m][0], v1 = acc[ai][0][m][1];
                    v4u w;
                    w.x = cvtpk(v0[0] * cs01[0] - v0[1] * cs01[1], v0[1] * cs01[0] + v0[0] * cs01[1]);
                    w.y = cvtpk(v0[2] * cs01[2] - v0[3] * cs01[3], v0[3] * cs01[2] + v0[2] * cs01[3]);
                    w.z = cvtpk(v1[0] * cs23[0] - v1[1] * cs23[1], v1[1] * cs23[0] + v1[0] * cs23[1]);
                    w.w = cvtpk(v1[2] * cs23[2] - v1[3] * cs23[3], v1[3] * cs23[2] + v1[2] * cs23[3]);
                    *(v4u*)((bf16*)(ws + WS_KR) + (size_t)row * 64 + 32 * wc + 8 * fq) = w;
                EPI_ROWS_END
            } else if (wc == 2) {
                const f32x4 b0 = *(const f32x4*)(bg + 8 * fq), b1 = *(const f32x4*)(bg + 8 * fq + 4);
                EPI_ROWS_BEGIN
                    float* gp = (float*)(ws + WS_GATES) + (size_t)row * 32 + 8 * fq;
                    *(f32x4*)gp = acc[ai][0][m][0] + b0; *(f32x4*)(gp + 4) = acc[ai][0][m][1] + b1;
                EPI_ROWS_END
            }
        }
    }
};
struct EpiQ {
    static constexpr bool PERM = true, AFTER_DRAIN = false;
    unsigned char* ws;
    __device__ __forceinline__ void operator()(const f32x4 (&acc)[2][2][4][2], const Unit& u, int wr, int wc, int fr, int fq) const {
        const int pn = u.pn; const int col0 = pn * 256 + wc * 32 + 8 * fq;
        const f32x2* rope = (const f32x2*)(ws + WS_ROPE);
        EPI_ROWS_BEGIN
            const float* sp = (const float*)(ws + WS_SSQ) + (size_t)row * 16; const f32x4 s0 = *(const f32x4*)sp, s1 = *(const f32x4*)(sp + 4);
            const float rs = 1.0f / sqrtf(((s0[0] + s0[1]) + (s0[2] + s0[3]) + (s1[0] + s1[1]) + (s1[2] + s1[3])) * (1.0f / 512.0f) + EPS);
            bf16* rowp = (bf16*)(ws + WS_Q) + (size_t)row * NQ + col0;
            if (pn < 4) {
#pragma unroll
                for (int bj = 0; bj < 2; ++bj) { const f32x4 v0 = acc[ai][bj][m][0] * rs, v1 = acc[ai][bj][m][1] * rs;
                    v4u w; w.x = cvtpk(v0[0], v0[1]); w.y = cvtpk(v0[2], v0[3]); w.z = cvtpk(v1[0], v1[1]); w.w = cvtpk(v1[2], v1[3]);
                    *(v4u*)(rowp + bj * HALF) = w; }
            } else {
                const int pos = seq_pos(row); const f32x2* rp = rope + pos * 32 + 16 * (wc & 1) + 4 * fq;
                const f32x4 cs01 = *(const f32x4*)rp, cs23 = *(const f32x4*)(rp + 2);
#pragma unroll
                for (int bj = 0; bj < 2; ++bj) { const f32x4 v0 = acc[ai][bj][m][0] * rs, v1 = acc[ai][bj][m][1] * rs;
                    v4u w;
                    w.x = cvtpk(v0[0] * cs01[0] - v0[1] * cs01[1], v0[1] * cs01[0] + v0[0] * cs01[1]);
                    w.y = cvtpk(v0[2] * cs01[2] - v0[3] * cs01[3], v0[3] * cs01[2] + v0[2] * cs01[3]);
                    w.z = cvtpk(v1[0] * cs23[0] - v1[1] * cs23[1], v1[1] * cs23[0] + v1[0] * cs23[1]);
                    w.w = cvtpk(v1[2] * cs23[2] - v1[3] * cs23[3], v1[3] * cs23[2] + v1[2] * cs23[3]);
                    *(v4u*)(rowp + bj * HALF) = w; }
            }
        EPI_ROWS_END
    }
};
struct EpiKV {
    static constexpr bool PERM = true, AFTER_DRAIN = false;
    unsigned char* ws;
    __device__ __forceinline__ void operator()(const f32x4 (&acc)[2][2][4][2], const Unit& u, int wr, int wc, int fr, int fq) const {
        const int pn = u.pn; bf16* base = (bf16*)(ws + (pn < 4 ? WS_KN : WS_V)); const int col0 = (pn & 3) * 256 + wc * 32 + 8 * fq;
        EPI_ROWS_BEGIN
            const float* sp = (const float*)(ws + WS_SSQ) + (size_t)row * 16 + 8; const f32x4 s0 = *(const f32x4*)sp, s1 = *(const f32x4*)(sp + 4);
            const float rs = 1.0f / sqrtf(((s0[0] + s0[1]) + (s0[2] + s0[3]) + (s1[0] + s1[1]) + (s1[2] + s1[3])) * (1.0f / 512.0f) + EPS);
            bf16* rowp = base + (size_t)row * 1024 + col0;
#pragma unroll
            for (int bj = 0; bj < 2; ++bj) { const f32x4 v0 = acc[ai][bj][m][0] * rs, v1 = acc[ai][bj][m][1] * rs;
                v4u w; w.x = cvtpk(v0[0], v0[1]); w.y = cvtpk(v0[2], v0[3]); w.z = cvtpk(v1[0], v1[1]); w.w = cvtpk(v1[2], v1[3]);
                *(v4u*)(rowp + bj * HALF) = w; }
        EPI_ROWS_END
    }
};
struct EpiP2 {
    static constexpr bool PERM = true, AFTER_DRAIN = false;
    unsigned char* ws;
    __device__ __forceinline__ void operator()(const f32x4 (&acc)[2][2][4][2], const Unit& u, int wr, int wc, int fr, int fq) const {
        const int pn = u.pn; bf16* base; int colt, pitch, mode;
        if (pn < 4) { base = (bf16*)(ws + WS_CQKV); colt = pn * 256; pitch = 1024; mode = 0; }
        else if (pn < 8) { base = (bf16*)(ws + WS_SO); colt = (pn - 4) * 256; pitch = 1024; mode = 1; }
        else if (pn < 12) { base = (bf16*)(ws + WS_SZ); colt = (pn - 8) * 256; pitch = 1024; mode = 2; }
        else if (pn < 20) { base = (bf16*)(ws + WS_SGA); colt = (pn - 12) * 256; pitch = 2048; mode = 1; }
        else { base = (bf16*)(ws + WS_SGB); colt = (pn - 20) * 256; pitch = 2048; mode = 1; }
        const int col0 = colt + wc * 32 + 8 * fq;
        EPI_ROWS_BEGIN
            bf16* rowp = base + (size_t)row * pitch + col0;
#pragma unroll
            for (int bj = 0; bj < 2; ++bj) { f32x4 v0 = acc[ai][bj][m][0], v1 = acc[ai][bj][m][1];
                if (mode == 1) {
#pragma unroll
                    for (int j = 0; j < 4; ++j) { v0[j] = sigmoidf_(v0[j]); v1[j] = sigmoidf_(v1[j]); }
                } else {
#pragma unroll
                    for (int j = 0; j < 4; ++j) { v0[j] = siluf_(v0[j]); v1[j] = siluf_(v1[j]); }
                    if (mode == 0) { const v4u o = *(const v4u*)(rowp + bj * HALF);
                        v0[0] *= bflo(o.x); v0[1] *= bfhi(o.x); v0[2] *= bflo(o.y); v0[3] *= bfhi(o.y); v1[0] *= bflo(o.z); v1[1] *= bfhi(o.z); v1[2] *= bflo(o.w); v1[3] *= bfhi(o.w); }
                }
                v4u w; w.x = cvtpk(v0[0], v0[1]); w.y = cvtpk(v0[2], v0[3]); w.z = cvtpk(v1[0], v1[1]); w.w = cvtpk(v1[2], v1[3]);
                *(v4u*)(rowp + bj * HALF) = w; }
        EPI_ROWS_END
    }
};
template <int MODE> struct EpiMerge {
    static constexpr bool PERM = true, AFTER_DRAIN = false;
    unsigned char* ws;
    __device__ __forceinline__ void operator()(const f32x4 (&acc)[2][2][4][2], const Unit& u, int wr, int wc, int fr, int fq) const {
        const int col0 = u.pn * 256 + wc * 32 + 8 * fq; const bf16* gate = (const bf16*)(ws + (MODE == 0 ? WS_SGA : WS_SGB)); bf16* T = (bf16*)(ws + WS_XN);
        EPI_ROWS_BEGIN
            const size_t off = (size_t)row * DM + col0;
#pragma unroll
            for (int bj = 0; bj < 2; ++bj) { f32x4 v0 = acc[ai][bj][m][0], v1 = acc[ai][bj][m][1]; const v4u g = *(const v4u*)(gate + off + bj * HALF);
                v0[0] *= bflo(g.x); v0[1] *= bfhi(g.x); v0[2] *= bflo(g.y); v0[3] *= bfhi(g.y); v1[0] *= bflo(g.z); v1[1] *= bfhi(g.z); v1[2] *= bflo(g.w); v1[3] *= bfhi(g.w);
                if (MODE == 1) { const v4u t = *(const v4u*)(T + off + bj * HALF);
                    v0[0] += bflo(t.x); v0[1] += bfhi(t.x); v0[2] += bflo(t.y); v0[3] += bfhi(t.y); v1[0] += bflo(t.z); v1[1] += bfhi(t.z); v1[2] += bflo(t.w); v1[3] += bfhi(t.w); }
                v4u w; w.x = cvtpk(v0[0], v0[1]); w.y = cvtpk(v0[2], v0[3]); w.z = cvtpk(v1[0], v1[1]); w.w = cvtpk(v1[2], v1[3]);
                *(v4u*)(T + off + bj * HALF) = w; }
        EPI_ROWS_END
    }
};
struct EpiOut {
    static constexpr bool PERM = false, AFTER_DRAIN = false;
    const float* xp; const float* xs; float* out; int layer;
    __device__ __forceinline__ void operator()(const f32x4 (&acc)[2][2][4][2], const Unit& u, int wr, int wc, int fr, int fq) const {
        const int col0 = u.pn * 256 + wc * 32 + 4 * fq;
        EPI_ROWS_BEGIN
            const float* xr = layer == 0 ? (row < MPROMPT ? xp + (size_t)row * DM : xs + (size_t)(row - MPROMPT) * DM) : out + (size_t)row * DM;
            float* orow = out + (size_t)row * DM + col0; xr += col0;
#pragma unroll
            for (int bj = 0; bj < 2; ++bj)
#pragma unroll
                for (int n = 0; n < 2; ++n) *(f32x4*)(orow + bj * HALF + n * 16) = *(const f32x4*)(xr + bj * HALF + n * 16) + acc[ai][bj][m][n];
            asm volatile("" ::: "memory");
        EPI_ROWS_END
    }
};

namespace att {
constexpr int NW = 8, QBLK = 32, KVBLK = 64;
constexpr float SCALE = 0.07216878364870322f;
constexpr float THR = 8.f;
constexpr int SDEPTH = 1;
constexpr int SHM_V = KVBLK * 128 * 2, SHM_K = KVBLK * 128 * 2, SHM_R = KVBLK * 64 * 2;
constexpr int OFF_V = 0, OFF_K = 2 * SHM_V, OFF_R = OFF_K + 2 * SHM_K, OFF_WS = OFF_R + 2 * SHM_R, OFF_QR = OFF_WS + NW * 64 * 4, SHM_ATTN = OFF_QR + NW * 8192;
#define KSWZ(row, colB) ((row) * 256 + ((colB) ^ (((row) & 7) << 4)))
#define RSWZ(row, chunk) ((row) * 128 + ((((chunk) ^ ((row) >> 1)) & 7) << 4))
#define SBAR() __builtin_amdgcn_sched_barrier(0)
__device__ __forceinline__ int crow(int r, int hi) { return (r & 3) + 8 * (r >> 2) + 4 * hi; }

__device__ __forceinline__ void partialSM(f32x16& p0, f32x16& p1, float& m_reg, float& mn, float& alpha) {
  constexpr float C = SCALE * 1.4426950408889634f;
  float pmax = p0[0];
#pragma unroll
  for (int r = 1; r < 16; ++r) pmax = fmaxf(pmax, p0[r]);
#pragma unroll
  for (int r = 0; r < 16; ++r) pmax = fmaxf(pmax, p1[r]);
  { auto rr = __builtin_amdgcn_permlane32_swap(__float_as_uint(pmax), __float_as_uint(pmax), false, false);
    pmax = fmaxf(__uint_as_float(rr[0]), __uint_as_float(rr[1])); }
  if (__builtin_expect(__all(pmax - m_reg <= THR / SCALE), 1)) { mn = m_reg; alpha = 1.f; }
  else { mn = fmaxf(m_reg, pmax); alpha = __builtin_amdgcn_exp2f((m_reg - mn) * C); m_reg = mn; }
  float mnC = -mn * C;
#pragma unroll
  for (int r = 0; r < 16; ++r) p0[r] = fmaf(p0[r], C, mnC);
#pragma unroll
  for (int r = 0; r < 16; ++r) p1[r] = fmaf(p1[r], C, mnC);
#pragma unroll
  for (int r = 0; r < 16; ++r) p0[r] = __builtin_amdgcn_exp2f(p0[r]);
}
__device__ __forceinline__ void finishSM(f32x16& p0, f32x16& p1, float alpha, float& l_reg, bf16x8& pa0, bf16x8& pa1, bf16x8& pa2, bf16x8& pa3) {
#pragma unroll
  for (int r = 0; r < 16; ++r) p1[r] = __builtin_amdgcn_exp2f(p1[r]);
  float ps = 0;
#pragma unroll
  for (int r = 0; r < 16; ++r) ps += p0[r];
#pragma unroll
  for (int r = 0; r < 16; ++r) ps += p1[r];
  { auto rr = __builtin_amdgcn_permlane32_swap(__float_as_uint(ps), __float_as_uint(ps), false, false);
    ps = __uint_as_float(rr[0]) + __uint_as_float(rr[1]); }
  l_reg = l_reg * alpha + ps;
#define PK4(P, BASE, OUT) do { unsigned a0 = cvtpk(P[BASE + 0], P[BASE + 1]), a1 = cvtpk(P[BASE + 2], P[BASE + 3]);   \
    unsigned b0 = cvtpk(P[BASE + 4], P[BASE + 5]), b1 = cvtpk(P[BASE + 6], P[BASE + 7]);                              \
    auto r0 = __builtin_amdgcn_permlane32_swap(a0, b0, false, false); auto r1 = __builtin_amdgcn_permlane32_swap(a1, b1, false, false); \
    v4u w = {r0[0], r1[0], r0[1], r1[1]}; OUT = *reinterpret_cast<bf16x8*>(&w); } while (0)
  PK4(p0, 0, pa0); PK4(p0, 8, pa1); PK4(p1, 0, pa2); PK4(p1, 8, pa3);
#undef PK4
}
__device__ __forceinline__ void qkt(f32x16& p0, f32x16& p1, const char* Ks, const char* Rs, const bf16x8* qr, const char* qrl, int r32, int hi) {
  p0 = f32x16{}; p1 = f32x16{};
#pragma unroll
  for (int d0 = 0; d0 < 8; ++d0) { const int cb = (d0 * 16 + hi * 8) * 2;
    bf16x8 b0 = *reinterpret_cast<const bf16x8*>(Ks + KSWZ(r32, cb));
    bf16x8 b1 = *reinterpret_cast<const bf16x8*>(Ks + KSWZ(32 + r32, cb));
    const bf16x8 qq = d0 < 4 ? qr[d0 & 3] : *reinterpret_cast<const bf16x8*>(qrl + (d0 - 4) * 1024);
    p0 = __builtin_amdgcn_mfma_f32_32x32x16_bf16(b0, qq, p0, 0, 0, 0);
    p1 = __builtin_amdgcn_mfma_f32_32x32x16_bf16(b1, qq, p1, 0, 0, 0); }
#pragma unroll
  for (int d0 = 0; d0 < 4; ++d0) { const int ch = d0 * 2 + hi;
    bf16x8 b0 = *reinterpret_cast<const bf16x8*>(Rs + RSWZ(r32, ch));
    bf16x8 b1 = *reinterpret_cast<const bf16x8*>(Rs + RSWZ(32 + r32, ch));
    const bf16x8 qq = *reinterpret_cast<const bf16x8*>(qrl + (4 + d0) * 1024);
    p0 = __builtin_amdgcn_mfma_f32_32x32x16_bf16(b0, qq, p0, 0, 0, 0);
    p1 = __builtin_amdgcn_mfma_f32_32x32x16_bf16(b1, qq, p1, 0, 0, 0); }
}
__device__ __forceinline__ int v_st(int k, int c) { const int kk = (k & ~0xC) | ((k & 4) << 1) | ((k & 8) >> 1); return ((kk >> 3) * 4 + (c >> 5)) * 512 + ((kk & 7) * 32 + (c & 31)) * 2; }
__device__ __forceinline__ int v_rd_base(int lane) { return ((lane & 3) << 3) | (((lane >> 2) & 3) << 6) | (((lane >> 4) & 1) << 5) | (((lane >> 5) & 1) << 8); }
constexpr int v_rd_off(int d0, int ks, int half) { return d0 * 512 + ks * 4096 + half * 2048; }
template <int OFF> __device__ __forceinline__ s16x4 tr_read(int vb) {
  s16x4 r; asm volatile("ds_read_b64_tr_b16 %0, %1 offset:%2" : "=&v"(r) : "v"(vb), "i"(OFF) : "memory"); return r;
}
template <int D0> __device__ __forceinline__ void pv_one(f32x16& od, int vb, bf16x8 pa0, bf16x8 pa1, bf16x8 pa2, bf16x8 pa3) {
  const s16x4 l0 = tr_read<v_rd_off(D0, 0, 0)>(vb), h0 = tr_read<v_rd_off(D0, 0, 1)>(vb), l1 = tr_read<v_rd_off(D0, 1, 0)>(vb), h1 = tr_read<v_rd_off(D0, 1, 1)>(vb);
  const s16x4 l2 = tr_read<v_rd_off(D0, 2, 0)>(vb), h2 = tr_read<v_rd_off(D0, 2, 1)>(vb), l3 = tr_read<v_rd_off(D0, 3, 0)>(vb), h3 = tr_read<v_rd_off(D0, 3, 1)>(vb);
  asm volatile("s_waitcnt lgkmcnt(0)" ::: "memory"); SBAR();
#define PK(L, H) (bf16x8){L[0], L[1], L[2], L[3], H[0], H[1], H[2], H[3]}
  od = __builtin_amdgcn_mfma_f32_32x32x16_bf16(pa0, PK(l0, h0), od, 0, 0, 0);
  od = __builtin_amdgcn_mfma_f32_32x32x16_bf16(pa1, PK(l1, h1), od, 0, 0, 0);
  od = __builtin_amdgcn_mfma_f32_32x32x16_bf16(pa2, PK(l2, h2), od, 0, 0, 0);
  od = __builtin_amdgcn_mfma_f32_32x32x16_bf16(pa3, PK(l3, h3), od, 0, 0, 0);
#undef PK
}
__device__ __forceinline__ void pv_d0(f32x16* o, int vb, bf16x8 pa0, bf16x8 pa1, bf16x8 pa2, bf16x8 pa3) {
  pv_one<0>(o[0], vb, pa0, pa1, pa2, pa3); pv_one<1>(o[1], vb, pa0, pa1, pa2, pa3); pv_one<2>(o[2], vb, pa0, pa1, pa2, pa3); pv_one<3>(o[3], vb, pa0, pa1, pa2, pa3);
}

constexpr int LDQ = NQ, LDK = 1024, LDR = 64;
__device__ __forceinline__ void attn_unit(const bf16* __restrict__ Qn, const bf16* __restrict__ Qr, const bf16* __restrict__ Kn, const bf16* __restrict__ Kr, const bf16* __restrict__ Vh,
                                          bf16* __restrict__ Ob, int seq, char* lds) {
  const int tid = opaque_tid(), wid = tid >> 6, lane = tid & 63, r32 = lane & 31, hi = lane >> 5;
  char* V_lds = lds + OFF_V; char* K_lds = lds + OFF_K; char* R_lds = lds + OFF_R;
  float* ws = (float*)(lds + OFF_WS) + wid * 64; float* li_l = ws; float* al_l = ws + 32;
  float m_reg = -1e30f, l_reg = 0; f32x16 o[4] = {}; bf16x8 qr[4];
  char* qrl = lds + OFF_QR + wid * 8192 + lane * 16;
  { const bf16* Qw = Qn + (long)(wid * QBLK + r32) * LDQ + hi * 8;
#pragma unroll
    for (int d0 = 0; d0 < 4; ++d0) qr[d0] = *reinterpret_cast<const bf16x8*>(Qw + d0 * 16);
#pragma unroll
    for (int d0 = 4; d0 < 8; ++d0) *reinterpret_cast<bf16x8*>(qrl + (d0 - 4) * 1024) = *reinterpret_cast<const bf16x8*>(Qw + d0 * 16);
    const bf16* Rw = Qr + (long)(wid * QBLK + r32) * LDQ + hi * 8;
#pragma unroll
    for (int d0 = 0; d0 < 4; ++d0) *reinterpret_cast<bf16x8*>(qrl + (4 + d0) * 1024) = *reinterpret_cast<const bf16x8*>(Rw + d0 * 16); }
  const int sr = tid >> 4, sc = (tid & 15) * 8, vst0 = v_st(sr, sc), vst1 = v_st(32 + sr, sc);
  const int rr_ = tid >> 3, rc_ = tid & 7;
  const int vb0 = (int)(uintptr_t)V_lds + v_rd_base(lane);
  struct { bf16x8 vs0, vs1, ks0, ks1, rs0; } sr_[SDEPTH];
#define SLOAD(i, k0) do { sr_[i].vs0 = *reinterpret_cast<const bf16x8*>(&Vh[(long)((k0) + sr) * LDK + sc]); sr_[i].vs1 = *reinterpret_cast<const bf16x8*>(&Vh[(long)((k0) + 32 + sr) * LDK + sc]); \
    sr_[i].ks0 = *reinterpret_cast<const bf16x8*>(&Kn[(long)((k0) + sr) * LDK + sc]); sr_[i].ks1 = *reinterpret_cast<const bf16x8*>(&Kn[(long)((k0) + 32 + sr) * LDK + sc]); \
    sr_[i].rs0 = *reinterpret_cast<const bf16x8*>(&Kr[(long)((k0) + rr_) * LDR + rc_ * 8]); } while (0)
#define SWRITE(b, i) do { *(bf16x8*)(V_lds + (b) * SHM_V + vst0) = sr_[i].vs0;          \
    *(bf16x8*)(V_lds + (b) * SHM_V + vst1) = sr_[i].vs1; int kc = sc * 2;               \
    *(bf16x8*)(K_lds + (b) * SHM_K + KSWZ(sr, kc)) = sr_[i].ks0;                       \
    *(bf16x8*)(K_lds + (b) * SHM_K + KSWZ(32 + sr, kc)) = sr_[i].ks1;                  \
    *(bf16x8*)(R_lds + (b) * SHM_R + RSWZ(rr_, rc_)) = sr_[i].rs0; } while (0)
#define SWAIT() do { if constexpr (SDEPTH == 2) asm volatile("s_waitcnt vmcnt(5)" ::: "memory"); else asm volatile("s_waitcnt vmcnt(0)" ::: "memory"); } while (0)
#define RESC(a) do { if (__any((a) < 1.f)) { if (hi == 0) al_l[r32] = (a); asm volatile("s_waitcnt lgkmcnt(0)" ::: "memory"); \
    _Pragma("unroll") for (int d = 0; d < 4; ++d) _Pragma("unroll") for (int r = 0; r < 16; ++r) o[d][r] *= al_l[crow(r, hi)]; } } while (0)
  f32x16 pA0, pA1, pB0, pB1; float mnA, mnB, alA, alB; bf16x8 pa0, pa1, pa2, pa3; const int NT = seq / KVBLK;
  constexpr int SE = 0, SO = SDEPTH - 1;
  SLOAD(SE, 0); asm volatile("s_waitcnt vmcnt(0)" ::: "memory"); SWRITE(0, SE); __syncthreads();
  qkt(pA0, pA1, K_lds, R_lds, qr, qrl, r32, hi); partialSM(pA0, pA1, m_reg, mnA, alA);
  SLOAD(SO, KVBLK); if constexpr (SDEPTH == 2) { if (2 < NT) SLOAD(SE, 2 * KVBLK); }
  SWAIT(); SWRITE(1, SO); __syncthreads();
  for (int j = 1; j + 1 < NT; j += 2) {
    SBAR(); qkt(pB0, pB1, K_lds + SHM_K, R_lds + SHM_R, qr, qrl, r32, hi);
    finishSM(pA0, pA1, alA, l_reg, pa0, pa1, pa2, pa3); SBAR();
    SLOAD(SO, (j + SDEPTH) * KVBLK); SBAR();
    pv_d0(o, vb0, pa0, pa1, pa2, pa3); partialSM(pB0, pB1, m_reg, mnB, alB);
    __syncthreads(); SWAIT(); SWRITE(0, SE);
    RESC(alB); __syncthreads();
    SBAR(); qkt(pA0, pA1, K_lds, R_lds, qr, qrl, r32, hi);
    finishSM(pB0, pB1, alB, l_reg, pa0, pa1, pa2, pa3); SBAR();
    if (SDEPTH == 1 || j + 3 < NT) SLOAD(SE, (j + 1 + SDEPTH) * KVBLK); SBAR();
    pv_d0(o, vb0 + SHM_V, pa0, pa1, pa2, pa3); partialSM(pA0, pA1, m_reg, mnA, alA);
    __syncthreads(); SWAIT(); SWRITE(1, SO);
    RESC(alA); __syncthreads();
  }
  SBAR(); qkt(pB0, pB1, K_lds + SHM_K, R_lds + SHM_R, qr, qrl, r32, hi);
  finishSM(pA0, pA1, alA, l_reg, pa0, pa1, pa2, pa3); SBAR();
  pv_d0(o, vb0, pa0, pa1, pa2, pa3); partialSM(pB0, pB1, m_reg, mnB, alB);
  __syncthreads(); RESC(alB);
  finishSM(pB0, pB1, alB, l_reg, pa0, pa1, pa2, pa3); SBAR();
  pv_d0(o, vb0 + SHM_V, pa0, pa1, pa2, pa3);
  if (hi == 0) li_l[r32] = l_reg; asm volatile("s_waitcnt lgkmcnt(0)" ::: "memory");
  float rli[16];
#pragma unroll
  for (int r = 0; r < 16; ++r) rli[r] = __builtin_amdgcn_rcpf(li_l[crow(r, hi)]);
  bf16* Ow = Ob + (long)(wid * QBLK) * LDK;
#pragma unroll
  for (int r = 0; r < 16; ++r) { const int orow = crow(r, hi);
#pragma unroll
    for (int d0 = 0; d0 < 4; ++d0) Ow[(long)orow * LDK + d0 * 32 + r32] = (bf16)(cvtpk(o[d0][r] * rli[r], 0.f) & 0xffffu); }
  __syncthreads();
#undef SLOAD
#undef SWRITE
#undef SWAIT
#undef RESC
}
#undef KSWZ
#undef RSWZ
}

namespace ml {
constexpr int PITCH = 288, TILE = 64 * PITCH;
constexpr int OFF_Q = 0, OFF_K = 2 * TILE, OFF_V = 4 * TILE;
constexpr int PPITCH = 144, OFF_P = 6 * TILE;
constexpr int OFF_SC = OFF_P + 64 * PPITCH;
constexpr int OFF_RSP = OFF_SC + 8 * 5 * 256;
constexpr int OFF_QN = OFF_RSP + 1024;
constexpr int OFF_NBF = OFF_QN + 256;
constexpr int LDS_END = OFF_NBF + 512;
static_assert(LDS_END <= MISC_OFF, "mLSTM LDS map");
__device__ __forceinline__ int rho(int t) { return (t & ~12) | ((t & 4) << 1) | ((t & 8) >> 1); }
typedef short v4i16_t __attribute__((ext_vector_type(4)));
__device__ __forceinline__ bf16x8 trfrag(LAS const unsigned char* tile, int tbase, int c0, int lane) {
    const int g = lane >> 4, li = lane & 15;
#if ML_FAST_TR
    const int q = li >> 2, p = li & 3;
    const s16x4 lo = __builtin_bit_cast(s16x4, __builtin_amdgcn_ds_read_tr16_b64_v4i16((LAS v4i16_t*)(tile + rho(tbase + 8 * g + q) * PITCH + (c0 + 4 * p) * 2)));
    const s16x4 hi = __builtin_bit_cast(s16x4, __builtin_amdgcn_ds_read_tr16_b64_v4i16((LAS v4i16_t*)(tile + rho(tbase + 8 * g + 4 + q) * PITCH + (c0 + 4 * p) * 2)));
    return (bf16x8){lo[0], lo[1], lo[2], lo[3], hi[0], hi[1], hi[2], hi[3]};
#else
    bf16x8 r;
#pragma unroll
    for (int i = 0; i < 8; ++i) r[i] = *(LAS const short*)(tile + rho(tbase + 8 * g + i) * PITCH + (c0 + li) * 2);
    return r;
#endif
}
__device__ __forceinline__ float logsigmoid(float x) { return fminf(x, 0.f) - log1pf(expf(-fabsf(x))); }

__device__ __forceinline__ void mlstm_item(LAS unsigned char* lds, const bf16* __restrict__ QM, const bf16* __restrict__ KM, const bf16* __restrict__ VM, const float* __restrict__ GATES,
                                           bf16* __restrict__ H, int row0, int S, int dir, int h) {
    const int tid = opaque_tid(), lane = tid & 63, w = __builtin_amdgcn_readfirstlane(tid >> 6), g = lane >> 4, li = lane & 15;
    const int NC = S / 64, hc = h * 128;
    const int srow = tid >> 3, scol = (tid & 7) * 16;
    LAS float* sc = (LAS float*)(lds + OFF_SC) + w * 320;
    LAS float* RSP = (LAS float*)(lds + OFF_RSP); LAS float* QNl = (LAS float*)(lds + OFF_QN);
    f32x4 X[8]; f32x4 nst = {0.f, 0.f, 0.f, 0.f};
#pragma unroll
    for (int d = 0; d < 8; ++d) X[d] = (f32x4){0.f, 0.f, 0.f, 0.f};
    float m_prev = 0.f;
    v4u stq[2], stk[2], stv[2];
#define ML_ROW(c, t) (dir ? (row0 + S - 1 - (64 * (c) + (t))) : (row0 + 64 * (c) + (t)))
#define ML_LOAD(c) do { const size_t go = (size_t)ML_ROW(c, srow) * 1024 + hc + scol; \
        stq[0] = *(const v4u*)(QM + go); stq[1] = *(const v4u*)(QM + go + 8); stk[0] = *(const v4u*)(KM + go); stk[1] = *(const v4u*)(KM + go + 8); \
        stv[0] = *(const v4u*)(VM + go); stv[1] = *(const v4u*)(VM + go + 8); } while (0)
#define ML_WRITE(b) do { const int lo_ = rho(srow) * PITCH + scol * 2; \
        *(LAS v4u*)(lds + OFF_Q + (b) * TILE + lo_) = stq[0]; *(LAS v4u*)(lds + OFF_Q + (b) * TILE + lo_ + 16) = stq[1]; \
        *(LAS v4u*)(lds + OFF_K + (b) * TILE + lo_) = stk[0]; *(LAS v4u*)(lds + OFF_K + (b) * TILE + lo_ + 16) = stk[1]; \
        *(LAS v4u*)(lds + OFF_V + (b) * TILE + lo_) = stv[0]; *(LAS v4u*)(lds + OFF_V + (b) * TILE + lo_ + 16) = stv[1]; } while (0)
    ML_LOAD(0); ML_WRITE(0);
    if (tid < 64) ((LAS unsigned*)(lds + OFF_NBF))[tid] = 0u;
    for (int c = 0; c < NC; ++c) {
        const int b = c & 1;
        LAS const unsigned char* Qt = lds + OFF_Q + b * TILE; LAS const unsigned char* Kt = lds + OFF_K + b * TILE; LAS const unsigned char* Vt = lds + OFF_V + b * TILE;
        if (c + 1 < NC) ML_LOAD(c + 1);
        float a_old, a_new;
        {
            const float* gp = GATES + (size_t)ML_ROW(c, lane) * 32;
            const float li_ = gp[dir * 8 + h], lf = logsigmoid(gp[16 + dir * 8 + h]);
            float bsum = lf;
#pragma unroll
            for (int o = 1; o < 64; o <<= 1) { const float v = __shfl_up(bsum, o); if (lane >= o) bsum += v; }
            const float gch = __shfl(bsum, 63);
            const float uu = li_ - bsum; float pm = uu;
#pragma unroll
            for (int o = 1; o < 64; o <<= 1) { const float v = __shfl_up(pm, o); if (lane >= o) pm = fmaxf(pm, v); }
            const float umax = __shfl(pm, 63);
            const float m_loc = gch + umax, m_new = fmaxf(gch + m_prev, m_loc);
            a_old = expf(gch + m_prev - m_new); a_new = expf(m_loc - m_new);
            const float Mj = fmaxf(m_prev, pm);
            sc[lane] = uu; sc[64 + lane] = Mj; sc[128 + lane] = expf(uu - umax); sc[192 + lane] = expf(m_prev - Mj); sc[256 + lane] = expf(-(bsum + Mj));
            m_prev = m_new;
        }
        __syncthreads();
#pragma unroll
        for (int tt = 0; tt < 2; ++tt) {
            const int tile = w * 2 + tt, lb = tile & 3, jb = tile >> 2;
            const int j = 16 * jb + li, l0 = 16 * lb + 4 * g;
            LAS unsigned char* pp = lds + OFF_P + j * PPITCH + l0 * 2;
            if (lb > jb) { *(LAS u32x2*)pp = (u32x2){0u, 0u}; if (g == 0) RSP[j * 4 + lb] = 0.f; }
            else {
                f32x4 s = {0.f, 0.f, 0.f, 0.f};
#pragma unroll
                for (int ks = 0; ks < 4; ++ks) {
                    const bf16x8 a = *(LAS const bf16x8*)(Kt + rho(16 * lb + li) * PITCH + (32 * ks + 8 * g) * 2);
                    const bf16x8 bq = *(LAS const bf16x8*)(Qt + rho(16 * jb + li) * PITCH + (32 * ks + 8 * g) * 2);
                    s = __builtin_amdgcn_mfma_f32_16x16x32_bf16(a, bq, s, 0, 0, 0);
                }
                const f32x4 u4 = *(LAS const f32x4*)(sc + l0); const float Mj = sc[64 + j];
                float p[4]; float rs = 0.f;
#pragma unroll
                for (int r = 0; r < 4; ++r) { p[r] = (l0 + r <= j) ? s[r] * __expf(u4[r] - Mj) : 0.f; rs += p[r]; }
                *(LAS u32x2*)pp = (u32x2){cvtpk(p[0], p[1]), cvtpk(p[2], p[3])};
                rs += __shfl_xor(rs, 16); rs += __shfl_xor(rs, 32);
                if (g == 0) RSP[j * 4 + lb] = rs;
            }
        }
        if (w < 4) {
            f32x4 s = {0.f, 0.f, 0.f, 0.f};
            LAS const unsigned char* nb = lds + OFF_NBF + b * 256;
#pragma unroll
            for (int ks = 0; ks < 4; ++ks) {
                bf16x8 a = *(LAS const bf16x8*)(nb + (32 * ks + 8 * g) * 2);
                if (li != 0) a = (bf16x8){0, 0, 0, 0, 0, 0, 0, 0};
                const bf16x8 bq = *(LAS const bf16x8*)(Qt + rho(16 * w + li) * PITCH + (32 * ks + 8 * g) * 2);
                s = __builtin_amdgcn_mfma_f32_16x16x32_bf16(a, bq, s, 0, 0, 0);
            }
            if (g == 0) QNl[16 * w + li] = s[0];
        }
        f32x4 Y[4];
        {
            bf16x8 ca[4];
#pragma unroll
            for (int ks = 0; ks < 4; ++ks) { v4u t; t.x = cvtpk(X[2 * ks][0], X[2 * ks][1]); t.y = cvtpk(X[2 * ks][2], X[2 * ks][3]); t.z = cvtpk(X[2 * ks + 1][0], X[2 * ks + 1][1]); t.w = cvtpk(X[2 * ks + 1][2], X[2 * ks + 1][3]);
                ca[ks] = __builtin_bit_cast(bf16x8, t); }
#pragma unroll
            for (int tb = 0; tb < 4; ++tb) {
                f32x4 y = {0.f, 0.f, 0.f, 0.f};
                LAS const unsigned char* qrow = Qt + rho(16 * tb + li) * PITCH;
#pragma unroll
                for (int ks = 0; ks < 4; ++ks) {
                    const u32x2 q0 = *(LAS const u32x2*)(qrow + (32 * ks + 4 * g) * 2), q1 = *(LAS const u32x2*)(qrow + (32 * ks + 16 + 4 * g) * 2);
                    const v4u qq = {q0.x, q0.y, q1.x, q1.y};
                    y = __builtin_amdgcn_mfma_f32_16x16x32_bf16(ca[ks], __builtin_bit_cast(bf16x8, qq), y, 0, 0, 0);
                }
                Y[tb] = y;
            }
        }
        __syncthreads();
        bf16x8 vf[2];
        vf[0] = trfrag(Vt, 0, 16 * w, lane); vf[1] = trfrag(Vt, 32, 16 * w, lane);
#pragma unroll
        for (int tb = 0; tb < 4; ++tb) {
            const int t = 16 * tb + li; const float wi = sc[192 + t];
            f32x4 y = Y[tb] * wi;
#pragma unroll
            for (int ks = 0; ks < 2; ++ks) {
                const bf16x8 pb = *(LAS const bf16x8*)(lds + OFF_P + t * PPITCH + (32 * ks + 8 * g) * 2);
                y = __builtin_amdgcn_mfma_f32_16x16x32_bf16(vf[ks], pb, y, 0, 0, 0);
            }
            const f32x4 rp = *(LAS const f32x4*)(RSP + t * 4);
            const float den = (rp[0] + rp[1]) + (rp[2] + rp[3]) + wi * QNl[t];
            const float inv = 1.0f / fmaxf(fabsf(den), sc[256 + t]);
            const u32x2 o = {cvtpk(y[0] * inv, y[1] * inv), cvtpk(y[2] * inv, y[3] * inv)};
            *(u32x2*)(H + (size_t)ML_ROW(c, t) * 1024 + hc + 16 * w + 4 * g) = o;
        }
        {
            bf16x8 vw[2]; bf16x8 wb[2];
#pragma unroll
            for (int ks = 0; ks < 2; ++ks) {
                const f32x4 w0 = *(LAS const f32x4*)(sc + 128 + 32 * ks + 8 * g), w1 = *(LAS const f32x4*)(sc + 128 + 32 * ks + 8 * g + 4);
                float wv[8] = {w0[0] * a_new, w0[1] * a_new, w0[2] * a_new, w0[3] * a_new, w1[0] * a_new, w1[1] * a_new, w1[2] * a_new, w1[3] * a_new};
                const v4u vraw = __builtin_bit_cast(v4u, vf[ks]); v4u t, tw;
#pragma unroll
                for (int e = 0; e < 4; ++e) { t[e] = cvtpk(bflo(vraw[e]) * wv[2 * e], bfhi(vraw[e]) * wv[2 * e + 1]); tw[e] = (li == 0) ? cvtpk(wv[2 * e], wv[2 * e + 1]) : 0u; }
                vw[ks] = __builtin_bit_cast(bf16x8, t); wb[ks] = __builtin_bit_cast(bf16x8, tw);
            }
            nst = nst * a_old;
#pragma unroll
            for (int d = 0; d < 8; ++d) {
                f32x4 x = X[d] * a_old;
#pragma unroll
                for (int ks = 0; ks < 2; ++ks) {
                    const bf16x8 kf = trfrag(Kt, 32 * ks, 16 * d, lane);
                    x = __builtin_amdgcn_mfma_f32_16x16x32_bf16(kf, vw[ks], x, 0, 0, 0);
                    if (d == w) nst = __builtin_amdgcn_mfma_f32_16x16x32_bf16(kf, wb[ks], nst, 0, 0, 0);
                }
                X[d] = x;
            }
            if (li == 0) *(LAS u32x2*)(lds + OFF_NBF + (b ^ 1) * 256 + (16 * w + 4 * g) * 2) = (u32x2){cvtpk(nst[0], nst[1]), cvtpk(nst[2], nst[3])};
        }
        if (c + 1 < NC) ML_WRITE(b ^ 1);
    }
    __syncthreads();
#undef ML_ROW
#undef ML_LOAD
#undef ML_WRITE
}
}

constexpr int Q_ML_P = 4, Q_ML_S = 16, Q_AT_P = 128, Q_AT_S = 128, QLEN = Q_ML_P + Q_ML_S + Q_AT_P + Q_AT_S;
__device__ __forceinline__ void p_mixer(Frame& F, int layer, unsigned xcc) {
    unsigned char* ws = F.ws;
    int qsel = (int)(xcc & 7u), tried = 0;
    for (;;) {
        if (F.tid == 0) {
            int item = -1, qq = qsel, tr = tried;
            while (tr < 8) {
                const unsigned idx = __hip_atomic_fetch_add(F.ctl + CW_QUEUE + (layer * 8 + qq) * 64, 1u, __ATOMIC_RELAXED, __HIP_MEMORY_SCOPE_AGENT);
                if (idx < (unsigned)QLEN) { item = qq * 1024 + (int)idx; break; }
                qq = (qq + 1) & 7; ++tr;
            }
            F.MISC[0] = (unsigned)item; F.MISC[1] = (unsigned)qq; F.MISC[2] = (unsigned)tr;
        }
        __syncthreads();
        const int item = (int)F.MISC[0]; qsel = (int)F.MISC[1]; tried = (int)F.MISC[2];
        __syncthreads();
        if (item < 0) break;
        const int h = item >> 10, i = item & 1023;
#ifndef NO_ML
        if (i < Q_ML_P + Q_ML_S) {
            int row0, S, dir;
            if (i < Q_ML_P) { row0 = (i >> 1) * SEQ_P; S = SEQ_P; dir = i & 1; }
            else { const int k = i - Q_ML_P; row0 = MPROMPT + (k >> 1) * SEQ_S; S = SEQ_S; dir = k & 1; }
#if defined(DBG_NO_ML)
            { bf16* hb = (bf16*)(ws + (dir ? WS_HBW : WS_HFW)) + (size_t)row0 * 1024 + h * 128; const int t_ = threadIdx.x; for (int q_ = t_; q_ < S * 16; q_ += 512) *(v4u*)(hb + (size_t)(q_ >> 4) * 1024 + (q_ & 15) * 8) = (v4u){0u, 0u, 0u, 0u}; }
            if (0)
#endif
            ml::mlstm_item(F.lds, (const bf16*)(ws + WS_QM), (const bf16*)(ws + WS_KM), (const bf16*)(ws + WS_VM), (const float*)(ws + WS_GATES),
                           (bf16*)(ws + (dir ? WS_HBW : WS_HFW)), row0, S, dir, h);
        } else
#endif
#ifndef NO_ATT
        {
            int row0, S, qb;
            if (i < Q_ML_P + Q_ML_S + Q_AT_P) { const int k = i - (Q_ML_P + Q_ML_S); row0 = (k >> 6) * SEQ_P; S = SEQ_P; qb = k & 63; }
            else { const int k = i - (Q_ML_P + Q_ML_S + Q_AT_P); row0 = MPROMPT + (k >> 4) * SEQ_S; S = SEQ_S; qb = k & 15; }
            const size_t qrow = (size_t)(row0 + 256 * qb);
#if defined(DBG_NO_ATT)
            { bf16* ob = (bf16*)(ws + WS_CQKV) + qrow * 1024 + h * 128; const int t_ = threadIdx.x; for (int q_ = t_; q_ < 256 * 16; q_ += 512) *(v4u*)(ob + (size_t)(q_ >> 4) * 1024 + (q_ & 15) * 8) = (v4u){0u, 0u, 0u, 0u}; }
            if (0)
#endif
            att::attn_unit((const bf16*)(ws + WS_Q) + qrow * NQ + h * 128, (const bf16*)(ws + WS_Q) + qrow * NQ + 1024 + h * 64,
                           (const bf16*)(ws + WS_KN) + (size_t)row0 * 1024 + h * 128, (const bf16*)(ws + WS_KR) + (size_t)row0 * 64, (const bf16*)(ws + WS_V) + (size_t)row0 * 1024 + h * 128,
                           (bf16*)(ws + WS_CQKV) + qrow * 1024 + h * 128, S, (char*)F.lds);
        }
#else
        {}
#endif
    }
}

constexpr int NPH = 1 + DEPTH * 10 + 1;
__global__ void __launch_bounds__(NWAVES * 64, 2) trunk_fwd(Args args) {
    extern __shared__ __attribute__((aligned(16))) unsigned char lds[];
    Frame F;
    F.lds = (LAS unsigned char*)lds; F.MISC = (volatile LAS unsigned*)(F.lds + MISC_OFF);
    F.tid = threadIdx.x; F.lane = F.tid & 63; F.wave = __builtin_amdgcn_readfirstlane(F.tid >> 6);
    F.G = gridDim.x; { const int bx = blockIdx.x; F.vcu = (F.G % 8 == 0) ? (bx % 8) * (F.G / 8) + bx / 8 : bx; }
    F.ws = args.ws; F.ctl = (gu32*)(args.ws + WS_CTL); F.out = args.out;
    for (int u = F.tid; u < (LDS_BYTES - MISC_OFF) / 4; u += NWAVES * 64) ((LAS unsigned*)(F.lds + MISC_OFF))[u] = 0u;
    __syncthreads();
    XcdBarrier bar; bar.bar = (unsigned*)(F.ctl + CW_BAR); bar.x = xb_xcc_id(); bar.st = F.MISC + 8;
#if !MK_PER_PHASE
    bar = xcd_barrier_post((unsigned*)(F.ctl + CW_BAR), F.MISC + 8);
#endif
    const unsigned xcc = bar.x;
    const int lo = args.ph_lo, hi = args.ph_hi;
#define IN(k) (lo <= (k) && (k) < hi)
#ifdef ONLY
#define PH_ON(k) ((k) == ONLY)
#else
#define PH_ON(k) true
#endif
#if MK_PER_PHASE
#define SEAM(k) do { } while (0)
#else
#define SEAM(k) do { if (IN(k) && IN((k) + 1)) xcd_barrier(bar); } while (0)
#endif
    unsigned char* ws = args.ws;
    if (PH_ON(0) && IN(0)) { p_prologue(F, args); } SEAM(0);
    for (int layer = 0; layer < DEPTH; ++layer) {
        const int p0 = 1 + layer * 10;
        const unsigned char* wl = ws + WS_W + (size_t)layer * LW;
        if (PH_ON(1) && IN(p0 + 0)) { p_norm(F, args, layer); } SEAM(p0 + 0);
        if (PH_ON(2) && IN(p0 + 1)) {
            pg8::Gemm g{(const pg8::bf16_t*)(ws + WS_XN), (const pg8::bf16_t*)(wl + W_P1), MTOK, NP1, DM, DM}; pg8::StaticOrder S; S.init(MTOK, NP1, F.G, (int)blockIdx.x);
            EpiP1 E{ws, args.in[IN_B_GATES] + layer * 32};
            pg8::gemm_phase<EpiP1, pg8::StaticOrder, true, true>(F.lds, g, S, E);
        } SEAM(p0 + 1);
        if (PH_ON(3) && IN(p0 + 2)) {
            { pg8::Gemm g{(const pg8::bf16_t*)(ws + WS_CQKV), (const pg8::bf16_t*)(wl + W_UQ), MTOK, NQ, 512, 1024}; pg8::StaticOrder S; S.init(MTOK, NQ, F.G, (int)blockIdx.x);
              EpiQ E{ws}; pg8::gemm_phase<EpiQ, pg8::StaticOrder, true, true>(F.lds, g, S, E); }
            { pg8::Gemm g{(const pg8::bf16_t*)(ws + WS_CQKV) + 512, (const pg8::bf16_t*)(wl + W_UKV), MTOK, NKV, 512, 1024}; pg8::StaticOrder S; S.init(MTOK, NKV, F.G, (int)blockIdx.x);
              EpiKV E{ws}; pg8::gemm_phase<EpiKV, pg8::StaticOrder, true, true>(F.lds, g, S, E); }
        } SEAM(p0 + 2);
        if (PH_ON(4) && IN(p0 + 3)) { p_mixer(F, layer, xcc); } SEAM(p0 + 3);
        if (PH_ON(5) && IN(p0 + 4)) {
            pg8::Gemm g{(const pg8::bf16_t*)(ws + WS_XN), (const pg8::bf16_t*)(wl + W_P2), MTOK, NP2, DM, DM}; pg8::StaticOrder S; S.init(MTOK, NP2, F.G, (int)blockIdx.x);
            EpiP2 E{ws}; pg8::gemm_phase<EpiP2, pg8::StaticOrder, true, true>(F.lds, g, S, E);
        } SEAM(p0 + 4);
        if (PH_ON(6) && IN(p0 + 5)) { p_comb(F, args, layer); } SEAM(p0 + 5);
        if (PH_ON(7) && IN(p0 + 6)) {
            pg8::Gemm g{(const pg8::bf16_t*)(ws + WS_CQKV), (const pg8::bf16_t*)(wl + W_OA), MTOK, DM, 1024, 1024}; pg8::StaticOrder S; S.init(MTOK, DM, F.G, (int)blockIdx.x);
            EpiMerge<0> E{ws}; pg8::gemm_phase<EpiMerge<0>, pg8::StaticOrder, true, true>(F.lds, g, S, E);
        }
        if (PH_ON(8) && IN(p0 + 7)) {
            pg8::Gemm g{(const pg8::bf16_t*)(ws + WS_HFW), (const pg8::bf16_t*)(wl + W_OB), MTOK, DM, 1024, 1024}; pg8::StaticOrder S; S.init(MTOK, DM, F.G, (int)blockIdx.x);
            EpiMerge<1> E{ws}; pg8::gemm_phase<EpiMerge<1>, pg8::StaticOrder, true, true>(F.lds, g, S, E);
        } SEAM(p0 + 7);
        if (PH_ON(9) && IN(p0 + 8)) {
            pg8::Gemm g{(const pg8::bf16_t*)(ws + WS_XN), (const pg8::bf16_t*)(wl + W_OUT), MTOK, DM, DM, DM}; pg8::StaticOrder S; S.init(MTOK, DM, F.G, (int)blockIdx.x);
            EpiOut E{args.in[IN_XP], args.in[IN_XS], F.out, layer}; pg8::gemm_phase<EpiOut, pg8::StaticOrder, true, true>(F.lds, g, S, E);
        } SEAM(p0 + 8);
    }
    if (PH_ON(10) && IN(NPH - 1)) { p_final(F, args); }
#undef IN
#undef SEAM
}

extern "C" void kernel_launch(void* const* d_in, const int* in_sizes, int n_in, void* d_out, int out_size, void* d_ws, size_t ws_size, hipStream_t stream) {
    static int grid = 0;
    if (grid == 0) {
        if (n_in != 14 || in_sizes[0] != MPROMPT * DM || in_sizes[1] != MPROMPT * DM || out_size != MTOK * DM || ws_size < WS_END) {
            fprintf(stderr, "kernel_launch: shape mismatch (n_in %d, in0 %d, out %d, ws %zu, need %zu); nothing launched\n", n_in, n_in > 0 ? in_sizes[0] : -1, out_size, ws_size, (size_t)WS_END); grid = -1; return; }
        int dev = 0, cus = 0, per_cu = 0;
        if (hipGetDevice(&dev) != hipSuccess || hipDeviceGetAttribute(&cus, hipDeviceAttributeMultiprocessorCount, dev) != hipSuccess) { grid = -1; return; }
        if (hipFuncSetAttribute((const void*)trunk_fwd, hipFuncAttributeMaxDynamicSharedMemorySize, LDS_BYTES) != hipSuccess) { fprintf(stderr, "kernel_launch: hipFuncSetAttribute failed\n"); grid = -1; return; }
        if (hipOccupancyMaxActiveBlocksPerMultiprocessor(&per_cu, (const void*)trunk_fwd, NWAVES * 64, LDS_BYTES) != hipSuccess || per_cu < 1)
            fprintf(stderr, "kernel_launch: note: occupancy query reports %d workgroups per CU\n", per_cu);
        (void)hipGetLastError();
        grid = cus;
    }
    if (grid < 0) return;
    if (hipMemsetAsync((char*)d_ws + WS_CTL, 0, CTL_ZERO_BYTES, stream) != hipSuccess) return;
    Args a{};
    for (int i = 0; i < 14; ++i) a.in[i] = (const float*)d_in[i];
    a.out = (float*)d_out; a.ws = (unsigned char*)d_ws;
#if MK_PER_PHASE
    for (int p = 0; p < NPH; ++p) {
        if (p >= 1 && p < NPH - 1 && ((p - 1) % 10) == 9) continue;
        if (p >= 1 && p < NPH - 1 && ((p - 1) % 10) == 7) continue;
        a.ph_lo = p; a.ph_hi = (p >= 1 && p < NPH - 1 && ((p - 1) % 10) == 6) ? p + 2 : p + 1;
        hipLaunchKernelGGL(trunk_fwd, dim3(grid), dim3(NWAVES * 64), LDS_BYTES, stream, a);
    }
#else
    a.ph_lo = 0; a.ph_hi = NPH;
    hipLaunchKernelGGL(trunk_fwd, dim3(grid), dim3(NWAVES * 64), LDS_BYTES, stream, a);
#endif
    const hipError_t le = hipPeekAtLastError();
    if (le != hipSuccess) fprintf(stderr, "kernel_launch: launch failed: %s\n", hipGetErrorName(le));
}
```

```cpp
#include <hip/hip_runtime.h>
#include <hip/hip_bf16.h>
#include <cstdio>
#include <cstdint>

#ifndef MK_PER_PHASE
#define MK_PER_PHASE 0
#endif
#ifndef ML_FAST_TR
#define ML_FAST_TR 1
#endif

namespace pg8 {
#define PG8_LAS __attribute__((address_space(3)))
typedef unsigned short bf16_t;
typedef short bf16x8 __attribute__((ext_vector_type(8)));
typedef float f32x4 __attribute__((ext_vector_type(4)));
typedef unsigned u32x4 __attribute__((ext_vector_type(4)));
constexpr int BM = 256, BK = 64, HALF = 128, HTB = HALF * BK * 2  , STAGE_BYTES = 8 * HTB, NXCD = 8, WGM = 8;

__host__ __device__ __forceinline__ int lds_byte(int r, int c) { const int st = (r >> 4) * 2 + (c >> 5), rr = r & 15, cc = c & 31, ob = rr * 64 + cc * 2; return st * 1024 + (ob ^ (((ob >> 9) & 1) << 5)); }
__host__ __device__ __forceinline__ void stage_rc(int b, int& R, int& C) { const int st = b / 1024, sb = b % 1024, swz = sb ^ (((sb >> 9) & 1) << 5); R = (st >> 1) * 16 + swz / 64; C = (st & 1) * 32 + (swz % 64) / 2; }
__host__ __device__ __forceinline__ int perm32(int rho) { const int n = rho >> 4, i = rho & 15; return 8 * (i >> 2) + 4 * n + (i & 3); }

__device__ __forceinline__ int fresh_tid() { int l; asm volatile("v_mbcnt_lo_u32_b32 %0, -1, 0\n\tv_mbcnt_hi_u32_b32 %0, -1, %0" : "=v"(l)); return (__builtin_amdgcn_readfirstlane((int)threadIdx.x >> 6) << 6) | l; }
struct Unit { int pm, pn; };
struct Gemm { const bf16_t* A; const bf16_t* Bt; int M, N, K, lda, ldb; int scA, scB; };
typedef int pg8_v4i __attribute__((ext_vector_type(4)));
typedef int pg8_v8i __attribute__((ext_vector_type(8)));
__device__ __forceinline__ pg8_v8i ld_frag8(const PG8_LAS unsigned char* p) {
    const bf16x8 lo = *(const PG8_LAS bf16x8*)p, hi = *(const PG8_LAS bf16x8*)(p + 16);
    return __builtin_bit_cast(pg8_v8i, __builtin_shufflevector(lo, hi, 0, 1, 2, 3, 4, 5, 6, 7, 8, 9, 10, 11, 12, 13, 14, 15)); }

struct StaticOrder {
    int nM, nN, nwg, G, c, wgm;
    __host__ __device__ void init(int M, int N, int G_, int c_) { nM = M / BM; nN = N / BM; nwg = nM * nN; G = G_; c = c_; wgm = WGM; }
    __host__ __device__ bool next(int i, Unit& u) const {
        const long L = (long)i * G + c; if (L >= nwg) return false;
        int wgid = (int)L; { const int q = nwg / NXCD, r = nwg % NXCD, xcd = wgid % NXCD, off = wgid / NXCD; wgid = (xcd < r ? xcd * (q + 1) : r * (q + 1) + (xcd - r) * q) + off; }
        const int nig = wgm * nN, gid = wgid / nig, fm = gid * wgm, gsz = (nM - fm) < wgm ? (nM - fm) : wgm;
        u.pm = fm + ((wgid % nig) % gsz); u.pn = (wgid % nig) / gsz; return true;
    }
    __device__ __forceinline__ void a_ready(const Unit&) const {}
    __device__ __forceinline__ void done(const Unit&) const {}
};

typedef float cvt_f32x2 __attribute__((ext_vector_type(2))); typedef __bf16 cvt_bf16x2 __attribute__((ext_vector_type(2)));
__device__ __forceinline__ unsigned cvt_pk_bf16(float lo, float hi) { return __builtin_bit_cast(unsigned, __builtin_convertvector((cvt_f32x2){lo, hi}, cvt_bf16x2)); }
typedef float f32x2 __attribute__((ext_vector_type(2)));
template <class Epi, class Sched, bool ALIGN_EPI = false, bool SP2 = false, bool FP8 = false, int SCA = 0x7F7F7F7F, int SCB = 0x7F7F7F7F>
__device__ __forceinline__ void gemm_phase(PG8_LAS unsigned char* lds, const Gemm g, const Sched& S, const Epi& E) {
    const int tid = fresh_tid();
    const int wid = __builtin_amdgcn_readfirstlane(tid >> 6), lane = tid & 63, wr = wid >> 2, wc = wid & 3, fr = lane & 15, fq = lane >> 4;
    const int K = g.K, nt = K / BK;
    unsigned voffA[2], voffB[2];
    { int R, C; stage_rc(tid * 16, R, C); const int Rb = Epi::PERM == 2 ? (64 * (R >> 5) + 16 * ((R & 15) >> 2) + 4 * ((R >> 4) & 1) + (R & 3)) : Epi::PERM ? ((R & ~31) + perm32(R & 31)) : R;
        voffA[0] = (unsigned)(R * g.lda + C) * 2u; voffB[0] = (unsigned)(Rb * g.ldb + C) * 2u; voffA[1] = voffA[0] + (unsigned)(64 * g.lda) * 2u; voffB[1] = voffB[0] + (unsigned)((Epi::PERM == 2 ? 128 : 64) * g.ldb) * 2u; }
    const size_t kstep = (size_t)(BK * 2);
    const size_t hstepA = (size_t)HALF * g.lda * 2, hstepB = (size_t)(Epi::PERM == 2 ? 8 : HALF) * g.ldb * 2;
    const size_t tstepA = 2 * hstepA, tstepB = (size_t)BM * g.ldb * 2;
    const unsigned ldsw = (unsigned)wid * 1024u;
    const int aoff = lds_byte(wr * 64 + fr, FP8 ? fq * 16 : fq * 8), boff = lds_byte(wc * 32 + fr, FP8 ? fq * 16 : fq * 8);
#define PG8_SA(b, h) (((b) * 2 + (h)) * HTB)
#define PG8_SB(b, h) ((4 + (b) * 2 + (h)) * HTB)
#define PG8_STAGE(bufoff, gbase, voff) do { _Pragma("unroll") for (int _i = 0; _i < 2; ++_i) \
        __builtin_amdgcn_global_load_lds((const unsigned*)((const char*)(gbase) + (voff)[_i]), (PG8_LAS unsigned*)(lds + (bufoff) + ldsw + _i * 8192), 16, 0, 0); } while (0)
#define PG8_LDA(dst, b, h) do { if constexpr (FP8) { _Pragma("unroll") for (int m = 0; m < 4; ++m) dst##8[m] = ld_frag8(lds + PG8_SA(b, h) + aoff + m * 2048); } \
        else { _Pragma("unroll") for (int m = 0; m < 4; ++m) _Pragma("unroll") for (int k = 0; k < 2; ++k) dst[m][k] = *(const PG8_LAS bf16x8*)(lds + PG8_SA(b, h) + aoff + m * 2048 + k * 1024); } } while (0)
#define PG8_LDB(dst, b, h) do { if constexpr (FP8) { _Pragma("unroll") for (int n = 0; n < 2; ++n) dst##8[n] = ld_frag8(lds + PG8_SB(b, h) + boff + n * 2048); } \
        else { _Pragma("unroll") for (int n = 0; n < 2; ++n) _Pragma("unroll") for (int k = 0; k < 2; ++k) dst[n][k] = *(const PG8_LAS bf16x8*)(lds + PG8_SB(b, h) + boff + n * 2048 + k * 1024); } } while (0)
#define PG8_CAT8(x) __builtin_shufflevector(__builtin_bit_cast(pg8_v4i, (x)[0]), __builtin_bit_cast(pg8_v4i, (x)[1]), 0, 1, 2, 3, 4, 5, 6, 7)
#define PG8_MMA(ai, bj, At, Bt) do { __builtin_amdgcn_s_setprio(1); _Pragma("unroll") for (int m = 0; m < 4; ++m) _Pragma("unroll") for (int n = 0; n < 2; ++n) { \
        if constexpr (FP8) asm volatile("v_mfma_f32_16x16x128_f8f6f4 %0, %1, %2, %0" : "+v"(acc[ai][bj][m][n]) : "v"(Bt##8[n]), "v"(At##8[m]));     \
        else { _Pragma("unroll") for (int k = 0; k < 2; ++k) acc[ai][bj][m][n] = __builtin_amdgcn_mfma_f32_16x16x32_bf16(Bt[n][k], At[m][k], acc[ai][bj][m][n], 0, 0, 0); } } __builtin_amdgcn_s_setprio(0); } while (0)
#define PG8_WAIT_V(n) asm volatile("s_waitcnt vmcnt(" #n ")" ::: "memory")
#define PG8_WAIT_L(n) asm volatile("s_waitcnt lgkmcnt(" #n ")" ::: "memory")
#define PG8_BAR __builtin_amdgcn_s_barrier()
#define PG8_SCHED __builtin_amdgcn_sched_barrier(0)
    Unit cur, nxt; int ui = 0;
    if (!S.next(0, cur)) return;
    f32x4 acc[2][2][4][2];
#pragma unroll
    for (int a = 0; a < 2; ++a)
#pragma unroll
        for (int b = 0; b < 2; ++b)
#pragma unroll
            for (int m = 0; m < 4; ++m)
#pragma unroll
                for (int n = 0; n < 2; ++n) acc[a][b][m][n] = (f32x4){0.f, 0.f, 0.f, 0.f};
    bf16x8 At[4][2], B0[2][2], B1[2][2]; pg8_v8i At8[4], B08[2], B18[2];
    const char* cA = (const char*)g.A + (size_t)cur.pm * tstepA; const char* cB = (const char*)g.Bt + (size_t)cur.pn * tstepB;
    S.a_ready(cur);
    if constexpr (SP2) {
        PG8_STAGE(PG8_SB(0, 0), cB, voffB); PG8_STAGE(PG8_SB(0, 1), cB + hstepB, voffB); PG8_STAGE(PG8_SA(0, 0), cA, voffA); PG8_STAGE(PG8_SA(0, 1), cA + hstepA, voffA);
        if (wr == 1) PG8_BAR;
        PG8_WAIT_V(2); PG8_BAR;
        PG8_STAGE(PG8_SB(1, 0), cB + kstep, voffB); PG8_STAGE(PG8_SA(1, 0), cA + kstep, voffA); PG8_STAGE(PG8_SB(1, 1), cB + hstepB + kstep, voffB);
        PG8_WAIT_V(6); PG8_BAR;
    } else {
        PG8_STAGE(PG8_SB(0, 0), cB, voffB); PG8_STAGE(PG8_SA(0, 0), cA, voffA); PG8_STAGE(PG8_SB(0, 1), cB + hstepB, voffB); PG8_STAGE(PG8_SA(0, 1), cA + hstepA, voffA);
        if (wr == 1) PG8_BAR;
        PG8_WAIT_V(4); PG8_BAR;
        PG8_STAGE(PG8_SB(1, 0), cB + kstep, voffB); PG8_STAGE(PG8_SA(1, 0), cA + kstep, voffA); PG8_STAGE(PG8_SB(1, 1), cB + hstepB + kstep, voffB);
        PG8_WAIT_V(6); PG8_BAR;
    }
    for (;;) {
        const bool has_next = S.next(ui + 1, nxt);
        const char* nA = has_next ? (const char*)g.A + (size_t)nxt.pm * tstepA : cA; const char* nB = has_next ? (const char*)g.Bt + (size_t)nxt.pn * tstepB : cB;
        _Pragma("nounroll") for (int t = 0; t < nt; t += 2) {
            const bool last = (t == nt - 2);
            const char* a1 = cA + (size_t)(t + 1) * kstep;
            const char* a2 = last ? nA : cA + (size_t)(t + 2) * kstep; const char* b2 = last ? nB : cB + (size_t)(t + 2) * kstep;
            const char* a3 = a2 + kstep; const char* b3 = b2 + kstep;
            if (last && has_next) S.a_ready(nxt);
            if constexpr (SP2) {
            PG8_LDB(B0, 0, 0); PG8_LDB(B1, 0, 1); PG8_SCHED; PG8_LDA(At, 0, 0); PG8_STAGE(PG8_SA(1, 1), a1 + hstepA, voffA);
            PG8_WAIT_V(8); PG8_WAIT_L(0); PG8_BAR; PG8_MMA(0, 0, At, B0); PG8_MMA(0, 1, At, B1); PG8_BAR; PG8_SCHED;
            PG8_LDA(At, 0, 1); PG8_STAGE(PG8_SB(0, 0), b2, voffB); PG8_STAGE(PG8_SB(0, 1), b2 + hstepB, voffB); PG8_STAGE(PG8_SA(0, 0), a2, voffA);
            PG8_WAIT_V(8); PG8_WAIT_L(0); PG8_BAR; PG8_MMA(1, 0, At, B0); PG8_MMA(1, 1, At, B1); PG8_BAR; PG8_SCHED;
            PG8_LDB(B0, 1, 0); PG8_LDB(B1, 1, 1); PG8_SCHED; PG8_LDA(At, 1, 0); PG8_STAGE(PG8_SA(0, 1), a2 + hstepA, voffA);
            PG8_WAIT_V(8); PG8_WAIT_L(0); PG8_BAR; PG8_MMA(0, 0, At, B0); PG8_MMA(0, 1, At, B1); PG8_BAR; PG8_SCHED;
            PG8_LDA(At, 1, 1); PG8_STAGE(PG8_SB(1, 0), b3, voffB); PG8_STAGE(PG8_SB(1, 1), b3 + hstepB, voffB); PG8_STAGE(PG8_SA(1, 0), a3, voffA);
            PG8_WAIT_V(8); PG8_WAIT_L(0); PG8_BAR; PG8_MMA(1, 0, At, B0); PG8_MMA(1, 1, At, B1); PG8_BAR; PG8_SCHED;
            } else {
            PG8_LDB(B0, 0, 0); PG8_SCHED; PG8_LDA(At, 0, 0); PG8_STAGE(PG8_SA(1, 1), a1 + hstepA, voffA);
            PG8_WAIT_L(8); PG8_BAR; PG8_WAIT_L(0); PG8_MMA(0, 0, At, B0); PG8_BAR; PG8_SCHED;
            PG8_LDB(B1, 0, 1); PG8_STAGE(PG8_SB(0, 0), b2, voffB);
            PG8_BAR; PG8_WAIT_L(0); PG8_MMA(0, 1, At, B1); PG8_BAR;
            PG8_LDA(At, 0, 1); PG8_STAGE(PG8_SA(0, 0), a2, voffA);
            PG8_BAR; PG8_WAIT_L(0); PG8_MMA(1, 0, At, B0); PG8_BAR; PG8_SCHED;
            PG8_STAGE(PG8_SB(0, 1), b2 + hstepB, voffB);
            PG8_WAIT_V(6); PG8_BAR; PG8_MMA(1, 1, At, B1); PG8_BAR;
            PG8_LDB(B0, 1, 0); PG8_SCHED; PG8_LDA(At, 1, 0); PG8_STAGE(PG8_SA(0, 1), a2 + hstepA, voffA);
            PG8_WAIT_L(8); PG8_BAR; PG8_WAIT_L(0); PG8_MMA(0, 0, At, B0); PG8_BAR; PG8_SCHED;
            PG8_LDB(B1, 1, 1); PG8_STAGE(PG8_SB(1, 0), b3, voffB);
            PG8_BAR; PG8_WAIT_L(0); PG8_MMA(0, 1, At, B1); PG8_BAR;
            PG8_LDA(At, 1, 1); PG8_STAGE(PG8_SA(1, 0), a3, voffA);
            PG8_BAR; PG8_WAIT_L(0); PG8_MMA(1, 0, At, B0); PG8_BAR; PG8_SCHED;
            PG8_STAGE(PG8_SB(1, 1), b3 + hstepB, voffB);
            PG8_WAIT_V(6); PG8_BAR; PG8_MMA(1, 1, At, B1); PG8_BAR;
            }
        }
        if constexpr (FP8) asm volatile("s_nop 15\n\ts_nop 15" ::: "memory");
        if constexpr (ALIGN_EPI) { if (wr == 0) PG8_BAR; }
        if constexpr (!Epi::AFTER_DRAIN) { const int t2 = fresh_tid();
            E(acc, cur, t2 >> 8, (t2 >> 6) & 3, t2 & 15, (t2 >> 4) & 3); S.done(cur); }
        if (!has_next) break;
#pragma unroll
        for (int a = 0; a < 2; ++a)
#pragma unroll
            for (int b = 0; b < 2; ++b)
#pragma unroll
                for (int m = 0; m < 4; ++m)
#pragma unroll
                    for (int n = 0; n < 2; ++n) acc[a][b][m][n] = (f32x4){0.f, 0.f, 0.f, 0.f};
        cur = nxt; cA = nA; cB = nB; ++ui;
        if constexpr (ALIGN_EPI) { if (wr == 1) PG8_BAR; }
    }
    PG8_WAIT_V(0);
    if constexpr (!ALIGN_EPI) { if (wr == 0) PG8_BAR; }
    PG8_BAR;
    if constexpr (Epi::AFTER_DRAIN) { E.fused(acc, cur, wr, wc, fr, fq, lds, wid, lane); S.done(cur); }
#undef PG8_SA
#undef PG8_SB
#undef PG8_STAGE
#undef PG8_LDA
#undef PG8_LDB
#undef PG8_MMA
#undef PG8_CAT8
#undef PG8_WAIT_V
#undef PG8_WAIT_L
#undef PG8_BAR
#undef PG8_SCHED
}

template <class Epi, class Mid, class Sched>
__device__ __forceinline__ void gemm_chain(PG8_LAS unsigned char* lds, const Gemm g1, const Gemm g2, const Sched& S, const Mid& M, const Epi& E) {
    const int tid = fresh_tid();
    const int wid = __builtin_amdgcn_readfirstlane(tid >> 6), lane = tid & 63, wr = wid >> 2, wc = wid & 3, fr = lane & 15, fq = lane >> 4;
    const int nt1 = g1.K / BK, nt2 = g2.K / BK;
    const size_t kstep = (size_t)(BK * 2);
    const size_t hA1 = (size_t)HALF * g1.lda * 2, hB1 = (size_t)HALF * g1.ldb * 2, hA2 = (size_t)HALF * g2.lda * 2, hB2 = (size_t)HALF * g2.ldb * 2;
    const unsigned ldsw = (unsigned)wid * 1024u;
#define PC_OFFS(F8, LDA_, LDB_) const int t3_ = fresh_tid(); unsigned VA[2], VB[2]; \
        { int R, C; stage_rc(t3_ * 16, R, C); const int Rb = Epi::PERM ? ((R & ~31) + perm32(R & 31)) : R; \
          VA[0] = (unsigned)(R * (LDA_) + C) * 2u; VB[0] = (unsigned)(Rb * (LDB_) + C) * 2u; VA[1] = VA[0] + (unsigned)(64 * (LDA_)) * 2u; VB[1] = VB[0] + (unsigned)(64 * (LDB_)) * 2u; } \
        const int aoff = lds_byte((t3_ >> 8) * 64 + (t3_ & 15), ((t3_ >> 4) & 3) * ((F8) ? 16 : 8)), boff = lds_byte(((t3_ >> 6) & 3) * 32 + (t3_ & 15), ((t3_ >> 4) & 3) * ((F8) ? 16 : 8));
#define PC_SA(b, h) (((b) * 2 + (h)) * HTB)
#define PC_SB(b, h) ((4 + (b) * 2 + (h)) * HTB)
#define PC_STAGE(bufoff, gbase, v0, v1) do { \
        __builtin_amdgcn_global_load_lds((const unsigned*)((const char*)(gbase) + (v0)), (PG8_LAS unsigned*)(lds + (bufoff) + ldsw), 16, 0, 0); \
        __builtin_amdgcn_global_load_lds((const unsigned*)((const char*)(gbase) + (v1)), (PG8_LAS unsigned*)(lds + (bufoff) + ldsw + 8192), 16, 0, 0); } while (0)
#define PC_LDA(F8, b, h) do { if constexpr (F8) { _Pragma("unroll") for (int m = 0; m < 4; ++m) At8[m] = ld_frag8(lds + PC_SA(b, h) + aoff + m * 2048); } \
        else { _Pragma("unroll") for (int m = 0; m < 4; ++m) _Pragma("unroll") for (int k = 0; k < 2; ++k) At[m][k] = *(const PG8_LAS bf16x8*)(lds + PC_SA(b, h) + aoff + m * 2048 + k * 1024); } } while (0)
#define PC_LDB(F8, W, b, h) do { if constexpr (F8) { _Pragma("unroll") for (int n = 0; n < 2; ++n) B##W##8[n] = ld_frag8(lds + PC_SB(b, h) + boff + n * 2048); } \
        else { _Pragma("unroll") for (int n = 0; n < 2; ++n) _Pragma("unroll") for (int k = 0; k < 2; ++k) B##W[n][k] = *(const PG8_LAS bf16x8*)(lds + PC_SB(b, h) + boff + n * 2048 + k * 1024); } } while (0)
#define PC_MMA(F8, ai, bj, W) do { __builtin_amdgcn_s_setprio(1); _Pragma("unroll") for (int m = 0; m < 4; ++m) _Pragma("unroll") for (int n = 0; n < 2; ++n) { \
        if constexpr (F8) asm volatile("v_mfma_f32_16x16x128_f8f6f4 %0, %1, %2, %0" : "+v"(acc[ai][bj][m][n]) : "v"(B##W##8[n]), "v"(At8[m])); \
        else { _Pragma("unroll") for (int k = 0; k < 2; ++k) acc[ai][bj][m][n] = __builtin_amdgcn_mfma_f32_16x16x32_bf16(B##W[n][k], At[m][k], acc[ai][bj][m][n], 0, 0, 0); } } __builtin_amdgcn_s_setprio(0); } while (0)
#define PC_WAIT_V(n) asm volatile("s_waitcnt vmcnt(" #n ")" ::: "memory")
#define PC_WAIT_L(n) asm volatile("s_waitcnt lgkmcnt(" #n ")" ::: "memory")
#define PC_BAR __builtin_amdgcn_s_barrier()
#define PC_SCHED __builtin_amdgcn_sched_barrier(0)
#define PC_KLOOP(F8, cA_, cB_, nt_, LDA_, LDB_, HA, HB, nA_, nB_, NLDA_, NLDB_, NHA, NHB) { PC_OFFS(F8, LDA_, LDB_) \
        _Pragma("nounroll") for (int t = 0; t < (nt_); t += 2) { \
            const bool last = (t == (nt_) - 2); \
            const char* a1 = (cA_) + (size_t)(t + 1) * kstep; \
            const char* a2 = last ? (nA_) : (cA_) + (size_t)(t + 2) * kstep; const char* b2 = last ? (nB_) : (cB_) + (size_t)(t + 2) * kstep; \
            const char* a3 = a2 + kstep; const char* b3 = b2 + kstep; \
            unsigned sa0 = VA[0], sa1 = VA[1], sb0 = VB[0], sb1 = VB[1]; const size_t sha = last ? (NHA) : (HA), shb = last ? (NHB) : (HB); \
            if (last) { int R, C; stage_rc(t3_ * 16, R, C); const int Rb = Epi::PERM ? ((R & ~31) + perm32(R & 31)) : R; \
                sa0 = (unsigned)(R * (NLDA_) + C) * 2u; sb0 = (unsigned)(Rb * (NLDB_) + C) * 2u; sa1 = sa0 + (unsigned)(64 * (NLDA_)) * 2u; sb1 = sb0 + (unsigned)(64 * (NLDB_)) * 2u; } \
            PC_LDB(F8, 0, 0, 0); PC_LDB(F8, 1, 0, 1); PC_SCHED; PC_LDA(F8, 0, 0); PC_STAGE(PC_SA(1, 1), a1 + (HA), VA[0], VA[1]); \
            PC_WAIT_V(8); PC_WAIT_L(0); PC_BAR; PC_MMA(F8, 0, 0, 0); PC_MMA(F8, 0, 1, 1); PC_BAR; PC_SCHED; \
            PC_LDA(F8, 0, 1); PC_STAGE(PC_SB(0, 0), b2, sb0, sb1); PC_STAGE(PC_SB(0, 1), b2 + shb, sb0, sb1); PC_STAGE(PC_SA(0, 0), a2, sa0, sa1); \
            PC_WAIT_V(8); PC_WAIT_L(0); PC_BAR; PC_MMA(F8, 1, 0, 0); PC_MMA(F8, 1, 1, 1); PC_BAR; PC_SCHED; \
            PC_LDB(F8, 0, 1, 0); PC_LDB(F8, 1, 1, 1); PC_SCHED; PC_LDA(F8, 1, 0); PC_STAGE(PC_SA(0, 1), a2 + sha, sa0, sa1); \
            PC_WAIT_V(8); PC_WAIT_L(0); PC_BAR; PC_MMA(F8, 0, 0, 0); PC_MMA(F8, 0, 1, 1); PC_BAR; PC_SCHED; \
            PC_LDA(F8, 1, 1); PC_STAGE(PC_SB(1, 0), b3, sb0, sb1); PC_STAGE(PC_SB(1, 1), b3 + shb, sb0, sb1); PC_STAGE(PC_SA(1, 0), a3, sa0, sa1); \
            PC_WAIT_V(8); PC_WAIT_L(0); PC_BAR; PC_MMA(F8, 1, 0, 0); PC_MMA(F8, 1, 1, 1); PC_BAR; PC_SCHED; \
        } }
    Unit cur, nxt; int ui = 0;
    if (!S.next(0, cur)) return;
    f32x4 acc[2][2][4][2];
#pragma unroll
    for (int a = 0; a < 2; ++a)
#pragma unroll
        for (int b = 0; b < 2; ++b)
#pragma unroll
            for (int m = 0; m < 4; ++m)
#pragma unroll
                for (int n = 0; n < 2; ++n) acc[a][b][m][n] = (f32x4){0.f, 0.f, 0.f, 0.f};
    bf16x8 At[4][2], B0[2][2], B1[2][2]; pg8_v8i At8[4], B08[2], B18[2];
    const char* c1A = (const char*)g1.A + (size_t)cur.pm * 2 * hA1; const char* c1B = (const char*)g1.Bt + (size_t)cur.pn * 2 * hB1;
    { PC_OFFS(false, g1.lda, g1.ldb) (void)aoff; (void)boff;
    PC_STAGE(PC_SB(0, 0), c1B, VB[0], VB[1]); PC_STAGE(PC_SB(0, 1), c1B + hB1, VB[0], VB[1]); PC_STAGE(PC_SA(0, 0), c1A, VA[0], VA[1]); PC_STAGE(PC_SA(0, 1), c1A + hA1, VA[0], VA[1]);
    if (wr == 1) PC_BAR;
    PC_WAIT_V(2); PC_BAR;
    PC_STAGE(PC_SB(1, 0), c1B + kstep, VB[0], VB[1]); PC_STAGE(PC_SA(1, 0), c1A + kstep, VA[0], VA[1]); PC_STAGE(PC_SB(1, 1), c1B + hB1 + kstep, VB[0], VB[1]);
    PC_WAIT_V(6); PC_BAR; }
    for (;;) {
        const bool has_next = S.next(ui + 1, nxt);
        const char* c2A = (const char*)g2.A + (size_t)cur.pm * 2 * hA2; const char* c2B = (const char*)g2.Bt + (size_t)cur.pn * 2 * hB2;
        const char* n1A = has_next ? (const char*)g1.A + (size_t)nxt.pm * 2 * hA1 : c1A; const char* n1B = has_next ? (const char*)g1.Bt + (size_t)nxt.pn * 2 * hB1 : c1B;
        PC_KLOOP(false, c1A, c1B, nt1, g1.lda, g1.ldb, hA1, hB1, c2A, c2B, g2.lda, g2.ldb, hA2, hB2)
        { const int t2 = fresh_tid(); M(acc, cur, t2 >> 8, (t2 >> 6) & 3, t2 & 15, (t2 >> 4) & 3); }
        PC_KLOOP(true, c2A, c2B, nt2, g2.lda, g2.ldb, hA2, hB2, n1A, n1B, g1.lda, g1.ldb, hA1, hB1)
        asm volatile("s_nop 15\n\ts_nop 15" ::: "memory");
        if (wr == 0) PC_BAR;
        { const int t2 = fresh_tid(); E(acc, cur, t2 >> 8, (t2 >> 6) & 3, t2 & 15, (t2 >> 4) & 3); }
        if (!has_next) break;
#pragma unroll
        for (int a = 0; a < 2; ++a)
#pragma unroll
            for (int b = 0; b < 2; ++b)
#pragma unroll
                for (int m = 0; m < 4; ++m)
#pragma unroll
                    for (int n = 0; n < 2; ++n) acc[a][b][m][n] = (f32x4){0.f, 0.f, 0.f, 0.f};
        cur = nxt; c1A = n1A; c1B = n1B; ++ui;
        if (wr == 1) PC_BAR;
    }
    PC_WAIT_V(0);
    PC_BAR;
#undef PC_SA
#undef PC_SB
#undef PC_STAGE
#undef PC_LDA
#undef PC_LDB
#undef PC_MMA
#undef PC_WAIT_V
#undef PC_WAIT_L
#undef PC_BAR
#undef PC_SCHED
#undef PC_KLOOP
#undef PC_OFFS
}
}

constexpr int DM = 2048, DEPTH = 2;
constexpr int MTOK = 65536, MPROMPT = 32768, SEQ_P = 16384, SEQ_S = 4096;
constexpr int IN_COLS = 11360;
constexpr int NP1 = 4352, NP2 = 7168, NQ = 1536, NKV = 2048;
constexpr int SRC_CQ = 0, SRC_CKV = 512, SRC_KROPE = 1024, SRC_ZA = 1088, SRC_QM = 2112, SRC_KM = 3136, SRC_VM = 4160, SRC_OM = 5184, SRC_ZM = 6208, SRC_GATES = 7232, SRC_GA = 7264, SRC_GB = 9312;
constexpr float EPS = 1e-6f;
constexpr int NWAVES = 8;

constexpr size_t MiB = 1u << 20, U = 128 * MiB;
constexpr size_t WS_XN = 0;
constexpr size_t WS_CQKV = 2 * U;
constexpr size_t WS_QM = 3 * U, WS_KM = 4 * U, WS_VM = 5 * U;
constexpr size_t WS_Q = 6 * U;
constexpr size_t WS_KN = 6 * U + U / 2 * 3, WS_V = WS_KN + U;
constexpr size_t WS_KR = WS_V + U;
constexpr size_t WS_K8 = WS_KN, WS_V8T = WS_V;
constexpr size_t WS_HFW = 10 * U, WS_HBW = 11 * U;
constexpr size_t WS_MG = 3 * U;
constexpr size_t WS_SGA = 5 * U, WS_SGB = 7 * U;
constexpr size_t WS_W = 12 * U;
constexpr int NP1A = 1024, NP1B = 3328, NP2A = 3072, NP2B = 4096;
constexpr size_t W_P1A = 0, W_P1B = W_P1A + (size_t)NP1A * DM, W_P2A = W_P1B + (size_t)NP1B * DM * 2, W_P2B = W_P2A + (size_t)NP2A * DM, W_UQ = W_P2B + (size_t)NP2B * DM * 2,
                 W_UKV = W_UQ + (size_t)NQ * 512, W_OA = W_UKV + (size_t)NKV * 512, W_OB = W_OA + (size_t)DM * 1024, W_OUT = W_OB + (size_t)DM * 1024 * 2, LW = W_OUT + (size_t)DM * DM * 2;
constexpr int SC_ONE = 0x7F7F7F7F, SC_M6 = 0x79797979, SC_M5 = 0x7A7A7A7A;
constexpr size_t WS_ROPE = WS_W + 2 * LW;
constexpr size_t WS_KRG = WS_ROPE + 4 * MiB;
constexpr size_t WS_SSQ = WS_KRG + 24 * MiB;
constexpr size_t WS_SCR = WS_SSQ + 4 * MiB;
constexpr size_t WS_RSKV = WS_SCR + 20 * MiB;
constexpr size_t WS_SSF = WS_KR + 4 * MiB;
constexpr size_t WS_HG = WS_RSKV + 512 * 1024;
constexpr size_t WS_CTL = WS_RSKV + 1 * MiB, CTL_ZERO_BYTES = 1 * MiB;
constexpr size_t WS_XN8 = WS_CTL + CTL_ZERO_BYTES;
constexpr size_t WS_YA8 = WS_XN8 + U;
constexpr size_t WS_END = WS_YA8 + U / 2;
static_assert(LW % 256 == 0 && WS_END < 2040 * MiB, "d_ws map");
constexpr int CW_BAR = 4096;
constexpr int CW_PANEL = 32768;
constexpr int CW_QUEUE = 16384;

constexpr int LDS_BYTES = 163840;
constexpr int MISC_OFF = 159744;

#define GAS __attribute__((address_space(1)))
#define LAS __attribute__((address_space(3)))
typedef unsigned short bf16;
typedef unsigned v4u __attribute__((ext_vector_type(4)));
typedef float f32x4 __attribute__((ext_vector_type(4)));
typedef short bf16x8 __attribute__((ext_vector_type(8)));
typedef GAS unsigned gu32;
typedef GAS unsigned long long gu64;
#define RLX_AGENT __ATOMIC_RELAXED, __HIP_MEMORY_SCOPE_AGENT
#define LDS_WAIT() asm volatile("s_waitcnt lgkmcnt(0)" ::: "memory")
#define VM_WAIT() asm volatile("s_waitcnt vmcnt(0)" ::: "memory")
__device__ __forceinline__ unsigned long long rt() { return __builtin_amdgcn_s_memrealtime(); }
__device__ __forceinline__ unsigned f2bf(float f) { unsigned u = __builtin_bit_cast(unsigned, f); return (u + 0x7fffu + ((u >> 16) & 1u)) >> 16; }
__device__ __forceinline__ unsigned pk2(float lo, float hi) { return f2bf(lo) | (f2bf(hi) << 16); }

#define XB_TMO      128
#define XB_XCNT(j)  (256  + 64 * (j))
#define XB_XSUB(j)  (1280 + 64 * (j))
#define XB_XGEN(j)  (2304 + 64 * (j))
#define XB_TOP      3328
#define XB_TOPGEN   3392
#define XCD_BAR_WORDS 3456
#define XB_SPIN_CAP (1u << 18)

__device__ __forceinline__ unsigned xb_ld(unsigned* p)              { return __hip_atomic_load(p, __ATOMIC_RELAXED, __HIP_MEMORY_SCOPE_AGENT); }
__device__ __forceinline__ unsigned xb_add(unsigned* p, unsigned v) { return __hip_atomic_fetch_add(p, v, __ATOMIC_RELAXED, __HIP_MEMORY_SCOPE_AGENT); }
__device__ __forceinline__ unsigned xb_xcc_id() { return (unsigned)__builtin_amdgcn_s_getreg((3 << 11) | 20) & 0xFu; }
#define XB_SPIN(cond, bar) do { unsigned _sp = 0; while (cond) { __builtin_amdgcn_s_sleep(1); \
    if ((++_sp & 255u) == 0u) { if (xb_ld(&(bar)[XB_TMO])) break; if (_sp > XB_SPIN_CAP) { atomicAdd(&(bar)[XB_TMO], 1u); break; } } } } while (0)

struct XcdBarrier {
    unsigned* bar; unsigned x;
    volatile LAS unsigned* st;
};

__device__ __forceinline__ XcdBarrier xcd_barrier_post(unsigned* bar, volatile LAS unsigned* st) {
    XcdBarrier b; b.bar = bar; b.x = xb_xcc_id(); b.st = st;
    if (threadIdx.x == 0) (void)xb_add(&bar[XB_XCNT(b.x)], 1u);
    return b;
}
__device__ __forceinline__ void xcd_barrier_complete(unsigned* bar, unsigned x, unsigned& nloc, unsigned& nx) {
    const unsigned G = gridDim.x * gridDim.y * gridDim.z;
    unsigned sum, cnt, mine, sp = 0u;
    for (;;) {
        sum = 0u; cnt = 0u; mine = 0u;
#pragma unroll
        for (unsigned j = 0; j < 16; ++j) { const unsigned c = xb_ld(&bar[XB_XCNT(j)]); sum += c; cnt += (c > 0u) ? 1u : 0u; mine = (j == x) ? c : mine; }
        if (sum == G) break;
        __builtin_amdgcn_s_sleep(1);
        if ((++sp & 255u) == 0u) { if (xb_ld(&bar[XB_TMO])) break; if (sp > XB_SPIN_CAP) { atomicAdd(&bar[XB_TMO], 1u); break; } }
    }
    nloc = mine > 0u ? mine : 1u; nx = cnt > 0u ? cnt : 1u;
}

__device__ __forceinline__ void xcd_barrier(const XcdBarrier& b) {
    asm volatile("s_waitcnt vmcnt(0)" ::: "memory");
    __syncthreads();
    if (threadIdx.x == 0) {
        unsigned* bar = b.bar;
        __builtin_amdgcn_s_waitcnt(0);
        unsigned nloc = b.st[0], nx = b.st[1];
        if (nloc == 0u) { xcd_barrier_complete(bar, b.x, nloc, nx); b.st[0] = nloc; b.st[1] = nx; }
        const unsigned old = xb_add(&bar[XB_XSUB(b.x)], 1u);
        const unsigned gen = old / nloc;
        if (old + 1u == (gen + 1u) * nloc) {
            __builtin_amdgcn_fence(__ATOMIC_RELEASE, "agent");
            asm volatile("s_waitcnt vmcnt(0)" ::: "memory");
            const unsigned og = xb_add(&bar[XB_TOP], 1u);
            const unsigned tg = og / nx;
            if (og + 1u == (tg + 1u) * nx) xb_add(&bar[XB_TOPGEN], 1u);
            else XB_SPIN(xb_ld(&bar[XB_TOPGEN]) == tg, bar);
            __builtin_amdgcn_fence(__ATOMIC_ACQUIRE, "agent");
            xb_add(&bar[XB_XGEN(b.x)], 1u);
            asm volatile("s_waitcnt vmcnt(0)" ::: "memory");
        } else {
            XB_SPIN(xb_ld(&bar[XB_XGEN(b.x)]) == gen, bar);
            __builtin_amdgcn_fence(__ATOMIC_ACQUIRE, "agent");
            asm volatile("s_waitcnt vmcnt(0)" ::: "memory");
        }
    }
    __syncthreads();
}


typedef float f32x2 __attribute__((ext_vector_type(2)));
typedef float f32x8v __attribute__((ext_vector_type(8)));
typedef unsigned u32x2 __attribute__((ext_vector_type(2)));
typedef short s16x4 __attribute__((ext_vector_type(4)));
typedef float f32x16 __attribute__((ext_vector_type(16)));

typedef float cvt_f32x2 __attribute__((ext_vector_type(2))); typedef __bf16 cvt_bf16x2 __attribute__((ext_vector_type(2)));
__device__ __forceinline__ unsigned cvtpk(float lo, float hi) { return __builtin_bit_cast(unsigned, __builtin_convertvector((cvt_f32x2){lo, hi}, cvt_bf16x2)); }
__device__ __forceinline__ float bflo(unsigned w) { return __uint_as_float(w << 16); }
__device__ __forceinline__ float bfhi(unsigned w) { return __uint_as_float(w & 0xffff0000u); }
__device__ __forceinline__ float sigmoidf_(float x) { return __builtin_amdgcn_rcpf(1.0f + __expf(-x)); }
__device__ __forceinline__ float siluf_(float x) { return x * __builtin_amdgcn_rcpf(1.0f + __expf(-x)); }
template <int K> __device__ __forceinline__ float swz_xor(float v) { return __int_as_float(__builtin_amdgcn_ds_swizzle(__float_as_int(v), 0x1F | (K << 10))); }
__device__ __forceinline__ float sum_x16(float v) { const auto rr = __builtin_amdgcn_permlane16_swap(__float_as_uint(v), __float_as_uint(v), false, false); return __uint_as_float(rr[0]) + __uint_as_float(rr[1]); }
__device__ __forceinline__ float sum_x32(float v) { const auto rr = __builtin_amdgcn_permlane32_swap(__float_as_uint(v), __float_as_uint(v), false, false); return __uint_as_float(rr[0]) + __uint_as_float(rr[1]); }
__device__ __forceinline__ float wave_sum(float v) { v += swz_xor<1>(v); v += swz_xor<2>(v); v += swz_xor<4>(v); v += swz_xor<8>(v); v = sum_x16(v); return sum_x32(v); }
__device__ __forceinline__ unsigned pk4_fp8(float a, float b, float c, float d) {
    a = __builtin_amdgcn_fmed3f(a, -448.f, 448.f); b = __builtin_amdgcn_fmed3f(b, -448.f, 448.f); c = __builtin_amdgcn_fmed3f(c, -448.f, 448.f); d = __builtin_amdgcn_fmed3f(d, -448.f, 448.f);
    int w = __builtin_amdgcn_cvt_pk_fp8_f32(a, b, 0, false); w = __builtin_amdgcn_cvt_pk_fp8_f32(c, d, w, true); return (unsigned)w; }
__device__ __forceinline__ int opaque_tid() { return pg8::fresh_tid(); }
__device__ __forceinline__ int seq_pos(int m) { return m < MPROMPT ? (m & (SEQ_P - 1)) : (m & (SEQ_S - 1)); }

struct Frame {
    LAS unsigned char* lds;
    volatile LAS unsigned* MISC;
    gu32* ctl;
    int tid, lane, wave, vcu, G;
    unsigned char* ws;
    float* out;
};
enum { IN_XP = 0, IN_XS = 1, IN_NORM_IN = 2, IN_W_IN = 3, IN_B_GATES = 4, IN_Q_A_NORM = 5, IN_W_UQ = 6, IN_KV_A_NORM = 7, IN_W_UKV = 8, IN_W_OA = 9, IN_M_HEAD_NORM = 10, IN_W_OB = 11, IN_W_OUT = 12, IN_NORM_F = 13 };
struct Args { const float* in[14]; float* out; unsigned char* ws; int ph_lo, ph_hi; };

__device__ __forceinline__ int wmap(int kind, int n) {
    if (kind == 0) {
        if (n < 3072) return SRC_QM + n;
        if (n < 3136) { const int j = n - 3072; return SRC_KROPE + (j >> 1) + 32 * (j & 1); }
        if (n < 3168) return SRC_GATES + (n - 3136);
        return -1;
    }
    if (kind == 5) return n;
    if (kind == 1) {
        if (n < 2048) { const int t = n >> 8, w = n & 255; return (w < 128 ? SRC_OM : SRC_ZM) + t * 128 + (w & 127); }
        return SRC_GB + (n - 2048);
    }
    if (kind == 6) {
        if (n < 1024) return SRC_ZA + n;
        return SRC_GA + (n - 1024);
    }
    if (kind == 2) {
        if (n < 1024) return (n >> 7) * 192 + (n & 127);
        const int j = n - 1024, h = j >> 6, jj = j & 63; return h * 192 + 128 + (jj >> 1) + 32 * (jj & 1);
    }
    if (kind == 3) {
        if (n < 1024) return (n >> 7) * 256 + (n & 127);
        const int j = n - 1024; return (j >> 7) * 256 + 128 + (j & 127);
    }
    return n;
}
__device__ __forceinline__ void transpose_item(const float* W, int K, int srcN, bf16* WT, int Ndst, int kind, const float* kgain, LAS float* scr, int item, int lane) {
    const int nblk = Ndst / 32, kb = item / nblk, nb = item % nblk, k0 = 64 * kb, n0 = 32 * nb;
    const int n = n0 + (lane & 31); const int sc = wmap(kind, n);
    const float cs = (kind == 0 && n < 1024) ? 0.08838834764831845f : 1.0f;
    float tv[32];
#pragma unroll
    for (int i = 0; i < 32; ++i) { const int kk = 2 * i + (lane >> 5);
        float v = 0.f; if (sc >= 0) { v = W[(size_t)(k0 + kk) * srcN + sc] * cs; if (kgain) v *= kgain[k0 + kk]; }
        tv[i] = v; }
#pragma unroll
    for (int i = 0; i < 32; ++i) scr[(2 * i + (lane >> 5)) * 33 + (lane & 31)] = tv[i];
    LDS_WAIT(); asm volatile("" ::: "memory");
    const int c = lane & 7;
#pragma unroll
    for (int j = 0; j < 4; ++j) { const int nn = (lane >> 3) + 8 * j; const LAS float* s = scr + (8 * c) * 33 + nn;
        v4u o; o.x = pk2(s[0 * 33], s[1 * 33]); o.y = pk2(s[2 * 33], s[3 * 33]); o.z = pk2(s[4 * 33], s[5 * 33]); o.w = pk2(s[6 * 33], s[7 * 33]);
        *(GAS v4u*)(WT + (size_t)(n0 + nn) * K + k0 + 8 * c) = o; }
    LDS_WAIT(); asm volatile("" ::: "memory");
}
__device__ __forceinline__ void transpose_item8(const float* W, int K, int srcN, unsigned char* WT, int Ndst, int kind, const float* kgain, float wscale, LAS float* scr, int item, int lane) {
    const int nblk = Ndst / 32, kb = item / nblk, nb = item % nblk, k0 = 64 * kb, n0 = 32 * nb;
    const int n = n0 + (lane & 31); const int sc = wmap(kind, n);
    float tv[32];
#pragma unroll
    for (int i = 0; i < 32; ++i) { const int kk = 2 * i + (lane >> 5);
        float v = 0.f; if (sc >= 0) { v = W[(size_t)(k0 + kk) * srcN + sc] * wscale; if (kgain) v *= kgain[k0 + kk]; }
        tv[i] = v; }
#pragma unroll
    for (int i = 0; i < 32; ++i) scr[(2 * i + (lane >> 5)) * 33 + (lane & 31)] = tv[i];
    LDS_WAIT(); asm volatile("" ::: "memory");
    const int nn = lane >> 1, kh = (lane & 1) * 32; const LAS float* s = scr + kh * 33 + nn;
#pragma unroll
    for (int c = 0; c < 2; ++c) { v4u o;
        o.x = pk4_fp8(s[(16 * c + 0) * 33], s[(16 * c + 1) * 33], s[(16 * c + 2) * 33], s[(16 * c + 3) * 33]); o.y = pk4_fp8(s[(16 * c + 4) * 33], s[(16 * c + 5) * 33], s[(16 * c + 6) * 33], s[(16 * c + 7) * 33]);
        o.z = pk4_fp8(s[(16 * c + 8) * 33], s[(16 * c + 9) * 33], s[(16 * c + 10) * 33], s[(16 * c + 11) * 33]); o.w = pk4_fp8(s[(16 * c + 12) * 33], s[(16 * c + 13) * 33], s[(16 * c + 14) * 33], s[(16 * c + 15) * 33]);
        *(GAS v4u*)(WT + (size_t)(n0 + nn) * K + k0 + kh + 16 * c) = o; }
    LDS_WAIT(); asm volatile("" ::: "memory");
}
__device__ __forceinline__ void conv_layer(Frame& F, const Args& A, const int l) {
    const int tid_ = opaque_tid(), lane_ = tid_ & 63, wave_ = __builtin_amdgcn_readfirstlane(tid_ >> 6);
    LAS float* scr = (LAS float*)(F.lds + wave_ * 16384);
    const int gw = F.vcu * NWAVES + wave_, NGW = F.G * NWAVES;
    constexpr int I_P1A = (DM / 64) * (NP1A / 32), I_P1B = (DM / 64) * (NP1B / 32), I_P2A = (DM / 64) * (NP2A / 32), I_P2B = (DM / 64) * (NP2B / 32), I_UQ = (512 / 64) * (NQ / 32),
                  I_UKV = (512 / 64) * (NKV / 32), I_OA = (1024 / 64) * (DM / 32), I_OB = I_OA, I_OUT = (DM / 64) * (DM / 32), I_LAYER = I_P1A + I_P1B + I_P2A + I_P2B + I_UQ + I_UKV + I_OA + I_OB + I_OUT;
    for (int it = gw; it < I_LAYER; it += NGW) {
        int r = it;
        unsigned char* wb = F.ws + WS_W + (size_t)l * LW;
        const float* win = A.in[IN_W_IN] + (size_t)l * DM * IN_COLS;
        if (r < I_P1A) { transpose_item8(win, DM, IN_COLS, wb + W_P1A, NP1A, 5, nullptr, 64.f, scr, r, lane_); continue; } r -= I_P1A;
        if (r < I_P1B) { transpose_item(win, DM, IN_COLS, (bf16*)(wb + W_P1B), NP1B, 0, nullptr, scr, r, lane_); continue; } r -= I_P1B;
        if (r < I_P2A) { transpose_item8(win, DM, IN_COLS, wb + W_P2A, NP2A, 6, nullptr, 64.f, scr, r, lane_); continue; } r -= I_P2A;
        if (r < I_P2B) { transpose_item(win, DM, IN_COLS, (bf16*)(wb + W_P2B), NP2B, 1, nullptr, scr, r, lane_); continue; } r -= I_P2B;
        if (r < I_UQ) { transpose_item8(A.in[IN_W_UQ] + (size_t)l * 512 * NQ, 512, NQ, wb + W_UQ, NQ, 2, A.in[IN_Q_A_NORM] + l * 512, 32.f, scr, r, lane_); continue; } r -= I_UQ;
        if (r < I_UKV) { transpose_item8(A.in[IN_W_UKV] + (size_t)l * 512 * NKV, 512, NKV, wb + W_UKV, NKV, 3, A.in[IN_KV_A_NORM] + l * 512, 32.f, scr, r, lane_); continue; } r -= I_UKV;
        if (r < I_OA) { transpose_item8(A.in[IN_W_OA] + (size_t)l * 1024 * DM, 1024, DM, wb + W_OA, DM, 4, nullptr, 32.f, scr, r, lane_); continue; } r -= I_OA;
        if (r < I_OB) { transpose_item(A.in[IN_W_OB] + (size_t)l * 1024 * DM, 1024, DM, (bf16*)(wb + W_OB), DM, 4, nullptr, scr, r, lane_); continue; } r -= I_OB;
        transpose_item(A.in[IN_W_OUT] + (size_t)l * DM * DM, DM, DM, (bf16*)(wb + W_OUT), DM, 4, nullptr, scr, r, lane_);
    }
}
__device__ __forceinline__ void p_prologue(Frame& F, const Args& A) {
    conv_layer(F, A, 0);
    const int tid_ = opaque_tid();
    for (int e = F.vcu * 512 + tid_; e < DEPTH * 1024; e += F.G * 512) ((float*)(F.ws + WS_HG))[e] = A.in[IN_M_HEAD_NORM][e];
    f32x2* rope = (f32x2*)(F.ws + WS_ROPE);
    for (int e = F.vcu * 512 + tid_; e < SEQ_P * 32; e += F.G * 512) {
        const int pos = e >> 5, i = e & 31;
        const float inv = powf(10000.0f, -(float)(2 * i) / 64.0f);
        const float ang = (float)pos * inv; float s, c; sincosf(ang, &s, &c);
        rope[e] = (f32x2){c, s};
    }
}

__device__ __forceinline__ const float* x_row(Frame& F, const Args& A, int layer, int m) {
    if (layer == 0) return m < MPROMPT ? A.in[IN_XP] + (size_t)m * DM : A.in[IN_XS] + (size_t)(m - MPROMPT) * DM;
    return F.out + (size_t)m * DM;
}
__device__ __forceinline__ void p_norm(Frame& F, const Args& A, int layer) {
    const int tid_ = opaque_tid(), lane_ = tid_ & 63, wave_ = __builtin_amdgcn_readfirstlane(tid_ >> 6);
    const int gw = F.vcu * NWAVES + wave_, NGW = F.G * NWAVES;
    const float* g = A.in[IN_NORM_IN] + layer * DM; bf16* XN = (bf16*)(F.ws + WS_XN);
    for (int m = gw; m < MTOK; m += NGW) {
        const GAS f32x4* xr = (const GAS f32x4*)x_row(F, A, layer, m) + lane_;
        f32x4 v[8]; float s = 0.f;
#pragma unroll
        for (int j = 0; j < 8; ++j) { v[j] = xr[64 * j]; s += (v[j].x * v[j].x + v[j].y * v[j].y) + (v[j].z * v[j].z + v[j].w * v[j].w); }
        const float rs = 1.0f / sqrtf(wave_sum(s) * (1.0f / DM) + EPS);
        GAS unsigned long long* o8 = (GAS unsigned long long*)(XN + (size_t)m * DM) + lane_;
#pragma unroll
        for (int j = 0; j < 8; ++j) { const f32x4 gg = *((const GAS f32x4*)g + lane_ + 64 * j);
            const float y0 = v[j].x * rs * gg.x, y1 = v[j].y * rs * gg.y, y2 = v[j].z * rs * gg.z, y3 = v[j].w * rs * gg.w;
            o8[64 * j] = (unsigned long long)cvtpk(y0, y1) | ((unsigned long long)cvtpk(y2, y3) << 32);
            ((GAS unsigned*)(F.ws + WS_XN8 + (size_t)m * DM))[lane_ + 64 * j] = pk4_fp8(y0, y1, y2, y3); }
    }
}
__device__ __forceinline__ void p_final(Frame& F, const Args& A) {
    const int tid_ = opaque_tid(), lane_ = tid_ & 63, wave_ = __builtin_amdgcn_readfirstlane(tid_ >> 6);
    const int gw = F.vcu * NWAVES + wave_, NGW = F.G * NWAVES;
    for (int m = gw; m < MTOK; m += NGW) {
        GAS f32x4* xr = (GAS f32x4*)(F.out + (size_t)m * DM) + lane_;
        f32x4 v[8]; float s = 0.f;
#pragma unroll
        for (int j = 0; j < 8; ++j) { v[j] = xr[64 * j]; s += (v[j].x * v[j].x + v[j].y * v[j].y) + (v[j].z * v[j].z + v[j].w * v[j].w); }
        const float rs = 1.0f / sqrtf(wave_sum(s) * (1.0f / DM) + EPS);
#pragma unroll
        for (int j = 0; j < 8; ++j) { const f32x4 gg = *((const GAS f32x4*)A.in[IN_NORM_F] + lane_ + 64 * j); xr[64 * j] = v[j] * rs * gg; }
    }
}

using pg8::Unit; using pg8::BM; using pg8::HALF;
#define EPI_ROWS_BEGIN  _Pragma("unroll") for (int ai = 0; ai < 2; ++ai) _Pragma("unroll") for (int m = 0; m < 4; ++m) { const int row = u.pm * BM + ai * HALF + wr * 64 + m * 16 + fr;
#define EPI_ROWS_END    asm volatile("" ::: "memory"); }
#define EPI_ROW(ai, m) (u.pm * BM + (ai) * HALF + wr * 64 + (m) * 16 + fr)
#define EPI_FENCE asm volatile("" ::: "memory")

struct EpiP1a {
    static constexpr int PERM = 2; static constexpr bool AFTER_DRAIN = false;
    unsigned char* ws; size_t dst;
    __device__ __forceinline__ void operator()(const f32x4 (&acc)[2][2][4][2], const Unit& u, int wr, int wc, int fr, int fq) const {
        const int pn = u.pn, col0 = pn * 256 + wc * 64 + 16 * fq;
        EPI_ROWS_BEGIN
            float s = 0.f; v4u w;
#pragma unroll
            for (int bj = 0; bj < 2; ++bj) { const f32x4 v0 = acc[ai][bj][m][0] * 0.015625f, v1 = acc[ai][bj][m][1] * 0.015625f;
                s += (v0[0] * v0[0] + v0[1] * v0[1]) + (v0[2] * v0[2] + v0[3] * v0[3]) + (v1[0] * v1[0] + v1[1] * v1[1]) + (v1[2] * v1[2] + v1[3] * v1[3]);
                w[2 * bj] = pk4_fp8(v0[0], v0[1], v0[2], v0[3]); w[2 * bj + 1] = pk4_fp8(v1[0], v1[1], v1[2], v1[3]); }
            *(v4u*)(ws + dst + (size_t)row * 1024 + col0) = w;
            s = sum_x16(s); s = sum_x32(s); if (fq == 0) ((float*)(ws + WS_SSQ))[(size_t)row * 16 + pn * 4 + wc] = s;
        EPI_ROWS_END
    }
};
struct EpiP1b {
    static constexpr bool PERM = true, AFTER_DRAIN = false;
    unsigned char* ws;
    __device__ __forceinline__ void operator()(const f32x4 (&acc)[2][2][4][2], const Unit& u, int wr, int wc, int fr, int fq) const {
        const int pn = u.pn;
        if (pn < 12) {
            bf16* base = (bf16*)(ws + WS_QM + (size_t)(pn >> 2) * U); const int col0 = (pn & 3) * 256 + wc * 32 + 8 * fq;
            EPI_ROWS_BEGIN
                bf16* rowp = base + (size_t)row * 1024 + col0;
#pragma unroll
                for (int bj = 0; bj < 2; ++bj) { const f32x4 v0 = acc[ai][bj][m][0], v1 = acc[ai][bj][m][1];
                    v4u w; w.x = cvtpk(v0[0], v0[1]); w.y = cvtpk(v0[2], v0[3]); w.z = cvtpk(v1[0], v1[1]); w.w = cvtpk(v1[2], v1[3]);
                    *(v4u*)(rowp + bj * HALF) = w; }
            EPI_ROWS_END
        } else if (wc < 2) {
#pragma unroll
            for (int ai = 0; ai < 2; ++ai) { f32x4 cs[4][2];
#pragma unroll
                for (int m = 0; m < 4; ++m) { const f32x2* rp = (const f32x2*)(ws + WS_ROPE) + seq_pos(EPI_ROW(ai, m)) * 32 + 16 * wc + 4 * fq; cs[m][0] = *(const f32x4*)rp; cs[m][1] = *(const f32x4*)(rp + 2); }
                EPI_FENCE;
#pragma unroll
                for (int m = 0; m < 4; ++m) { const f32x4 cs01 = cs[m][0], cs23 = cs[m][1]; const f32x4 a = acc[ai][0][m][0], b = acc[ai][0][m][1];
                    *(u32x2*)(ws + WS_KR + (size_t)EPI_ROW(ai, m) * 64 + 32 * wc + 8 * fq) = (u32x2){
                        pk4_fp8(a[0] * cs01[0] - a[1] * cs01[1], a[1] * cs01[0] + a[0] * cs01[1], a[2] * cs01[2] - a[3] * cs01[3], a[3] * cs01[2] + a[2] * cs01[3]),
                        pk4_fp8(b[0] * cs23[0] - b[1] * cs23[1], b[1] * cs23[0] + b[0] * cs23[1], b[2] * cs23[2] - b[3] * cs23[3], b[3] * cs23[2] + b[2] * cs23[3])};
                    EPI_FENCE; } }
        } else if (wc == 2) {
            EPI_ROWS_BEGIN
                float* gp = (float*)(ws + WS_KRG) + (size_t)row * 96 + 64 + 8 * fq;
                *(f32x4*)gp = acc[ai][0][m][0]; *(f32x4*)(gp + 4) = acc[ai][0][m][1];
            EPI_ROWS_END
        }
    }
};
struct EpiQ {
    static constexpr bool PERM = true, AFTER_DRAIN = false;
    unsigned char* ws;
    __device__ __forceinline__ void operator()(const f32x4 (&acc)[2][2][4][2], const Unit& u, int wr, int wc, int fr, int fq) const {
        const int col0 = u.pn * 256 + wc * 32 + 8 * fq;
#pragma unroll
        for (int ai = 0; ai < 2; ++ai) {
            f32x4 sq[4][2];
#pragma unroll
            for (int m = 0; m < 4; ++m) { const float* sp = (const float*)(ws + WS_SSQ) + (size_t)EPI_ROW(ai, m) * 16; sq[m][0] = *(const f32x4*)sp; sq[m][1] = *(const f32x4*)(sp + 4); }
            EPI_FENCE;
#pragma unroll
            for (int m = 0; m < 4; ++m) { const int row = EPI_ROW(ai, m); const f32x4 s0 = sq[m][0], s1 = sq[m][1];
                const float rs = 0.03125f / sqrtf(((s0[0] + s0[1]) + (s0[2] + s0[3]) + (s1[0] + s1[1]) + (s1[2] + s1[3])) * (1.0f / 512.0f) + EPS);
                bf16* rowp = (bf16*)(ws + WS_Q) + (size_t)row * NQ + col0;
#pragma unroll
                for (int bj = 0; bj < 2; ++bj) { const f32x4 v0 = acc[ai][bj][m][0] * rs, v1 = acc[ai][bj][m][1] * rs;
                    v4u w; w.x = cvtpk(v0[0], v0[1]); w.y = cvtpk(v0[2], v0[3]); w.z = cvtpk(v1[0], v1[1]); w.w = cvtpk(v1[2], v1[3]);
                    *(v4u*)(rowp + bj * HALF) = w; }
                EPI_FENCE; }
        }
    }
};
struct EpiK8 {
    static constexpr int PERM = 2; static constexpr bool AFTER_DRAIN = false;
    unsigned char* ws;
    __device__ __forceinline__ void operator()(const f32x4 (&acc)[2][2][4][2], const Unit& u, int wr, int wc, int fr, int fq) const {
        const int col0 = u.pn * 256 + wc * 64 + 16 * fq;
#pragma unroll
        for (int ai = 0; ai < 2; ++ai) {
            f32x4 sq[4][2];
#pragma unroll
            for (int m = 0; m < 4; ++m) { const float* sp = (const float*)(ws + WS_SSQ) + (size_t)EPI_ROW(ai, m) * 16 + 8; sq[m][0] = *(const f32x4*)sp; sq[m][1] = *(const f32x4*)(sp + 4); }
            EPI_FENCE;
#pragma unroll
            for (int m = 0; m < 4; ++m) { const int row = EPI_ROW(ai, m); const f32x4 s0 = sq[m][0], s1 = sq[m][1];
                const float rs = 0.03125f / sqrtf(((s0[0] + s0[1]) + (s0[2] + s0[3]) + (s1[0] + s1[1]) + (s1[2] + s1[3])) * (1.0f / 512.0f) + EPS);
                v4u w;
#pragma unroll
                for (int bj = 0; bj < 2; ++bj) { const f32x4 v0 = acc[ai][bj][m][0] * rs, v1 = acc[ai][bj][m][1] * rs;
                    w[2 * bj] = pk4_fp8(v0[0], v0[1], v0[2], v0[3]); w[2 * bj + 1] = pk4_fp8(v1[0], v1[1], v1[2], v1[3]); }
                *(v4u*)(ws + WS_K8 + (size_t)row * 1024 + col0) = w;
                EPI_FENCE; }
        }
    }
};
struct EpiVT {
    static constexpr int PERM = 2; static constexpr bool AFTER_DRAIN = false;
    unsigned char* ws;
    __device__ __forceinline__ void operator()(const f32x4 (&acc)[2][2][4][2], const Unit& u, int wr, int wc, int fr, int fq) const {
        const int tok0 = u.pn * 256 + wc * 64 + 16 * fq;
        const int J0 = 2 * fq, pos = 4 * (J0 & 3) + 16 * (J0 >> 2);
        f32x4 rq[2][2];
#pragma unroll
        for (int bj = 0; bj < 2; ++bj) { f32x4 sq[8][2];
#pragma unroll
            for (int e = 0; e < 8; ++e) { const float* sp = (const float*)(ws + WS_SSQ) + (size_t)(tok0 + 8 * bj + e) * 16 + 8; sq[e][0] = *(const f32x4*)sp; sq[e][1] = *(const f32x4*)(sp + 4); }
            EPI_FENCE;
#pragma unroll
            for (int e = 0; e < 8; ++e) { const f32x4 s0 = sq[e][0], s1 = sq[e][1];
                rq[bj][e >> 2][e & 3] = 0.03125f / sqrtf(((s0[0] + s0[1]) + (s0[2] + s0[3]) + (s1[0] + s1[1]) + (s1[2] + s1[3])) * (1.0f / 512.0f) + EPS); } }
        EPI_ROWS_BEGIN
            unsigned char* rowp = ws + WS_V8T + ((size_t)(tok0 >> 6) * 1024 + row) * 64 + pos;
            const f32x4 a0 = acc[ai][0][m][0] * rq[0][0], a1 = acc[ai][0][m][1] * rq[0][1], b0 = acc[ai][1][m][0] * rq[1][0], b1 = acc[ai][1][m][1] * rq[1][1];
            *(u32x2*)rowp = (u32x2){pk4_fp8(a0[0], a0[1], a0[2], a0[3]), pk4_fp8(b0[0], b0[1], b0[2], b0[3])};
            *(u32x2*)(rowp + 32) = (u32x2){pk4_fp8(a1[0], a1[1], a1[2], a1[3]), pk4_fp8(b1[0], b1[1], b1[2], b1[3])};
        EPI_ROWS_END
    }
};
struct EpiP2a {
    static constexpr int PERM = 2; static constexpr bool AFTER_DRAIN = false;
    unsigned char* ws; size_t sga;
    __device__ __forceinline__ void operator()(const f32x4 (&acc)[2][2][4][2], const Unit& u, int wr, int wc, int fr, int fq) const {
        const int pn = u.pn;
        if (pn < 4) {
            const int col0 = pn * 256 + wc * 64 + 16 * fq;
#pragma unroll
            for (int ai = 0; ai < 2; ++ai) { v4u ov[4][2];
#pragma unroll
              for (int m = 0; m < 4; ++m) { const bf16* orow = (const bf16*)(ws + WS_CQKV) + (size_t)EPI_ROW(ai, m) * 1024 + col0; ov[m][0] = *(const v4u*)orow; ov[m][1] = *(const v4u*)(orow + 8); }
              EPI_FENCE;
#pragma unroll
              for (int m = 0; m < 4; ++m) { const int row = EPI_ROW(ai, m); v4u w;
#pragma unroll
                for (int bj = 0; bj < 2; ++bj) { f32x4 v0 = acc[ai][bj][m][0] * 0.015625f, v1 = acc[ai][bj][m][1] * 0.015625f;
                    const v4u o = ov[m][bj];
#pragma unroll
                    for (int j = 0; j < 4; ++j) { v0[j] = 64.f * siluf_(v0[j]); v1[j] = 64.f * siluf_(v1[j]); }
                    v0[0] *= bflo(o.x); v0[1] *= bfhi(o.x); v0[2] *= bflo(o.y); v0[3] *= bfhi(o.y); v1[0] *= bflo(o.z); v1[1] *= bfhi(o.z); v1[2] *= bflo(o.w); v1[3] *= bfhi(o.w);
                    w[2 * bj] = pk4_fp8(v0[0], v0[1], v0[2], v0[3]); w[2 * bj + 1] = pk4_fp8(v1[0], v1[1], v1[2], v1[3]); }
                *(v4u*)(ws + WS_YA8 + (size_t)row * 1024 + col0) = w;
                EPI_FENCE; } }
        } else {
            const int col0 = (pn - 4) * 256 + wc * 64 + 16 * fq;
            EPI_ROWS_BEGIN
                bf16* rowp = (bf16*)(ws + sga) + (size_t)row * 2048 + col0;
#pragma unroll
                for (int bj = 0; bj < 2; ++bj) { f32x4 v0 = acc[ai][bj][m][0] * 0.015625f, v1 = acc[ai][bj][m][1] * 0.015625f;
#pragma unroll
                    for (int j = 0; j < 4; ++j) { v0[j] = sigmoidf_(v0[j]); v1[j] = sigmoidf_(v1[j]); }
                    v4u w; w.x = cvtpk(v0[0], v0[1]); w.y = cvtpk(v0[2], v0[3]); w.z = cvtpk(v1[0], v1[1]); w.w = cvtpk(v1[2], v1[3]);
                    *(v4u*)(rowp + 8 * bj) = w; }
            EPI_ROWS_END
        }
    }
};
struct EpiP2b {
    static constexpr bool PERM = true, AFTER_DRAIN = false;
    unsigned char* ws; int layer;
    __device__ __forceinline__ void operator()(const f32x4 (&acc)[2][2][4][2], const Unit& u, int wr_, int wc_, int fr_, int fq_) const {
        const int t_ = opaque_tid(), wr = t_ >> 8, wc = (t_ >> 6) & 3, fr = t_ & 15, fq = (t_ >> 4) & 3;
        const int pn = u.pn;
        if (pn < 8) {
            extern __shared__ __attribute__((aligned(16))) unsigned char lds[];
            LAS float* red = (LAS float*)((LAS unsigned char*)lds + 131072);
            const int colh = pn * 128 + wc * 32 + 8 * fq;
#pragma unroll
            for (int ai = 0; ai < 2; ++ai) { v4u ha[4], hb[4];
#pragma unroll
                for (int m = 0; m < 4; ++m) { const size_t off = (size_t)EPI_ROW(ai, m) * 1024 + colh; ha[m] = *(const v4u*)((const bf16*)(ws + WS_HFW) + off); hb[m] = *(const v4u*)((const bf16*)(ws + WS_HBW) + off); }
                EPI_FENCE;
#pragma unroll
                for (int m = 0; m < 4; ++m) { const v4u a = ha[m], b = hb[m]; float s = 0.f;
#pragma unroll
                    for (int e = 0; e < 4; ++e) { const float lo = bflo(a[e]) + bflo(b[e]), hi = bfhi(a[e]) + bfhi(b[e]); s += lo * lo + hi * hi; }
                    s = sum_x16(s); s = sum_x32(s);
                    if (fq == 0) red[(wr * 128 + ai * 64 + m * 16 + fr) * 4 + wc] = s; }
                EPI_FENCE; }
            LDS_WAIT(); __builtin_amdgcn_s_barrier(); asm volatile("" ::: "memory");
            const int t2_ = opaque_tid(), wr2 = t2_ >> 8, fr2 = t2_ & 15, colh2 = pn * 128 + ((t2_ >> 6) & 3) * 32 + 8 * ((t2_ >> 4) & 3);
#define EPI_ROW2(ai, m) (u.pm * BM + (ai) * HALF + wr2 * 64 + (m) * 16 + fr2)
            const float* gain = (const float*)(ws + WS_HG) + layer * 1024 + colh2; const f32x4 g0 = *(const f32x4*)gain, g1 = *(const f32x4*)(gain + 4);
#pragma unroll
            for (int ai = 0; ai < 2; ++ai)
#pragma unroll
              for (int mh = 0; mh < 2; ++mh) { v4u ha[2], hb[2];
#pragma unroll
                for (int mm = 0; mm < 2; ++mm) { const size_t off = (size_t)EPI_ROW2(ai, 2 * mh + mm) * 1024 + colh2; ha[mm] = *(const v4u*)((const bf16*)(ws + WS_HFW) + off); hb[mm] = *(const v4u*)((const bf16*)(ws + WS_HBW) + off); }
                EPI_FENCE;
#pragma unroll
                for (int mm = 0; mm < 2; ++mm) { const int m = 2 * mh + mm; const size_t off = (size_t)EPI_ROW2(ai, m) * 1024 + colh2;
                    const f32x4 pr = *(const LAS f32x4*)(red + (wr2 * 128 + ai * 64 + m * 16 + fr2) * 4);
                    const float rs = 1.0f / sqrtf(((pr[0] + pr[1]) + (pr[2] + pr[3])) * (1.0f / 128.0f) + EPS);
                    const v4u a = ha[mm], b = hb[mm];
                    const f32x4 o0 = acc[ai][0][m][0], o1 = acc[ai][0][m][1], z0 = acc[ai][1][m][0], z1 = acc[ai][1][m][1];
                    float y[8];
#pragma unroll
                    for (int e = 0; e < 4; ++e) { y[2 * e] = (bflo(a[e]) + bflo(b[e])) * rs; y[2 * e + 1] = (bfhi(a[e]) + bfhi(b[e])) * rs; }
#pragma unroll
                    for (int j = 0; j < 4; ++j) { y[j] *= g0[j] * sigmoidf_(o0[j]) * (z0[j] * sigmoidf_(z0[j])); y[4 + j] *= g1[j] * sigmoidf_(o1[j]) * (z1[j] * sigmoidf_(z1[j])); }
                    v4u w; w.x = cvtpk(y[0], y[1]); w.y = cvtpk(y[2], y[3]); w.z = cvtpk(y[4], y[5]); w.w = cvtpk(y[6], y[7]);
                    *(v4u*)((bf16*)(ws + WS_HFW) + off) = w;
                    EPI_FENCE; } }
        } else {
            const int col0 = (pn - 8) * 256 + wc * 32 + 8 * fq;
            EPI_ROWS_BEGIN
                bf16* rowp = (bf16*)(ws + WS_SGB) + (size_t)row * 2048 + col0;
#pragma unroll
                for (int bj = 0; bj < 2; ++bj) { f32x4 v0 = acc[ai][bj][m][0], v1 = acc[ai][bj][m][1];
#pragma unroll
                    for (int j = 0; j < 4; ++j) { v0[j] = sigmoidf_(v0[j]); v1[j] = sigmoidf_(v1[j]); }
                    v4u w; w.x = cvtpk(v0[0], v0[1]); w.y = cvtpk(v0[2], v0[3]); w.z = cvtpk(v1[0], v1[1]); w.w = cvtpk(v1[2], v1[3]);
                    *(v4u*)(rowp + bj * HALF) = w; }
            EPI_ROWS_END
        }
    }
};
struct MidMerge {
    unsigned char* ws;
    __device__ __forceinline__ void operator()(f32x4 (&acc)[2][2][4][2], const Unit& u, int wr, int wc, int fr, int fq) const {
        const int col0 = u.pn * 256 + wc * 32 + 8 * fq;
#pragma unroll
        for (int ai = 0; ai < 2; ++ai)
#pragma unroll
          for (int mh = 0; mh < 2; ++mh) {
            v4u ga[2][2], gb[2][2];
#pragma unroll
            for (int mm = 0; mm < 2; ++mm)
#pragma unroll
                for (int bj = 0; bj < 2; ++bj) { const size_t off = (size_t)EPI_ROW(ai, 2 * mh + mm) * DM + col0 + bj * HALF; ga[mm][bj] = *(const v4u*)((const bf16*)(ws + WS_SGA) + off); gb[mm][bj] = *(const v4u*)((const bf16*)(ws + WS_SGB) + off); }
            EPI_FENCE;
#pragma unroll
            for (int mm = 0; mm < 2; ++mm)
#pragma unroll
                for (int bj = 0; bj < 2; ++bj) { const int m = 2 * mh + mm; const v4u a = ga[mm][bj], b = gb[mm][bj]; float r[8];
#pragma unroll
                    for (int e = 0; e < 4; ++e) { r[2 * e] = 2048.f * bflo(b[e]) * __builtin_amdgcn_rcpf(fmaxf(bflo(a[e]), 9.094947e-13f)); r[2 * e + 1] = 2048.f * bfhi(b[e]) * __builtin_amdgcn_rcpf(fmaxf(bfhi(a[e]), 9.094947e-13f)); }
                    f32x4 v0 = acc[ai][bj][m][0], v1 = acc[ai][bj][m][1];
                    v0[0] *= r[0]; v0[1] *= r[1]; v0[2] *= r[2]; v0[3] *= r[3]; v1[0] *= r[4]; v1[1] *= r[5]; v1[2] *= r[6]; v1[3] *= r[7];
                    acc[ai][bj][m][0] = v0; acc[ai][bj][m][1] = v1; }
            EPI_FENCE;
          }
    }
};
struct EpiMerge2 {
    static constexpr bool PERM = true, AFTER_DRAIN = false;
    unsigned char* ws;
    __device__ __forceinline__ void operator()(const f32x4 (&acc)[2][2][4][2], const Unit& u, int wr, int wc, int fr, int fq) const {
        const int col0 = u.pn * 256 + wc * 32 + 8 * fq; bf16* T = (bf16*)(ws + WS_MG);
#pragma unroll
        for (int ai = 0; ai < 2; ++ai) {
            v4u gv[4][2];
#pragma unroll
            for (int m = 0; m < 4; ++m)
#pragma unroll
                for (int bj = 0; bj < 2; ++bj) gv[m][bj] = *(const v4u*)((const bf16*)(ws + WS_SGA) + (size_t)EPI_ROW(ai, m) * DM + col0 + bj * HALF);
            EPI_FENCE;
#pragma unroll
            for (int m = 0; m < 4; ++m) { const size_t off = (size_t)EPI_ROW(ai, m) * DM + col0;
#pragma unroll
                for (int bj = 0; bj < 2; ++bj) { f32x4 v0 = acc[ai][bj][m][0] * 0.00048828125f, v1 = acc[ai][bj][m][1] * 0.00048828125f; const v4u g = gv[m][bj];
                    v0[0] *= fmaxf(bflo(g.x), 9.094947e-13f); v0[1] *= fmaxf(bfhi(g.x), 9.094947e-13f); v0[2] *= fmaxf(bflo(g.y), 9.094947e-13f); v0[3] *= fmaxf(bfhi(g.y), 9.094947e-13f);
                    v1[0] *= fmaxf(bflo(g.z), 9.094947e-13f); v1[1] *= fmaxf(bfhi(g.z), 9.094947e-13f); v1[2] *= fmaxf(bflo(g.w), 9.094947e-13f); v1[3] *= fmaxf(bfhi(g.w), 9.094947e-13f);
                    v4u w; w.x = cvtpk(v0[0], v0[1]); w.y = cvtpk(v0[2], v0[3]); w.z = cvtpk(v1[0], v1[1]); w.w = cvtpk(v1[2], v1[3]);
                    *(v4u*)(T + off + bj * HALF) = w; }
                EPI_FENCE; }
        }
    }
};
template <bool LAST> struct EpiOutX {
    static constexpr bool PERM = true, AFTER_DRAIN = false;
    const float* xp; const float* xs; float* out; unsigned char* ws; const float* gn; int layer;
    __device__ __forceinline__ void operator()(f32x4 (&acc)[2][2][4][2], const Unit& u, int wr, int wc, int fr, int fq) const {
        extern __shared__ __attribute__((aligned(16))) unsigned char lds[];
        LAS float* red = (LAS float*)((LAS unsigned char*)lds + 131072);
        const int col0 = u.pn * 256 + wc * 32 + 8 * fq;
#pragma unroll
        for (int ai = 0; ai < 2; ++ai) {
            f32x4 xv[4][2][2];
#pragma unroll
            for (int m = 0; m < 4; ++m) { const int row = EPI_ROW(ai, m);
                const float* xr = (layer == 0 ? (row < MPROMPT ? xp + (size_t)row * DM : xs + (size_t)(row - MPROMPT) * DM) : out + (size_t)row * DM) + col0;
#pragma unroll
                for (int bj = 0; bj < 2; ++bj)
#pragma unroll
                    for (int n = 0; n < 2; ++n) xv[m][bj][n] = *(const f32x4*)(xr + bj * HALF + n * 4); }
            EPI_FENCE;
#pragma unroll
            for (int m = 0; m < 4; ++m) { float s = 0.f;
#pragma unroll
                for (int bj = 0; bj < 2; ++bj)
#pragma unroll
                    for (int n = 0; n < 2; ++n) { const f32x4 v = xv[m][bj][n] + acc[ai][bj][m][n]; acc[ai][bj][m][n] = v; s += (v[0] * v[0] + v[1] * v[1]) + (v[2] * v[2] + v[3] * v[3]); }
                s = sum_x16(s); s = sum_x32(s);
                if (fq == 0) red[(wr * 128 + ai * 64 + m * 16 + fr) * 4 + wc] = s; }
            EPI_FENCE;
        }
        LDS_WAIT(); __builtin_amdgcn_s_barrier(); asm volatile("" ::: "memory");
        const int t_ = opaque_tid();
        if (t_ < 256) { const int wr_t = t_ >> 7, rl = t_ & 127; const f32x4 pr = *(const LAS f32x4*)(red + (wr_t * 128 + rl) * 4);
            const int row_t = u.pm * BM + (rl >> 6) * HALF + wr_t * 64 + (rl & 63);
            __hip_atomic_store((float*)(ws + WS_SSF) + (size_t)row_t * 8 + u.pn, (pr[0] + pr[1]) + (pr[2] + pr[3]), __ATOMIC_RELAXED, __HIP_MEMORY_SCOPE_AGENT); }
        asm volatile("s_waitcnt vmcnt(0)" ::: "memory");
        __syncthreads();
        if (t_ == 0) { unsigned* cnt = (unsigned*)(ws + WS_CTL) + CW_PANEL + layer * 256 + u.pm;
            __hip_atomic_fetch_add(cnt, 1u, __ATOMIC_RELAXED, __HIP_MEMORY_SCOPE_AGENT);
            unsigned sp = 0; while (__hip_atomic_load(cnt, __ATOMIC_RELAXED, __HIP_MEMORY_SCOPE_AGENT) < 8u && ++sp < (1u << 22)) __builtin_amdgcn_s_sleep(1);
            __builtin_amdgcn_fence(__ATOMIC_ACQUIRE, "agent"); asm volatile("s_waitcnt vmcnt(0)" ::: "memory"); }
        __syncthreads();
        const int t2_ = opaque_tid(), wr2 = t2_ >> 8, fr2 = t2_ & 15, colb = u.pn * 256 + ((t2_ >> 6) & 3) * 32 + 8 * ((t2_ >> 4) & 3);
        f32x4 g[2][2];
#pragma unroll
        for (int bj = 0; bj < 2; ++bj) { g[bj][0] = *(const f32x4*)(gn + colb + bj * HALF); g[bj][1] = *(const f32x4*)(gn + colb + bj * HALF + 4); }
#pragma unroll
        for (int ai = 0; ai < 2; ++ai) { f32x4 sf[4][2];
#pragma unroll
            for (int m = 0; m < 4; ++m) { const float* sp = (const float*)(ws + WS_SSF) + (size_t)(u.pm * BM + ai * HALF + wr2 * 64 + m * 16 + fr2) * 8; sf[m][0] = *(const f32x4*)sp; sf[m][1] = *(const f32x4*)(sp + 4); }
            EPI_FENCE;
#pragma unroll
            for (int m = 0; m < 4; ++m) { const int row = u.pm * BM + ai * HALF + wr2 * 64 + m * 16 + fr2; const f32x4 a = sf[m][0], b = sf[m][1];
                const float rs = 1.0f / sqrtf((((a[0] + a[1]) + (a[2] + a[3])) + ((b[0] + b[1]) + (b[2] + b[3]))) * (1.0f / DM) + EPS);
                float* orow = out + (size_t)row * DM + colb;
#pragma unroll
                for (int bj = 0; bj < 2; ++bj) {
                    const f32x4 y0 = acc[ai][bj][m][0], y1 = acc[ai][bj][m][1]; const f32x4 n0 = y0 * rs * g[bj][0], n1 = y1 * rs * g[bj][1];
                    if constexpr (LAST) { *(f32x4*)(orow + bj * HALF) = n0; *(f32x4*)(orow + bj * HALF + 4) = n1; }
                    else { *(f32x4*)(orow + bj * HALF) = y0; *(f32x4*)(orow + bj * HALF + 4) = y1;
                        v4u w; w.x = cvtpk(n0[0], n0[1]); w.y = cvtpk(n0[2], n0[3]); w.z = cvtpk(n1[0], n1[1]); w.w = cvtpk(n1[2], n1[3]);
                        *(v4u*)((bf16*)(ws + WS_XN) + (size_t)row * DM + colb + bj * HALF) = w;
                        *(u32x2*)(ws + WS_XN8 + (size_t)row * DM + colb + bj * HALF) = (u32x2){pk4_fp8(n0[0], n0[1], n0[2], n0[3]), pk4_fp8(n1[0], n1[1], n1[2], n1[3])}; } }
                EPI_FENCE; } }
    }
};
struct EpiOut {
    static constexpr bool PERM = false, AFTER_DRAIN = false;
    const float* xp; const float* xs; float* out; int layer;
    __device__ __forceinline__ void operator()(const f32x4 (&acc)[2][2][4][2], const Unit& u, int wr, int wc, int fr, int fq) const {
        const int col0 = u.pn * 256 + wc * 32 + 4 * fq;
#pragma unroll
        for (int ai = 0; ai < 2; ++ai) {
            f32x4 xv[4][2][2];
#pragma unroll
            for (int m = 0; m < 4; ++m) { const int row = EPI_ROW(ai, m);
                const float* xr = (layer == 0 ? (row < MPROMPT ? xp + (size_t)row * DM : xs + (size_t)(row - MPROMPT) * DM) : out + (size_t)row * DM) + col0;
#pragma unroll
                for (int bj = 0; bj < 2; ++bj)
#pragma unroll
                    for (int n = 0; n < 2; ++n) xv[m][bj][n] = *(const f32x4*)(xr + bj * HALF + n * 16); }
            EPI_FENCE;
#pragma unroll
            for (int m = 0; m < 4; ++m) { float* orow = out + (size_t)EPI_ROW(ai, m) * DM + col0;
#pragma unroll
                for (int bj = 0; bj < 2; ++bj)
#pragma unroll
                    for (int n = 0; n < 2; ++n) *(f32x4*)(orow + bj * HALF + n * 16) = xv[m][bj][n] + acc[ai][bj][m][n];
                EPI_FENCE; }
        }
    }
};

namespace att8 {
constexpr int NW = 8, QBLK = 32, KVBLK = 64;
constexpr float CL2 = 0.07216878364870322f * 1.4426950408889634f;
constexpr float QSC = CL2 * 8.0f;
constexpr float BIAS = 7.0f, THR = 1.5f;
constexpr int NB = 3, SZ_KN = 64 * 128, SZ_KR = 64 * 64, SZ_VT = 128 * 64;
constexpr int OFF_KN = 0, OFF_KR = OFF_KN + NB * SZ_KN, OFF_VT = OFF_KR + NB * SZ_KR, OFF_WS = OFF_VT + NB * SZ_VT, SHM_ATTN = OFF_WS + NW * 64 * 4;
typedef int v8i __attribute__((ext_vector_type(8)));
__device__ __forceinline__ int crow(int r, int hi) { return (r & 3) + 8 * (r >> 2) + 4 * hi; }
#define SBAR8() __builtin_amdgcn_sched_barrier(0)
__device__ __forceinline__ v8i ld2x16(const char* pa, const char* pb) { const v4u a = *reinterpret_cast<const v4u*>(pa), b = *reinterpret_cast<const v4u*>(pb); return (v8i){(int)a.x, (int)a.y, (int)a.z, (int)a.w, (int)b.x, (int)b.y, (int)b.z, (int)b.w}; }
#define MFMA8(A, B, Cc) __builtin_amdgcn_mfma_scale_f32_32x32x64_f8f6f4(A, B, Cc, 0, 0, 0, 0, 0, 0)

template <int VAR = 0>
__device__ __forceinline__ void attn_unit(const bf16* __restrict__ Qn, const bf16* __restrict__ Qr, const unsigned char* __restrict__ K8, const unsigned char* __restrict__ KR8,
                                          const unsigned char* __restrict__ V8T, bf16* __restrict__ Ob, int seq, const f32x2* __restrict__ rope, int qpos0, char* lds) {
  const int tid = opaque_tid(), wid = tid >> 6, lane = tid & 63, r32 = lane & 31, hi = lane >> 5;
  const int wv = __builtin_amdgcn_readfirstlane(wid);
  float* ws = (float*)(lds + OFF_WS) + wid * 64; float* li_l = ws; float* al_l = ws + 32;
  v8i qf[3];
  { const bf16* Qw = Qn + (long)(wid * QBLK + r32) * NQ;
#pragma unroll
    for (int ks = 0; ks < 2; ++ks) {
#pragma unroll
      for (int c = 0; c < 4; ++c) { const v4u raw = *reinterpret_cast<const v4u*>(Qw + 64 * ks + 32 * hi + 8 * c);
        qf[ks][2 * c] = (int)pk4_fp8(bflo(raw.x) * QSC, bfhi(raw.x) * QSC, bflo(raw.y) * QSC, bfhi(raw.y) * QSC);
        qf[ks][2 * c + 1] = (int)pk4_fp8(bflo(raw.z) * QSC, bfhi(raw.z) * QSC, bflo(raw.w) * QSC, bfhi(raw.w) * QSC); } }
    const bf16* Rw = Qr + (long)(wid * QBLK + r32) * NQ + 32 * hi;
    const f32x2* rp = rope + (qpos0 + wid * QBLK + r32) * 32 + 16 * hi;
#pragma unroll
    for (int c = 0; c < 4; ++c) { const v4u raw = *reinterpret_cast<const v4u*>(Rw + 8 * c);
      const f32x4 cs01 = *(const f32x4*)(rp + 4 * c), cs23 = *(const f32x4*)(rp + 4 * c + 2);
      float a0, a1, a2, a3, a4, a5, a6, a7;
      { const float x1 = bflo(raw.x), x2 = bfhi(raw.x); a0 = x1 * cs01[0] - x2 * cs01[1]; a1 = x2 * cs01[0] + x1 * cs01[1]; }
      { const float x1 = bflo(raw.y), x2 = bfhi(raw.y); a2 = x1 * cs01[2] - x2 * cs01[3]; a3 = x2 * cs01[2] + x1 * cs01[3]; }
      { const float x1 = bflo(raw.z), x2 = bfhi(raw.z); a4 = x1 * cs23[0] - x2 * cs23[1]; a5 = x2 * cs23[0] + x1 * cs23[1]; }
      { const float x1 = bflo(raw.w), x2 = bfhi(raw.w); a6 = x1 * cs23[2] - x2 * cs23[3]; a7 = x2 * cs23[2] + x1 * cs23[3]; }
      qf[2][2 * c] = (int)pk4_fp8(a0 * QSC, a1 * QSC, a2 * QSC, a3 * QSC); qf[2][2 * c + 1] = (int)pk4_fp8(a4 * QSC, a5 * QSC, a6 * QSC, a7 * QSC); } }
  const int dk_key = 8 * wv + (lane >> 3), dr_key = 16 * (wv & 3) + (lane >> 2), dv_d = 16 * wv + (lane >> 2);
  const unsigned char* gk = K8 + (long)dk_key * 1024 + (((lane & 7) ^ ((dk_key >> 1) & 7)) << 4);
  const unsigned char* gr = KR8 + (long)dr_key * 64 + (((lane & 3) ^ ((dr_key >> 2) & 3)) << 4);
  const unsigned char* gv = V8T + (long)dv_d * 64 + (((lane & 3) ^ ((dv_d >> 2) & 3)) << 4);
  LAS unsigned char* ldsa = (LAS unsigned char*)lds;
#define DMA8(tk, bk, tv, bv) do { if constexpr (VAR & 8) break; \
    __builtin_amdgcn_global_load_lds((const unsigned*)(gk + (long)(tk) * (KVBLK * 1024)), (LAS unsigned*)(ldsa + OFF_KN + (bk) * SZ_KN + wv * 1024), 16, 0, 0); \
    __builtin_amdgcn_global_load_lds((const unsigned*)(gr + (long)(tk) * (KVBLK * 64)), (LAS unsigned*)(ldsa + OFF_KR + (bk) * SZ_KR + (wv & 3) * 1024), 16, 0, 0); \
    __builtin_amdgcn_global_load_lds((const unsigned*)(gv + (long)(tv) * (KVBLK * 1024)), (LAS unsigned*)(ldsa + OFF_VT + (bv) * SZ_VT + wv * 1024), 16, 0, 0); } while (0)
#define TBAR8() do { if constexpr (!(VAR & 8)) asm volatile("s_waitcnt vmcnt(3)" ::: "memory"); if constexpr (VAR & 16) break; asm volatile("s_waitcnt lgkmcnt(0)" ::: "memory"); __builtin_amdgcn_s_barrier(); asm volatile("" ::: "memory"); } while (0)
  const int g8 = (r32 >> 1) & 7, g4 = (r32 >> 2) & 3;
  const int kn0 = r32 * 128 + (((2 * hi) ^ g8) << 4), kn1 = r32 * 128 + (((2 * hi + 1) ^ g8) << 4);
  const int rv0 = r32 * 64 + (((2 * hi) ^ g4) << 4), rv1 = r32 * 64 + (((2 * hi + 1) ^ g4) << 4);
  float nm = BIAS, l_reg = 0.f;
  const f32x16 zero16 = {}; f32x16 o[4] = {};
  const int NT = seq / KVBLK;
#define EXPR8(P, ra, rb) do { if constexpr (VAR & 2) break; _Pragma("unroll") for (int r = (ra); r < (rb); ++r) P[r] = __builtin_amdgcn_exp2f(fmaf(P[r], 0.125f, nm)); } while (0)
#define QKM8(A, B, Cc) ((VAR & 1) ? ({ f32x16 t_ = Cc; asm volatile("" : "+v"(t_) : "v"(A)); t_; }) : MFMA8(A, B, Cc))
#define PVM8(A, B, Cc) ((VAR & 4) ? ({ f32x16 t_ = Cc; asm volatile("" : "+v"(t_) : "v"(B)); t_; }) : MFMA8(A, B, Cc))
#define CVT8(P, PK, base) _Pragma("unroll") for (int q = 0; q < 4; ++q) { int w_ = __builtin_amdgcn_cvt_pk_fp8_f32(P[4 * q], P[4 * q + 1], 0, false); w_ = __builtin_amdgcn_cvt_pk_fp8_f32(P[4 * q + 2], P[4 * q + 3], w_, true); PK[(base) + q] = w_; }
#define TRIP8(KB, VB, PKIN, PKOUT, DO_PV, FIRST) do { \
    const char* kn_ = lds + OFF_KN + (KB) * SZ_KN; const char* kr_ = lds + OFF_KR + (KB) * SZ_KR; const char* vt_ = lds + OFF_VT + (VB) * SZ_VT; \
    v8i f0 = ld2x16(kn_ + kn0, kn_ + kn1), f1 = ld2x16(kn_ + (kn0 ^ 64), kn_ + (kn1 ^ 64)), f2 = ld2x16(kr_ + rv0, kr_ + rv1); SBAR8(); \
    p0 = QKM8(f0, qf[0], zero16); f0 = ld2x16(kn_ + kn0 + 4096, kn_ + kn1 + 4096); SBAR8(); \
    p0 = QKM8(f1, qf[1], p0); f1 = ld2x16(kn_ + (kn0 ^ 64) + 4096, kn_ + (kn1 ^ 64) + 4096); SBAR8(); \
    p0 = QKM8(f2, qf[2], p0); f2 = ld2x16(kr_ + rv0 + 2048, kr_ + rv1 + 2048); SBAR8(); \
    p1 = QKM8(f0, qf[0], zero16); if constexpr (DO_PV) f0 = ld2x16(vt_ + rv0, vt_ + rv1); SBAR8(); \
    float mx0 = p0[0]; _Pragma("unroll") for (int r = 1; r < 16; ++r) mx0 = fmaxf(mx0, p0[r]); \
    EXPR8(p0, 0, 4); SBAR8(); \
    p1 = QKM8(f1, qf[1], p1); if constexpr (DO_PV) f1 = ld2x16(vt_ + rv0 + 2048, vt_ + rv1 + 2048); SBAR8(); \
    EXPR8(p0, 4, 10); SBAR8(); \
    p1 = QKM8(f2, qf[2], p1); if constexpr (DO_PV) f2 = ld2x16(vt_ + rv0 + 4096, vt_ + rv1 + 4096); SBAR8(); \
    EXPR8(p0, 10, 16); SBAR8(); \
    if constexpr (DO_PV) { o[0] = PVM8(PKIN, f0, o[0]); f0 = ld2x16(vt_ + rv0 + 6144, vt_ + rv1 + 6144); } SBAR8(); \
    float mx1 = p1[0]; _Pragma("unroll") for (int r = 1; r < 16; ++r) mx1 = fmaxf(mx1, p1[r]); \
    EXPR8(p1, 0, 4); SBAR8(); \
    if constexpr (DO_PV) o[1] = PVM8(PKIN, f1, o[1]); SBAR8(); \
    EXPR8(p1, 4, 10); SBAR8(); \
    if constexpr (DO_PV) o[2] = PVM8(PKIN, f2, o[2]); SBAR8(); \
    EXPR8(p1, 10, 16); SBAR8(); \
    if constexpr (DO_PV) o[3] = PVM8(PKIN, f0, o[3]); SBAR8(); \
    float ps = 0.f; _Pragma("unroll") for (int r = 0; r < 16; ++r) ps += p0[r]; \
    if constexpr (!(FIRST)) { CVT8(p0, PKOUT, 0); } \
    float mx = fmaxf(mx0, mx1); \
    { auto rr = __builtin_amdgcn_permlane32_swap(__float_as_uint(mx), __float_as_uint(mx), false, false); mx = fmaxf(__uint_as_float(rr[0]), __uint_as_float(rr[1])); } \
    mx = fmaf(mx, 0.125f, nm); \
    if ((FIRST) || !__all(mx <= BIAS + THR)) { \
      const float delta = (FIRST) ? (mx - BIAS) : fmaxf(mx - BIAS, 0.f); \
      const float alpha = __builtin_amdgcn_exp2f(-delta); \
      nm -= delta; l_reg *= alpha; ps *= alpha; \
      _Pragma("unroll") for (int r = 0; r < 16; ++r) { p0[r] *= alpha; p1[r] *= alpha; } \
      CVT8(p0, PKOUT, 0); \
      if constexpr (!(FIRST)) { if (hi == 0) al_l[r32] = alpha; asm volatile("s_waitcnt lgkmcnt(0)" ::: "memory"); \
        _Pragma("unroll") for (int d = 0; d < 4; ++d) _Pragma("unroll") for (int r = 0; r < 16; ++r) o[d][r] *= al_l[crow(r, hi)]; } \
    } \
    _Pragma("unroll") for (int r = 0; r < 16; ++r) ps += p1[r]; \
    CVT8(p1, PKOUT, 4); \
    { auto rr = __builtin_amdgcn_permlane32_swap(__float_as_uint(ps), __float_as_uint(ps), false, false); ps = __uint_as_float(rr[0]) + __uint_as_float(rr[1]); } \
    l_reg += ps; } while (0)
  f32x16 p0, p1; v8i pkp, pkq;
#define TCL(t) ((t) < NT ? (t) : NT - 1)
  asm volatile("s_waitcnt vmcnt(0)" ::: "memory");
  DMA8(0, 0, 0, 0); DMA8(1, 1, 0, 0);
  TBAR8();
  DMA8(2, 2, 1, 1);
  TRIP8(0, 0, pkq, pkp, false, true);
  TBAR8();
  int kb = 1, vb = 0;
  for (int j = 1; j < NT; j += 2) {
    { const int kb2 = kb == 0 ? 2 : kb - 1, vb2 = vb == 0 ? 2 : vb - 1;
      DMA8(TCL(j + 2), kb2, TCL(j + 1), vb2);
      TRIP8(kb, vb, pkp, pkq, true, false);
      TBAR8(); vb = kb; kb = kb == 2 ? 0 : kb + 1; }
    if (j + 1 < NT) {
      const int kb2 = kb == 0 ? 2 : kb - 1, vb2 = vb == 0 ? 2 : vb - 1;
      DMA8(TCL(j + 3), kb2, TCL(j + 2), vb2);
      TRIP8(kb, vb, pkq, pkp, true, false);
      TBAR8(); vb = kb; kb = kb == 2 ? 0 : kb + 1;
    }
  }
  { const char* vt_ = lds + OFF_VT + vb * SZ_VT;
    const v8i v0_ = ld2x16(vt_ + rv0, vt_ + rv1), v1_ = ld2x16(vt_ + rv0 + 2048, vt_ + rv1 + 2048), v2_ = ld2x16(vt_ + rv0 + 4096, vt_ + rv1 + 4096), v3_ = ld2x16(vt_ + rv0 + 6144, vt_ + rv1 + 6144);
    o[0] = PVM8(pkq, v0_, o[0]); o[1] = PVM8(pkq, v1_, o[1]); o[2] = PVM8(pkq, v2_, o[2]); o[3] = PVM8(pkq, v3_, o[3]); }
#undef TCL
  if (hi == 0) li_l[r32] = l_reg; asm volatile("s_waitcnt lgkmcnt(0)" ::: "memory");
  float rli[16];
#pragma unroll
  for (int r = 0; r < 16; ++r) rli[r] = __builtin_amdgcn_rcpf(li_l[crow(r, hi)]);
  bf16* Ow = Ob + (long)(wid * QBLK) * 1024;
#pragma unroll
  for (int r = 0; r < 16; ++r) { const int orow = crow(r, hi);
#pragma unroll
    for (int d0 = 0; d0 < 4; ++d0) Ow[(long)orow * 1024 + d0 * 32 + r32] = (bf16)(cvtpk(o[d0][r] * rli[r], 0.f) & 0xffffu); }
  asm volatile("s_waitcnt vmcnt(0)" ::: "memory");
  __syncthreads();
#undef DMA8
#undef TBAR8
#undef TRIP8
#undef QKM8
#undef PVM8
#undef EXPR8
#undef CVT8
}
#undef MFMA8
}

namespace ml {
constexpr int PITCH = 288, TILE = 64 * PITCH;
constexpr int OFF_Q = 0, OFF_K = 2 * TILE, OFF_V = 4 * TILE;
constexpr int PPITCH = 144, OFF_P = 6 * TILE;
constexpr int OFF_SC = OFF_P + 64 * PPITCH;
constexpr int OFF_RSP = OFF_SC + 8 * 2 * 5 * 256;
constexpr int OFF_QN = OFF_RSP + 1024;
constexpr int OFF_NBF = OFF_QN + 256;
constexpr int OFF_CH = OFF_NBF + 512;
constexpr int LDS_END = OFF_CH + 5 * 1024;
static_assert(LDS_END <= MISC_OFF, "mLSTM LDS map");
__device__ __forceinline__ int rho(int t) { return (t & ~12) | ((t & 4) << 1) | ((t & 8) >> 1); }
typedef short v4i16_t __attribute__((ext_vector_type(4)));
__device__ __forceinline__ bf16x8 trfrag(LAS const unsigned char* tile, int tbase, int c0, int lane) {
    const int g = lane >> 4, li = lane & 15;
#if ML_FAST_TR
    const int q = li >> 2, p = li & 3;
    const s16x4 lo = __builtin_bit_cast(s16x4, __builtin_amdgcn_ds_read_tr16_b64_v4i16((LAS v4i16_t*)(tile + rho(tbase + 8 * g + q) * PITCH + (c0 + 4 * p) * 2)));
    const s16x4 hi = __builtin_bit_cast(s16x4, __builtin_amdgcn_ds_read_tr16_b64_v4i16((LAS v4i16_t*)(tile + rho(tbase + 8 * g + 4 + q) * PITCH + (c0 + 4 * p) * 2)));
    return (bf16x8){lo[0], lo[1], lo[2], lo[3], hi[0], hi[1], hi[2], hi[3]};
#else
    bf16x8 r;
#pragma unroll
    for (int i = 0; i < 8; ++i) r[i] = *(LAS const short*)(tile + rho(tbase + 8 * g + i) * PITCH + (c0 + li) * 2);
    return r;
#endif
}
__device__ __forceinline__ float logsigmoid(float x) { return fminf(x, 0.f) - log1pf(expf(-fabsf(x))); }

__device__ __forceinline__ void mlstm_item(LAS unsigned char* lds, const bf16* __restrict__ QM, const bf16* __restrict__ KM, const bf16* __restrict__ VM, const float* __restrict__ KRG, const float* __restrict__ BG,
                                           float* SCR, bf16* __restrict__ H, int row0, int S, int dir, int h) {
    const int tid = opaque_tid(), lane = tid & 63, w = __builtin_amdgcn_readfirstlane(tid >> 6), g = lane >> 4, li = lane & 15;
    const int NC = S / 64, hc = h * 128;
    const int srow = tid >> 3, scol = (tid & 7) * 16;
    LAS float* sc = (LAS float*)(lds + OFF_SC) + w * 640;
    LAS float* RSP = (LAS float*)(lds + OFF_RSP); LAS float* QNl = (LAS float*)(lds + OFF_QN);
#define ML_ROW(c, t) (dir ? (row0 + S - 1 - (64 * (c) + (t))) : (row0 + 64 * (c) + (t)))
    float* scr = SCR + ((size_t)(dir * 8 + h) * MTOK + row0) * 5;
    LAS float* CHG = (LAS float*)(lds + OFF_CH); LAS float* CHU = CHG + 256; LAS float* CHM = CHG + 512; LAS float* CHAO = CHG + 768; LAS float* CHAN = CHG + 1024;
    for (int c = w; c < NC; c += 8) {
        const float* gp = KRG + (size_t)ML_ROW(c, lane) * 96 + 64;
        const float li_ = gp[dir * 8 + h] + BG[dir * 8 + h], lf = logsigmoid(gp[16 + dir * 8 + h] + BG[16 + dir * 8 + h]);
        float bsum = lf;
#pragma unroll
        for (int o = 1; o < 64; o <<= 1) { const float v = __int_as_float(__builtin_amdgcn_ds_bpermute(((lane - o) & 63) << 2, __float_as_int(bsum))); if (lane >= o) bsum += v; }
        const float uu = li_ - bsum; float pm = uu;
#pragma unroll
        for (int o = 1; o < 64; o <<= 1) { const float v = __int_as_float(__builtin_amdgcn_ds_bpermute(((lane - o) & 63) << 2, __float_as_int(pm))); if (lane >= o) pm = fmaxf(pm, v); }
        float* sp = scr + (size_t)c * 320 + lane;
        sp[0] = uu; sp[64] = pm; sp[128] = bsum;
        if (lane == 63) { CHG[c] = bsum; CHU[c] = pm; }
    }
    __syncthreads();
    if (w == 0) {
        float m = 0.f;
        for (int c = 0; c < NC; ++c) { const float gch = CHG[c], um = CHU[c]; const float m_loc = gch + um, m_new = fmaxf(gch + m, m_loc);
            if (lane == 0) { CHM[c] = m; CHAO[c] = expf(gch + m - m_new); CHAN[c] = expf(m_loc - m_new); }
            m = m_new; }
    }
    __syncthreads();
    for (int c = w; c < NC; c += 8) {
        float* sp = scr + (size_t)c * 320 + lane;
        const float uu = sp[0], pm = sp[64], bsum = sp[128]; const float mp = CHM[c], um = CHU[c], an = CHAN[c];
        const float Mj = fmaxf(mp, pm);
        sp[64] = Mj; sp[128] = expf(uu - um) * an; sp[192] = expf(mp - Mj); sp[256] = expf(-(bsum + Mj));
    }
    asm volatile("s_waitcnt vmcnt(0)" ::: "memory");
    __syncthreads();
    f32x4 X[8]; f32x4 nst = {0.f, 0.f, 0.f, 0.f};
#pragma unroll
    for (int d = 0; d < 8; ++d) X[d] = (f32x4){0.f, 0.f, 0.f, 0.f};
    v4u stq[2], stk[2], stv[2]; float scv[5];
#define ML_LOAD(c) do { const size_t go = (size_t)ML_ROW(c, srow) * 1024 + hc + scol; \
        stq[0] = *(const v4u*)(QM + go); stq[1] = *(const v4u*)(QM + go + 8); stk[0] = *(const v4u*)(KM + go); stk[1] = *(const v4u*)(KM + go + 8); \
        stv[0] = *(const v4u*)(VM + go); stv[1] = *(const v4u*)(VM + go + 8); \
        _Pragma("unroll") for (int k_ = 0; k_ < 5; ++k_) scv[k_] = __hip_atomic_load(scr + (size_t)(c) * 320 + k_ * 64 + lane, __ATOMIC_RELAXED, __HIP_MEMORY_SCOPE_AGENT); } while (0)
#define ML_WRITE(b) do { const int lo_ = rho(srow) * PITCH + scol * 2; \
        *(LAS v4u*)(lds + OFF_Q + (b) * TILE + lo_) = stq[0]; *(LAS v4u*)(lds + OFF_Q + (b) * TILE + lo_ + 16) = stq[1]; \
        *(LAS v4u*)(lds + OFF_K + (b) * TILE + lo_) = stk[0]; *(LAS v4u*)(lds + OFF_K + (b) * TILE + lo_ + 16) = stk[1]; \
        *(LAS v4u*)(lds + OFF_V + (b) * TILE + lo_) = stv[0]; *(LAS v4u*)(lds + OFF_V + (b) * TILE + lo_ + 16) = stv[1]; \
        _Pragma("unroll") for (int k_ = 0; k_ < 5; ++k_) sc[((b) * 5 + k_) * 64 + lane] = scv[k_]; } while (0)
    ML_LOAD(0); ML_WRITE(0);
    if (tid < 64) ((LAS unsigned*)(lds + OFF_NBF))[tid] = 0u;
    for (int c = 0; c < NC; ++c) {
        const int b = c & 1;
        LAS const unsigned char* Qt = lds + OFF_Q + b * TILE; LAS const unsigned char* Kt = lds + OFF_K + b * TILE; LAS const unsigned char* Vt = lds + OFF_V + b * TILE;
        LAS const float* scb = sc + b * 320;
        { const int cn = (c + 1 < NC) ? c + 1 : c; ML_LOAD(cn); }
        const float a_old = CHAO[c];
        __syncthreads();
        {
            bf16x8 ka[2][4], qb_[2][4], na[4], nq[4];
#pragma unroll
            for (int tt = 0; tt < 2; ++tt) { const int tile = w * 2 + tt, lb = tile & 3, jb = tile >> 2;
#pragma unroll
                for (int ks = 0; ks < 4; ++ks) { ka[tt][ks] = *(LAS const bf16x8*)(Kt + rho(16 * lb + li) * PITCH + (32 * ks + 8 * g) * 2);
                    qb_[tt][ks] = *(LAS const bf16x8*)(Qt + rho(16 * jb + li) * PITCH + (32 * ks + 8 * g) * 2); } }
            { LAS const unsigned char* nb = lds + OFF_NBF + b * 256;
#pragma unroll
              for (int ks = 0; ks < 4; ++ks) { na[ks] = *(LAS const bf16x8*)(nb + (32 * ks + 8 * g) * 2); if (li != 0) na[ks] = (bf16x8){0, 0, 0, 0, 0, 0, 0, 0};
                  nq[ks] = *(LAS const bf16x8*)(Qt + rho(16 * (w & 3) + li) * PITCH + (32 * ks + 8 * g) * 2); } }
#pragma unroll
            for (int tt = 0; tt < 2; ++tt) {
                const int tile = w * 2 + tt, lb = tile & 3, jb = tile >> 2;
                const int j = 16 * jb + li, l0 = 16 * lb + 4 * g;
                f32x4 s = {0.f, 0.f, 0.f, 0.f};
#pragma unroll
                for (int ks = 0; ks < 4; ++ks) s = __builtin_amdgcn_mfma_f32_16x16x32_bf16(ka[tt][ks], qb_[tt][ks], s, 0, 0, 0);
                const f32x4 u4 = *(LAS const f32x4*)(scb + l0); const float Mj = scb[64 + j];
                float p[4]; float rs = 0.f;
#pragma unroll
                for (int r = 0; r < 4; ++r) { p[r] = (l0 + r <= j) ? s[r] * __expf(u4[r] - Mj) : 0.f; rs += p[r]; }
                *(LAS u32x2*)(lds + OFF_P + j * PPITCH + l0 * 2) = (u32x2){cvtpk(p[0], p[1]), cvtpk(p[2], p[3])};
                rs = sum_x16(rs); rs = sum_x32(rs);
                if (g == 0) RSP[j * 4 + lb] = rs;
            }
            { f32x4 s = {0.f, 0.f, 0.f, 0.f};
#pragma unroll
              for (int ks = 0; ks < 4; ++ks) s = __builtin_amdgcn_mfma_f32_16x16x32_bf16(na[ks], nq[ks], s, 0, 0, 0);
              if (g == 0) QNl[16 * (w & 3) + li] = s[0]; }
        }
        f32x4 Y[4];
        {
            bf16x8 ca[4];
#pragma unroll
            for (int ks = 0; ks < 4; ++ks) { v4u t; t.x = cvtpk(X[2 * ks][0], X[2 * ks][1]); t.y = cvtpk(X[2 * ks][2], X[2 * ks][3]); t.z = cvtpk(X[2 * ks + 1][0], X[2 * ks + 1][1]); t.w = cvtpk(X[2 * ks + 1][2], X[2 * ks + 1][3]);
                ca[ks] = __builtin_bit_cast(bf16x8, t); }
#pragma unroll
            for (int tb = 0; tb < 4; ++tb) {
                LAS const unsigned char* qrow = Qt + rho(16 * tb + li) * PITCH;
                v4u qq[4];
#pragma unroll
                for (int ks = 0; ks < 4; ++ks) { const u32x2 q0 = *(LAS const u32x2*)(qrow + (32 * ks + 4 * g) * 2), q1 = *(LAS const u32x2*)(qrow + (32 * ks + 16 + 4 * g) * 2); qq[ks] = (v4u){q0.x, q0.y, q1.x, q1.y}; }
                f32x4 y = {0.f, 0.f, 0.f, 0.f};
#pragma unroll
                for (int ks = 0; ks < 4; ++ks) y = __builtin_amdgcn_mfma_f32_16x16x32_bf16(ca[ks], __builtin_bit_cast(bf16x8, qq[ks]), y, 0, 0, 0);
                Y[tb] = y;
            }
        }
        __syncthreads();
        bf16x8 vf[2];
        vf[0] = trfrag(Vt, 0, 16 * w, lane); vf[1] = trfrag(Vt, 32, 16 * w, lane);
        {
            bf16x8 pb[4][2]; f32x4 rp[4]; float wi[4], qn[4], cl[4];
#pragma unroll
            for (int tb = 0; tb < 4; ++tb) { const int t = 16 * tb + li;
                pb[tb][0] = *(LAS const bf16x8*)(lds + OFF_P + t * PPITCH + (8 * g) * 2); pb[tb][1] = *(LAS const bf16x8*)(lds + OFF_P + t * PPITCH + (32 + 8 * g) * 2);
                rp[tb] = *(LAS const f32x4*)(RSP + t * 4); wi[tb] = scb[192 + t]; qn[tb] = QNl[t]; cl[tb] = scb[256 + t]; }
#pragma unroll
            for (int tb = 0; tb < 4; ++tb) {
                const int t = 16 * tb + li;
                f32x4 y = Y[tb] * wi[tb];
                y = __builtin_amdgcn_mfma_f32_16x16x32_bf16(vf[0], pb[tb][0], y, 0, 0, 0);
                y = __builtin_amdgcn_mfma_f32_16x16x32_bf16(vf[1], pb[tb][1], y, 0, 0, 0);
                const float den = (rp[tb][0] + rp[tb][1]) + (rp[tb][2] + rp[tb][3]) + wi[tb] * qn[tb];
                const float inv = __builtin_amdgcn_rcpf(fmaxf(fabsf(den), cl[tb]));
                const u32x2 o = {cvtpk(y[0] * inv, y[1] * inv), cvtpk(y[2] * inv, y[3] * inv)};
                *(u32x2*)(H + (size_t)ML_ROW(c, t) * 1024 + hc + 16 * w + 4 * g) = o;
            }
        }
        {
            bf16x8 vw[2]; bf16x8 wb[2];
#pragma unroll
            for (int ks = 0; ks < 2; ++ks) {
                const f32x4 w0 = *(LAS const f32x4*)(scb + 128 + 32 * ks + 8 * g), w1 = *(LAS const f32x4*)(scb + 128 + 32 * ks + 8 * g + 4);
                float wv[8] = {w0[0], w0[1], w0[2], w0[3], w1[0], w1[1], w1[2], w1[3]};
                const v4u vraw = __builtin_bit_cast(v4u, vf[ks]); v4u t, tw;
#pragma unroll
                for (int e = 0; e < 4; ++e) { t[e] = cvtpk(bflo(vraw[e]) * wv[2 * e], bfhi(vraw[e]) * wv[2 * e + 1]); tw[e] = (li == 0) ? cvtpk(wv[2 * e], wv[2 * e + 1]) : 0u; }
                vw[ks] = __builtin_bit_cast(bf16x8, t); wb[ks] = __builtin_bit_cast(bf16x8, tw);
            }
            bf16x8 kf[8][2], kn[2];
#pragma unroll
            for (int d = 0; d < 8; ++d) { kf[d][0] = trfrag(Kt, 0, 16 * d, lane); kf[d][1] = trfrag(Kt, 32, 16 * d, lane); }
            kn[0] = trfrag(Kt, 0, 16 * w, lane); kn[1] = trfrag(Kt, 32, 16 * w, lane);
#pragma unroll
            for (int d = 0; d < 8; ++d) {
                f32x4 x = X[d] * a_old;
                x = __builtin_amdgcn_mfma_f32_16x16x32_bf16(kf[d][0], vw[0], x, 0, 0, 0);
                x = __builtin_amdgcn_mfma_f32_16x16x32_bf16(kf[d][1], vw[1], x, 0, 0, 0);
                X[d] = x;
            }
            nst = nst * a_old;
            nst = __builtin_amdgcn_mfma_f32_16x16x32_bf16(kn[0], wb[0], nst, 0, 0, 0);
            nst = __builtin_amdgcn_mfma_f32_16x16x32_bf16(kn[1], wb[1], nst, 0, 0, 0);
            if (li == 0) *(LAS u32x2*)(lds + OFF_NBF + (b ^ 1) * 256 + (16 * w + 4 * g) * 2) = (u32x2){cvtpk(nst[0], nst[1]), cvtpk(nst[2], nst[3])};
        }
        ML_WRITE(b ^ 1);
    }
    __syncthreads();
#undef ML_ROW
#undef ML_LOAD
#undef ML_WRITE
}
}

constexpr int Q_ML_P = 4, Q_ML_S = 16, Q_AT_P = 128, Q_AT_S = 128, QLEN = Q_ML_P + Q_ML_S + Q_AT_P + Q_AT_S;
template <int AVAR = 0>
__device__ __forceinline__ void p_mixer(Frame& F, const Args& A, const float* bgl, int lq, unsigned xcc, bool ml_only = false, bool att_only = false) {
    unsigned char* ws = F.ws;
    int qsel = (int)(xcc & 7u), tried = 0;
    int conv_at = (lq + 1 < DEPTH) ? (F.vcu & 3) : -1, nitem = 0;
    for (;;) {
        if (nitem == conv_at) { asm volatile("s_waitcnt vmcnt(0)" ::: "memory"); __syncthreads(); conv_layer(F, A, lq + 1); conv_at = -1; __syncthreads(); }
        ++nitem;
        if (F.tid == 0) {
            int item = -1, qq = qsel, tr = tried;
            while (tr < 8) {
                const unsigned idx = __hip_atomic_fetch_add(F.ctl + CW_QUEUE + (lq * 8 + qq) * 64, 1u, __ATOMIC_RELAXED, __HIP_MEMORY_SCOPE_AGENT);
                if (idx < (unsigned)QLEN) { item = qq * 1024 + (int)idx; break; }
                qq = (qq + 1) & 7; ++tr;
            }
            F.MISC[0] = (unsigned)item; F.MISC[1] = (unsigned)qq; F.MISC[2] = (unsigned)tr;
        }
        __syncthreads();
        const int item = (int)F.MISC[0]; qsel = (int)F.MISC[1]; tried = (int)F.MISC[2];
        __syncthreads();
        if (item < 0) { if (conv_at >= 0) { asm volatile("s_waitcnt vmcnt(0)" ::: "memory"); __syncthreads(); conv_layer(F, A, lq + 1); } break; }
        const int h = item >> 10, i = item & 1023;
#ifndef NO_ML
        if (i < Q_ML_P + Q_ML_S) {
            if (att_only) continue;
            int row0, S, dir;
            if (i < Q_ML_P) { row0 = (i >> 1) * SEQ_P; S = SEQ_P; dir = i & 1; }
            else { const int k = i - Q_ML_P; row0 = MPROMPT + (k >> 1) * SEQ_S; S = SEQ_S; dir = k & 1; }
            ml::mlstm_item(F.lds, (const bf16*)(ws + WS_QM), (const bf16*)(ws + WS_KM), (const bf16*)(ws + WS_VM), (const float*)(ws + WS_KRG), bgl,
                           (float*)(ws + WS_SCR), (bf16*)(ws + (dir ? WS_HBW : WS_HFW)), row0, S, dir, h);
        } else
#endif
#ifndef NO_ATT
        {
            int row0, S, qb;
            if (i < Q_ML_P + Q_ML_S + Q_AT_P) { const int k = i - (Q_ML_P + Q_ML_S); row0 = (k >> 6) * SEQ_P; S = SEQ_P; qb = k & 63; }
            else { const int k = i - (Q_ML_P + Q_ML_S + Q_AT_P); row0 = MPROMPT + (k >> 4) * SEQ_S; S = SEQ_S; qb = k & 15; }
            const size_t qrow = (size_t)(row0 + 256 * qb);
            if (ml_only) continue;
            att8::attn_unit<AVAR>((const bf16*)(ws + WS_Q) + qrow * NQ + h * 128, (const bf16*)(ws + WS_Q) + qrow * NQ + 1024 + h * 64,
                            ws + WS_K8 + (size_t)row0 * 1024 + h * 128, ws + WS_KR + (size_t)row0 * 64, ws + WS_V8T + ((size_t)(row0 >> 6) * 1024 + h * 128) * 64,
                            (bf16*)(ws + WS_CQKV) + qrow * 1024 + h * 128, S, (const f32x2*)(ws + WS_ROPE), 256 * qb, (char*)F.lds);
        }
#else
        {}
#endif
    }
}


constexpr int NPH = 1 + DEPTH * 10 + 1;
__global__ void __launch_bounds__(NWAVES * 64, 2) trunk_fwd(Args args) {
    extern __shared__ __attribute__((aligned(16))) unsigned char lds[];
    Frame F;
    F.lds = (LAS unsigned char*)lds; F.MISC = (volatile LAS unsigned*)(F.lds + MISC_OFF);
    F.tid = threadIdx.x; F.lane = F.tid & 63; F.wave = __builtin_amdgcn_readfirstlane(F.tid >> 6);
    F.G = gridDim.x; { const int bx = blockIdx.x; F.vcu = (F.G % 8 == 0) ? (bx % 8) * (F.G / 8) + bx / 8 : bx; }
    F.ws = args.ws; F.ctl = (gu32*)(args.ws + WS_CTL); F.out = args.out;
    for (int u = F.tid; u < (LDS_BYTES - MISC_OFF) / 4; u += NWAVES * 64) ((LAS unsigned*)(F.lds + MISC_OFF))[u] = 0u;
    __syncthreads();
    XcdBarrier bar; bar.bar = (unsigned*)(F.ctl + CW_BAR); bar.x = xb_xcc_id(); bar.st = F.MISC + 8;
#if !MK_PER_PHASE
    bar = xcd_barrier_post((unsigned*)(F.ctl + CW_BAR), F.MISC + 8);
#endif
    const unsigned xcc = bar.x;
    const int lo = args.ph_lo, hi = args.ph_hi;
#define IN(k) (lo <= (k) && (k) < hi)
#if MK_PER_PHASE
#define SEAM(k) do { } while (0)
#else
#define SEAM(k) do { if (IN(k) && IN((k) + 1)) xcd_barrier(bar); } while (0)
#endif
    unsigned char* ws = args.ws;
    if (IN(0)) { p_prologue(F, args); }
#if MK_PER_PHASE
    SEAM(0);
#endif
    for (int layer = 0; layer < DEPTH; ++layer) {
        const int p0 = 1 + layer * 10;
        asm volatile("" : "+s"(ws));
        F.ws = ws;
        const unsigned char* wl = ws + WS_W + (size_t)layer * LW;
        if (layer == 0 || F.G != 256) { if (IN(p0 + 0)) { p_norm(F, args, layer); } SEAM(p0 + 0); }
        if (IN(p0 + 1)) {
            { pg8::Gemm g{(const pg8::bf16_t*)(ws + WS_XN8), (const pg8::bf16_t*)(wl + W_P1A), MTOK, NP1A, DM / 2, DM / 2, DM / 2, SC_ONE, SC_M6}; pg8::StaticOrder S; S.init(MTOK, NP1A, F.G, (int)blockIdx.x);
              EpiP1a E{ws, WS_CQKV}; pg8::gemm_phase<EpiP1a, pg8::StaticOrder, true, true, true, SC_ONE, SC_M6>(F.lds, g, S, E);
            }
            { pg8::Gemm g{(const pg8::bf16_t*)(ws + WS_XN), (const pg8::bf16_t*)(wl + W_P1B), MTOK, NP1B, DM, DM, DM, SC_ONE, SC_ONE}; pg8::StaticOrder S; S.init(MTOK, NP1B, F.G, (int)blockIdx.x);
              EpiP1b E{ws}; pg8::gemm_phase<EpiP1b, pg8::StaticOrder, true, true>(F.lds, g, S, E); }
        } SEAM(p0 + 1);
        if (IN(p0 + 2)) {
            { pg8::Gemm g{(const pg8::bf16_t*)(ws + WS_CQKV), (const pg8::bf16_t*)(wl + W_UQ), MTOK, NQ, 256, 512, 256, SC_ONE, SC_M5}; pg8::StaticOrder S; S.init(MTOK, NQ, F.G, (int)blockIdx.x);
              EpiQ E{ws}; pg8::gemm_phase<EpiQ, pg8::StaticOrder, true, true, true, SC_ONE, SC_M5>(F.lds, g, S, E); }
            { pg8::Gemm g{(const pg8::bf16_t*)(ws + WS_CQKV + 512), (const pg8::bf16_t*)(wl + W_UKV), MTOK, 1024, 256, 512, 256, SC_ONE, SC_M5}; pg8::StaticOrder S; S.init(MTOK, 1024, F.G, (int)blockIdx.x);
              EpiK8 E{ws}; pg8::gemm_phase<EpiK8, pg8::StaticOrder, true, true, true, SC_ONE, SC_M5>(F.lds, g, S, E); }
            { pg8::Gemm g{(const pg8::bf16_t*)(wl + W_UKV + (size_t)1024 * 512), (const pg8::bf16_t*)(ws + WS_CQKV + 512), 1024, MTOK, 256, 256, 512, SC_M5, SC_ONE}; pg8::StaticOrder S; S.init(1024, MTOK, F.G, (int)blockIdx.x);
              EpiVT E{ws}; pg8::gemm_phase<EpiVT, pg8::StaticOrder, true, true, true, SC_M5, SC_ONE>(F.lds, g, S, E); }
        } SEAM(p0 + 2);
        if (IN(p0 + 3)) { p_mixer(F, args, args.in[IN_B_GATES] + layer * 32, layer, xcc); }
        SEAM(p0 + 3);
        if (IN(p0 + 4)) {
            { pg8::Gemm g{(const pg8::bf16_t*)(ws + WS_XN8), (const pg8::bf16_t*)(wl + W_P2A), MTOK, NP2A, DM / 2, DM / 2, DM / 2, SC_ONE, SC_M6}; pg8::StaticOrder S; S.init(MTOK, NP2A, F.G, (int)blockIdx.x);
              EpiP2a E{ws, WS_SGA}; pg8::gemm_phase<EpiP2a, pg8::StaticOrder, true, true, true, SC_ONE, SC_M6>(F.lds, g, S, E);
            }
            { pg8::Gemm g{(const pg8::bf16_t*)(ws + WS_XN), (const pg8::bf16_t*)(wl + W_P2B), MTOK, NP2B, DM, DM, DM, SC_ONE, SC_ONE}; pg8::StaticOrder S; S.init(MTOK, NP2B, F.G, (int)blockIdx.x);
              EpiP2b E{ws, layer}; pg8::gemm_phase<EpiP2b, pg8::StaticOrder, true, true>(F.lds, g, S, E); }
        } SEAM(p0 + 4);
        if (IN(p0 + 5)) {
            pg8::Gemm g1{(const pg8::bf16_t*)(ws + WS_HFW), (const pg8::bf16_t*)(wl + W_OB), MTOK, DM, 1024, 1024, 1024, 0x7F7F7F7F, 0x7F7F7F7F};
            pg8::Gemm g2{(const pg8::bf16_t*)(ws + WS_YA8), (const pg8::bf16_t*)(wl + W_OA), MTOK, DM, 512, 512, 512, SC_M6, SC_M5};
            pg8::StaticOrder S; S.init(MTOK, DM, F.G, (int)blockIdx.x);
            MidMerge Mm{ws}; EpiMerge2 E{ws}; pg8::gemm_chain<EpiMerge2, MidMerge, pg8::StaticOrder>(F.lds, g1, g2, S, Mm, E);
        } SEAM(p0 + 5);
        if (IN(p0 + 8)) {
            pg8::Gemm g{(const pg8::bf16_t*)(ws + WS_MG), (const pg8::bf16_t*)(wl + W_OUT), MTOK, DM, DM, DM, DM, 0x7F7F7F7F, 0x7F7F7F7F}; pg8::StaticOrder S; S.init(MTOK, DM, F.G, (int)blockIdx.x);
            if (F.G == 256) { S.wgm = 4;
                if (layer + 1 == DEPTH) { EpiOutX<true> E{args.in[IN_XP], args.in[IN_XS], F.out, ws, args.in[IN_NORM_F], layer}; pg8::gemm_phase<EpiOutX<true>, pg8::StaticOrder, true, true>(F.lds, g, S, E); }
                else { EpiOutX<false> E{args.in[IN_XP], args.in[IN_XS], F.out, ws, args.in[IN_NORM_IN] + (layer + 1) * DM, layer}; pg8::gemm_phase<EpiOutX<false>, pg8::StaticOrder, true, true>(F.lds, g, S, E); }
            } else { EpiOut E{args.in[IN_XP], args.in[IN_XS], F.out, layer}; pg8::gemm_phase<EpiOut, pg8::StaticOrder, true, true>(F.lds, g, S, E); }
        } if (layer + 1 < DEPTH || F.G != 256) SEAM(p0 + 8);
    }
    if (IN(NPH - 1) && F.G != 256) { p_final(F, args); }
#undef IN
#undef SEAM
}

extern "C" void kernel_launch(void* const* d_in, const int* in_sizes, int n_in, void* d_out, int out_size, void* d_ws, size_t ws_size, hipStream_t stream) {
    static int grid = 0;
    if (grid == 0) {
        if (n_in != 14 || in_sizes[0] != MPROMPT * DM || in_sizes[1] != MPROMPT * DM || out_size != MTOK * DM || ws_size < WS_END) {
            fprintf(stderr, "kernel_launch: shape mismatch (n_in %d, in0 %d, out %d, ws %zu, need %zu); nothing launched\n", n_in, n_in > 0 ? in_sizes[0] : -1, out_size, ws_size, (size_t)WS_END); grid = -1; return; }
        int dev = 0, cus = 0, per_cu = 0;
        if (hipGetDevice(&dev) != hipSuccess || hipDeviceGetAttribute(&cus, hipDeviceAttributeMultiprocessorCount, dev) != hipSuccess) { grid = -1; return; }
        if (hipFuncSetAttribute((const void*)trunk_fwd, hipFuncAttributeMaxDynamicSharedMemorySize, LDS_BYTES) != hipSuccess) { fprintf(stderr, "kernel_launch: hipFuncSetAttribute failed\n"); grid = -1; return; }
        if (hipOccupancyMaxActiveBlocksPerMultiprocessor(&per_cu, (const void*)trunk_fwd, NWAVES * 64, LDS_BYTES) != hipSuccess || per_cu < 1)
            fprintf(stderr, "kernel_launch: note: occupancy query reports %d workgroups per CU\n", per_cu);
        (void)hipGetLastError();
        grid = cus;
    }
    if (grid < 0) return;
    if (hipMemsetAsync((char*)d_ws + WS_CTL, 0, CTL_ZERO_BYTES, stream) != hipSuccess) return;
    Args a{};
    for (int i = 0; i < 14; ++i) a.in[i] = (const float*)d_in[i];
    a.out = (float*)d_out; a.ws = (unsigned char*)d_ws;
#if MK_PER_PHASE
    for (int p = 0; p < NPH; ++p) {
        if (p >= 1 && p < NPH - 1 && (((p - 1) % 10) == 9 || ((p - 1) % 10) == 6)) continue;
        a.ph_lo = p; a.ph_hi = p + 1;
        hipLaunchKernelGGL(trunk_fwd, dim3(grid), dim3(NWAVES * 64), LDS_BYTES, stream, a);
    }
#else
    a.ph_lo = 0; a.ph_hi = NPH;
    hipLaunchKernelGGL(trunk_fwd, dim3(grid), dim3(NWAVES * 64), LDS_BYTES, stream, a);
#endif
    const hipError_t le = hipPeekAtLastError();
    if (le != hipSuccess) fprintf(stderr, "kernel_launch: launch failed: %s\n", hipGetErrorName(le));
}
```

```cpp
#include <hip/hip_runtime.h>
#include <hip/hip_bf16.h>
#include <cstdio>
#include <cstdint>

#ifndef MK_PER_PHASE
#define MK_PER_PHASE 0
#endif
#ifndef ML_FAST_TR
#define ML_FAST_TR 1
#endif

namespace pg8 {
#define PG8_LAS __attribute__((address_space(3)))
typedef unsigned short bf16_t;
typedef short bf16x8 __attribute__((ext_vector_type(8)));
typedef float f32x4 __attribute__((ext_vector_type(4)));
typedef unsigned u32x4 __attribute__((ext_vector_type(4)));
constexpr int BM = 256, BK = 64, HALF = 128, HTB = HALF * BK * 2  , STAGE_BYTES = 8 * HTB, NXCD = 8, WGM = 8;

__host__ __device__ __forceinline__ int lds_byte(int r, int c) { const int st = (r >> 4) * 2 + (c >> 5), rr = r & 15, cc = c & 31, ob = rr * 64 + cc * 2; return st * 1024 + (ob ^ (((ob >> 9) & 1) << 5)); }
__host__ __device__ __forceinline__ void stage_rc(int b, int& R, int& C) { const int st = b / 1024, sb = b % 1024, swz = sb ^ (((sb >> 9) & 1) << 5); R = (st >> 1) * 16 + swz / 64; C = (st & 1) * 32 + (swz % 64) / 2; }
__host__ __device__ __forceinline__ int perm32(int rho) { const int n = rho >> 4, i = rho & 15; return 8 * (i >> 2) + 4 * n + (i & 3); }

__device__ __forceinline__ int fresh_tid() { int l; asm volatile("v_mbcnt_lo_u32_b32 %0, -1, 0\n\tv_mbcnt_hi_u32_b32 %0, -1, %0" : "=v"(l)); return (__builtin_amdgcn_readfirstlane((int)threadIdx.x >> 6) << 6) | l; }
struct Unit { int pm, pn; };
struct Gemm { const bf16_t* A; const bf16_t* Bt; int M, N, K, lda, ldb; int scA, scB; };
typedef int pg8_v4i __attribute__((ext_vector_type(4)));
typedef int pg8_v8i __attribute__((ext_vector_type(8)));
__device__ __forceinline__ pg8_v8i ld_frag8(const PG8_LAS unsigned char* p) {
    const bf16x8 lo = *(const PG8_LAS bf16x8*)p, hi = *(const PG8_LAS bf16x8*)(p + 16);
    return __builtin_bit_cast(pg8_v8i, __builtin_shufflevector(lo, hi, 0, 1, 2, 3, 4, 5, 6, 7, 8, 9, 10, 11, 12, 13, 14, 15)); }

struct StaticOrder {
    int nM, nN, nwg, G, c, wgm;
    __host__ __device__ void init(int M, int N, int G_, int c_) { nM = M / BM; nN = N / BM; nwg = nM * nN; G = G_; c = c_; wgm = WGM; }
    __host__ __device__ bool next(int i, Unit& u) const {
        const long L = (long)i * G + c; if (L >= nwg) return false;
        int wgid = (int)L; { const int q = nwg / NXCD, r = nwg % NXCD, xcd = wgid % NXCD, off = wgid / NXCD; wgid = (xcd < r ? xcd * (q + 1) : r * (q + 1) + (xcd - r) * q) + off; }
        const int nig = wgm * nN, gid = wgid / nig, fm = gid * wgm, gsz = (nM - fm) < wgm ? (nM - fm) : wgm;
        u.pm = fm + ((wgid % nig) % gsz); u.pn = (wgid % nig) / gsz; return true;
    }
    __device__ __forceinline__ void a_ready(const Unit&) const {}
    __device__ __forceinline__ void done(const Unit&) const {}
};

typedef float cvt_f32x2 __attribute__((ext_vector_type(2))); typedef __bf16 cvt_bf16x2 __attribute__((ext_vector_type(2)));
__device__ __forceinline__ unsigned cvt_pk_bf16(float lo, float hi) { return __builtin_bit_cast(unsigned, __builtin_convertvector((cvt_f32x2){lo, hi}, cvt_bf16x2)); }
typedef float f32x2 __attribute__((ext_vector_type(2)));
template <class Epi, class Sched, bool ALIGN_EPI = false, bool SP2 = false, bool FP8 = false, int SCA = 0x7F7F7F7F, int SCB = 0x7F7F7F7F>
__device__ __forceinline__ void gemm_phase(PG8_LAS unsigned char* lds, const Gemm g, const Sched& S, const Epi& E) {
    const int tid = fresh_tid();
    const int wid = __builtin_amdgcn_readfirstlane(tid >> 6), lane = tid & 63, wr = wid >> 2, wc = wid & 3, fr = lane & 15, fq = lane >> 4;
    const int K = g.K, nt = K / BK;
    unsigned voffA[2], voffB[2];
    { int R, C; stage_rc(tid * 16, R, C); const int Rb = Epi::PERM == 2 ? (64 * (R >> 5) + 16 * ((R & 15) >> 2) + 4 * ((R >> 4) & 1) + (R & 3)) : Epi::PERM ? ((R & ~31) + perm32(R & 31)) : R;
        voffA[0] = (unsigned)(R * g.lda + C) * 2u; voffB[0] = (unsigned)(Rb * g.ldb + C) * 2u; voffA[1] = voffA[0] + (unsigned)(64 * g.lda) * 2u; voffB[1] = voffB[0] + (unsigned)((Epi::PERM == 2 ? 128 : 64) * g.ldb) * 2u; }
    const size_t kstep = (size_t)(BK * 2);
    const size_t hstepA = (size_t)HALF * g.lda * 2, hstepB = (size_t)(Epi::PERM == 2 ? 8 : HALF) * g.ldb * 2;
    const size_t tstepA = 2 * hstepA, tstepB = (size_t)BM * g.ldb * 2;
    const unsigned ldsw = (unsigned)wid * 1024u;
    const int aoff = lds_byte(wr * 64 + fr, FP8 ? fq * 16 : fq * 8), boff = lds_byte(wc * 32 + fr, FP8 ? fq * 16 : fq * 8);
#define PG8_SA(b, h) (((b) * 2 + (h)) * HTB)
#define PG8_SB(b, h) ((4 + (b) * 2 + (h)) * HTB)
#define PG8_STAGE(bufoff, gbase, voff) do { _Pragma("unroll") for (int _i = 0; _i < 2; ++_i) \
        __builtin_amdgcn_global_load_lds((const unsigned*)((const char*)(gbase) + (voff)[_i]), (PG8_LAS unsigned*)(lds + (bufoff) + ldsw + _i * 8192), 16, 0, 0); } while (0)
#define PG8_LDA(dst, b, h) do { if constexpr (FP8) { _Pragma("unroll") for (int m = 0; m < 4; ++m) dst##8[m] = ld_frag8(lds + PG8_SA(b, h) + aoff + m * 2048); } \
        else { _Pragma("unroll") for (int m = 0; m < 4; ++m) _Pragma("unroll") for (int k = 0; k < 2; ++k) dst[m][k] = *(const PG8_LAS bf16x8*)(lds + PG8_SA(b, h) + aoff + m * 2048 + k * 1024); } } while (0)
#define PG8_LDB(dst, b, h) do { if constexpr (FP8) { _Pragma("unroll") for (int n = 0; n < 2; ++n) dst##8[n] = ld_frag8(lds + PG8_SB(b, h) + boff + n * 2048); } \
        else { _Pragma("unroll") for (int n = 0; n < 2; ++n) _Pragma("unroll") for (int k = 0; k < 2; ++k) dst[n][k] = *(const PG8_LAS bf16x8*)(lds + PG8_SB(b, h) + boff + n * 2048 + k * 1024); } } while (0)
#define PG8_CAT8(x) __builtin_shufflevector(__builtin_bit_cast(pg8_v4i, (x)[0]), __builtin_bit_cast(pg8_v4i, (x)[1]), 0, 1, 2, 3, 4, 5, 6, 7)
#define PG8_MMA(ai, bj, At, Bt) do { __builtin_amdgcn_s_setprio(1); _Pragma("unroll") for (int m = 0; m < 4; ++m) _Pragma("unroll") for (int n = 0; n < 2; ++n) { \
        if constexpr (FP8) asm volatile("v_mfma_f32_16x16x128_f8f6f4 %0, %1, %2, %0" : "+v"(acc[ai][bj][m][n]) : "v"(Bt##8[n]), "v"(At##8[m]));     \
        else { _Pragma("unroll") for (int k = 0; k < 2; ++k) acc[ai][bj][m][n] = __builtin_amdgcn_mfma_f32_16x16x32_bf16(Bt[n][k], At[m][k], acc[ai][bj][m][n], 0, 0, 0); } } __builtin_amdgcn_s_setprio(0); } while (0)
#define PG8_WAIT_V(n) asm volatile("s_waitcnt vmcnt(" #n ")" ::: "memory")
#define PG8_WAIT_L(n) asm volatile("s_waitcnt lgkmcnt(" #n ")" ::: "memory")
#define PG8_BAR __builtin_amdgcn_s_barrier()
#define PG8_SCHED __builtin_amdgcn_sched_barrier(0)
    Unit cur, nxt; int ui = 0;
    if (!S.next(0, cur)) return;
    f32x4 acc[2][2][4][2];
#pragma unroll
    for (int a = 0; a < 2; ++a)
#pragma unroll
        for (int b = 0; b < 2; ++b)
#pragma unroll
            for (int m = 0; m < 4; ++m)
#pragma unroll
                for (int n = 0; n < 2; ++n) acc[a][b][m][n] = (f32x4){0.f, 0.f, 0.f, 0.f};
    bf16x8 At[4][2], B0[2][2], B1[2][2]; pg8_v8i At8[4], B08[2], B18[2];
    const char* cA = (const char*)g.A + (size_t)cur.pm * tstepA; const char* cB = (const char*)g.Bt + (size_t)cur.pn * tstepB;
    S.a_ready(cur);
    if constexpr (SP2) {
        PG8_STAGE(PG8_SB(0, 0), cB, voffB); PG8_STAGE(PG8_SB(0, 1), cB + hstepB, voffB); PG8_STAGE(PG8_SA(0, 0), cA, voffA); PG8_STAGE(PG8_SA(0, 1), cA + hstepA, voffA);
        if (wr == 1) PG8_BAR;
        PG8_WAIT_V(2); PG8_BAR;
        PG8_STAGE(PG8_SB(1, 0), cB + kstep, voffB); PG8_STAGE(PG8_SA(1, 0), cA + kstep, voffA); PG8_STAGE(PG8_SB(1, 1), cB + hstepB + kstep, voffB);
        PG8_WAIT_V(6); PG8_BAR;
    } else {
        PG8_STAGE(PG8_SB(0, 0), cB, voffB); PG8_STAGE(PG8_SA(0, 0), cA, voffA); PG8_STAGE(PG8_SB(0, 1), cB + hstepB, voffB); PG8_STAGE(PG8_SA(0, 1), cA + hstepA, voffA);
        if (wr == 1) PG8_BAR;
        PG8_WAIT_V(4); PG8_BAR;
        PG8_STAGE(PG8_SB(1, 0), cB + kstep, voffB); PG8_STAGE(PG8_SA(1, 0), cA + kstep, voffA); PG8_STAGE(PG8_SB(1, 1), cB + hstepB + kstep, voffB);
        PG8_WAIT_V(6); PG8_BAR;
    }
    for (;;) {
        const bool has_next = S.next(ui + 1, nxt);
        const char* nA = has_next ? (const char*)g.A + (size_t)nxt.pm * tstepA : cA; const char* nB = has_next ? (const char*)g.Bt + (size_t)nxt.pn * tstepB : cB;
        _Pragma("nounroll") for (int t = 0; t < nt; t += 2) {
            const bool last = (t == nt - 2);
            const char* a1 = cA + (size_t)(t + 1) * kstep;
            const char* a2 = last ? nA : cA + (size_t)(t + 2) * kstep; const char* b2 = last ? nB : cB + (size_t)(t + 2) * kstep;
            const char* a3 = a2 + kstep; const char* b3 = b2 + kstep;
            if (last && has_next) S.a_ready(nxt);
            if constexpr (SP2) {
            PG8_LDB(B0, 0, 0); PG8_LDB(B1, 0, 1); PG8_SCHED; PG8_LDA(At, 0, 0); PG8_STAGE(PG8_SA(1, 1), a1 + hstepA, voffA);
            PG8_WAIT_V(8); PG8_WAIT_L(0); PG8_BAR; PG8_MMA(0, 0, At, B0); PG8_MMA(0, 1, At, B1); PG8_BAR; PG8_SCHED;
            PG8_LDA(At, 0, 1); PG8_STAGE(PG8_SB(0, 0), b2, voffB); PG8_STAGE(PG8_SB(0, 1), b2 + hstepB, voffB); PG8_STAGE(PG8_SA(0, 0), a2, voffA);
            PG8_WAIT_V(8); PG8_WAIT_L(0); PG8_BAR; PG8_MMA(1, 0, At, B0); PG8_MMA(1, 1, At, B1); PG8_BAR; PG8_SCHED;
            PG8_LDB(B0, 1, 0); PG8_LDB(B1, 1, 1); PG8_SCHED; PG8_LDA(At, 1, 0); PG8_STAGE(PG8_SA(0, 1), a2 + hstepA, voffA);
            PG8_WAIT_V(8); PG8_WAIT_L(0); PG8_BAR; PG8_MMA(0, 0, At, B0); PG8_MMA(0, 1, At, B1); PG8_BAR; PG8_SCHED;
            PG8_LDA(At, 1, 1); PG8_STAGE(PG8_SB(1, 0), b3, voffB); PG8_STAGE(PG8_SB(1, 1), b3 + hstepB, voffB); PG8_STAGE(PG8_SA(1, 0), a3, voffA);
            PG8_WAIT_V(8); PG8_WAIT_L(0); PG8_BAR; PG8_MMA(1, 0, At, B0); PG8_MMA(1, 1, At, B1); PG8_BAR; PG8_SCHED;
            } else {
            PG8_LDB(B0, 0, 0); PG8_SCHED; PG8_LDA(At, 0, 0); PG8_STAGE(PG8_SA(1, 1), a1 + hstepA, voffA);
            PG8_WAIT_L(8); PG8_BAR; PG8_WAIT_L(0); PG8_MMA(0, 0, At, B0); PG8_BAR; PG8_SCHED;
            PG8_LDB(B1, 0, 1); PG8_STAGE(PG8_SB(0, 0), b2, voffB);
            PG8_BAR; PG8_WAIT_L(0); PG8_MMA(0, 1, At, B1); PG8_BAR;
            PG8_LDA(At, 0, 1); PG8_STAGE(PG8_SA(0, 0), a2, voffA);
            PG8_BAR; PG8_WAIT_L(0); PG8_MMA(1, 0, At, B0); PG8_BAR; PG8_SCHED;
            PG8_STAGE(PG8_SB(0, 1), b2 + hstepB, voffB);
            PG8_WAIT_V(6); PG8_BAR; PG8_MMA(1, 1, At, B1); PG8_BAR;
            PG8_LDB(B0, 1, 0); PG8_SCHED; PG8_LDA(At, 1, 0); PG8_STAGE(PG8_SA(0, 1), a2 + hstepA, voffA);
            PG8_WAIT_L(8); PG8_BAR; PG8_WAIT_L(0); PG8_MMA(0, 0, At, B0); PG8_BAR; PG8_SCHED;
            PG8_LDB(B1, 1, 1); PG8_STAGE(PG8_SB(1, 0), b3, voffB);
            PG8_BAR; PG8_WAIT_L(0); PG8_MMA(0, 1, At, B1); PG8_BAR;
            PG8_LDA(At, 1, 1); PG8_STAGE(PG8_SA(1, 0), a3, voffA);
            PG8_BAR; PG8_WAIT_L(0); PG8_MMA(1, 0, At, B0); PG8_BAR; PG8_SCHED;
            PG8_STAGE(PG8_SB(1, 1), b3 + hstepB, voffB);
            PG8_WAIT_V(6); PG8_BAR; PG8_MMA(1, 1, At, B1); PG8_BAR;
            }
        }
        if constexpr (FP8) asm volatile("s_nop 15\n\ts_nop 15" ::: "memory");
        if constexpr (ALIGN_EPI) { if (wr == 0) PG8_BAR; }
        if constexpr (!Epi::AFTER_DRAIN) { const int t2 = fresh_tid();
            E(acc, cur, t2 >> 8, (t2 >> 6) & 3, t2 & 15, (t2 >> 4) & 3); S.done(cur); }
        if (!has_next) break;
#pragma unroll
        for (int a = 0; a < 2; ++a)
#pragma unroll
            for (int b = 0; b < 2; ++b)
#pragma unroll
                for (int m = 0; m < 4; ++m)
#pragma unroll
                    for (int n = 0; n < 2; ++n) acc[a][b][m][n] = (f32x4){0.f, 0.f, 0.f, 0.f};
        cur = nxt; cA = nA; cB = nB; ++ui;
        if constexpr (ALIGN_EPI) { if (wr == 1) PG8_BAR; }
    }
    PG8_WAIT_V(0);
    if constexpr (!ALIGN_EPI) { if (wr == 0) PG8_BAR; }
    PG8_BAR;
    if constexpr (Epi::AFTER_DRAIN) { E.fused(acc, cur, wr, wc, fr, fq, lds, wid, lane); S.done(cur); }
#undef PG8_SA
#undef PG8_SB
#undef PG8_STAGE
#undef PG8_LDA
#undef PG8_LDB
#undef PG8_MMA
#undef PG8_CAT8
#undef PG8_WAIT_V
#undef PG8_WAIT_L
#undef PG8_BAR
#undef PG8_SCHED
}

template <class Epi, class Mid, class Sched>
__device__ __forceinline__ void gemm_chain(PG8_LAS unsigned char* lds, const Gemm g1, const Gemm g2, const Sched& S, const Mid& M, const Epi& E) {
    const int tid = fresh_tid();
    const int wid = __builtin_amdgcn_readfirstlane(tid >> 6), lane = tid & 63, wr = wid >> 2, wc = wid & 3, fr = lane & 15, fq = lane >> 4;
    const int nt1 = g1.K / BK, nt2 = g2.K / BK;
    const size_t kstep = (size_t)(BK * 2);
    const size_t hA1 = (size_t)HALF * g1.lda * 2, hB1 = (size_t)HALF * g1.ldb * 2, hA2 = (size_t)HALF * g2.lda * 2, hB2 = (size_t)HALF * g2.ldb * 2;
    const unsigned ldsw = (unsigned)wid * 1024u;
#define PC_OFFS(F8, LDA_, LDB_) const int t3_ = fresh_tid(); unsigned VA[2], VB[2]; \
        { int R, C; stage_rc(t3_ * 16, R, C); const int Rb = Epi::PERM ? ((R & ~31) + perm32(R & 31)) : R; \
          VA[0] = (unsigned)(R * (LDA_) + C) * 2u; VB[0] = (unsigned)(Rb * (LDB_) + C) * 2u; VA[1] = VA[0] + (unsigned)(64 * (LDA_)) * 2u; VB[1] = VB[0] + (unsigned)(64 * (LDB_)) * 2u; } \
        const int aoff = lds_byte((t3_ >> 8) * 64 + (t3_ & 15), ((t3_ >> 4) & 3) * ((F8) ? 16 : 8)), boff = lds_byte(((t3_ >> 6) & 3) * 32 + (t3_ & 15), ((t3_ >> 4) & 3) * ((F8) ? 16 : 8));
#define PC_SA(b, h) (((b) * 2 + (h)) * HTB)
#define PC_SB(b, h) ((4 + (b) * 2 + (h)) * HTB)
#define PC_STAGE(bufoff, gbase, v0, v1) do { \
        __builtin_amdgcn_global_load_lds((const unsigned*)((const char*)(gbase) + (v0)), (PG8_LAS unsigned*)(lds + (bufoff) + ldsw), 16, 0, 0); \
        __builtin_amdgcn_global_load_lds((const unsigned*)((const char*)(gbase) + (v1)), (PG8_LAS unsigned*)(lds + (bufoff) + ldsw + 8192), 16, 0, 0); } while (0)
#define PC_LDA(F8, b, h) do { if constexpr (F8) { _Pragma("unroll") for (int m = 0; m < 4; ++m) At8[m] = ld_frag8(lds + PC_SA(b, h) + aoff + m * 2048); } \
        else { _Pragma("unroll") for (int m = 0; m < 4; ++m) _Pragma("unroll") for (int k = 0; k < 2; ++k) At[m][k] = *(const PG8_LAS bf16x8*)(lds + PC_SA(b, h) + aoff + m * 2048 + k * 1024); } } while (0)
#define PC_LDB(F8, W, b, h) do { if constexpr (F8) { _Pragma("unroll") for (int n = 0; n < 2; ++n) B##W##8[n] = ld_frag8(lds + PC_SB(b, h) + boff + n * 2048); } \
        else { _Pragma("unroll") for (int n = 0; n < 2; ++n) _Pragma("unroll") for (int k = 0; k < 2; ++k) B##W[n][k] = *(const PG8_LAS bf16x8*)(lds + PC_SB(b, h) + boff + n * 2048 + k * 1024); } } while (0)
#define PC_MMA(F8, ai, bj, W) do { __builtin_amdgcn_s_setprio(1); _Pragma("unroll") for (int m = 0; m < 4; ++m) _Pragma("unroll") for (int n = 0; n < 2; ++n) { \
        if constexpr (F8) asm volatile("v_mfma_f32_16x16x128_f8f6f4 %0, %1, %2, %0" : "+v"(acc[ai][bj][m][n]) : "v"(B##W##8[n]), "v"(At8[m])); \
        else { _Pragma("unroll") for (int k = 0; k < 2; ++k) acc[ai][bj][m][n] = __builtin_amdgcn_mfma_f32_16x16x32_bf16(B##W[n][k], At[m][k], acc[ai][bj][m][n], 0, 0, 0); } } __builtin_amdgcn_s_setprio(0); } while (0)
#define PC_WAIT_V(n) asm volatile("s_waitcnt vmcnt(" #n ")" ::: "memory")
#define PC_WAIT_L(n) asm volatile("s_waitcnt lgkmcnt(" #n ")" ::: "memory")
#define PC_BAR __builtin_amdgcn_s_barrier()
#define PC_SCHED __builtin_amdgcn_sched_barrier(0)
#define PC_KLOOP(F8, cA_, cB_, nt_, LDA_, LDB_, HA, HB, nA_, nB_, NLDA_, NLDB_, NHA, NHB) { PC_OFFS(F8, LDA_, LDB_) \
        _Pragma("nounroll") for (int t = 0; t < (nt_); t += 2) { \
            const bool last = (t == (nt_) - 2); \
            const char* a1 = (cA_) + (size_t)(t + 1) * kstep; \
            const char* a2 = last ? (nA_) : (cA_) + (size_t)(t + 2) * kstep; const char* b2 = last ? (nB_) : (cB_) + (size_t)(t + 2) * kstep; \
            const char* a3 = a2 + kstep; const char* b3 = b2 + kstep; \
            unsigned sa0 = VA[0], sa1 = VA[1], sb0 = VB[0], sb1 = VB[1]; const size_t sha = last ? (NHA) : (HA), shb = last ? (NHB) : (HB); \
            if (last) { int R, C; stage_rc(t3_ * 16, R, C); const int Rb = Epi::PERM ? ((R & ~31) + perm32(R & 31)) : R; \
                sa0 = (unsigned)(R * (NLDA_) + C) * 2u; sb0 = (unsigned)(Rb * (NLDB_) + C) * 2u; sa1 = sa0 + (unsigned)(64 * (NLDA_)) * 2u; sb1 = sb0 + (unsigned)(64 * (NLDB_)) * 2u; } \
            PC_LDB(F8, 0, 0, 0); PC_LDB(F8, 1, 0, 1); PC_SCHED; PC_LDA(F8, 0, 0); PC_STAGE(PC_SA(1, 1), a1 + (HA), VA[0], VA[1]); \
            PC_WAIT_V(8); PC_WAIT_L(0); PC_BAR; PC_MMA(F8, 0, 0, 0); PC_MMA(F8, 0, 1, 1); PC_BAR; PC_SCHED; \
            PC_LDA(F8, 0, 1); PC_STAGE(PC_SB(0, 0), b2, sb0, sb1); PC_STAGE(PC_SB(0, 1), b2 + shb, sb0, sb1); PC_STAGE(PC_SA(0, 0), a2, sa0, sa1); \
            PC_WAIT_V(8); PC_WAIT_L(0); PC_BAR; PC_MMA(F8, 1, 0, 0); PC_MMA(F8, 1, 1, 1); PC_BAR; PC_SCHED; \
            PC_LDB(F8, 0, 1, 0); PC_LDB(F8, 1, 1, 1); PC_SCHED; PC_LDA(F8, 1, 0); PC_STAGE(PC_SA(0, 1), a2 + sha, sa0, sa1); \
            PC_WAIT_V(8); PC_WAIT_L(0); PC_BAR; PC_MMA(F8, 0, 0, 0); PC_MMA(F8, 0, 1, 1); PC_BAR; PC_SCHED; \
            PC_LDA(F8, 1, 1); PC_STAGE(PC_SB(1, 0), b3, sb0, sb1); PC_STAGE(PC_SB(1, 1), b3 + shb, sb0, sb1); PC_STAGE(PC_SA(1, 0), a3, sa0, sa1); \
            PC_WAIT_V(8); PC_WAIT_L(0); PC_BAR; PC_MMA(F8, 1, 0, 0); PC_MMA(F8, 1, 1, 1); PC_BAR; PC_SCHED; \
        } }
    Unit cur, nxt; int ui = 0;
    if (!S.next(0, cur)) return;
    f32x4 acc[2][2][4][2];
#pragma unroll
    for (int a = 0; a < 2; ++a)
#pragma unroll
        for (int b = 0; b < 2; ++b)
#pragma unroll
            for (int m = 0; m < 4; ++m)
#pragma unroll
                for (int n = 0; n < 2; ++n) acc[a][b][m][n] = (f32x4){0.f, 0.f, 0.f, 0.f};
    bf16x8 At[4][2], B0[2][2], B1[2][2]; pg8_v8i At8[4], B08[2], B18[2];
    const char* c1A = (const char*)g1.A + (size_t)cur.pm * 2 * hA1; const char* c1B = (const char*)g1.Bt + (size_t)cur.pn * 2 * hB1;
    { PC_OFFS(false, g1.lda, g1.ldb) (void)aoff; (void)boff;
    PC_STAGE(PC_SB(0, 0), c1B, VB[0], VB[1]); PC_STAGE(PC_SB(0, 1), c1B + hB1, VB[0], VB[1]); PC_STAGE(PC_SA(0, 0), c1A, VA[0], VA[1]); PC_STAGE(PC_SA(0, 1), c1A + hA1, VA[0], VA[1]);
    if (wr == 1) PC_BAR;
    PC_WAIT_V(2); PC_BAR;
    PC_STAGE(PC_SB(1, 0), c1B + kstep, VB[0], VB[1]); PC_STAGE(PC_SA(1, 0), c1A + kstep, VA[0], VA[1]); PC_STAGE(PC_SB(1, 1), c1B + hB1 + kstep, VB[0], VB[1]);
    PC_WAIT_V(6); PC_BAR; }
    for (;;) {
        const bool has_next = S.next(ui + 1, nxt);
        const char* c2A = (const char*)g2.A + (size_t)cur.pm * 2 * hA2; const char* c2B = (const char*)g2.Bt + (size_t)cur.pn * 2 * hB2;
        const char* n1A = has_next ? (const char*)g1.A + (size_t)nxt.pm * 2 * hA1 : c1A; const char* n1B = has_next ? (const char*)g1.Bt + (size_t)nxt.pn * 2 * hB1 : c1B;
        PC_KLOOP(false, c1A, c1B, nt1, g1.lda, g1.ldb, hA1, hB1, c2A, c2B, g2.lda, g2.ldb, hA2, hB2)
        { const int t2 = fresh_tid(); M(acc, cur, t2 >> 8, (t2 >> 6) & 3, t2 & 15, (t2 >> 4) & 3); }
        PC_KLOOP(true, c2A, c2B, nt2, g2.lda, g2.ldb, hA2, hB2, n1A, n1B, g1.lda, g1.ldb, hA1, hB1)
        asm volatile("s_nop 15\n\ts_nop 15" ::: "memory");
        if (wr == 0) PC_BAR;
        { const int t2 = fresh_tid(); E(acc, cur, t2 >> 8, (t2 >> 6) & 3, t2 & 15, (t2 >> 4) & 3); }
        if (!has_next) break;
#pragma unroll
        for (int a = 0; a < 2; ++a)
#pragma unroll
            for (int b = 0; b < 2; ++b)
#pragma unroll
                for (int m = 0; m < 4; ++m)
#pragma unroll
                    for (int n = 0; n < 2; ++n) acc[a][b][m][n] = (f32x4){0.f, 0.f, 0.f, 0.f};
        cur = nxt; c1A = n1A; c1B = n1B; ++ui;
        if (wr == 1) PC_BAR;
    }
    PC_WAIT_V(0);
    PC_BAR;
#undef PC_SA
#undef PC_SB
#undef PC_STAGE
#undef PC_LDA
#undef PC_LDB
#undef PC_MMA
#undef PC_WAIT_V
#undef PC_WAIT_L
#undef PC_BAR
#undef PC_SCHED
#undef PC_KLOOP
#undef PC_OFFS
}
}

constexpr int DM = 2048, DEPTH = 2;
constexpr int MTOK = 65536, MPROMPT = 32768, SEQ_P = 16384, SEQ_S = 4096;
constexpr int IN_COLS = 11360;
constexpr int NP1 = 4352, NP2 = 7168, NQ = 1536, NKV = 2048;
constexpr int SRC_CQ = 0, SRC_CKV = 512, SRC_KROPE = 1024, SRC_ZA = 1088, SRC_QM = 2112, SRC_KM = 3136, SRC_VM = 4160, SRC_OM = 5184, SRC_ZM = 6208, SRC_GATES = 7232, SRC_GA = 7264, SRC_GB = 9312;
constexpr float EPS = 1e-6f;
constexpr int NWAVES = 8;

constexpr size_t MiB = 1u << 20, U = 128 * MiB;
constexpr size_t WS_XN = 0;
constexpr size_t WS_CQKV = 2 * U;
constexpr size_t WS_QM = 3 * U, WS_KM = 4 * U, WS_VM = 5 * U;
constexpr size_t WS_Q = 6 * U;
constexpr size_t WS_KN = 6 * U + U / 2 * 3, WS_V = WS_KN + U;
constexpr size_t WS_KR = WS_V + U;
constexpr size_t WS_K8 = WS_KN, WS_V8T = WS_V;
constexpr size_t WS_HFW = 10 * U, WS_HBW = 11 * U;
constexpr size_t WS_MG = 3 * U;
constexpr size_t WS_SGA = 5 * U, WS_SGB = 7 * U;
constexpr size_t WS_W = 12 * U;
constexpr int NP1A = 1024, NP1B = 3328, NP2A = 3072, NP2B = 4096;
constexpr size_t W_P1A = 0, W_P1B = W_P1A + (size_t)NP1A * DM, W_P2A = W_P1B + (size_t)NP1B * DM * 2, W_P2B = W_P2A + (size_t)NP2A * DM, W_UQ = W_P2B + (size_t)NP2B * DM * 2,
                 W_UKV = W_UQ + (size_t)NQ * 512, W_OA = W_UKV + (size_t)NKV * 512, W_OB = W_OA + (size_t)DM * 1024, W_OUT = W_OB + (size_t)DM * 1024 * 2, LW = W_OUT + (size_t)DM * DM * 2;
constexpr int SC_ONE = 0x7F7F7F7F, SC_M6 = 0x79797979, SC_M5 = 0x7A7A7A7A;
constexpr size_t WS_ROPE = WS_W + 2 * LW;
constexpr size_t WS_KRG = WS_ROPE + 4 * MiB;
constexpr size_t WS_SSQ = WS_KRG + 24 * MiB;
constexpr size_t WS_SCR = WS_SSQ + 4 * MiB;
constexpr size_t WS_RSKV = WS_SCR + 20 * MiB;
constexpr size_t WS_SSF = WS_KR + 4 * MiB;
constexpr size_t WS_HG = WS_RSKV + 512 * 1024;
constexpr size_t WS_CTL = WS_RSKV + 1 * MiB, CTL_ZERO_BYTES = 1 * MiB;
constexpr size_t WS_XN8 = WS_CTL + CTL_ZERO_BYTES;
constexpr size_t WS_YA8 = WS_XN8 + U;
constexpr size_t WS_END = WS_YA8 + U / 2;
static_assert(LW % 256 == 0 && WS_END < 2040 * MiB, "d_ws map");
constexpr int CW_BAR = 4096;
constexpr int CW_PANEL = 32768;
constexpr int CW_QUEUE = 16384;

constexpr int LDS_BYTES = 163840;
constexpr int MISC_OFF = 159744;

#define GAS __attribute__((address_space(1)))
#define LAS __attribute__((address_space(3)))
typedef unsigned short bf16;
typedef unsigned v4u __attribute__((ext_vector_type(4)));
typedef float f32x4 __attribute__((ext_vector_type(4)));
typedef short bf16x8 __attribute__((ext_vector_type(8)));
typedef GAS unsigned gu32;
typedef GAS unsigned long long gu64;
#define RLX_AGENT __ATOMIC_RELAXED, __HIP_MEMORY_SCOPE_AGENT
#define LDS_WAIT() asm volatile("s_waitcnt lgkmcnt(0)" ::: "memory")
#define VM_WAIT() asm volatile("s_waitcnt vmcnt(0)" ::: "memory")
__device__ __forceinline__ unsigned long long rt() { return __builtin_amdgcn_s_memrealtime(); }
__device__ __forceinline__ unsigned f2bf(float f) { unsigned u = __builtin_bit_cast(unsigned, f); return (u + 0x7fffu + ((u >> 16) & 1u)) >> 16; }
__device__ __forceinline__ unsigned pk2(float lo, float hi) { return f2bf(lo) | (f2bf(hi) << 16); }

#define XB_TMO      128
#define XB_XCNT(j)  (256  + 64 * (j))
#define XB_XSUB(j)  (1280 + 64 * (j))
#define XB_XGEN(j)  (2304 + 64 * (j))
#define XB_TOP      3328
#define XB_TOPGEN   3392
#define XCD_BAR_WORDS 3456
#define XB_SPIN_CAP (1u << 18)

__device__ __forceinline__ unsigned xb_ld(unsigned* p)              { return __hip_atomic_load(p, __ATOMIC_RELAXED, __HIP_MEMORY_SCOPE_AGENT); }
__device__ __forceinline__ unsigned xb_add(unsigned* p, unsigned v) { return __hip_atomic_fetch_add(p, v, __ATOMIC_RELAXED, __HIP_MEMORY_SCOPE_AGENT); }
__device__ __forceinline__ unsigned xb_xcc_id() { return (unsigned)__builtin_amdgcn_s_getreg((3 << 11) | 20) & 0xFu; }
#define XB_SPIN(cond, bar) do { unsigned _sp = 0; while (cond) { __builtin_amdgcn_s_sleep(1); \
    if ((++_sp & 255u) == 0u) { if (xb_ld(&(bar)[XB_TMO])) break; if (_sp > XB_SPIN_CAP) { atomicAdd(&(bar)[XB_TMO], 1u); break; } } } } while (0)

struct XcdBarrier {
    unsigned* bar; unsigned x;
    volatile LAS unsigned* st;
};

__device__ __forceinline__ XcdBarrier xcd_barrier_post(unsigned* bar, volatile LAS unsigned* st) {
    XcdBarrier b; b.bar = bar; b.x = xb_xcc_id(); b.st = st;
    if (threadIdx.x == 0) (void)xb_add(&bar[XB_XCNT(b.x)], 1u);
    return b;
}
__device__ __forceinline__ void xcd_barrier_complete(unsigned* bar, unsigned x, unsigned& nloc, unsigned& nx) {
    const unsigned G = gridDim.x * gridDim.y * gridDim.z;
    unsigned sum, cnt, mine, sp = 0u;
    for (;;) {
        sum = 0u; cnt = 0u; mine = 0u;
#pragma unroll
        for (unsigned j = 0; j < 16; ++j) { const unsigned c = xb_ld(&bar[XB_XCNT(j)]); sum += c; cnt += (c > 0u) ? 1u : 0u; mine = (j == x) ? c : mine; }
        if (sum == G) break;
        __builtin_amdgcn_s_sleep(1);
        if ((++sp & 255u) == 0u) { if (xb_ld(&bar[XB_TMO])) break; if (sp > XB_SPIN_CAP) { atomicAdd(&bar[XB_TMO], 1u); break; } }
    }
    nloc = mine > 0u ? mine : 1u; nx = cnt > 0u ? cnt : 1u;
}

__device__ __forceinline__ void xcd_barrier(const XcdBarrier& b) {
    asm volatile("s_waitcnt vmcnt(0)" ::: "memory");
    __syncthreads();
    if (threadIdx.x == 0) {
        unsigned* bar = b.bar;
        __builtin_amdgcn_s_waitcnt(0);
        unsigned nloc = b.st[0], nx = b.st[1];
        if (nloc == 0u) { xcd_barrier_complete(bar, b.x, nloc, nx); b.st[0] = nloc; b.st[1] = nx; }
        const unsigned old = xb_add(&bar[XB_XSUB(b.x)], 1u);
        const unsigned gen = old / nloc;
        if (old + 1u == (gen + 1u) * nloc) {
            __builtin_amdgcn_fence(__ATOMIC_RELEASE, "agent");
            asm volatile("s_waitcnt vmcnt(0)" ::: "memory");
            const unsigned og = xb_add(&bar[XB_TOP], 1u);
            const unsigned tg = og / nx;
            if (og + 1u == (tg + 1u) * nx) xb_add(&bar[XB_TOPGEN], 1u);
            else XB_SPIN(xb_ld(&bar[XB_TOPGEN]) == tg, bar);
            __builtin_amdgcn_fence(__ATOMIC_ACQUIRE, "agent");
            xb_add(&bar[XB_XGEN(b.x)], 1u);
            asm volatile("s_waitcnt vmcnt(0)" ::: "memory");
        } else {
            XB_SPIN(xb_ld(&bar[XB_XGEN(b.x)]) == gen, bar);
            __builtin_amdgcn_fence(__ATOMIC_ACQUIRE, "agent");
            asm volatile("s_waitcnt vmcnt(0)" ::: "memory");
        }
    }
    __syncthreads();
}


typedef float f32x2 __attribute__((ext_vector_type(2)));
typedef float f32x8v __attribute__((ext_vector_type(8)));
typedef unsigned u32x2 __attribute__((ext_vector_type(2)));
typedef short s16x4 __attribute__((ext_vector_type(4)));
typedef float f32x16 __attribute__((ext_vector_type(16)));

typedef float cvt_f32x2 __attribute__((ext_vector_type(2))); typedef __bf16 cvt_bf16x2 __attribute__((ext_vector_type(2)));
__device__ __forceinline__ unsigned cvtpk(float lo, float hi) { return __builtin_bit_cast(unsigned, __builtin_convertvector((cvt_f32x2){lo, hi}, cvt_bf16x2)); }
__device__ __forceinline__ float bflo(unsigned w) { return __uint_as_float(w << 16); }
__device__ __forceinline__ float bfhi(unsigned w) { return __uint_as_float(w & 0xffff0000u); }
__device__ __forceinline__ float sigmoidf_(float x) { return __builtin_amdgcn_rcpf(1.0f + __expf(-x)); }
__device__ __forceinline__ float siluf_(float x) { return x * __builtin_amdgcn_rcpf(1.0f + __expf(-x)); }
template <int K> __device__ __forceinline__ float swz_xor(float v) { return __int_as_float(__builtin_amdgcn_ds_swizzle(__float_as_int(v), 0x1F | (K << 10))); }
__device__ __forceinline__ float sum_x16(float v) { const auto rr = __builtin_amdgcn_permlane16_swap(__float_as_uint(v), __float_as_uint(v), false, false); return __uint_as_float(rr[0]) + __uint_as_float(rr[1]); }
__device__ __forceinline__ float sum_x32(float v) { const auto rr = __builtin_amdgcn_permlane32_swap(__float_as_uint(v), __float_as_uint(v), false, false); return __uint_as_float(rr[0]) + __uint_as_float(rr[1]); }
__device__ __forceinline__ float wave_sum(float v) { v += swz_xor<1>(v); v += swz_xor<2>(v); v += swz_xor<4>(v); v += swz_xor<8>(v); v = sum_x16(v); return sum_x32(v); }
__device__ __forceinline__ unsigned pk4_fp8(float a, float b, float c, float d) {
    a = __builtin_amdgcn_fmed3f(a, -448.f, 448.f); b = __builtin_amdgcn_fmed3f(b, -448.f, 448.f); c = __builtin_amdgcn_fmed3f(c, -448.f, 448.f); d = __builtin_amdgcn_fmed3f(d, -448.f, 448.f);
    int w = __builtin_amdgcn_cvt_pk_fp8_f32(a, b, 0, false); w = __builtin_amdgcn_cvt_pk_fp8_f32(c, d, w, true); return (unsigned)w; }
__device__ __forceinline__ int opaque_tid() { return pg8::fresh_tid(); }
__device__ __forceinline__ int seq_pos(int m) { return m < MPROMPT ? (m & (SEQ_P - 1)) : (m & (SEQ_S - 1)); }

struct Frame {
    LAS unsigned char* lds;
    volatile LAS unsigned* MISC;
    gu32* ctl;
    int tid, lane, wave, vcu, G;
    unsigned char* ws;
    float* out;
};
enum { IN_XP = 0, IN_XS = 1, IN_NORM_IN = 2, IN_W_IN = 3, IN_B_GATES = 4, IN_Q_A_NORM = 5, IN_W_UQ = 6, IN_KV_A_NORM = 7, IN_W_UKV = 8, IN_W_OA = 9, IN_M_HEAD_NORM = 10, IN_W_OB = 11, IN_W_OUT = 12, IN_NORM_F = 13 };
struct Args { const float* in[14]; float* out; unsigned char* ws; int ph_lo, ph_hi; };

__device__ __forceinline__ int wmap(int kind, int n) {
    if (kind == 0) {
        if (n < 3072) return SRC_QM + n;
        if (n < 3136) { const int j = n - 3072; return SRC_KROPE + (j >> 1) + 32 * (j & 1); }
        if (n < 3168) return SRC_GATES + (n - 3136);
        return -1;
    }
    if (kind == 5) return n;
    if (kind == 1) {
        if (n < 2048) { const int t = n >> 8, w = n & 255; return (w < 128 ? SRC_OM : SRC_ZM) + t * 128 + (w & 127); }
        return SRC_GB + (n - 2048);
    }
    if (kind == 6) {
        if (n < 1024) return SRC_ZA + n;
        return SRC_GA + (n - 1024);
    }
    if (kind == 2) {
        if (n < 1024) return (n >> 7) * 192 + (n & 127);
        const int j = n - 1024, h = j >> 6, jj = j & 63; return h * 192 + 128 + (jj >> 1) + 32 * (jj & 1);
    }
    if (kind == 3) {
        if (n < 1024) return (n >> 7) * 256 + (n & 127);
        const int j = n - 1024; return (j >> 7) * 256 + 128 + (j & 127);
    }
    return n;
}
__device__ __forceinline__ void transpose_item(const float* W, int K, int srcN, bf16* WT, int Ndst, int kind, const float* kgain, LAS float* scr, int item, int lane) {
    const int nblk = Ndst / 32, kb = item / nblk, nb = item % nblk, k0 = 64 * kb, n0 = 32 * nb;
    const int n = n0 + (lane & 31); const int sc = wmap(kind, n);
    const float cs = (kind == 0 && n < 1024) ? 0.08838834764831845f : 1.0f;
    float tv[32];
#pragma unroll
    for (int i = 0; i < 32; ++i) { const int kk = 2 * i + (lane >> 5);
        float v = 0.f; if (sc >= 0) { v = W[(size_t)(k0 + kk) * srcN + sc] * cs; if (kgain) v *= kgain[k0 + kk]; }
        tv[i] = v; }
#pragma unroll
    for (int i = 0; i < 32; ++i) scr[(2 * i + (lane >> 5)) * 33 + (lane & 31)] = tv[i];
    LDS_WAIT(); asm volatile("" ::: "memory");
    const int c = lane & 7;
#pragma unroll
    for (int j = 0; j < 4; ++j) { const int nn = (lane >> 3) + 8 * j; const LAS float* s = scr + (8 * c) * 33 + nn;
        v4u o; o.x = pk2(s[0 * 33], s[1 * 33]); o.y = pk2(s[2 * 33], s[3 * 33]); o.z = pk2(s[4 * 33], s[5 * 33]); o.w = pk2(s[6 * 33], s[7 * 33]);
        *(GAS v4u*)(WT + (size_t)(n0 + nn) * K + k0 + 8 * c) = o; }
    LDS_WAIT(); asm volatile("" ::: "memory");
}
__device__ __forceinline__ void transpose_item8(const float* W, int K, int srcN, unsigned char* WT, int Ndst, int kind, const float* kgain, float wscale, LAS float* scr, int item, int lane) {
    const int nblk = Ndst / 32, kb = item / nblk, nb = item % nblk, k0 = 64 * kb, n0 = 32 * nb;
    const int n = n0 + (lane & 31); const int sc = wmap(kind, n);
    float tv[32];
#pragma unroll
    for (int i = 0; i < 32; ++i) { const int kk = 2 * i + (lane >> 5);
        float v = 0.f; if (sc >= 0) { v = W[(size_t)(k0 + kk) * srcN + sc] * wscale; if (kgain) v *= kgain[k0 + kk]; }
        tv[i] = v; }
#pragma unroll
    for (int i = 0; i < 32; ++i) scr[(2 * i + (lane >> 5)) * 33 + (lane & 31)] = tv[i];
    LDS_WAIT(); asm volatile("" ::: "memory");
    const int nn = lane >> 1, kh = (lane & 1) * 32; const LAS float* s = scr + kh * 33 + nn;
#pragma unroll
    for (int c = 0; c < 2; ++c) { v4u o;
        o.x = pk4_fp8(s[(16 * c + 0) * 33], s[(16 * c + 1) * 33], s[(16 * c + 2) * 33], s[(16 * c + 3) * 33]); o.y = pk4_fp8(s[(16 * c + 4) * 33], s[(16 * c + 5) * 33], s[(16 * c + 6) * 33], s[(16 * c + 7) * 33]);
        o.z = pk4_fp8(s[(16 * c + 8) * 33], s[(16 * c + 9) * 33], s[(16 * c + 10) * 33], s[(16 * c + 11) * 33]); o.w = pk4_fp8(s[(16 * c + 12) * 33], s[(16 * c + 13) * 33], s[(16 * c + 14) * 33], s[(16 * c + 15) * 33]);
        *(GAS v4u*)(WT + (size_t)(n0 + nn) * K + k0 + kh + 16 * c) = o; }
    LDS_WAIT(); asm volatile("" ::: "memory");
}
__device__ __forceinline__ void p_prologue(Frame& F, const Args& A) {
    const int tid_ = opaque_tid(), lane_ = tid_ & 63, wave_ = __builtin_amdgcn_readfirstlane(tid_ >> 6);
    LAS float* scr = (LAS float*)(F.lds + wave_ * 16384);
    const int gw = F.vcu * NWAVES + wave_, NGW = F.G * NWAVES;
    constexpr int I_P1A = (DM / 64) * (NP1A / 32), I_P1B = (DM / 64) * (NP1B / 32), I_P2A = (DM / 64) * (NP2A / 32), I_P2B = (DM / 64) * (NP2B / 32), I_UQ = (512 / 64) * (NQ / 32),
                  I_UKV = (512 / 64) * (NKV / 32), I_OA = (1024 / 64) * (DM / 32), I_OB = I_OA, I_OUT = (DM / 64) * (DM / 32), I_LAYER = I_P1A + I_P1B + I_P2A + I_P2B + I_UQ + I_UKV + I_OA + I_OB + I_OUT;
    for (int it = gw; it < DEPTH * I_LAYER; it += NGW) {
        const int l = it / I_LAYER; int r = it - l * I_LAYER;
        unsigned char* wb = F.ws + WS_W + (size_t)l * LW;
        const float* win = A.in[IN_W_IN] + (size_t)l * DM * IN_COLS;
        if (r < I_P1A) { transpose_item8(win, DM, IN_COLS, wb + W_P1A, NP1A, 5, nullptr, 64.f, scr, r, lane_); continue; } r -= I_P1A;
        if (r < I_P1B) { transpose_item(win, DM, IN_COLS, (bf16*)(wb + W_P1B), NP1B, 0, nullptr, scr, r, lane_); continue; } r -= I_P1B;
        if (r < I_P2A) { transpose_item8(win, DM, IN_COLS, wb + W_P2A, NP2A, 6, nullptr, 64.f, scr, r, lane_); continue; } r -= I_P2A;
        if (r < I_P2B) { transpose_item(win, DM, IN_COLS, (bf16*)(wb + W_P2B), NP2B, 1, nullptr, scr, r, lane_); continue; } r -= I_P2B;
        if (r < I_UQ) { transpose_item8(A.in[IN_W_UQ] + (size_t)l * 512 * NQ, 512, NQ, wb + W_UQ, NQ, 2, A.in[IN_Q_A_NORM] + l * 512, 32.f, scr, r, lane_); continue; } r -= I_UQ;
        if (r < I_UKV) { transpose_item8(A.in[IN_W_UKV] + (size_t)l * 512 * NKV, 512, NKV, wb + W_UKV, NKV, 3, A.in[IN_KV_A_NORM] + l * 512, 32.f, scr, r, lane_); continue; } r -= I_UKV;
        if (r < I_OA) { transpose_item8(A.in[IN_W_OA] + (size_t)l * 1024 * DM, 1024, DM, wb + W_OA, DM, 4, nullptr, 32.f, scr, r, lane_); continue; } r -= I_OA;
        if (r < I_OB) { transpose_item(A.in[IN_W_OB] + (size_t)l * 1024 * DM, 1024, DM, (bf16*)(wb + W_OB), DM, 4, nullptr, scr, r, lane_); continue; } r -= I_OB;
        transpose_item(A.in[IN_W_OUT] + (size_t)l * DM * DM, DM, DM, (bf16*)(wb + W_OUT), DM, 4, nullptr, scr, r, lane_);
    }
    for (int e = F.vcu * 512 + tid_; e < DEPTH * 1024; e += F.G * 512) ((float*)(F.ws + WS_HG))[e] = A.in[IN_M_HEAD_NORM][e];
    f32x2* rope = (f32x2*)(F.ws + WS_ROPE);
    for (int e = F.vcu * 512 + tid_; e < SEQ_P * 32; e += F.G * 512) {
        const int pos = e >> 5, i = e & 31;
        const float inv = powf(10000.0f, -(float)(2 * i) / 64.0f);
        const float ang = (float)pos * inv; float s, c; sincosf(ang, &s, &c);
        rope[e] = (f32x2){c, s};
    }
}

__device__ __forceinline__ const float* x_row(Frame& F, const Args& A, int layer, int m) {
    if (layer == 0) return m < MPROMPT ? A.in[IN_XP] + (size_t)m * DM : A.in[IN_XS] + (size_t)(m - MPROMPT) * DM;
    return F.out + (size_t)m * DM;
}
__device__ __forceinline__ void p_norm(Frame& F, const Args& A, int layer) {
    const int tid_ = opaque_tid(), lane_ = tid_ & 63, wave_ = __builtin_amdgcn_readfirstlane(tid_ >> 6);
    const int gw = F.vcu * NWAVES + wave_, NGW = F.G * NWAVES;
    const float* g = A.in[IN_NORM_IN] + layer * DM; bf16* XN = (bf16*)(F.ws + WS_XN);
    for (int m = gw; m < MTOK; m += NGW) {
        const GAS f32x4* xr = (const GAS f32x4*)x_row(F, A, layer, m) + lane_;
        f32x4 v[8]; float s = 0.f;
#pragma unroll
        for (int j = 0; j < 8; ++j) { v[j] = xr[64 * j]; s += (v[j].x * v[j].x + v[j].y * v[j].y) + (v[j].z * v[j].z + v[j].w * v[j].w); }
        const float rs = 1.0f / sqrtf(wave_sum(s) * (1.0f / DM) + EPS);
        GAS unsigned long long* o8 = (GAS unsigned long long*)(XN + (size_t)m * DM) + lane_;
#pragma unroll
        for (int j = 0; j < 8; ++j) { const f32x4 gg = *((const GAS f32x4*)g + lane_ + 64 * j);
            const float y0 = v[j].x * rs * gg.x, y1 = v[j].y * rs * gg.y, y2 = v[j].z * rs * gg.z, y3 = v[j].w * rs * gg.w;
            o8[64 * j] = (unsigned long long)cvtpk(y0, y1) | ((unsigned long long)cvtpk(y2, y3) << 32);
            ((GAS unsigned*)(F.ws + WS_XN8 + (size_t)m * DM))[lane_ + 64 * j] = pk4_fp8(y0, y1, y2, y3); }
    }
}
__device__ __forceinline__ void p_final(Frame& F, const Args& A) {
    const int tid_ = opaque_tid(), lane_ = tid_ & 63, wave_ = __builtin_amdgcn_readfirstlane(tid_ >> 6);
    const int gw = F.vcu * NWAVES + wave_, NGW = F.G * NWAVES;
    for (int m = gw; m < MTOK; m += NGW) {
        GAS f32x4* xr = (GAS f32x4*)(F.out + (size_t)m * DM) + lane_;
        f32x4 v[8]; float s = 0.f;
#pragma unroll
        for (int j = 0; j < 8; ++j) { v[j] = xr[64 * j]; s += (v[j].x * v[j].x + v[j].y * v[j].y) + (v[j].z * v[j].z + v[j].w * v[j].w); }
        const float rs = 1.0f / sqrtf(wave_sum(s) * (1.0f / DM) + EPS);
#pragma unroll
        for (int j = 0; j < 8; ++j) { const f32x4 gg = *((const GAS f32x4*)A.in[IN_NORM_F] + lane_ + 64 * j); xr[64 * j] = v[j] * rs * gg; }
    }
}

using pg8::Unit; using pg8::BM; using pg8::HALF;
#define EPI_ROWS_BEGIN  _Pragma("unroll") for (int ai = 0; ai < 2; ++ai) _Pragma("unroll") for (int m = 0; m < 4; ++m) { const int row = u.pm * BM + ai * HALF + wr * 64 + m * 16 + fr;
#define EPI_ROWS_END    asm volatile("" ::: "memory"); }
#define EPI_ROW(ai, m) (u.pm * BM + (ai) * HALF + wr * 64 + (m) * 16 + fr)
#define EPI_FENCE asm volatile("" ::: "memory")

struct EpiP1a {
    static constexpr int PERM = 2; static constexpr bool AFTER_DRAIN = false;
    unsigned char* ws; size_t dst;
    __device__ __forceinline__ void operator()(const f32x4 (&acc)[2][2][4][2], const Unit& u, int wr, int wc, int fr, int fq) const {
        const int pn = u.pn, col0 = pn * 256 + wc * 64 + 16 * fq;
        EPI_ROWS_BEGIN
            float s = 0.f; v4u w;
#pragma unroll
            for (int bj = 0; bj < 2; ++bj) { const f32x4 v0 = acc[ai][bj][m][0] * 0.015625f, v1 = acc[ai][bj][m][1] * 0.015625f;
                s += (v0[0] * v0[0] + v0[1] * v0[1]) + (v0[2] * v0[2] + v0[3] * v0[3]) + (v1[0] * v1[0] + v1[1] * v1[1]) + (v1[2] * v1[2] + v1[3] * v1[3]);
                w[2 * bj] = pk4_fp8(v0[0], v0[1], v0[2], v0[3]); w[2 * bj + 1] = pk4_fp8(v1[0], v1[1], v1[2], v1[3]); }
            *(v4u*)(ws + dst + (size_t)row * 1024 + col0) = w;
            s = sum_x16(s); s = sum_x32(s); if (fq == 0) ((float*)(ws + WS_SSQ))[(size_t)row * 16 + pn * 4 + wc] = s;
        EPI_ROWS_END
    }
};
struct EpiP1b {
    static constexpr bool PERM = true, AFTER_DRAIN = false;
    unsigned char* ws;
    __device__ __forceinline__ void operator()(const f32x4 (&acc)[2][2][4][2], const Unit& u, int wr, int wc, int fr, int fq) const {
        const int pn = u.pn;
        if (pn < 12) {
            bf16* base = (bf16*)(ws + WS_QM + (size_t)(pn >> 2) * U); const int col0 = (pn & 3) * 256 + wc * 32 + 8 * fq;
            EPI_ROWS_BEGIN
                bf16* rowp = base + (size_t)row * 1024 + col0;
#pragma unroll
                for (int bj = 0; bj < 2; ++bj) { const f32x4 v0 = acc[ai][bj][m][0], v1 = acc[ai][bj][m][1];
                    v4u w; w.x = cvtpk(v0[0], v0[1]); w.y = cvtpk(v0[2], v0[3]); w.z = cvtpk(v1[0], v1[1]); w.w = cvtpk(v1[2], v1[3]);
                    *(v4u*)(rowp + bj * HALF) = w; }
            EPI_ROWS_END
        } else if (wc < 2) {
#pragma unroll
            for (int ai = 0; ai < 2; ++ai) { f32x4 cs[4][2];
#pragma unroll
                for (int m = 0; m < 4; ++m) { const f32x2* rp = (const f32x2*)(ws + WS_ROPE) + seq_pos(EPI_ROW(ai, m)) * 32 + 16 * wc + 4 * fq; cs[m][0] = *(const f32x4*)rp; cs[m][1] = *(const f32x4*)(rp + 2); }
                EPI_FENCE;
#pragma unroll
                for (int m = 0; m < 4; ++m) { const f32x4 cs01 = cs[m][0], cs23 = cs[m][1]; const f32x4 a = acc[ai][0][m][0], b = acc[ai][0][m][1];
                    *(u32x2*)(ws + WS_KR + (size_t)EPI_ROW(ai, m) * 64 + 32 * wc + 8 * fq) = (u32x2){
                        pk4_fp8(a[0] * cs01[0] - a[1] * cs01[1], a[1] * cs01[0] + a[0] * cs01[1], a[2] * cs01[2] - a[3] * cs01[3], a[3] * cs01[2] + a[2] * cs01[3]),
                        pk4_fp8(b[0] * cs23[0] - b[1] * cs23[1], b[1] * cs23[0] + b[0] * cs23[1], b[2] * cs23[2] - b[3] * cs23[3], b[3] * cs23[2] + b[2] * cs23[3])};
                    EPI_FENCE; } }
        } else if (wc == 2) {
            EPI_ROWS_BEGIN
                float* gp = (float*)(ws + WS_KRG) + (size_t)row * 96 + 64 + 8 * fq;
                *(f32x4*)gp = acc[ai][0][m][0]; *(f32x4*)(gp + 4) = acc[ai][0][m][1];
            EPI_ROWS_END
        }
    }
};
struct EpiQ {
    static constexpr bool PERM = true, AFTER_DRAIN = false;
    unsigned char* ws;
    __device__ __forceinline__ void operator()(const f32x4 (&acc)[2][2][4][2], const Unit& u, int wr, int wc, int fr, int fq) const {
        const int col0 = u.pn * 256 + wc * 32 + 8 * fq;
#pragma unroll
        for (int ai = 0; ai < 2; ++ai) {
            f32x4 sq[4][2];
#pragma unroll
            for (int m = 0; m < 4; ++m) { const float* sp = (const float*)(ws + WS_SSQ) + (size_t)EPI_ROW(ai, m) * 16; sq[m][0] = *(const f32x4*)sp; sq[m][1] = *(const f32x4*)(sp + 4); }
            EPI_FENCE;
#pragma unroll
            for (int m = 0; m < 4; ++m) { const int row = EPI_ROW(ai, m); const f32x4 s0 = sq[m][0], s1 = sq[m][1];
                const float rs = 0.03125f / sqrtf(((s0[0] + s0[1]) + (s0[2] + s0[3]) + (s1[0] + s1[1]) + (s1[2] + s1[3])) * (1.0f / 512.0f) + EPS);
                bf16* rowp = (bf16*)(ws + WS_Q) + (size_t)row * NQ + col0;
#pragma unroll
                for (int bj = 0; bj < 2; ++bj) { const f32x4 v0 = acc[ai][bj][m][0] * rs, v1 = acc[ai][bj][m][1] * rs;
                    v4u w; w.x = cvtpk(v0[0], v0[1]); w.y = cvtpk(v0[2], v0[3]); w.z = cvtpk(v1[0], v1[1]); w.w = cvtpk(v1[2], v1[3]);
                    *(v4u*)(rowp + bj * HALF) = w; }
                EPI_FENCE; }
        }
    }
};
struct EpiK8 {
    static constexpr int PERM = 2; static constexpr bool AFTER_DRAIN = false;
    unsigned char* ws;
    __device__ __forceinline__ void operator()(const f32x4 (&acc)[2][2][4][2], const Unit& u, int wr, int wc, int fr, int fq) const {
        const int col0 = u.pn * 256 + wc * 64 + 16 * fq;
#pragma unroll
        for (int ai = 0; ai < 2; ++ai) {
            f32x4 sq[4][2];
#pragma unroll
            for (int m = 0; m < 4; ++m) { const float* sp = (const float*)(ws + WS_SSQ) + (size_t)EPI_ROW(ai, m) * 16 + 8; sq[m][0] = *(const f32x4*)sp; sq[m][1] = *(const f32x4*)(sp + 4); }
            EPI_FENCE;
#pragma unroll
            for (int m = 0; m < 4; ++m) { const int row = EPI_ROW(ai, m); const f32x4 s0 = sq[m][0], s1 = sq[m][1];
                const float rs = 0.03125f / sqrtf(((s0[0] + s0[1]) + (s0[2] + s0[3]) + (s1[0] + s1[1]) + (s1[2] + s1[3])) * (1.0f / 512.0f) + EPS);
                v4u w;
#pragma unroll
                for (int bj = 0; bj < 2; ++bj) { const f32x4 v0 = acc[ai][bj][m][0] * rs, v1 = acc[ai][bj][m][1] * rs;
                    w[2 * bj] = pk4_fp8(v0[0], v0[1], v0[2], v0[3]); w[2 * bj + 1] = pk4_fp8(v1[0], v1[1], v1[2], v1[3]); }
                *(v4u*)(ws + WS_K8 + (size_t)row * 1024 + col0) = w;
                EPI_FENCE; }
        }
    }
};
struct EpiVT {
    static constexpr int PERM = 2; static constexpr bool AFTER_DRAIN = false;
    unsigned char* ws;
    __device__ __forceinline__ void operator()(const f32x4 (&acc)[2][2][4][2], const Unit& u, int wr, int wc, int fr, int fq) const {
        const int tok0 = u.pn * 256 + wc * 64 + 16 * fq;
        const int J0 = 2 * fq, pos = 4 * (J0 & 3) + 16 * (J0 >> 2);
        f32x4 rq[2][2];
#pragma unroll
        for (int bj = 0; bj < 2; ++bj) { f32x4 sq[8][2];
#pragma unroll
            for (int e = 0; e < 8; ++e) { const float* sp = (const float*)(ws + WS_SSQ) + (size_t)(tok0 + 8 * bj + e) * 16 + 8; sq[e][0] = *(const f32x4*)sp; sq[e][1] = *(const f32x4*)(sp + 4); }
            EPI_FENCE;
#pragma unroll
            for (int e = 0; e < 8; ++e) { const f32x4 s0 = sq[e][0], s1 = sq[e][1];
                rq[bj][e >> 2][e & 3] = 0.03125f / sqrtf(((s0[0] + s0[1]) + (s0[2] + s0[3]) + (s1[0] + s1[1]) + (s1[2] + s1[3])) * (1.0f / 512.0f) + EPS); } }
        EPI_ROWS_BEGIN
            unsigned char* rowp = ws + WS_V8T + ((size_t)(tok0 >> 6) * 1024 + row) * 64 + pos;
            const f32x4 a0 = acc[ai][0][m][0] * rq[0][0], a1 = acc[ai][0][m][1] * rq[0][1], b0 = acc[ai][1][m][0] * rq[1][0], b1 = acc[ai][1][m][1] * rq[1][1];
            *(u32x2*)rowp = (u32x2){pk4_fp8(a0[0], a0[1], a0[2], a0[3]), pk4_fp8(b0[0], b0[1], b0[2], b0[3])};
            *(u32x2*)(rowp + 32) = (u32x2){pk4_fp8(a1[0], a1[1], a1[2], a1[3]), pk4_fp8(b1[0], b1[1], b1[2], b1[3])};
        EPI_ROWS_END
    }
};
struct EpiP2a {
    static constexpr int PERM = 2; static constexpr bool AFTER_DRAIN = false;
    unsigned char* ws; size_t sga;
    __device__ __forceinline__ void operator()(const f32x4 (&acc)[2][2][4][2], const Unit& u, int wr, int wc, int fr, int fq) const {
        const int pn = u.pn;
        if (pn < 4) {
            const int col0 = pn * 256 + wc * 64 + 16 * fq;
#pragma unroll
            for (int ai = 0; ai < 2; ++ai) { v4u ov[4][2];
#pragma unroll
              for (int m = 0; m < 4; ++m) { const bf16* orow = (const bf16*)(ws + WS_CQKV) + (size_t)EPI_ROW(ai, m) * 1024 + col0; ov[m][0] = *(const v4u*)orow; ov[m][1] = *(const v4u*)(orow + 8); }
              EPI_FENCE;
#pragma unroll
              for (int m = 0; m < 4; ++m) { const int row = EPI_ROW(ai, m); v4u w;
#pragma unroll
                for (int bj = 0; bj < 2; ++bj) { f32x4 v0 = acc[ai][bj][m][0] * 0.015625f, v1 = acc[ai][bj][m][1] * 0.015625f;
                    const v4u o = ov[m][bj];
#pragma unroll
                    for (int j = 0; j < 4; ++j) { v0[j] = 64.f * siluf_(v0[j]); v1[j] = 64.f * siluf_(v1[j]); }
                    v0[0] *= bflo(o.x); v0[1] *= bfhi(o.x); v0[2] *= bflo(o.y); v0[3] *= bfhi(o.y); v1[0] *= bflo(o.z); v1[1] *= bfhi(o.z); v1[2] *= bflo(o.w); v1[3] *= bfhi(o.w);
                    w[2 * bj] = pk4_fp8(v0[0], v0[1], v0[2], v0[3]); w[2 * bj + 1] = pk4_fp8(v1[0], v1[1], v1[2], v1[3]); }
                *(v4u*)(ws + WS_YA8 + (size_t)row * 1024 + col0) = w;
                EPI_FENCE; } }
        } else {
            const int col0 = (pn - 4) * 256 + wc * 64 + 16 * fq;
            EPI_ROWS_BEGIN
                bf16* rowp = (bf16*)(ws + sga) + (size_t)row * 2048 + col0;
#pragma unroll
                for (int bj = 0; bj < 2; ++bj) { f32x4 v0 = acc[ai][bj][m][0] * 0.015625f, v1 = acc[ai][bj][m][1] * 0.015625f;
#pragma unroll
                    for (int j = 0; j < 4; ++j) { v0[j] = sigmoidf_(v0[j]); v1[j] = sigmoidf_(v1[j]); }
                    v4u w; w.x = cvtpk(v0[0], v0[1]); w.y = cvtpk(v0[2], v0[3]); w.z = cvtpk(v1[0], v1[1]); w.w = cvtpk(v1[2], v1[3]);
                    *(v4u*)(rowp + 8 * bj) = w; }
            EPI_ROWS_END
        }
    }
};
struct EpiP2b {
    static constexpr bool PERM = true, AFTER_DRAIN = false;
    unsigned char* ws; int layer;
    __device__ __forceinline__ void operator()(const f32x4 (&acc)[2][2][4][2], const Unit& u, int wr_, int wc_, int fr_, int fq_) const {
        const int t_ = opaque_tid(), wr = t_ >> 8, wc = (t_ >> 6) & 3, fr = t_ & 15, fq = (t_ >> 4) & 3;
        const int pn = u.pn;
        if (pn < 8) {
            extern __shared__ __attribute__((aligned(16))) unsigned char lds[];
            LAS float* red = (LAS float*)((LAS unsigned char*)lds + 131072);
            const int colh = pn * 128 + wc * 32 + 8 * fq;
#pragma unroll
            for (int ai = 0; ai < 2; ++ai) { v4u ha[4], hb[4];
#pragma unroll
                for (int m = 0; m < 4; ++m) { const size_t off = (size_t)EPI_ROW(ai, m) * 1024 + colh; ha[m] = *(const v4u*)((const bf16*)(ws + WS_HFW) + off); hb[m] = *(const v4u*)((const bf16*)(ws + WS_HBW) + off); }
                EPI_FENCE;
#pragma unroll
                for (int m = 0; m < 4; ++m) { const v4u a = ha[m], b = hb[m]; float s = 0.f;
#pragma unroll
                    for (int e = 0; e < 4; ++e) { const float lo = bflo(a[e]) + bflo(b[e]), hi = bfhi(a[e]) + bfhi(b[e]); s += lo * lo + hi * hi; }
                    s = sum_x16(s); s = sum_x32(s);
                    if (fq == 0) red[(wr * 128 + ai * 64 + m * 16 + fr) * 4 + wc] = s; }
                EPI_FENCE; }
            LDS_WAIT(); __builtin_amdgcn_s_barrier(); asm volatile("" ::: "memory");
            const int t2_ = opaque_tid(), wr2 = t2_ >> 8, fr2 = t2_ & 15, colh2 = pn * 128 + ((t2_ >> 6) & 3) * 32 + 8 * ((t2_ >> 4) & 3);
#define EPI_ROW2(ai, m) (u.pm * BM + (ai) * HALF + wr2 * 64 + (m) * 16 + fr2)
            const float* gain = (const float*)(ws + WS_HG) + layer * 1024 + colh2; const f32x4 g0 = *(const f32x4*)gain, g1 = *(const f32x4*)(gain + 4);
#pragma unroll
            for (int ai = 0; ai < 2; ++ai)
#pragma unroll
              for (int mh = 0; mh < 2; ++mh) { v4u ha[2], hb[2];
#pragma unroll
                for (int mm = 0; mm < 2; ++mm) { const size_t off = (size_t)EPI_ROW2(ai, 2 * mh + mm) * 1024 + colh2; ha[mm] = *(const v4u*)((const bf16*)(ws + WS_HFW) + off); hb[mm] = *(const v4u*)((const bf16*)(ws + WS_HBW) + off); }
                EPI_FENCE;
#pragma unroll
                for (int mm = 0; mm < 2; ++mm) { const int m = 2 * mh + mm; const size_t off = (size_t)EPI_ROW2(ai, m) * 1024 + colh2;
                    const f32x4 pr = *(const LAS f32x4*)(red + (wr2 * 128 + ai * 64 + m * 16 + fr2) * 4);
                    const float rs = 1.0f / sqrtf(((pr[0] + pr[1]) + (pr[2] + pr[3])) * (1.0f / 128.0f) + EPS);
                    const v4u a = ha[mm], b = hb[mm];
                    const f32x4 o0 = acc[ai][0][m][0], o1 = acc[ai][0][m][1], z0 = acc[ai][1][m][0], z1 = acc[ai][1][m][1];
                    float y[8];
#pragma unroll
                    for (int e = 0; e < 4; ++e) { y[2 * e] = (bflo(a[e]) + bflo(b[e])) * rs; y[2 * e + 1] = (bfhi(a[e]) + bfhi(b[e])) * rs; }
#pragma unroll
                    for (int j = 0; j < 4; ++j) { y[j] *= g0[j] * sigmoidf_(o0[j]) * (z0[j] * sigmoidf_(z0[j])); y[4 + j] *= g1[j] * sigmoidf_(o1[j]) * (z1[j] * sigmoidf_(z1[j])); }
                    v4u w; w.x = cvtpk(y[0], y[1]); w.y = cvtpk(y[2], y[3]); w.z = cvtpk(y[4], y[5]); w.w = cvtpk(y[6], y[7]);
                    *(v4u*)((bf16*)(ws + WS_HFW) + off) = w;
                    EPI_FENCE; } }
        } else {
            const int col0 = (pn - 8) * 256 + wc * 32 + 8 * fq;
            EPI_ROWS_BEGIN
                bf16* rowp = (bf16*)(ws + WS_SGB) + (size_t)row * 2048 + col0;
#pragma unroll
                for (int bj = 0; bj < 2; ++bj) { f32x4 v0 = acc[ai][bj][m][0], v1 = acc[ai][bj][m][1];
#pragma unroll
                    for (int j = 0; j < 4; ++j) { v0[j] = sigmoidf_(v0[j]); v1[j] = sigmoidf_(v1[j]); }
                    v4u w; w.x = cvtpk(v0[0], v0[1]); w.y = cvtpk(v0[2], v0[3]); w.z = cvtpk(v1[0], v1[1]); w.w = cvtpk(v1[2], v1[3]);
                    *(v4u*)(rowp + bj * HALF) = w; }
            EPI_ROWS_END
        }
    }
};
struct MidMerge {
    unsigned char* ws;
    __device__ __forceinline__ void operator()(f32x4 (&acc)[2][2][4][2], const Unit& u, int wr, int wc, int fr, int fq) const {
        const int col0 = u.pn * 256 + wc * 32 + 8 * fq;
#pragma unroll
        for (int ai = 0; ai < 2; ++ai)
#pragma unroll
          for (int mh = 0; mh < 2; ++mh) {
            v4u ga[2][2], gb[2][2];
#pragma unroll
            for (int mm = 0; mm < 2; ++mm)
#pragma unroll
                for (int bj = 0; bj < 2; ++bj) { const size_t off = (size_t)EPI_ROW(ai, 2 * mh + mm) * DM + col0 + bj * HALF; ga[mm][bj] = *(const v4u*)((const bf16*)(ws + WS_SGA) + off); gb[mm][bj] = *(const v4u*)((const bf16*)(ws + WS_SGB) + off); }
            EPI_FENCE;
#pragma unroll
            for (int mm = 0; mm < 2; ++mm)
#pragma unroll
                for (int bj = 0; bj < 2; ++bj) { const int m = 2 * mh + mm; const v4u a = ga[mm][bj], b = gb[mm][bj]; float r[8];
#pragma unroll
                    for (int e = 0; e < 4; ++e) { r[2 * e] = 2048.f * bflo(b[e]) * __builtin_amdgcn_rcpf(fmaxf(bflo(a[e]), 9.094947e-13f)); r[2 * e + 1] = 2048.f * bfhi(b[e]) * __builtin_amdgcn_rcpf(fmaxf(bfhi(a[e]), 9.094947e-13f)); }
                    f32x4 v0 = acc[ai][bj][m][0], v1 = acc[ai][bj][m][1];
                    v0[0] *= r[0]; v0[1] *= r[1]; v0[2] *= r[2]; v0[3] *= r[3]; v1[0] *= r[4]; v1[1] *= r[5]; v1[2] *= r[6]; v1[3] *= r[7];
                    acc[ai][bj][m][0] = v0; acc[ai][bj][m][1] = v1; }
            EPI_FENCE;
          }
    }
};
struct EpiMerge2 {
    static constexpr bool PERM = true, AFTER_DRAIN = false;
    unsigned char* ws;
    __device__ __forceinline__ void operator()(const f32x4 (&acc)[2][2][4][2], const Unit& u, int wr, int wc, int fr, int fq) const {
        const int col0 = u.pn * 256 + wc * 32 + 8 * fq; bf16* T = (bf16*)(ws + WS_MG);
#pragma unroll
        for (int ai = 0; ai < 2; ++ai) {
            v4u gv[4][2];
#pragma unroll
            for (int m = 0; m < 4; ++m)
#pragma unroll
                for (int bj = 0; bj < 2; ++bj) gv[m][bj] = *(const v4u*)((const bf16*)(ws + WS_SGA) + (size_t)EPI_ROW(ai, m) * DM + col0 + bj * HALF);
            EPI_FENCE;
#pragma unroll
            for (int m = 0; m < 4; ++m) { const size_t off = (size_t)EPI_ROW(ai, m) * DM + col0;
#pragma unroll
                for (int bj = 0; bj < 2; ++bj) { f32x4 v0 = acc[ai][bj][m][0] * 0.00048828125f, v1 = acc[ai][bj][m][1] * 0.00048828125f; const v4u g = gv[m][bj];
                    v0[0] *= fmaxf(bflo(g.x), 9.094947e-13f); v0[1] *= fmaxf(bfhi(g.x), 9.094947e-13f); v0[2] *= fmaxf(bflo(g.y), 9.094947e-13f); v0[3] *= fmaxf(bfhi(g.y), 9.094947e-13f);
                    v1[0] *= fmaxf(bflo(g.z), 9.094947e-13f); v1[1] *= fmaxf(bfhi(g.z), 9.094947e-13f); v1[2] *= fmaxf(bflo(g.w), 9.094947e-13f); v1[3] *= fmaxf(bfhi(g.w), 9.094947e-13f);
                    v4u w; w.x = cvtpk(v0[0], v0[1]); w.y = cvtpk(v0[2], v0[3]); w.z = cvtpk(v1[0], v1[1]); w.w = cvtpk(v1[2], v1[3]);
                    *(v4u*)(T + off + bj * HALF) = w; }
                EPI_FENCE; }
        }
    }
};
template <bool LAST> struct EpiOutX {
    static constexpr bool PERM = true, AFTER_DRAIN = false;
    const float* xp; const float* xs; float* out; unsigned char* ws; const float* gn; int layer;
    __device__ __forceinline__ void operator()(f32x4 (&acc)[2][2][4][2], const Unit& u, int wr, int wc, int fr, int fq) const {
        extern __shared__ __attribute__((aligned(16))) unsigned char lds[];
        LAS float* red = (LAS float*)((LAS unsigned char*)lds + 131072);
        const int col0 = u.pn * 256 + wc * 32 + 8 * fq;
#pragma unroll
        for (int ai = 0; ai < 2; ++ai) {
            f32x4 xv[4][2][2];
#pragma unroll
            for (int m = 0; m < 4; ++m) { const int row = EPI_ROW(ai, m);
                const float* xr = (layer == 0 ? (row < MPROMPT ? xp + (size_t)row * DM : xs + (size_t)(row - MPROMPT) * DM) : out + (size_t)row * DM) + col0;
#pragma unroll
                for (int bj = 0; bj < 2; ++bj)
#pragma unroll
                    for (int n = 0; n < 2; ++n) xv[m][bj][n] = *(const f32x4*)(xr + bj * HALF + n * 4); }
            EPI_FENCE;
#pragma unroll
            for (int m = 0; m < 4; ++m) { float s = 0.f;
#pragma unroll
                for (int bj = 0; bj < 2; ++bj)
#pragma unroll
                    for (int n = 0; n < 2; ++n) { const f32x4 v = xv[m][bj][n] + acc[ai][bj][m][n]; acc[ai][bj][m][n] = v; s += (v[0] * v[0] + v[1] * v[1]) + (v[2] * v[2] + v[3] * v[3]); }
                s = sum_x16(s); s = sum_x32(s);
                if (fq == 0) red[(wr * 128 + ai * 64 + m * 16 + fr) * 4 + wc] = s; }
            EPI_FENCE;
        }
        LDS_WAIT(); __builtin_amdgcn_s_barrier(); asm volatile("" ::: "memory");
        const int t_ = opaque_tid();
        if (t_ < 256) { const int wr_t = t_ >> 7, rl = t_ & 127; const f32x4 pr = *(const LAS f32x4*)(red + (wr_t * 128 + rl) * 4);
            const int row_t = u.pm * BM + (rl >> 6) * HALF + wr_t * 64 + (rl & 63);
            __hip_atomic_store((float*)(ws + WS_SSF) + (size_t)row_t * 8 + u.pn, (pr[0] + pr[1]) + (pr[2] + pr[3]), __ATOMIC_RELAXED, __HIP_MEMORY_SCOPE_AGENT); }
        asm volatile("s_waitcnt vmcnt(0)" ::: "memory");
        __syncthreads();
        if (t_ == 0) { unsigned* cnt = (unsigned*)(ws + WS_CTL) + CW_PANEL + layer * 256 + u.pm;
            __hip_atomic_fetch_add(cnt, 1u, __ATOMIC_RELAXED, __HIP_MEMORY_SCOPE_AGENT);
            unsigned sp = 0; while (__hip_atomic_load(cnt, __ATOMIC_RELAXED, __HIP_MEMORY_SCOPE_AGENT) < 8u && ++sp < (1u << 22)) __builtin_amdgcn_s_sleep(1);
            __builtin_amdgcn_fence(__ATOMIC_ACQUIRE, "agent"); asm volatile("s_waitcnt vmcnt(0)" ::: "memory"); }
        __syncthreads();
        const int t2_ = opaque_tid(), wr2 = t2_ >> 8, fr2 = t2_ & 15, colb = u.pn * 256 + ((t2_ >> 6) & 3) * 32 + 8 * ((t2_ >> 4) & 3);
        f32x4 g[2][2];
#pragma unroll
        for (int bj = 0; bj < 2; ++bj) { g[bj][0] = *(const f32x4*)(gn + colb + bj * HALF); g[bj][1] = *(const f32x4*)(gn + colb + bj * HALF + 4); }
#pragma unroll
        for (int ai = 0; ai < 2; ++ai) { f32x4 sf[4][2];
#pragma unroll
            for (int m = 0; m < 4; ++m) { const float* sp = (const float*)(ws + WS_SSF) + (size_t)(u.pm * BM + ai * HALF + wr2 * 64 + m * 16 + fr2) * 8; sf[m][0] = *(const f32x4*)sp; sf[m][1] = *(const f32x4*)(sp + 4); }
            EPI_FENCE;
#pragma unroll
            for (int m = 0; m < 4; ++m) { const int row = u.pm * BM + ai * HALF + wr2 * 64 + m * 16 + fr2; const f32x4 a = sf[m][0], b = sf[m][1];
                const float rs = 1.0f / sqrtf((((a[0] + a[1]) + (a[2] + a[3])) + ((b[0] + b[1]) + (b[2] + b[3]))) * (1.0f / DM) + EPS);
                float* orow = out + (size_t)row * DM + colb;
#pragma unroll
                for (int bj = 0; bj < 2; ++bj) {
                    const f32x4 y0 = acc[ai][bj][m][0], y1 = acc[ai][bj][m][1]; const f32x4 n0 = y0 * rs * g[bj][0], n1 = y1 * rs * g[bj][1];
                    if constexpr (LAST) { *(f32x4*)(orow + bj * HALF) = n0; *(f32x4*)(orow + bj * HALF + 4) = n1; }
                    else { *(f32x4*)(orow + bj * HALF) = y0; *(f32x4*)(orow + bj * HALF + 4) = y1;
                        v4u w; w.x = cvtpk(n0[0], n0[1]); w.y = cvtpk(n0[2], n0[3]); w.z = cvtpk(n1[0], n1[1]); w.w = cvtpk(n1[2], n1[3]);
                        *(v4u*)((bf16*)(ws + WS_XN) + (size_t)row * DM + colb + bj * HALF) = w;
                        *(u32x2*)(ws + WS_XN8 + (size_t)row * DM + colb + bj * HALF) = (u32x2){pk4_fp8(n0[0], n0[1], n0[2], n0[3]), pk4_fp8(n1[0], n1[1], n1[2], n1[3])}; } }
                EPI_FENCE; } }
    }
};
struct EpiOut {
    static constexpr bool PERM = false, AFTER_DRAIN = false;
    const float* xp; const float* xs; float* out; int layer;
    __device__ __forceinline__ void operator()(const f32x4 (&acc)[2][2][4][2], const Unit& u, int wr, int wc, int fr, int fq) const {
        const int col0 = u.pn * 256 + wc * 32 + 4 * fq;
#pragma unroll
        for (int ai = 0; ai < 2; ++ai) {
            f32x4 xv[4][2][2];
#pragma unroll
            for (int m = 0; m < 4; ++m) { const int row = EPI_ROW(ai, m);
                const float* xr = (layer == 0 ? (row < MPROMPT ? xp + (size_t)row * DM : xs + (size_t)(row - MPROMPT) * DM) : out + (size_t)row * DM) + col0;
#pragma unroll
                for (int bj = 0; bj < 2; ++bj)
#pragma unroll
                    for (int n = 0; n < 2; ++n) xv[m][bj][n] = *(const f32x4*)(xr + bj * HALF + n * 16); }
            EPI_FENCE;
#pragma unroll
            for (int m = 0; m < 4; ++m) { float* orow = out + (size_t)EPI_ROW(ai, m) * DM + col0;
#pragma unroll
                for (int bj = 0; bj < 2; ++bj)
#pragma unroll
                    for (int n = 0; n < 2; ++n) *(f32x4*)(orow + bj * HALF + n * 16) = xv[m][bj][n] + acc[ai][bj][m][n];
                EPI_FENCE; }
        }
    }
};

namespace att8 {
constexpr int NW = 8, QBLK = 32, KVBLK = 64;
constexpr float CL2 = 0.07216878364870322f * 1.4426950408889634f;
constexpr float QSC = CL2 * 8.0f;
constexpr float BIAS = 7.0f, THR = 1.5f;
constexpr int NB = 3, SZ_KN = 64 * 128, SZ_KR = 64 * 64, SZ_VT = 128 * 64;
constexpr int OFF_KN = 0, OFF_KR = OFF_KN + NB * SZ_KN, OFF_VT = OFF_KR + NB * SZ_KR, OFF_WS = OFF_VT + NB * SZ_VT, SHM_ATTN = OFF_WS + NW * 64 * 4;
typedef int v8i __attribute__((ext_vector_type(8)));
__device__ __forceinline__ int crow(int r, int hi) { return (r & 3) + 8 * (r >> 2) + 4 * hi; }
#define SBAR8() __builtin_amdgcn_sched_barrier(0)
__device__ __forceinline__ v8i ld2x16(const char* pa, const char* pb) { const v4u a = *reinterpret_cast<const v4u*>(pa), b = *reinterpret_cast<const v4u*>(pb); return (v8i){(int)a.x, (int)a.y, (int)a.z, (int)a.w, (int)b.x, (int)b.y, (int)b.z, (int)b.w}; }
#define MFMA8S(A, B, Cc) __builtin_amdgcn_mfma_scale_f32_32x32x64_f8f6f4(A, B, Cc, 0, 0, 0, 0x7C7C7C7C, 0, 0x7F7F7F7F)
#define MFMA8(A, B, Cc) __builtin_amdgcn_mfma_scale_f32_32x32x64_f8f6f4(A, B, Cc, 0, 0, 0, 0, 0, 0)

template <int VAR = 0>
__device__ __forceinline__ void attn_unit(const bf16* __restrict__ Qn, const bf16* __restrict__ Qr, const unsigned char* __restrict__ K8, const unsigned char* __restrict__ KR8,
                                          const unsigned char* __restrict__ V8T, bf16* __restrict__ Ob, int seq, const f32x2* __restrict__ rope, int qpos0, char* lds) {
  const int tid = opaque_tid(), wid = tid >> 6, lane = tid & 63, r32 = lane & 31, hi = lane >> 5;
  const int wv = __builtin_amdgcn_readfirstlane(wid);
  float* ws = (float*)(lds + OFF_WS) + wid * 64; float* li_l = ws; float* al_l = ws + 32;
  v8i qf[3];
  { const bf16* Qw = Qn + (long)(wid * QBLK + r32) * NQ;
#pragma unroll
    for (int ks = 0; ks < 2; ++ks) {
#pragma unroll
      for (int c = 0; c < 4; ++c) { const v4u raw = *reinterpret_cast<const v4u*>(Qw + 64 * ks + 32 * hi + 8 * c);
        qf[ks][2 * c] = (int)pk4_fp8(bflo(raw.x) * QSC, bfhi(raw.x) * QSC, bflo(raw.y) * QSC, bfhi(raw.y) * QSC);
        qf[ks][2 * c + 1] = (int)pk4_fp8(bflo(raw.z) * QSC, bfhi(raw.z) * QSC, bflo(raw.w) * QSC, bfhi(raw.w) * QSC); } }
    const bf16* Rw = Qr + (long)(wid * QBLK + r32) * NQ + 32 * hi;
    const f32x2* rp = rope + (qpos0 + wid * QBLK + r32) * 32 + 16 * hi;
#pragma unroll
    for (int c = 0; c < 4; ++c) { const v4u raw = *reinterpret_cast<const v4u*>(Rw + 8 * c);
      const f32x4 cs01 = *(const f32x4*)(rp + 4 * c), cs23 = *(const f32x4*)(rp + 4 * c + 2);
      float a0, a1, a2, a3, a4, a5, a6, a7;
      { const float x1 = bflo(raw.x), x2 = bfhi(raw.x); a0 = x1 * cs01[0] - x2 * cs01[1]; a1 = x2 * cs01[0] + x1 * cs01[1]; }
      { const float x1 = bflo(raw.y), x2 = bfhi(raw.y); a2 = x1 * cs01[2] - x2 * cs01[3]; a3 = x2 * cs01[2] + x1 * cs01[3]; }
      { const float x1 = bflo(raw.z), x2 = bfhi(raw.z); a4 = x1 * cs23[0] - x2 * cs23[1]; a5 = x2 * cs23[0] + x1 * cs23[1]; }
      { const float x1 = bflo(raw.w), x2 = bfhi(raw.w); a6 = x1 * cs23[2] - x2 * cs23[3]; a7 = x2 * cs23[2] + x1 * cs23[3]; }
      qf[2][2 * c] = (int)pk4_fp8(a0 * QSC, a1 * QSC, a2 * QSC, a3 * QSC); qf[2][2 * c + 1] = (int)pk4_fp8(a4 * QSC, a5 * QSC, a6 * QSC, a7 * QSC); } }
  const int dk_key = 8 * wv + (lane >> 3), dr_key = 16 * (wv & 3) + (lane >> 2), dv_d = 16 * wv + (lane >> 2);
  const unsigned char* gk = K8 + (long)dk_key * 1024 + (((lane & 7) ^ ((dk_key >> 1) & 7)) << 4);
  const unsigned char* gr = KR8 + (long)dr_key * 64 + (((lane & 3) ^ ((dr_key >> 2) & 3)) << 4);
  const unsigned char* gv = V8T + (long)dv_d * 64 + (((lane & 3) ^ ((dv_d >> 2) & 3)) << 4);
  LAS unsigned char* ldsa = (LAS unsigned char*)lds;
#define DMA8(tk, bk, tv, bv) do { if constexpr (VAR & 8) break; \
    __builtin_amdgcn_global_load_lds((const unsigned*)(gk + (long)(tk) * (KVBLK * 1024)), (LAS unsigned*)(ldsa + OFF_KN + (bk) * SZ_KN + wv * 1024), 16, 0, 0); \
    __builtin_amdgcn_global_load_lds((const unsigned*)(gr + (long)(tk) * (KVBLK * 64)), (LAS unsigned*)(ldsa + OFF_KR + (bk) * SZ_KR + (wv & 3) * 1024), 16, 0, 0); \
    __builtin_amdgcn_global_load_lds((const unsigned*)(gv + (long)(tv) * (KVBLK * 1024)), (LAS unsigned*)(ldsa + OFF_VT + (bv) * SZ_VT + wv * 1024), 16, 0, 0); } while (0)
#define TBAR8() do { if constexpr (!(VAR & 8)) asm volatile("s_waitcnt vmcnt(3)" ::: "memory"); if constexpr (VAR & 16) break; asm volatile("s_waitcnt lgkmcnt(0)" ::: "memory"); __builtin_amdgcn_s_barrier(); asm volatile("" ::: "memory"); } while (0)
  const int g8 = (r32 >> 1) & 7, g4 = (r32 >> 2) & 3;
  const int kn0 = r32 * 128 + (((2 * hi) ^ g8) << 4), kn1 = r32 * 128 + (((2 * hi + 1) ^ g8) << 4);
  const int rv0 = r32 * 64 + (((2 * hi) ^ g4) << 4), rv1 = r32 * 64 + (((2 * hi + 1) ^ g4) << 4);
  float nm = BIAS, l_reg = 0.f;
  const f32x16 zero16 = {}; f32x16 o[4] = {};
  f32x16 nmv;
  _Pragma("unroll") for (int r = 0; r < 16; ++r) nmv[r] = nm; asm volatile("" : "+v"(nmv));
  const int NT = seq / KVBLK;
#define EXPR8(P, ra, rb) do { if constexpr (VAR & 2) break; _Pragma("unroll") for (int r = (ra); r < (rb); ++r) P[r] = __builtin_amdgcn_exp2f(P[r]); } while (0)
#define QKM8(A, B, Cc) ((VAR & 1) ? ({ f32x16 t_ = Cc; asm volatile("" : "+v"(t_) : "v"(A)); t_; }) : MFMA8S(A, B, Cc))
#define PVM8(A, B, Cc) ((VAR & 4) ? ({ f32x16 t_ = Cc; asm volatile("" : "+v"(t_) : "v"(B)); t_; }) : MFMA8(A, B, Cc))
#define CVT8(P, PK, base) _Pragma("unroll") for (int q = 0; q < 4; ++q) { int w_ = __builtin_amdgcn_cvt_pk_fp8_f32(P[4 * q], P[4 * q + 1], 0, false); w_ = __builtin_amdgcn_cvt_pk_fp8_f32(P[4 * q + 2], P[4 * q + 3], w_, true); PK[(base) + q] = w_; }
#define TRIP8(KB, VB, PKIN, PKOUT, DO_PV, FIRST) do { \
    const char* kn_ = lds + OFF_KN + (KB) * SZ_KN; const char* kr_ = lds + OFF_KR + (KB) * SZ_KR; const char* vt_ = lds + OFF_VT + (VB) * SZ_VT; \
    v8i f0 = ld2x16(kn_ + kn0, kn_ + kn1), f1 = ld2x16(kn_ + (kn0 ^ 64), kn_ + (kn1 ^ 64)), f2 = ld2x16(kr_ + rv0, kr_ + rv1); SBAR8(); \
    p0 = QKM8(f0, qf[0], nmv); f0 = ld2x16(kn_ + kn0 + 4096, kn_ + kn1 + 4096); SBAR8(); \
    p0 = QKM8(f1, qf[1], p0); f1 = ld2x16(kn_ + (kn0 ^ 64) + 4096, kn_ + (kn1 ^ 64) + 4096); SBAR8(); \
    p0 = QKM8(f2, qf[2], p0); f2 = ld2x16(kr_ + rv0 + 2048, kr_ + rv1 + 2048); SBAR8(); \
    p1 = QKM8(f0, qf[0], nmv); if constexpr (DO_PV) f0 = ld2x16(vt_ + rv0, vt_ + rv1); SBAR8(); \
    float mx0 = p0[0]; _Pragma("unroll") for (int r = 1; r < 16; ++r) mx0 = fmaxf(mx0, p0[r]); \
    EXPR8(p0, 0, 4); SBAR8(); \
    p1 = QKM8(f1, qf[1], p1); if constexpr (DO_PV) f1 = ld2x16(vt_ + rv0 + 2048, vt_ + rv1 + 2048); SBAR8(); \
    EXPR8(p0, 4, 10); SBAR8(); \
    p1 = QKM8(f2, qf[2], p1); if constexpr (DO_PV) f2 = ld2x16(vt_ + rv0 + 4096, vt_ + rv1 + 4096); SBAR8(); \
    EXPR8(p0, 10, 16); SBAR8(); \
    if constexpr (DO_PV) { o[0] = PVM8(PKIN, f0, o[0]); f0 = ld2x16(vt_ + rv0 + 6144, vt_ + rv1 + 6144); } SBAR8(); \
    float mx1 = p1[0]; _Pragma("unroll") for (int r = 1; r < 16; ++r) mx1 = fmaxf(mx1, p1[r]); \
    EXPR8(p1, 0, 4); SBAR8(); \
    if constexpr (DO_PV) o[1] = PVM8(PKIN, f1, o[1]); SBAR8(); \
    EXPR8(p1, 4, 10); SBAR8(); \
    if constexpr (DO_PV) o[2] = PVM8(PKIN, f2, o[2]); SBAR8(); \
    EXPR8(p1, 10, 16); SBAR8(); \
    if constexpr (DO_PV) o[3] = PVM8(PKIN, f0, o[3]); SBAR8(); \
    float ps = 0.f; _Pragma("unroll") for (int r = 0; r < 16; ++r) ps += p0[r]; \
    if constexpr (!(FIRST)) { CVT8(p0, PKOUT, 0); } \
    float mx = fmaxf(mx0, mx1); \
    { auto rr = __builtin_amdgcn_permlane32_swap(__float_as_uint(mx), __float_as_uint(mx), false, false); mx = fmaxf(__uint_as_float(rr[0]), __uint_as_float(rr[1])); } \
    if ((FIRST) || !__all(mx <= BIAS + THR)) { \
      const float delta = (FIRST) ? (mx - BIAS) : fmaxf(mx - BIAS, 0.f); \
      const float alpha = __builtin_amdgcn_exp2f(-delta); \
      nm -= delta; l_reg *= alpha; ps *= alpha; \
      _Pragma("unroll") for (int r = 0; r < 16; ++r) nmv[r] = nm; asm volatile("" : "+v"(nmv)); \
      _Pragma("unroll") for (int r = 0; r < 16; ++r) { p0[r] *= alpha; p1[r] *= alpha; } \
      CVT8(p0, PKOUT, 0); \
      if constexpr (!(FIRST)) { if (hi == 0) al_l[r32] = alpha; asm volatile("s_waitcnt lgkmcnt(0)" ::: "memory"); \
        _Pragma("unroll") for (int d = 0; d < 4; ++d) _Pragma("unroll") for (int r = 0; r < 16; ++r) o[d][r] *= al_l[crow(r, hi)]; } \
    } \
    _Pragma("unroll") for (int r = 0; r < 16; ++r) ps += p1[r]; \
    CVT8(p1, PKOUT, 4); \
    { auto rr = __builtin_amdgcn_permlane32_swap(__float_as_uint(ps), __float_as_uint(ps), false, false); ps = __uint_as_float(rr[0]) + __uint_as_float(rr[1]); } \
    l_reg += ps; } while (0)
  f32x16 p0, p1; v8i pkp, pkq;
#define TCL(t) ((t) < NT ? (t) : NT - 1)
  asm volatile("s_waitcnt vmcnt(0)" ::: "memory");
  DMA8(0, 0, 0, 0); DMA8(1, 1, 0, 0);
  TBAR8();
  DMA8(2, 2, 1, 1);
  TRIP8(0, 0, pkq, pkp, false, true);
  TBAR8();
  int kb = 1, vb = 0;
  for (int j = 1; j < NT; j += 2) {
    { const int kb2 = kb == 0 ? 2 : kb - 1, vb2 = vb == 0 ? 2 : vb - 1;
      DMA8(TCL(j + 2), kb2, TCL(j + 1), vb2);
      TRIP8(kb, vb, pkp, pkq, true, false);
      TBAR8(); vb = kb; kb = kb == 2 ? 0 : kb + 1; }
    if (j + 1 < NT) {
      const int kb2 = kb == 0 ? 2 : kb - 1, vb2 = vb == 0 ? 2 : vb - 1;
      DMA8(TCL(j + 3), kb2, TCL(j + 2), vb2);
      TRIP8(kb, vb, pkq, pkp, true, false);
      TBAR8(); vb = kb; kb = kb == 2 ? 0 : kb + 1;
    }
  }
  { const char* vt_ = lds + OFF_VT + vb * SZ_VT;
    const v8i v0_ = ld2x16(vt_ + rv0, vt_ + rv1), v1_ = ld2x16(vt_ + rv0 + 2048, vt_ + rv1 + 2048), v2_ = ld2x16(vt_ + rv0 + 4096, vt_ + rv1 + 4096), v3_ = ld2x16(vt_ + rv0 + 6144, vt_ + rv1 + 6144);
    o[0] = PVM8(pkq, v0_, o[0]); o[1] = PVM8(pkq, v1_, o[1]); o[2] = PVM8(pkq, v2_, o[2]); o[3] = PVM8(pkq, v3_, o[3]); }
#undef TCL
  if (hi == 0) li_l[r32] = l_reg; asm volatile("s_waitcnt lgkmcnt(0)" ::: "memory");
  float rli[16];
#pragma unroll
  for (int r = 0; r < 16; ++r) rli[r] = __builtin_amdgcn_rcpf(li_l[crow(r, hi)]);
  bf16* Ow = Ob + (long)(wid * QBLK) * 1024;
#pragma unroll
  for (int r = 0; r < 16; ++r) { const int orow = crow(r, hi);
#pragma unroll
    for (int d0 = 0; d0 < 4; ++d0) Ow[(long)orow * 1024 + d0 * 32 + r32] = (bf16)(cvtpk(o[d0][r] * rli[r], 0.f) & 0xffffu); }
  asm volatile("s_waitcnt vmcnt(0)" ::: "memory");
  __syncthreads();
#undef DMA8
#undef TBAR8
#undef TRIP8
#undef QKM8
#undef PVM8
#undef EXPR8
#undef CVT8
}
#undef MFMA8
}

namespace ml {
constexpr int PITCH = 288, TILE = 64 * PITCH;
constexpr int OFF_Q = 0, OFF_K = 2 * TILE, OFF_V = 4 * TILE;
constexpr int PPITCH = 144, OFF_P = 6 * TILE;
constexpr int OFF_SC = OFF_P + 64 * PPITCH;
constexpr int OFF_RSP = OFF_SC + 8 * 2 * 5 * 256;
constexpr int OFF_QN = OFF_RSP + 1024;
constexpr int OFF_NBF = OFF_QN + 256;
constexpr int OFF_CH = OFF_NBF + 512;
constexpr int LDS_END = OFF_CH + 5 * 1024;
static_assert(LDS_END <= MISC_OFF, "mLSTM LDS map");
__device__ __forceinline__ int rho(int t) { return (t & ~12) | ((t & 4) << 1) | ((t & 8) >> 1); }
typedef short v4i16_t __attribute__((ext_vector_type(4)));
__device__ __forceinline__ bf16x8 trfrag(LAS const unsigned char* tile, int tbase, int c0, int lane) {
    const int g = lane >> 4, li = lane & 15;
#if ML_FAST_TR
    const int q = li >> 2, p = li & 3;
    const s16x4 lo = __builtin_bit_cast(s16x4, __builtin_amdgcn_ds_read_tr16_b64_v4i16((LAS v4i16_t*)(tile + rho(tbase + 8 * g + q) * PITCH + (c0 + 4 * p) * 2)));
    const s16x4 hi = __builtin_bit_cast(s16x4, __builtin_amdgcn_ds_read_tr16_b64_v4i16((LAS v4i16_t*)(tile + rho(tbase + 8 * g + 4 + q) * PITCH + (c0 + 4 * p) * 2)));
    return (bf16x8){lo[0], lo[1], lo[2], lo[3], hi[0], hi[1], hi[2], hi[3]};
#else
    bf16x8 r;
#pragma unroll
    for (int i = 0; i < 8; ++i) r[i] = *(LAS const short*)(tile + rho(tbase + 8 * g + i) * PITCH + (c0 + li) * 2);
    return r;
#endif
}
__device__ __forceinline__ float logsigmoid(float x) { return fminf(x, 0.f) - log1pf(expf(-fabsf(x))); }

__device__ __forceinline__ void mlstm_item(LAS unsigned char* lds, const bf16* __restrict__ QM, const bf16* __restrict__ KM, const bf16* __restrict__ VM, const float* __restrict__ KRG, const float* __restrict__ BG,
                                           float* SCR, bf16* __restrict__ H, int row0, int S, int dir, int h) {
    const int tid = opaque_tid(), lane = tid & 63, w = __builtin_amdgcn_readfirstlane(tid >> 6), g = lane >> 4, li = lane & 15;
    const int NC = S / 64, hc = h * 128;
    const int srow = tid >> 3, scol = (tid & 7) * 16;
    LAS float* sc = (LAS float*)(lds + OFF_SC) + w * 640;
    LAS float* RSP = (LAS float*)(lds + OFF_RSP); LAS float* QNl = (LAS float*)(lds + OFF_QN);
#define ML_ROW(c, t) (dir ? (row0 + S - 1 - (64 * (c) + (t))) : (row0 + 64 * (c) + (t)))
    float* scr = SCR + ((size_t)(dir * 8 + h) * MTOK + row0) * 5;
    LAS float* CHG = (LAS float*)(lds + OFF_CH); LAS float* CHU = CHG + 256; LAS float* CHM = CHG + 512; LAS float* CHAO = CHG + 768; LAS float* CHAN = CHG + 1024;
    for (int c = w; c < NC; c += 8) {
        const float* gp = KRG + (size_t)ML_ROW(c, lane) * 96 + 64;
        const float li_ = gp[dir * 8 + h] + BG[dir * 8 + h], lf = logsigmoid(gp[16 + dir * 8 + h] + BG[16 + dir * 8 + h]);
        float bsum = lf;
#pragma unroll
        for (int o = 1; o < 64; o <<= 1) { const float v = __int_as_float(__builtin_amdgcn_ds_bpermute(((lane - o) & 63) << 2, __float_as_int(bsum))); if (lane >= o) bsum += v; }
        const float uu = li_ - bsum; float pm = uu;
#pragma unroll
        for (int o = 1; o < 64; o <<= 1) { const float v = __int_as_float(__builtin_amdgcn_ds_bpermute(((lane - o) & 63) << 2, __float_as_int(pm))); if (lane >= o) pm = fmaxf(pm, v); }
        float* sp = scr + (size_t)c * 320 + lane;
        sp[0] = uu; sp[64] = pm; sp[128] = bsum;
        if (lane == 63) { CHG[c] = bsum; CHU[c] = pm; }
    }
    __syncthreads();
    if (w == 0) {
        float m = 0.f;
        for (int c = 0; c < NC; ++c) { const float gch = CHG[c], um = CHU[c]; const float m_loc = gch + um, m_new = fmaxf(gch + m, m_loc);
            if (lane == 0) { CHM[c] = m; CHAO[c] = expf(gch + m - m_new); CHAN[c] = expf(m_loc - m_new); }
            m = m_new; }
    }
    __syncthreads();
    for (int c = w; c < NC; c += 8) {
        float* sp = scr + (size_t)c * 320 + lane;
        const float uu = sp[0], pm = sp[64], bsum = sp[128]; const float mp = CHM[c], um = CHU[c], an = CHAN[c];
        const float Mj = fmaxf(mp, pm);
        sp[64] = Mj; sp[128] = expf(uu - um) * an; sp[192] = expf(mp - Mj); sp[256] = expf(-(bsum + Mj));
    }
    asm volatile("s_waitcnt vmcnt(0)" ::: "memory");
    __syncthreads();
    f32x4 X[8]; f32x4 nst = {0.f, 0.f, 0.f, 0.f};
#pragma unroll
    for (int d = 0; d < 8; ++d) X[d] = (f32x4){0.f, 0.f, 0.f, 0.f};
    v4u stq[2], stk[2], stv[2]; float scv[5];
#define ML_LOAD(c) do { const size_t go = (size_t)ML_ROW(c, srow) * 1024 + hc + scol; \
        stq[0] = *(const v4u*)(QM + go); stq[1] = *(const v4u*)(QM + go + 8); stk[0] = *(const v4u*)(KM + go); stk[1] = *(const v4u*)(KM + go + 8); \
        stv[0] = *(const v4u*)(VM + go); stv[1] = *(const v4u*)(VM + go + 8); \
        _Pragma("unroll") for (int k_ = 0; k_ < 5; ++k_) scv[k_] = __hip_atomic_load(scr + (size_t)(c) * 320 + k_ * 64 + lane, __ATOMIC_RELAXED, __HIP_MEMORY_SCOPE_AGENT); } while (0)
#define ML_WRITE(b) do { const int lo_ = rho(srow) * PITCH + scol * 2; \
        *(LAS v4u*)(lds + OFF_Q + (b) * TILE + lo_) = stq[0]; *(LAS v4u*)(lds + OFF_Q + (b) * TILE + lo_ + 16) = stq[1]; \
        *(LAS v4u*)(lds + OFF_K + (b) * TILE + lo_) = stk[0]; *(LAS v4u*)(lds + OFF_K + (b) * TILE + lo_ + 16) = stk[1]; \
        *(LAS v4u*)(lds + OFF_V + (b) * TILE + lo_) = stv[0]; *(LAS v4u*)(lds + OFF_V + (b) * TILE + lo_ + 16) = stv[1]; \
        _Pragma("unroll") for (int k_ = 0; k_ < 5; ++k_) sc[((b) * 5 + k_) * 64 + lane] = scv[k_]; } while (0)
    ML_LOAD(0); ML_WRITE(0);
    if (tid < 64) ((LAS unsigned*)(lds + OFF_NBF))[tid] = 0u;
    for (int c = 0; c < NC; ++c) {
        const int b = c & 1;
        LAS const unsigned char* Qt = lds + OFF_Q + b * TILE; LAS const unsigned char* Kt = lds + OFF_K + b * TILE; LAS const unsigned char* Vt = lds + OFF_V + b * TILE;
        LAS const float* scb = sc + b * 320;
        { const int cn = (c + 1 < NC) ? c + 1 : c; ML_LOAD(cn); }
        const float a_old = CHAO[c];
        __syncthreads();
        {
            bf16x8 ka[2][4], qb_[2][4], na[4], nq[4];
#pragma unroll
            for (int tt = 0; tt < 2; ++tt) { const int tile = w * 2 + tt, lb = tile & 3, jb = tile >> 2;
#pragma unroll
                for (int ks = 0; ks < 4; ++ks) { ka[tt][ks] = *(LAS const bf16x8*)(Kt + rho(16 * lb + li) * PITCH + (32 * ks + 8 * g) * 2);
                    qb_[tt][ks] = *(LAS const bf16x8*)(Qt + rho(16 * jb + li) * PITCH + (32 * ks + 8 * g) * 2); } }
            { LAS const unsigned char* nb = lds + OFF_NBF + b * 256;
#pragma unroll
              for (int ks = 0; ks < 4; ++ks) { na[ks] = *(LAS const bf16x8*)(nb + (32 * ks + 8 * g) * 2); if (li != 0) na[ks] = (bf16x8){0, 0, 0, 0, 0, 0, 0, 0};
                  nq[ks] = *(LAS const bf16x8*)(Qt + rho(16 * (w & 3) + li) * PITCH + (32 * ks + 8 * g) * 2); } }
#pragma unroll
            for (int tt = 0; tt < 2; ++tt) {
                const int tile = w * 2 + tt, lb = tile & 3, jb = tile >> 2;
                const int j = 16 * jb + li, l0 = 16 * lb + 4 * g;
                f32x4 s = {0.f, 0.f, 0.f, 0.f};
#pragma unroll
                for (int ks = 0; ks < 4; ++ks) s = __builtin_amdgcn_mfma_f32_16x16x32_bf16(ka[tt][ks], qb_[tt][ks], s, 0, 0, 0);
                const f32x4 u4 = *(LAS const f32x4*)(scb + l0); const float Mj = scb[64 + j];
                float p[4]; float rs = 0.f;
#pragma unroll
                for (int r = 0; r < 4; ++r) { p[r] = (l0 + r <= j) ? s[r] * __expf(u4[r] - Mj) : 0.f; rs += p[r]; }
                *(LAS u32x2*)(lds + OFF_P + j * PPITCH + l0 * 2) = (u32x2){cvtpk(p[0], p[1]), cvtpk(p[2], p[3])};
                rs = sum_x16(rs); rs = sum_x32(rs);
                if (g == 0) RSP[j * 4 + lb] = rs;
            }
            { f32x4 s = {0.f, 0.f, 0.f, 0.f};
#pragma unroll
              for (int ks = 0; ks < 4; ++ks) s = __builtin_amdgcn_mfma_f32_16x16x32_bf16(na[ks], nq[ks], s, 0, 0, 0);
              if (g == 0) QNl[16 * (w & 3) + li] = s[0]; }
        }
        f32x4 Y[4];
        {
            bf16x8 ca[4];
#pragma unroll
            for (int ks = 0; ks < 4; ++ks) { v4u t; t.x = cvtpk(X[2 * ks][0], X[2 * ks][1]); t.y = cvtpk(X[2 * ks][2], X[2 * ks][3]); t.z = cvtpk(X[2 * ks + 1][0], X[2 * ks + 1][1]); t.w = cvtpk(X[2 * ks + 1][2], X[2 * ks + 1][3]);
                ca[ks] = __builtin_bit_cast(bf16x8, t); }
#pragma unroll
            for (int tb = 0; tb < 4; ++tb) {
                LAS const unsigned char* qrow = Qt + rho(16 * tb + li) * PITCH;
                v4u qq[4];
#pragma unroll
                for (int ks = 0; ks < 4; ++ks) { const u32x2 q0 = *(LAS const u32x2*)(qrow + (32 * ks + 4 * g) * 2), q1 = *(LAS const u32x2*)(qrow + (32 * ks + 16 + 4 * g) * 2); qq[ks] = (v4u){q0.x, q0.y, q1.x, q1.y}; }
                f32x4 y = {0.f, 0.f, 0.f, 0.f};
#pragma unroll
                for (int ks = 0; ks < 4; ++ks) y = __builtin_amdgcn_mfma_f32_16x16x32_bf16(ca[ks], __builtin_bit_cast(bf16x8, qq[ks]), y, 0, 0, 0);
                Y[tb] = y;
            }
        }
        __syncthreads();
        bf16x8 vf[2];
        vf[0] = trfrag(Vt, 0, 16 * w, lane); vf[1] = trfrag(Vt, 32, 16 * w, lane);
        {
            bf16x8 pb[4][2]; f32x4 rp[4]; float wi[4], qn[4], cl[4];
#pragma unroll
            for (int tb = 0; tb < 4; ++tb) { const int t = 16 * tb + li;
                pb[tb][0] = *(LAS const bf16x8*)(lds + OFF_P + t * PPITCH + (8 * g) * 2); pb[tb][1] = *(LAS const bf16x8*)(lds + OFF_P + t * PPITCH + (32 + 8 * g) * 2);
                rp[tb] = *(LAS const f32x4*)(RSP + t * 4); wi[tb] = scb[192 + t]; qn[tb] = QNl[t]; cl[tb] = scb[256 + t]; }
#pragma unroll
            for (int tb = 0; tb < 4; ++tb) {
                const int t = 16 * tb + li;
                f32x4 y = Y[tb] * wi[tb];
                y = __builtin_amdgcn_mfma_f32_16x16x32_bf16(vf[0], pb[tb][0], y, 0, 0, 0);
                y = __builtin_amdgcn_mfma_f32_16x16x32_bf16(vf[1], pb[tb][1], y, 0, 0, 0);
                const float den = (rp[tb][0] + rp[tb][1]) + (rp[tb][2] + rp[tb][3]) + wi[tb] * qn[tb];
                const float inv = __builtin_amdgcn_rcpf(fmaxf(fabsf(den), cl[tb]));
                const u32x2 o = {cvtpk(y[0] * inv, y[1] * inv), cvtpk(y[2] * inv, y[3] * inv)};
                *(u32x2*)(H + (size_t)ML_ROW(c, t) * 1024 + hc + 16 * w + 4 * g) = o;
            }
        }
        {
            bf16x8 vw[2]; bf16x8 wb[2];
#pragma unroll
            for (int ks = 0; ks < 2; ++ks) {
                const f32x4 w0 = *(LAS const f32x4*)(scb + 128 + 32 * ks + 8 * g), w1 = *(LAS const f32x4*)(scb + 128 + 32 * ks + 8 * g + 4);
                float wv[8] = {w0[0], w0[1], w0[2], w0[3], w1[0], w1[1], w1[2], w1[3]};
                const v4u vraw = __builtin_bit_cast(v4u, vf[ks]); v4u t, tw;
#pragma unroll
                for (int e = 0; e < 4; ++e) { t[e] = cvtpk(bflo(vraw[e]) * wv[2 * e], bfhi(vraw[e]) * wv[2 * e + 1]); tw[e] = (li == 0) ? cvtpk(wv[2 * e], wv[2 * e + 1]) : 0u; }
                vw[ks] = __builtin_bit_cast(bf16x8, t); wb[ks] = __builtin_bit_cast(bf16x8, tw);
            }
            bf16x8 kf[8][2], kn[2];
#pragma unroll
            for (int d = 0; d < 8; ++d) { kf[d][0] = trfrag(Kt, 0, 16 * d, lane); kf[d][1] = trfrag(Kt, 32, 16 * d, lane); }
            kn[0] = trfrag(Kt, 0, 16 * w, lane); kn[1] = trfrag(Kt, 32, 16 * w, lane);
#pragma unroll
            for (int d = 0; d < 8; ++d) {
                f32x4 x = X[d] * a_old;
                x = __builtin_amdgcn_mfma_f32_16x16x32_bf16(kf[d][0], vw[0], x, 0, 0, 0);
                x = __builtin_amdgcn_mfma_f32_16x16x32_bf16(kf[d][1], vw[1], x, 0, 0, 0);
                X[d] = x;
            }
            nst = nst * a_old;
            nst = __builtin_amdgcn_mfma_f32_16x16x32_bf16(kn[0], wb[0], nst, 0, 0, 0);
            nst = __builtin_amdgcn_mfma_f32_16x16x32_bf16(kn[1], wb[1], nst, 0, 0, 0);
            if (li == 0) *(LAS u32x2*)(lds + OFF_NBF + (b ^ 1) * 256 + (16 * w + 4 * g) * 2) = (u32x2){cvtpk(nst[0], nst[1]), cvtpk(nst[2], nst[3])};
        }
        ML_WRITE(b ^ 1);
    }
    __syncthreads();
#undef ML_ROW
#undef ML_LOAD
#undef ML_WRITE
}
}

constexpr int Q_ML_P = 4, Q_ML_S = 16, Q_AT_P = 128, Q_AT_S = 128, QLEN = Q_ML_P + Q_ML_S + Q_AT_P + Q_AT_S;
template <int AVAR = 0>
__device__ __forceinline__ void p_mixer(Frame& F, const float* bgl, int lq, unsigned xcc, bool ml_only = false, bool att_only = false) {
    unsigned char* ws = F.ws;
    int qsel = (int)(xcc & 7u), tried = 0;
    for (;;) {
        if (F.tid == 0) {
            int item = -1, qq = qsel, tr = tried;
            while (tr < 8) {
                const unsigned idx = __hip_atomic_fetch_add(F.ctl + CW_QUEUE + (lq * 8 + qq) * 64, 1u, __ATOMIC_RELAXED, __HIP_MEMORY_SCOPE_AGENT);
                if (idx < (unsigned)QLEN) { item = qq * 1024 + (int)idx; break; }
                qq = (qq + 1) & 7; ++tr;
            }
            F.MISC[0] = (unsigned)item; F.MISC[1] = (unsigned)qq; F.MISC[2] = (unsigned)tr;
        }
        __syncthreads();
        const int item = (int)F.MISC[0]; qsel = (int)F.MISC[1]; tried = (int)F.MISC[2];
        __syncthreads();
        if (item < 0) break;
        const int h = item >> 10, i = item & 1023;
#ifndef NO_ML
        if (i < Q_ML_P + Q_ML_S) {
            if (att_only) continue;
            int row0, S, dir;
            if (i < Q_ML_P) { row0 = (i >> 1) * SEQ_P; S = SEQ_P; dir = i & 1; }
            else { const int k = i - Q_ML_P; row0 = MPROMPT + (k >> 1) * SEQ_S; S = SEQ_S; dir = k & 1; }
            ml::mlstm_item(F.lds, (const bf16*)(ws + WS_QM), (const bf16*)(ws + WS_KM), (const bf16*)(ws + WS_VM), (const float*)(ws + WS_KRG), bgl,
                           (float*)(ws + WS_SCR), (bf16*)(ws + (dir ? WS_HBW : WS_HFW)), row0, S, dir, h);
        } else
#endif
#ifndef NO_ATT
        {
            int row0, S, qb;
            if (i < Q_ML_P + Q_ML_S + Q_AT_P) { const int k = i - (Q_ML_P + Q_ML_S); row0 = (k >> 6) * SEQ_P; S = SEQ_P; qb = k & 63; }
            else { const int k = i - (Q_ML_P + Q_ML_S + Q_AT_P); row0 = MPROMPT + (k >> 4) * SEQ_S; S = SEQ_S; qb = k & 15; }
            const size_t qrow = (size_t)(row0 + 256 * qb);
            if (ml_only) continue;
            att8::attn_unit<AVAR>((const bf16*)(ws + WS_Q) + qrow * NQ + h * 128, (const bf16*)(ws + WS_Q) + qrow * NQ + 1024 + h * 64,
                            ws + WS_K8 + (size_t)row0 * 1024 + h * 128, ws + WS_KR + (size_t)row0 * 64, ws + WS_V8T + ((size_t)(row0 >> 6) * 1024 + h * 128) * 64,
                            (bf16*)(ws + WS_CQKV) + qrow * 1024 + h * 128, S, (const f32x2*)(ws + WS_ROPE), 256 * qb, (char*)F.lds);
        }
#else
        {}
#endif
    }
}


constexpr int NPH = 1 + DEPTH * 10 + 1;
__global__ void __launch_bounds__(NWAVES * 64, 2) trunk_fwd(Args args) {
    extern __shared__ __attribute__((aligned(16))) unsigned char lds[];
    Frame F;
    F.lds = (LAS unsigned char*)lds; F.MISC = (volatile LAS unsigned*)(F.lds + MISC_OFF);
    F.tid = threadIdx.x; F.lane = F.tid & 63; F.wave = __builtin_amdgcn_readfirstlane(F.tid >> 6);
    F.G = gridDim.x; { const int bx = blockIdx.x; F.vcu = (F.G % 8 == 0) ? (bx % 8) * (F.G / 8) + bx / 8 : bx; }
    F.ws = args.ws; F.ctl = (gu32*)(args.ws + WS_CTL); F.out = args.out;
    for (int u = F.tid; u < (LDS_BYTES - MISC_OFF) / 4; u += NWAVES * 64) ((LAS unsigned*)(F.lds + MISC_OFF))[u] = 0u;
    __syncthreads();
    XcdBarrier bar; bar.bar = (unsigned*)(F.ctl + CW_BAR); bar.x = xb_xcc_id(); bar.st = F.MISC + 8;
#if !MK_PER_PHASE
    bar = xcd_barrier_post((unsigned*)(F.ctl + CW_BAR), F.MISC + 8);
#endif
    const unsigned xcc = bar.x;
    const int lo = args.ph_lo, hi = args.ph_hi;
#define IN(k) (lo <= (k) && (k) < hi)
#if MK_PER_PHASE
#define SEAM(k) do { } while (0)
#else
#define SEAM(k) do { if (IN(k) && IN((k) + 1)) xcd_barrier(bar); } while (0)
#endif
    unsigned char* ws = args.ws;
    if (IN(0)) { p_prologue(F, args); }
#if MK_PER_PHASE
    SEAM(0);
#endif
    for (int layer = 0; layer < DEPTH; ++layer) {
        const int p0 = 1 + layer * 10;
        asm volatile("" : "+s"(ws));
        F.ws = ws;
        const unsigned char* wl = ws + WS_W + (size_t)layer * LW;
        if (layer == 0 || F.G != 256) { if (IN(p0 + 0)) { p_norm(F, args, layer); } SEAM(p0 + 0); }
        if (IN(p0 + 1)) {
            { pg8::Gemm g{(const pg8::bf16_t*)(ws + WS_XN8), (const pg8::bf16_t*)(wl + W_P1A), MTOK, NP1A, DM / 2, DM / 2, DM / 2, SC_ONE, SC_M6}; pg8::StaticOrder S; S.init(MTOK, NP1A, F.G, (int)blockIdx.x);
              EpiP1a E{ws, WS_CQKV}; pg8::gemm_phase<EpiP1a, pg8::StaticOrder, true, true, true, SC_ONE, SC_M6>(F.lds, g, S, E);
            }
            { pg8::Gemm g{(const pg8::bf16_t*)(ws + WS_XN), (const pg8::bf16_t*)(wl + W_P1B), MTOK, NP1B, DM, DM, DM, SC_ONE, SC_ONE}; pg8::StaticOrder S; S.init(MTOK, NP1B, F.G, (int)blockIdx.x);
              EpiP1b E{ws}; pg8::gemm_phase<EpiP1b, pg8::StaticOrder, true, true>(F.lds, g, S, E); }
        } SEAM(p0 + 1);
        if (IN(p0 + 2)) {
            { pg8::Gemm g{(const pg8::bf16_t*)(ws + WS_CQKV), (const pg8::bf16_t*)(wl + W_UQ), MTOK, NQ, 256, 512, 256, SC_ONE, SC_M5}; pg8::StaticOrder S; S.init(MTOK, NQ, F.G, (int)blockIdx.x);
              EpiQ E{ws}; pg8::gemm_phase<EpiQ, pg8::StaticOrder, true, true, true, SC_ONE, SC_M5>(F.lds, g, S, E); }
            { pg8::Gemm g{(const pg8::bf16_t*)(ws + WS_CQKV + 512), (const pg8::bf16_t*)(wl + W_UKV), MTOK, 1024, 256, 512, 256, SC_ONE, SC_M5}; pg8::StaticOrder S; S.init(MTOK, 1024, F.G, (int)blockIdx.x);
              EpiK8 E{ws}; pg8::gemm_phase<EpiK8, pg8::StaticOrder, true, true, true, SC_ONE, SC_M5>(F.lds, g, S, E); }
            { pg8::Gemm g{(const pg8::bf16_t*)(wl + W_UKV + (size_t)1024 * 512), (const pg8::bf16_t*)(ws + WS_CQKV + 512), 1024, MTOK, 256, 256, 512, SC_M5, SC_ONE}; pg8::StaticOrder S; S.init(1024, MTOK, F.G, (int)blockIdx.x);
              EpiVT E{ws}; pg8::gemm_phase<EpiVT, pg8::StaticOrder, true, true, true, SC_M5, SC_ONE>(F.lds, g, S, E); }
        } SEAM(p0 + 2);
        if (IN(p0 + 3)) { p_mixer(F, args.in[IN_B_GATES] + layer * 32, layer, xcc); }
        SEAM(p0 + 3);
        if (IN(p0 + 4)) {
            { pg8::Gemm g{(const pg8::bf16_t*)(ws + WS_XN8), (const pg8::bf16_t*)(wl + W_P2A), MTOK, NP2A, DM / 2, DM / 2, DM / 2, SC_ONE, SC_M6}; pg8::StaticOrder S; S.init(MTOK, NP2A, F.G, (int)blockIdx.x);
              EpiP2a E{ws, WS_SGA}; pg8::gemm_phase<EpiP2a, pg8::StaticOrder, true, true, true, SC_ONE, SC_M6>(F.lds, g, S, E);
            }
            { pg8::Gemm g{(const pg8::bf16_t*)(ws + WS_XN), (const pg8::bf16_t*)(wl + W_P2B), MTOK, NP2B, DM, DM, DM, SC_ONE, SC_ONE}; pg8::StaticOrder S; S.init(MTOK, NP2B, F.G, (int)blockIdx.x);
              EpiP2b E{ws, layer}; pg8::gemm_phase<EpiP2b, pg8::StaticOrder, true, true>(F.lds, g, S, E); }
        } SEAM(p0 + 4);
        if (IN(p0 + 5)) {
            pg8::Gemm g1{(const pg8::bf16_t*)(ws + WS_HFW), (const pg8::bf16_t*)(wl + W_OB), MTOK, DM, 1024, 1024, 1024, 0x7F7F7F7F, 0x7F7F7F7F};
            pg8::Gemm g2{(const pg8::bf16_t*)(ws + WS_YA8), (const pg8::bf16_t*)(wl + W_OA), MTOK, DM, 512, 512, 512, SC_M6, SC_M5};
            pg8::StaticOrder S; S.init(MTOK, DM, F.G, (int)blockIdx.x);
            MidMerge Mm{ws}; EpiMerge2 E{ws}; pg8::gemm_chain<EpiMerge2, MidMerge, pg8::StaticOrder>(F.lds, g1, g2, S, Mm, E);
        } SEAM(p0 + 5);
        if (IN(p0 + 8)) {
            pg8::Gemm g{(const pg8::bf16_t*)(ws + WS_MG), (const pg8::bf16_t*)(wl + W_OUT), MTOK, DM, DM, DM, DM, 0x7F7F7F7F, 0x7F7F7F7F}; pg8::StaticOrder S; S.init(MTOK, DM, F.G, (int)blockIdx.x);
            if (F.G == 256) { S.wgm = 4;
                if (layer + 1 == DEPTH) { EpiOutX<true> E{args.in[IN_XP], args.in[IN_XS], F.out, ws, args.in[IN_NORM_F], layer}; pg8::gemm_phase<EpiOutX<true>, pg8::StaticOrder, true, true>(F.lds, g, S, E); }
                else { EpiOutX<false> E{args.in[IN_XP], args.in[IN_XS], F.out, ws, args.in[IN_NORM_IN] + (layer + 1) * DM, layer}; pg8::gemm_phase<EpiOutX<false>, pg8::StaticOrder, true, true>(F.lds, g, S, E); }
            } else { EpiOut E{args.in[IN_XP], args.in[IN_XS], F.out, layer}; pg8::gemm_phase<EpiOut, pg8::StaticOrder, true, true>(F.lds, g, S, E); }
        } if (layer + 1 < DEPTH || F.G != 256) SEAM(p0 + 8);
    }
    if (IN(NPH - 1) && F.G != 256) { p_final(F, args); }
#undef IN
#undef SEAM
}

extern "C" void kernel_launch(void* const* d_in, const int* in_sizes, int n_in, void* d_out, int out_size, void* d_ws, size_t ws_size, hipStream_t stream) {
    static int grid = 0;
    if (grid == 0) {
        if (n_in != 14 || in_sizes[0] != MPROMPT * DM || in_sizes[1] != MPROMPT * DM || out_size != MTOK * DM || ws_size < WS_END) {
            fprintf(stderr, "kernel_launch: shape mismatch (n_in %d, in0 %d, out %d, ws %zu, need %zu); nothing launched\n", n_in, n_in > 0 ? in_sizes[0] : -1, out_size, ws_size, (size_t)WS_END); grid = -1; return; }
        int dev = 0, cus = 0, per_cu = 0;
        if (hipGetDevice(&dev) != hipSuccess || hipDeviceGetAttribute(&cus, hipDeviceAttributeMultiprocessorCount, dev) != hipSuccess) { grid = -1; return; }
        if (hipFuncSetAttribute((const void*)trunk_fwd, hipFuncAttributeMaxDynamicSharedMemorySize, LDS_BYTES) != hipSuccess) { fprintf(stderr, "kernel_launch: hipFuncSetAttribute failed\n"); grid = -1; return; }
        if (hipOccupancyMaxActiveBlocksPerMultiprocessor(&per_cu, (const void*)trunk_fwd, NWAVES * 64, LDS_BYTES) != hipSuccess || per_cu < 1)
            fprintf(stderr, "kernel_launch: note: occupancy query reports %d workgroups per CU\n", per_cu);
        (void)hipGetLastError();
        grid = cus;
    }
    if (grid < 0) return;
    if (hipMemsetAsync((char*)d_ws + WS_CTL, 0, CTL_ZERO_BYTES, stream) != hipSuccess) return;
    Args a{};
    for (int i = 0; i < 14; ++i) a.in[i] = (const float*)d_in[i];
    a.out = (float*)d_out; a.ws = (unsigned char*)d_ws;
#if MK_PER_PHASE
    for (int p = 0; p < NPH; ++p) {
        if (p >= 1 && p < NPH - 1 && (((p - 1) % 10) == 9 || ((p - 1) % 10) == 6)) continue;
        a.ph_lo = p; a.ph_hi = p + 1;
        hipLaunchKernelGGL(trunk_fwd, dim3(grid), dim3(NWAVES * 64), LDS_BYTES, stream, a);
    }
#else
    a.ph_lo = 0; a.ph_hi = NPH;
    hipLaunchKernelGGL(trunk_fwd, dim3(grid), dim3(NWAVES * 64), LDS_BYTES, stream, a);
#endif
    const hipError_t le = hipPeekAtLastError();
    if (le != hipSuccess) fprintf(stderr, "kernel_launch: launch failed: %s\n", hipGetErrorName(le));
}
```

```cpp
#include <hip/hip_runtime.h>
#include <hip/hip_bf16.h>
#include <cstdio>
#include <cstdint>

#ifndef MK_PER_PHASE
#define MK_PER_PHASE 0
#endif
#ifndef ML_FAST_TR
#define ML_FAST_TR 1
#endif

namespace pg8 {
#define PG8_LAS __attribute__((address_space(3)))
typedef unsigned short bf16_t;
typedef short bf16x8 __attribute__((ext_vector_type(8)));
typedef float f32x4 __attribute__((ext_vector_type(4)));
typedef unsigned u32x4 __attribute__((ext_vector_type(4)));
constexpr int BM = 256, BK = 64, HALF = 128, HTB = HALF * BK * 2  , STAGE_BYTES = 8 * HTB, NXCD = 8, WGM = 8;

__host__ __device__ __forceinline__ int lds_byte(int r, int c) { const int st = (r >> 4) * 2 + (c >> 5), rr = r & 15, cc = c & 31, ob = rr * 64 + cc * 2; return st * 1024 + (ob ^ (((ob >> 9) & 1) << 5)); }
__host__ __device__ __forceinline__ void stage_rc(int b, int& R, int& C) { const int st = b / 1024, sb = b % 1024, swz = sb ^ (((sb >> 9) & 1) << 5); R = (st >> 1) * 16 + swz / 64; C = (st & 1) * 32 + (swz % 64) / 2; }
__host__ __device__ __forceinline__ int perm32(int rho) { const int n = rho >> 4, i = rho & 15; return 8 * (i >> 2) + 4 * n + (i & 3); }

__device__ __forceinline__ int fresh_tid() { int l; asm volatile("v_mbcnt_lo_u32_b32 %0, -1, 0\n\tv_mbcnt_hi_u32_b32 %0, -1, %0" : "=v"(l)); return (__builtin_amdgcn_readfirstlane((int)threadIdx.x >> 6) << 6) | l; }
struct Unit { int pm, pn; };
struct Gemm { const bf16_t* A; const bf16_t* Bt; int M, N, K, lda, ldb; int scA, scB; };
typedef int pg8_v4i __attribute__((ext_vector_type(4)));
typedef int pg8_v8i __attribute__((ext_vector_type(8)));
__device__ __forceinline__ pg8_v8i ld_frag8(const PG8_LAS unsigned char* p) {
    const bf16x8 lo = *(const PG8_LAS bf16x8*)p, hi = *(const PG8_LAS bf16x8*)(p + 16);
    return __builtin_bit_cast(pg8_v8i, __builtin_shufflevector(lo, hi, 0, 1, 2, 3, 4, 5, 6, 7, 8, 9, 10, 11, 12, 13, 14, 15)); }

struct StaticOrder {
    int nM, nN, nwg, G, c, wgm;
    __host__ __device__ void init(int M, int N, int G_, int c_) { nM = M / BM; nN = N / BM; nwg = nM * nN; G = G_; c = c_; wgm = WGM; }
    __host__ __device__ bool next(int i, Unit& u) const {
        const long L = (long)i * G + c; if (L >= nwg) return false;
        int wgid = (int)L; { const int q = nwg / NXCD, r = nwg % NXCD, xcd = wgid % NXCD, off = wgid / NXCD; wgid = (xcd < r ? xcd * (q + 1) : r * (q + 1) + (xcd - r) * q) + off; }
        const int nig = wgm * nN, gid = wgid / nig, fm = gid * wgm, gsz = (nM - fm) < wgm ? (nM - fm) : wgm;
        u.pm = fm + ((wgid % nig) % gsz); u.pn = (wgid % nig) / gsz; return true;
    }
    __device__ __forceinline__ void a_ready(const Unit&) const {}
    __device__ __forceinline__ void done(const Unit&) const {}
};

typedef float cvt_f32x2 __attribute__((ext_vector_type(2))); typedef __bf16 cvt_bf16x2 __attribute__((ext_vector_type(2)));
__device__ __forceinline__ unsigned cvt_pk_bf16(float lo, float hi) { return __builtin_bit_cast(unsigned, __builtin_convertvector((cvt_f32x2){lo, hi}, cvt_bf16x2)); }
typedef float f32x2 __attribute__((ext_vector_type(2)));
template <class Epi, class Sched, bool ALIGN_EPI = false, bool SP2 = false, bool FP8 = false, int SCA = 0x7F7F7F7F, int SCB = 0x7F7F7F7F>
__device__ __forceinline__ void gemm_phase(PG8_LAS unsigned char* lds, const Gemm g, const Sched& S, const Epi& E) {
    const int tid = fresh_tid();
    const int wid = __builtin_amdgcn_readfirstlane(tid >> 6), lane = tid & 63, wr = wid >> 2, wc = wid & 3, fr = lane & 15, fq = lane >> 4;
    const int K = g.K, nt = K / BK;
    unsigned voffA[2], voffB[2];
    { int R, C; stage_rc(tid * 16, R, C); const int Rb = Epi::PERM == 2 ? (64 * (R >> 5) + 16 * ((R & 15) >> 2) + 4 * ((R >> 4) & 1) + (R & 3)) : Epi::PERM ? ((R & ~31) + perm32(R & 31)) : R;
        voffA[0] = (unsigned)(R * g.lda + C) * 2u; voffB[0] = (unsigned)(Rb * g.ldb + C) * 2u; voffA[1] = voffA[0] + (unsigned)(64 * g.lda) * 2u; voffB[1] = voffB[0] + (unsigned)((Epi::PERM == 2 ? 128 : 64) * g.ldb) * 2u; }
    const size_t kstep = (size_t)(BK * 2);
    const size_t hstepA = (size_t)HALF * g.lda * 2, hstepB = (size_t)(Epi::PERM == 2 ? 8 : HALF) * g.ldb * 2;
    const size_t tstepA = 2 * hstepA, tstepB = (size_t)BM * g.ldb * 2;
    const unsigned ldsw = (unsigned)wid * 1024u;
    const int aoff = lds_byte(wr * 64 + fr, FP8 ? fq * 16 : fq * 8), boff = lds_byte(wc * 32 + fr, FP8 ? fq * 16 : fq * 8);
#define PG8_SA(b, h) (((b) * 2 + (h)) * HTB)
#define PG8_SB(b, h) ((4 + (b) * 2 + (h)) * HTB)
#define PG8_STAGE(bufoff, gbase, voff) do { _Pragma("unroll") for (int _i = 0; _i < 2; ++_i) \
        __builtin_amdgcn_global_load_lds((const unsigned*)((const char*)(gbase) + (voff)[_i]), (PG8_LAS unsigned*)(lds + (bufoff) + ldsw + _i * 8192), 16, 0, 0); } while (0)
#define PG8_LDA(dst, b, h) do { if constexpr (FP8) { _Pragma("unroll") for (int m = 0; m < 4; ++m) dst##8[m] = ld_frag8(lds + PG8_SA(b, h) + aoff + m * 2048); } \
        else { _Pragma("unroll") for (int m = 0; m < 4; ++m) _Pragma("unroll") for (int k = 0; k < 2; ++k) dst[m][k] = *(const PG8_LAS bf16x8*)(lds + PG8_SA(b, h) + aoff + m * 2048 + k * 1024); } } while (0)
#define PG8_LDB(dst, b, h) do { if constexpr (FP8) { _Pragma("unroll") for (int n = 0; n < 2; ++n) dst##8[n] = ld_frag8(lds + PG8_SB(b, h) + boff + n * 2048); } \
        else { _Pragma("unroll") for (int n = 0; n < 2; ++n) _Pragma("unroll") for (int k = 0; k < 2; ++k) dst[n][k] = *(const PG8_LAS bf16x8*)(lds + PG8_SB(b, h) + boff + n * 2048 + k * 1024); } } while (0)
#define PG8_CAT8(x) __builtin_shufflevector(__builtin_bit_cast(pg8_v4i, (x)[0]), __builtin_bit_cast(pg8_v4i, (x)[1]), 0, 1, 2, 3, 4, 5, 6, 7)
#define PG8_MMA(ai, bj, At, Bt) do { __builtin_amdgcn_s_setprio(1); _Pragma("unroll") for (int m = 0; m < 4; ++m) _Pragma("unroll") for (int n = 0; n < 2; ++n) { \
        if constexpr (FP8) asm volatile("v_mfma_f32_16x16x128_f8f6f4 %0, %1, %2, %0" : "+v"(acc[ai][bj][m][n]) : "v"(Bt##8[n]), "v"(At##8[m]));     \
        else { _Pragma("unroll") for (int k = 0; k < 2; ++k) acc[ai][bj][m][n] = __builtin_amdgcn_mfma_f32_16x16x32_bf16(Bt[n][k], At[m][k], acc[ai][bj][m][n], 0, 0, 0); } } __builtin_amdgcn_s_setprio(0); } while (0)
#define PG8_WAIT_V(n) asm volatile("s_waitcnt vmcnt(" #n ")" ::: "memory")
#define PG8_WAIT_L(n) asm volatile("s_waitcnt lgkmcnt(" #n ")" ::: "memory")
#define PG8_BAR __builtin_amdgcn_s_barrier()
#define PG8_SCHED __builtin_amdgcn_sched_barrier(0)
    Unit cur, nxt; int ui = 0;
    if (!S.next(0, cur)) return;
    f32x4 acc[2][2][4][2];
#pragma unroll
    for (int a = 0; a < 2; ++a)
#pragma unroll
        for (int b = 0; b < 2; ++b)
#pragma unroll
            for (int m = 0; m < 4; ++m)
#pragma unroll
                for (int n = 0; n < 2; ++n) acc[a][b][m][n] = (f32x4){0.f, 0.f, 0.f, 0.f};
    bf16x8 At[4][2], B0[2][2], B1[2][2]; pg8_v8i At8[4], B08[2], B18[2];
    const char* cA = (const char*)g.A + (size_t)cur.pm * tstepA; const char* cB = (const char*)g.Bt + (size_t)cur.pn * tstepB;
    S.a_ready(cur);
    if constexpr (SP2) {
        PG8_STAGE(PG8_SB(0, 0), cB, voffB); PG8_STAGE(PG8_SB(0, 1), cB + hstepB, voffB); PG8_STAGE(PG8_SA(0, 0), cA, voffA); PG8_STAGE(PG8_SA(0, 1), cA + hstepA, voffA);
        if (wr == 1) PG8_BAR;
        PG8_WAIT_V(2); PG8_BAR;
        PG8_STAGE(PG8_SB(1, 0), cB + kstep, voffB); PG8_STAGE(PG8_SA(1, 0), cA + kstep, voffA); PG8_STAGE(PG8_SB(1, 1), cB + hstepB + kstep, voffB);
        PG8_WAIT_V(6); PG8_BAR;
    } else {
        PG8_STAGE(PG8_SB(0, 0), cB, voffB); PG8_STAGE(PG8_SA(0, 0), cA, voffA); PG8_STAGE(PG8_SB(0, 1), cB + hstepB, voffB); PG8_STAGE(PG8_SA(0, 1), cA + hstepA, voffA);
        if (wr == 1) PG8_BAR;
        PG8_WAIT_V(4); PG8_BAR;
        PG8_STAGE(PG8_SB(1, 0), cB + kstep, voffB); PG8_STAGE(PG8_SA(1, 0), cA + kstep, voffA); PG8_STAGE(PG8_SB(1, 1), cB + hstepB + kstep, voffB);
        PG8_WAIT_V(6); PG8_BAR;
    }
    for (;;) {
        const bool has_next = S.next(ui + 1, nxt);
        const char* nA = has_next ? (const char*)g.A + (size_t)nxt.pm * tstepA : cA; const char* nB = has_next ? (const char*)g.Bt + (size_t)nxt.pn * tstepB : cB;
        _Pragma("nounroll") for (int t = 0; t < nt; t += 2) {
            const bool last = (t == nt - 2);
            const char* a1 = cA + (size_t)(t + 1) * kstep;
            const char* a2 = last ? nA : cA + (size_t)(t + 2) * kstep; const char* b2 = last ? nB : cB + (size_t)(t + 2) * kstep;
            const char* a3 = a2 + kstep; const char* b3 = b2 + kstep;
            if (last && has_next) S.a_ready(nxt);
            if constexpr (SP2) {
            PG8_LDB(B0, 0, 0); PG8_LDB(B1, 0, 1); PG8_SCHED; PG8_LDA(At, 0, 0); PG8_STAGE(PG8_SA(1, 1), a1 + hstepA, voffA);
            PG8_WAIT_V(8); PG8_WAIT_L(0); PG8_BAR; PG8_MMA(0, 0, At, B0); PG8_MMA(0, 1, At, B1); PG8_BAR; PG8_SCHED;
            PG8_LDA(At, 0, 1); PG8_STAGE(PG8_SB(0, 0), b2, voffB); PG8_STAGE(PG8_SB(0, 1), b2 + hstepB, voffB); PG8_STAGE(PG8_SA(0, 0), a2, voffA);
            PG8_WAIT_V(8); PG8_WAIT_L(0); PG8_BAR; PG8_MMA(1, 0, At, B0); PG8_MMA(1, 1, At, B1); PG8_BAR; PG8_SCHED;
            PG8_LDB(B0, 1, 0); PG8_LDB(B1, 1, 1); PG8_SCHED; PG8_LDA(At, 1, 0); PG8_STAGE(PG8_SA(0, 1), a2 + hstepA, voffA);
            PG8_WAIT_V(8); PG8_WAIT_L(0); PG8_BAR; PG8_MMA(0, 0, At, B0); PG8_MMA(0, 1, At, B1); PG8_BAR; PG8_SCHED;
            PG8_LDA(At, 1, 1); PG8_STAGE(PG8_SB(1, 0), b3, voffB); PG8_STAGE(PG8_SB(1, 1), b3 + hstepB, voffB); PG8_STAGE(PG8_SA(1, 0), a3, voffA);
            PG8_WAIT_V(8); PG8_WAIT_L(0); PG8_BAR; PG8_MMA(1, 0, At, B0); PG8_MMA(1, 1, At, B1); PG8_BAR; PG8_SCHED;
            } else {
            PG8_LDB(B0, 0, 0); PG8_SCHED; PG8_LDA(At, 0, 0); PG8_STAGE(PG8_SA(1, 1), a1 + hstepA, voffA);
            PG8_WAIT_L(8); PG8_BAR; PG8_WAIT_L(0); PG8_MMA(0, 0, At, B0); PG8_BAR; PG8_SCHED;
            PG8_LDB(B1, 0, 1); PG8_STAGE(PG8_SB(0, 0), b2, voffB);
            PG8_BAR; PG8_WAIT_L(0); PG8_MMA(0, 1, At, B1); PG8_BAR;
            PG8_LDA(At, 0, 1); PG8_STAGE(PG8_SA(0, 0), a2, voffA);
            PG8_BAR; PG8_WAIT_L(0); PG8_MMA(1, 0, At, B0); PG8_BAR; PG8_SCHED;
            PG8_STAGE(PG8_SB(0, 1), b2 + hstepB, voffB);
            PG8_WAIT_V(6); PG8_BAR; PG8_MMA(1, 1, At, B1); PG8_BAR;
            PG8_LDB(B0, 1, 0); PG8_SCHED; PG8_LDA(At, 1, 0); PG8_STAGE(PG8_SA(0, 1), a2 + hstepA, voffA);
            PG8_WAIT_L(8); PG8_BAR; PG8_WAIT_L(0); PG8_MMA(0, 0, At, B0); PG8_BAR; PG8_SCHED;
            PG8_LDB(B1, 1, 1); PG8_STAGE(PG8_SB(1, 0), b3, voffB);
            PG8_BAR; PG8_WAIT_L(0); PG8_MMA(0, 1, At, B1); PG8_BAR;
            PG8_LDA(At, 1, 1); PG8_STAGE(PG8_SA(1, 0), a3, voffA);
            PG8_BAR; PG8_WAIT_L(0); PG8_MMA(1, 0, At, B0); PG8_BAR; PG8_SCHED;
            PG8_STAGE(PG8_SB(1, 1), b3 + hstepB, voffB);
            PG8_WAIT_V(6); PG8_BAR; PG8_MMA(1, 1, At, B1); PG8_BAR;
            }
        }
        if constexpr (FP8) asm volatile("s_nop 15\n\ts_nop 15" ::: "memory");
        if constexpr (ALIGN_EPI) { if (wr == 0) PG8_BAR; }
        if constexpr (!Epi::AFTER_DRAIN) { const int t2 = fresh_tid();
            E(acc, cur, t2 >> 8, (t2 >> 6) & 3, t2 & 15, (t2 >> 4) & 3); S.done(cur); }
        if (!has_next) break;
#pragma unroll
        for (int a = 0; a < 2; ++a)
#pragma unroll
            for (int b = 0; b < 2; ++b)
#pragma unroll
                for (int m = 0; m < 4; ++m)
#pragma unroll
                    for (int n = 0; n < 2; ++n) acc[a][b][m][n] = (f32x4){0.f, 0.f, 0.f, 0.f};
        cur = nxt; cA = nA; cB = nB; ++ui;
        if constexpr (ALIGN_EPI) { if (wr == 1) PG8_BAR; }
    }
    PG8_WAIT_V(0);
    if constexpr (!ALIGN_EPI) { if (wr == 0) PG8_BAR; }
    PG8_BAR;
    if constexpr (Epi::AFTER_DRAIN) { E.fused(acc, cur, wr, wc, fr, fq, lds, wid, lane); S.done(cur); }
#undef PG8_SA
#undef PG8_SB
#undef PG8_STAGE
#undef PG8_LDA
#undef PG8_LDB
#undef PG8_MMA
#undef PG8_CAT8
#undef PG8_WAIT_V
#undef PG8_WAIT_L
#undef PG8_BAR
#undef PG8_SCHED
}

template <class Epi, class Mid, class Sched>
__device__ __forceinline__ void gemm_chain(PG8_LAS unsigned char* lds, const Gemm g1, const Gemm g2, const Sched& S, const Mid& M, const Epi& E) {
    const int tid = fresh_tid();
    const int wid = __builtin_amdgcn_readfirstlane(tid >> 6), lane = tid & 63, wr = wid >> 2, wc = wid & 3, fr = lane & 15, fq = lane >> 4;
    const int nt1 = g1.K / BK, nt2 = g2.K / BK;
    const size_t kstep = (size_t)(BK * 2);
    const size_t hA1 = (size_t)HALF * g1.lda * 2, hB1 = (size_t)HALF * g1.ldb * 2, hA2 = (size_t)HALF * g2.lda * 2, hB2 = (size_t)HALF * g2.ldb * 2;
    const unsigned ldsw = (unsigned)wid * 1024u;
#define PC_OFFS(F8, LDA_, LDB_) const int t3_ = fresh_tid(); unsigned VA[2], VB[2]; \
        { int R, C; stage_rc(t3_ * 16, R, C); const int Rb = Epi::PERM ? ((R & ~31) + perm32(R & 31)) : R; \
          VA[0] = (unsigned)(R * (LDA_) + C) * 2u; VB[0] = (unsigned)(Rb * (LDB_) + C) * 2u; VA[1] = VA[0] + (unsigned)(64 * (LDA_)) * 2u; VB[1] = VB[0] + (unsigned)(64 * (LDB_)) * 2u; } \
        const int aoff = lds_byte((t3_ >> 8) * 64 + (t3_ & 15), ((t3_ >> 4) & 3) * ((F8) ? 16 : 8)), boff = lds_byte(((t3_ >> 6) & 3) * 32 + (t3_ & 15), ((t3_ >> 4) & 3) * ((F8) ? 16 : 8));
#define PC_SA(b, h) (((b) * 2 + (h)) * HTB)
#define PC_SB(b, h) ((4 + (b) * 2 + (h)) * HTB)
#define PC_STAGE(bufoff, gbase, v0, v1) do { \
        __builtin_amdgcn_global_load_lds((const unsigned*)((const char*)(gbase) + (v0)), (PG8_LAS unsigned*)(lds + (bufoff) + ldsw), 16, 0, 0); \
        __builtin_amdgcn_global_load_lds((const unsigned*)((const char*)(gbase) + (v1)), (PG8_LAS unsigned*)(lds + (bufoff) + ldsw + 8192), 16, 0, 0); } while (0)
#define PC_LDA(F8, b, h) do { if constexpr (F8) { _Pragma("unroll") for (int m = 0; m < 4; ++m) At8[m] = ld_frag8(lds + PC_SA(b, h) + aoff + m * 2048); } \
        else { _Pragma("unroll") for (int m = 0; m < 4; ++m) _Pragma("unroll") for (int k = 0; k < 2; ++k) At[m][k] = *(const PG8_LAS bf16x8*)(lds + PC_SA(b, h) + aoff + m * 2048 + k * 1024); } } while (0)
#define PC_LDB(F8, W, b, h) do { if constexpr (F8) { _Pragma("unroll") for (int n = 0; n < 2; ++n) B##W##8[n] = ld_frag8(lds + PC_SB(b, h) + boff + n * 2048); } \
        else { _Pragma("unroll") for (int n = 0; n < 2; ++n) _Pragma("unroll") for (int k = 0; k < 2; ++k) B##W[n][k] = *(const PG8_LAS bf16x8*)(lds + PC_SB(b, h) + boff + n * 2048 + k * 1024); } } while (0)
#define PC_MMA(F8, ai, bj, W) do { __builtin_amdgcn_s_setprio(1); _Pragma("unroll") for (int m = 0; m < 4; ++m) _Pragma("unroll") for (int n = 0; n < 2; ++n) { \
        if constexpr (F8) asm volatile("v_mfma_f32_16x16x128_f8f6f4 %0, %1, %2, %0" : "+v"(acc[ai][bj][m][n]) : "v"(B##W##8[n]), "v"(At8[m])); \
        else { _Pragma("unroll") for (int k = 0; k < 2; ++k) acc[ai][bj][m][n] = __builtin_amdgcn_mfma_f32_16x16x32_bf16(B##W[n][k], At[m][k], acc[ai][bj][m][n], 0, 0, 0); } } __builtin_amdgcn_s_setprio(0); } while (0)
#define PC_WAIT_V(n) asm volatile("s_waitcnt vmcnt(" #n ")" ::: "memory")
#define PC_WAIT_L(n) asm volatile("s_waitcnt lgkmcnt(" #n ")" ::: "memory")
#define PC_BAR __builtin_amdgcn_s_barrier()
#define PC_SCHED __builtin_amdgcn_sched_barrier(0)
#define PC_KLOOP(F8, cA_, cB_, nt_, LDA_, LDB_, HA, HB, nA_, nB_, NLDA_, NLDB_, NHA, NHB) { PC_OFFS(F8, LDA_, LDB_) \
        _Pragma("nounroll") for (int t = 0; t < (nt_); t += 2) { \
            const bool last = (t == (nt_) - 2); \
            const char* a1 = (cA_) + (size_t)(t + 1) * kstep; \
            const char* a2 = last ? (nA_) : (cA_) + (size_t)(t + 2) * kstep; const char* b2 = last ? (nB_) : (cB_) + (size_t)(t + 2) * kstep; \
            const char* a3 = a2 + kstep; const char* b3 = b2 + kstep; \
            unsigned sa0 = VA[0], sa1 = VA[1], sb0 = VB[0], sb1 = VB[1]; const size_t sha = last ? (NHA) : (HA), shb = last ? (NHB) : (HB); \
            if (last) { int R, C; stage_rc(t3_ * 16, R, C); const int Rb = Epi::PERM ? ((R & ~31) + perm32(R & 31)) : R; \
                sa0 = (unsigned)(R * (NLDA_) + C) * 2u; sb0 = (unsigned)(Rb * (NLDB_) + C) * 2u; sa1 = sa0 + (unsigned)(64 * (NLDA_)) * 2u; sb1 = sb0 + (unsigned)(64 * (NLDB_)) * 2u; } \
            PC_LDB(F8, 0, 0, 0); PC_LDB(F8, 1, 0, 1); PC_SCHED; PC_LDA(F8, 0, 0); PC_STAGE(PC_SA(1, 1), a1 + (HA), VA[0], VA[1]); \
            PC_WAIT_V(8); PC_WAIT_L(0); PC_BAR; PC_MMA(F8, 0, 0, 0); PC_MMA(F8, 0, 1, 1); PC_BAR; PC_SCHED; \
            PC_LDA(F8, 0, 1); PC_STAGE(PC_SB(0, 0), b2, sb0, sb1); PC_STAGE(PC_SB(0, 1), b2 + shb, sb0, sb1); PC_STAGE(PC_SA(0, 0), a2, sa0, sa1); \
            PC_WAIT_V(8); PC_WAIT_L(0); PC_BAR; PC_MMA(F8, 1, 0, 0); PC_MMA(F8, 1, 1, 1); PC_BAR; PC_SCHED; \
            PC_LDB(F8, 0, 1, 0); PC_LDB(F8, 1, 1, 1); PC_SCHED; PC_LDA(F8, 1, 0); PC_STAGE(PC_SA(0, 1), a2 + sha, sa0, sa1); \
            PC_WAIT_V(8); PC_WAIT_L(0); PC_BAR; PC_MMA(F8, 0, 0, 0); PC_MMA(F8, 0, 1, 1); PC_BAR; PC_SCHED; \
            PC_LDA(F8, 1, 1); PC_STAGE(PC_SB(1, 0), b3, sb0, sb1); PC_STAGE(PC_SB(1, 1), b3 + shb, sb0, sb1); PC_STAGE(PC_SA(1, 0), a3, sa0, sa1); \
            PC_WAIT_V(8); PC_WAIT_L(0); PC_BAR; PC_MMA(F8, 1, 0, 0); PC_MMA(F8, 1, 1, 1); PC_BAR; PC_SCHED; \
        } }
    Unit cur, nxt; int ui = 0;
    if (!S.next(0, cur)) return;
    f32x4 acc[2][2][4][2];
#pragma unroll
    for (int a = 0; a < 2; ++a)
#pragma unroll
        for (int b = 0; b < 2; ++b)
#pragma unroll
            for (int m = 0; m < 4; ++m)
#pragma unroll
                for (int n = 0; n < 2; ++n) acc[a][b][m][n] = (f32x4){0.f, 0.f, 0.f, 0.f};
    bf16x8 At[4][2], B0[2][2], B1[2][2]; pg8_v8i At8[4], B08[2], B18[2];
    const char* c1A = (const char*)g1.A + (size_t)cur.pm * 2 * hA1; const char* c1B = (const char*)g1.Bt + (size_t)cur.pn * 2 * hB1;
    { PC_OFFS(false, g1.lda, g1.ldb) (void)aoff; (void)boff;
    PC_STAGE(PC_SB(0, 0), c1B, VB[0], VB[1]); PC_STAGE(PC_SB(0, 1), c1B + hB1, VB[0], VB[1]); PC_STAGE(PC_SA(0, 0), c1A, VA[0], VA[1]); PC_STAGE(PC_SA(0, 1), c1A + hA1, VA[0], VA[1]);
    if (wr == 1) PC_BAR;
    PC_WAIT_V(2); PC_BAR;
    PC_STAGE(PC_SB(1, 0), c1B + kstep, VB[0], VB[1]); PC_STAGE(PC_SA(1, 0), c1A + kstep, VA[0], VA[1]); PC_STAGE(PC_SB(1, 1), c1B + hB1 + kstep, VB[0], VB[1]);
    PC_WAIT_V(6); PC_BAR; }
    for (;;) {
        const bool has_next = S.next(ui + 1, nxt);
        const char* c2A = (const char*)g2.A + (size_t)cur.pm * 2 * hA2; const char* c2B = (const char*)g2.Bt + (size_t)cur.pn * 2 * hB2;
        const char* n1A = has_next ? (const char*)g1.A + (size_t)nxt.pm * 2 * hA1 : c1A; const char* n1B = has_next ? (const char*)g1.Bt + (size_t)nxt.pn * 2 * hB1 : c1B;
        PC_KLOOP(false, c1A, c1B, nt1, g1.lda, g1.ldb, hA1, hB1, c2A, c2B, g2.lda, g2.ldb, hA2, hB2)
        { const int t2 = fresh_tid(); M(acc, cur, t2 >> 8, (t2 >> 6) & 3, t2 & 15, (t2 >> 4) & 3); }
        PC_KLOOP(true, c2A, c2B, nt2, g2.lda, g2.ldb, hA2, hB2, n1A, n1B, g1.lda, g1.ldb, hA1, hB1)
        asm volatile("s_nop 15\n\ts_nop 15" ::: "memory");
        if (wr == 0) PC_BAR;
        { const int t2 = fresh_tid(); E(acc, cur, t2 >> 8, (t2 >> 6) & 3, t2 & 15, (t2 >> 4) & 3); }
        if (!has_next) break;
#pragma unroll
        for (int a = 0; a < 2; ++a)
#pragma unroll
            for (int b = 0; b < 2; ++b)
#pragma unroll
                for (int m = 0; m < 4; ++m)
#pragma unroll
                    for (int n = 0; n < 2; ++n) acc[a][b][m][n] = (f32x4){0.f, 0.f, 0.f, 0.f};
        cur = nxt; c1A = n1A; c1B = n1B; ++ui;
        if (wr == 1) PC_BAR;
    }
    PC_WAIT_V(0);
    PC_BAR;
#undef PC_SA
#undef PC_SB
#undef PC_STAGE
#undef PC_LDA
#undef PC_LDB
#undef PC_MMA
#undef PC_WAIT_V
#undef PC_WAIT_L
#undef PC_BAR
#undef PC_SCHED
#undef PC_KLOOP
#undef PC_OFFS
}
}

constexpr int DM = 2048, DEPTH = 2;
constexpr int MTOK = 65536, MPROMPT = 32768, SEQ_P = 16384, SEQ_S = 4096;
constexpr int IN_COLS = 11360;
constexpr int NP1 = 4352, NP2 = 7168, NQ = 1536, NKV = 2048;
constexpr int SRC_CQ = 0, SRC_CKV = 512, SRC_KROPE = 1024, SRC_ZA = 1088, SRC_QM = 2112, SRC_KM = 3136, SRC_VM = 4160, SRC_OM = 5184, SRC_ZM = 6208, SRC_GATES = 7232, SRC_GA = 7264, SRC_GB = 9312;
constexpr float EPS = 1e-6f;
constexpr int NWAVES = 8;

constexpr size_t MiB = 1u << 20, U = 128 * MiB;
constexpr size_t WS_XN = 0;
constexpr size_t WS_CQKV = 2 * U;
constexpr size_t WS_QM = 3 * U, WS_KM = 4 * U, WS_VM = 5 * U;
constexpr size_t WS_Q = 6 * U;
constexpr size_t WS_KN = 6 * U + U / 2 * 3, WS_V = WS_KN + U;
constexpr size_t WS_KR = WS_V + U;
constexpr size_t WS_K8 = WS_KN, WS_V8T = WS_V;
constexpr size_t WS_HFW = 10 * U, WS_HBW = 11 * U;
constexpr size_t WS_MG = 3 * U;
constexpr size_t WS_SGA = 5 * U, WS_SGB = 7 * U;
constexpr size_t WS_W = 12 * U;
constexpr int NP1A = 1024, NP1B = 3328, NP2A = 3072, NP2B = 4096;
constexpr size_t W_P1A = 0, W_P1B = W_P1A + (size_t)NP1A * DM, W_P2A = W_P1B + (size_t)NP1B * DM * 2, W_P2B = W_P2A + (size_t)NP2A * DM, W_UQ = W_P2B + (size_t)NP2B * DM * 2,
                 W_UKV = W_UQ + (size_t)NQ * 512, W_OA = W_UKV + (size_t)NKV * 512, W_OB = W_OA + (size_t)DM * 1024, W_OUT = W_OB + (size_t)DM * 1024 * 2, LW = W_OUT + (size_t)DM * DM * 2;
constexpr int SC_ONE = 0x7F7F7F7F, SC_M6 = 0x79797979, SC_M5 = 0x7A7A7A7A;
constexpr size_t WS_ROPE = WS_W + 2 * LW;
constexpr size_t WS_KRG = WS_ROPE + 4 * MiB;
constexpr size_t WS_SSQ = WS_KRG + 24 * MiB;
constexpr size_t WS_SCR = WS_SSQ + 4 * MiB;
constexpr size_t WS_RSKV = WS_SCR + 20 * MiB;
constexpr size_t WS_SSF = WS_KR + 4 * MiB;
constexpr size_t WS_HG = WS_RSKV + 512 * 1024;
constexpr size_t WS_CTL = WS_RSKV + 1 * MiB, CTL_ZERO_BYTES = 1 * MiB;
constexpr size_t WS_XN8 = WS_CTL + CTL_ZERO_BYTES;
constexpr size_t WS_YA8 = WS_XN8 + U;
constexpr size_t WS_END = WS_YA8 + U / 2;
static_assert(LW % 256 == 0 && WS_END < 2040 * MiB, "d_ws map");
constexpr int CW_BAR = 4096;
constexpr int CW_PANEL = 32768;
constexpr int CW_QUEUE = 16384;

constexpr int LDS_BYTES = 163840;
constexpr int MISC_OFF = 159744;

#define GAS __attribute__((address_space(1)))
#define LAS __attribute__((address_space(3)))
typedef unsigned short bf16;
typedef unsigned v4u __attribute__((ext_vector_type(4)));
typedef float f32x4 __attribute__((ext_vector_type(4)));
typedef short bf16x8 __attribute__((ext_vector_type(8)));
typedef GAS unsigned gu32;
typedef GAS unsigned long long gu64;
#define RLX_AGENT __ATOMIC_RELAXED, __HIP_MEMORY_SCOPE_AGENT
#define LDS_WAIT() asm volatile("s_waitcnt lgkmcnt(0)" ::: "memory")
#define VM_WAIT() asm volatile("s_waitcnt vmcnt(0)" ::: "memory")
__device__ __forceinline__ unsigned long long rt() { return __builtin_amdgcn_s_memrealtime(); }
__device__ __forceinline__ unsigned f2bf(float f) { unsigned u = __builtin_bit_cast(unsigned, f); return (u + 0x7fffu + ((u >> 16) & 1u)) >> 16; }
__device__ __forceinline__ unsigned pk2(float lo, float hi) { return f2bf(lo) | (f2bf(hi) << 16); }

#define XB_TMO      128
#define XB_XCNT(j)  (256  + 64 * (j))
#define XB_XSUB(j)  (1280 + 64 * (j))
#define XB_XGEN(j)  (2304 + 64 * (j))
#define XB_TOP      3328
#define XB_TOPGEN   3392
#define XCD_BAR_WORDS 3456
#define XB_SPIN_CAP (1u << 18)

__device__ __forceinline__ unsigned xb_ld(unsigned* p)              { return __hip_atomic_load(p, __ATOMIC_RELAXED, __HIP_MEMORY_SCOPE_AGENT); }
__device__ __forceinline__ unsigned xb_add(unsigned* p, unsigned v) { return __hip_atomic_fetch_add(p, v, __ATOMIC_RELAXED, __HIP_MEMORY_SCOPE_AGENT); }
__device__ __forceinline__ unsigned xb_xcc_id() { return (unsigned)__builtin_amdgcn_s_getreg((3 << 11) | 20) & 0xFu; }
#define XB_SPIN(cond, bar) do { unsigned _sp = 0; while (cond) { __builtin_amdgcn_s_sleep(1); \
    if ((++_sp & 255u) == 0u) { if (xb_ld(&(bar)[XB_TMO])) break; if (_sp > XB_SPIN_CAP) { atomicAdd(&(bar)[XB_TMO], 1u); break; } } } } while (0)

struct XcdBarrier {
    unsigned* bar; unsigned x;
    volatile LAS unsigned* st;
};

__device__ __forceinline__ XcdBarrier xcd_barrier_post(unsigned* bar, volatile LAS unsigned* st) {
    XcdBarrier b; b.bar = bar; b.x = xb_xcc_id(); b.st = st;
    if (threadIdx.x == 0) (void)xb_add(&bar[XB_XCNT(b.x)], 1u);
    return b;
}
__device__ __forceinline__ void xcd_barrier_complete(unsigned* bar, unsigned x, unsigned& nloc, unsigned& nx) {
    const unsigned G = gridDim.x * gridDim.y * gridDim.z;
    unsigned sum, cnt, mine, sp = 0u;
    for (;;) {
        sum = 0u; cnt = 0u; mine = 0u;
#pragma unroll
        for (unsigned j = 0; j < 16; ++j) { const unsigned c = xb_ld(&bar[XB_XCNT(j)]); sum += c; cnt += (c > 0u) ? 1u : 0u; mine = (j == x) ? c : mine; }
        if (sum == G) break;
        __builtin_amdgcn_s_sleep(1);
        if ((++sp & 255u) == 0u) { if (xb_ld(&bar[XB_TMO])) break; if (sp > XB_SPIN_CAP) { atomicAdd(&bar[XB_TMO], 1u); break; } }
    }
    nloc = mine > 0u ? mine : 1u; nx = cnt > 0u ? cnt : 1u;
}

__device__ __forceinline__ void xcd_barrier(const XcdBarrier& b) {
    asm volatile("s_waitcnt vmcnt(0)" ::: "memory");
    __syncthreads();
    if (threadIdx.x == 0) {
        unsigned* bar = b.bar;
        __builtin_amdgcn_s_waitcnt(0);
        unsigned nloc = b.st[0], nx = b.st[1];
        if (nloc == 0u) { xcd_barrier_complete(bar, b.x, nloc, nx); b.st[0] = nloc; b.st[1] = nx; }
        const unsigned old = xb_add(&bar[XB_XSUB(b.x)], 1u);
        const unsigned gen = old / nloc;
        if (old + 1u == (gen + 1u) * nloc) {
            __builtin_amdgcn_fence(__ATOMIC_RELEASE, "agent");
            asm volatile("s_waitcnt vmcnt(0)" ::: "memory");
            const unsigned og = xb_add(&bar[XB_TOP], 1u);
            const unsigned tg = og / nx;
            if (og + 1u == (tg + 1u) * nx) xb_add(&bar[XB_TOPGEN], 1u);
            else XB_SPIN(xb_ld(&bar[XB_TOPGEN]) == tg, bar);
            __builtin_amdgcn_fence(__ATOMIC_ACQUIRE, "agent");
            xb_add(&bar[XB_XGEN(b.x)], 1u);
            asm volatile("s_waitcnt vmcnt(0)" ::: "memory");
        } else {
            XB_SPIN(xb_ld(&bar[XB_XGEN(b.x)]) == gen, bar);
            __builtin_amdgcn_fence(__ATOMIC_ACQUIRE, "agent");
            asm volatile("s_waitcnt vmcnt(0)" ::: "memory");
        }
    }
    __syncthreads();
}


typedef float f32x2 __attribute__((ext_vector_type(2)));
typedef float f32x8v __attribute__((ext_vector_type(8)));
typedef unsigned u32x2 __attribute__((ext_vector_type(2)));
typedef short s16x4 __attribute__((ext_vector_type(4)));
typedef float f32x16 __attribute__((ext_vector_type(16)));

typedef float cvt_f32x2 __attribute__((ext_vector_type(2))); typedef __bf16 cvt_bf16x2 __attribute__((ext_vector_type(2)));
__device__ __forceinline__ unsigned cvtpk(float lo, float hi) { return __builtin_bit_cast(unsigned, __builtin_convertvector((cvt_f32x2){lo, hi}, cvt_bf16x2)); }
__device__ __forceinline__ float bflo(unsigned w) { return __uint_as_float(w << 16); }
__device__ __forceinline__ float bfhi(unsigned w) { return __uint_as_float(w & 0xffff0000u); }
__device__ __forceinline__ float sigmoidf_(float x) { return __builtin_amdgcn_rcpf(1.0f + __expf(-x)); }
__device__ __forceinline__ float siluf_(float x) { return x * __builtin_amdgcn_rcpf(1.0f + __expf(-x)); }
template <int K> __device__ __forceinline__ float swz_xor(float v) { return __int_as_float(__builtin_amdgcn_ds_swizzle(__float_as_int(v), 0x1F | (K << 10))); }
__device__ __forceinline__ float sum_x16(float v) { const auto rr = __builtin_amdgcn_permlane16_swap(__float_as_uint(v), __float_as_uint(v), false, false); return __uint_as_float(rr[0]) + __uint_as_float(rr[1]); }
__device__ __forceinline__ float sum_x32(float v) { const auto rr = __builtin_amdgcn_permlane32_swap(__float_as_uint(v), __float_as_uint(v), false, false); return __uint_as_float(rr[0]) + __uint_as_float(rr[1]); }
__device__ __forceinline__ float wave_sum(float v) { v += swz_xor<1>(v); v += swz_xor<2>(v); v += swz_xor<4>(v); v += swz_xor<8>(v); v = sum_x16(v); return sum_x32(v); }
__device__ __forceinline__ unsigned pk4_fp8(float a, float b, float c, float d) {
    a = __builtin_amdgcn_fmed3f(a, -448.f, 448.f); b = __builtin_amdgcn_fmed3f(b, -448.f, 448.f); c = __builtin_amdgcn_fmed3f(c, -448.f, 448.f); d = __builtin_amdgcn_fmed3f(d, -448.f, 448.f);
    int w = __builtin_amdgcn_cvt_pk_fp8_f32(a, b, 0, false); w = __builtin_amdgcn_cvt_pk_fp8_f32(c, d, w, true); return (unsigned)w; }
__device__ __forceinline__ int opaque_tid() { return pg8::fresh_tid(); }
__device__ __forceinline__ int seq_pos(int m) { return m < MPROMPT ? (m & (SEQ_P - 1)) : (m & (SEQ_S - 1)); }

struct Frame {
    LAS unsigned char* lds;
    volatile LAS unsigned* MISC;
    gu32* ctl;
    int tid, lane, wave, vcu, G;
    unsigned char* ws;
    float* out;
};
enum { IN_XP = 0, IN_XS = 1, IN_NORM_IN = 2, IN_W_IN = 3, IN_B_GATES = 4, IN_Q_A_NORM = 5, IN_W_UQ = 6, IN_KV_A_NORM = 7, IN_W_UKV = 8, IN_W_OA = 9, IN_M_HEAD_NORM = 10, IN_W_OB = 11, IN_W_OUT = 12, IN_NORM_F = 13 };
struct Args { const float* in[14]; float* out; unsigned char* ws; int ph_lo, ph_hi; };

__device__ __forceinline__ int wmap(int kind, int n) {
    if (kind == 0) {
        if (n < 3072) return SRC_QM + n;
        if (n < 3136) { const int j = n - 3072; return SRC_KROPE + (j >> 1) + 32 * (j & 1); }
        if (n < 3168) return SRC_GATES + (n - 3136);
        return -1;
    }
    if (kind == 5) return n;
    if (kind == 1) {
        if (n < 2048) { const int t = n >> 8, w = n & 255; return (w < 128 ? SRC_OM : SRC_ZM) + t * 128 + (w & 127); }
        return SRC_GB + (n - 2048);
    }
    if (kind == 6) {
        if (n < 1024) return SRC_ZA + n;
        return SRC_GA + (n - 1024);
    }
    if (kind == 2) {
        if (n < 1024) return (n >> 7) * 192 + (n & 127);
        const int j = n - 1024, h = j >> 6, jj = j & 63; return h * 192 + 128 + (jj >> 1) + 32 * (jj & 1);
    }
    if (kind == 3) {
        if (n < 1024) return (n >> 7) * 256 + (n & 127);
        const int j = n - 1024; return (j >> 7) * 256 + 128 + (j & 127);
    }
    return n;
}
__device__ __forceinline__ void transpose_item(const float* W, int K, int srcN, bf16* WT, int Ndst, int kind, const float* kgain, LAS float* scr, int item, int lane) {
    const int nblk = Ndst / 32, kb = item / nblk, nb = item % nblk, k0 = 64 * kb, n0 = 32 * nb;
    const int n = n0 + (lane & 31); const int sc = wmap(kind, n);
    const float cs = (kind == 0 && n < 1024) ? 0.08838834764831845f : 1.0f;
    float tv[32];
#pragma unroll
    for (int i = 0; i < 32; ++i) { const int kk = 2 * i + (lane >> 5);
        float v = 0.f; if (sc >= 0) { v = W[(size_t)(k0 + kk) * srcN + sc] * cs; if (kgain) v *= kgain[k0 + kk]; }
        tv[i] = v; }
#pragma unroll
    for (int i = 0; i < 32; ++i) scr[(2 * i + (lane >> 5)) * 33 + (lane & 31)] = tv[i];
    LDS_WAIT(); asm volatile("" ::: "memory");
    const int c = lane & 7;
#pragma unroll
    for (int j = 0; j < 4; ++j) { const int nn = (lane >> 3) + 8 * j; const LAS float* s = scr + (8 * c) * 33 + nn;
        v4u o; o.x = pk2(s[0 * 33], s[1 * 33]); o.y = pk2(s[2 * 33], s[3 * 33]); o.z = pk2(s[4 * 33], s[5 * 33]); o.w = pk2(s[6 * 33], s[7 * 33]);
        *(GAS v4u*)(WT + (size_t)(n0 + nn) * K + k0 + 8 * c) = o; }
    LDS_WAIT(); asm volatile("" ::: "memory");
}
__device__ __forceinline__ void transpose_item8(const float* W, int K, int srcN, unsigned char* WT, int Ndst, int kind, const float* kgain, float wscale, LAS float* scr, int item, int lane) {
    const int nblk = Ndst / 32, kb = item / nblk, nb = item % nblk, k0 = 64 * kb, n0 = 32 * nb;
    const int n = n0 + (lane & 31); const int sc = wmap(kind, n);
    float tv[32];
#pragma unroll
    for (int i = 0; i < 32; ++i) { const int kk = 2 * i + (lane >> 5);
        float v = 0.f; if (sc >= 0) { v = W[(size_t)(k0 + kk) * srcN + sc] * wscale; if (kgain) v *= kgain[k0 + kk]; }
        tv[i] = v; }
#pragma unroll
    for (int i = 0; i < 32; ++i) scr[(2 * i + (lane >> 5)) * 33 + (lane & 31)] = tv[i];
    LDS_WAIT(); asm volatile("" ::: "memory");
    const int nn = lane >> 1, kh = (lane & 1) * 32; const LAS float* s = scr + kh * 33 + nn;
#pragma unroll
    for (int c = 0; c < 2; ++c) { v4u o;
        o.x = pk4_fp8(s[(16 * c + 0) * 33], s[(16 * c + 1) * 33], s[(16 * c + 2) * 33], s[(16 * c + 3) * 33]); o.y = pk4_fp8(s[(16 * c + 4) * 33], s[(16 * c + 5) * 33], s[(16 * c + 6) * 33], s[(16 * c + 7) * 33]);
        o.z = pk4_fp8(s[(16 * c + 8) * 33], s[(16 * c + 9) * 33], s[(16 * c + 10) * 33], s[(16 * c + 11) * 33]); o.w = pk4_fp8(s[(16 * c + 12) * 33], s[(16 * c + 13) * 33], s[(16 * c + 14) * 33], s[(16 * c + 15) * 33]);
        *(GAS v4u*)(WT + (size_t)(n0 + nn) * K + k0 + kh + 16 * c) = o; }
    LDS_WAIT(); asm volatile("" ::: "memory");
}
__device__ __forceinline__ void p_prologue(Frame& F, const Args& A) {
    const int tid_ = opaque_tid(), lane_ = tid_ & 63, wave_ = __builtin_amdgcn_readfirstlane(tid_ >> 6);
    LAS float* scr = (LAS float*)(F.lds + wave_ * 16384);
    const int gw = F.vcu * NWAVES + wave_, NGW = F.G * NWAVES;
    constexpr int I_P1A = (DM / 64) * (NP1A / 32), I_P1B = (DM / 64) * (NP1B / 32), I_P2A = (DM / 64) * (NP2A / 32), I_P2B = (DM / 64) * (NP2B / 32), I_UQ = (512 / 64) * (NQ / 32),
                  I_UKV = (512 / 64) * (NKV / 32), I_OA = (1024 / 64) * (DM / 32), I_OB = I_OA, I_OUT = (DM / 64) * (DM / 32), I_LAYER = I_P1A + I_P1B + I_P2A + I_P2B + I_UQ + I_UKV + I_OA + I_OB + I_OUT;
    for (int it = gw; it < DEPTH * I_LAYER; it += NGW) {
        const int l = it / I_LAYER; int r = it - l * I_LAYER;
        unsigned char* wb = F.ws + WS_W + (size_t)l * LW;
        const float* win = A.in[IN_W_IN] + (size_t)l * DM * IN_COLS;
        if (r < I_P1A) { transpose_item8(win, DM, IN_COLS, wb + W_P1A, NP1A, 5, nullptr, 64.f, scr, r, lane_); continue; } r -= I_P1A;
        if (r < I_P1B) { transpose_item(win, DM, IN_COLS, (bf16*)(wb + W_P1B), NP1B, 0, nullptr, scr, r, lane_); continue; } r -= I_P1B;
        if (r < I_P2A) { transpose_item8(win, DM, IN_COLS, wb + W_P2A, NP2A, 6, nullptr, 64.f, scr, r, lane_); continue; } r -= I_P2A;
        if (r < I_P2B) { transpose_item(win, DM, IN_COLS, (bf16*)(wb + W_P2B), NP2B, 1, nullptr, scr, r, lane_); continue; } r -= I_P2B;
        if (r < I_UQ) { transpose_item8(A.in[IN_W_UQ] + (size_t)l * 512 * NQ, 512, NQ, wb + W_UQ, NQ, 2, A.in[IN_Q_A_NORM] + l * 512, 32.f, scr, r, lane_); continue; } r -= I_UQ;
        if (r < I_UKV) { transpose_item8(A.in[IN_W_UKV] + (size_t)l * 512 * NKV, 512, NKV, wb + W_UKV, NKV, 3, A.in[IN_KV_A_NORM] + l * 512, 32.f, scr, r, lane_); continue; } r -= I_UKV;
        if (r < I_OA) { transpose_item8(A.in[IN_W_OA] + (size_t)l * 1024 * DM, 1024, DM, wb + W_OA, DM, 4, nullptr, 32.f, scr, r, lane_); continue; } r -= I_OA;
        if (r < I_OB) { transpose_item(A.in[IN_W_OB] + (size_t)l * 1024 * DM, 1024, DM, (bf16*)(wb + W_OB), DM, 4, nullptr, scr, r, lane_); continue; } r -= I_OB;
        transpose_item(A.in[IN_W_OUT] + (size_t)l * DM * DM, DM, DM, (bf16*)(wb + W_OUT), DM, 4, nullptr, scr, r, lane_);
    }
    for (int e = F.vcu * 512 + tid_; e < DEPTH * 1024; e += F.G * 512) ((float*)(F.ws + WS_HG))[e] = A.in[IN_M_HEAD_NORM][e];
    f32x2* rope = (f32x2*)(F.ws + WS_ROPE);
    for (int e = F.vcu * 512 + tid_; e < SEQ_P * 32; e += F.G * 512) {
        const int pos = e >> 5, i = e & 31;
        const float inv = powf(10000.0f, -(float)(2 * i) / 64.0f);
        const float ang = (float)pos * inv; float s, c; sincosf(ang, &s, &c);
        rope[e] = (f32x2){c, s};
    }
}

__device__ __forceinline__ const float* x_row(Frame& F, const Args& A, int layer, int m) {
    if (layer == 0) return m < MPROMPT ? A.in[IN_XP] + (size_t)m * DM : A.in[IN_XS] + (size_t)(m - MPROMPT) * DM;
    return F.out + (size_t)m * DM;
}
__device__ __forceinline__ void p_norm(Frame& F, const Args& A, int layer) {
    const int tid_ = opaque_tid(), lane_ = tid_ & 63, wave_ = __builtin_amdgcn_readfirstlane(tid_ >> 6);
    const int gw = F.vcu * NWAVES + wave_, NGW = F.G * NWAVES;
    const float* g = A.in[IN_NORM_IN] + layer * DM; bf16* XN = (bf16*)(F.ws + WS_XN);
    for (int m = gw; m < MTOK; m += NGW) {
        const GAS f32x4* xr = (const GAS f32x4*)x_row(F, A, layer, m) + lane_;
        f32x4 v[8]; float s = 0.f;
#pragma unroll
        for (int j = 0; j < 8; ++j) { v[j] = xr[64 * j]; s += (v[j].x * v[j].x + v[j].y * v[j].y) + (v[j].z * v[j].z + v[j].w * v[j].w); }
        const float rs = 1.0f / sqrtf(wave_sum(s) * (1.0f / DM) + EPS);
        GAS unsigned long long* o8 = (GAS unsigned long long*)(XN + (size_t)m * DM) + lane_;
#pragma unroll
        for (int j = 0; j < 8; ++j) { const f32x4 gg = *((const GAS f32x4*)g + lane_ + 64 * j);
            const float y0 = v[j].x * rs * gg.x, y1 = v[j].y * rs * gg.y, y2 = v[j].z * rs * gg.z, y3 = v[j].w * rs * gg.w;
            o8[64 * j] = (unsigned long long)cvtpk(y0, y1) | ((unsigned long long)cvtpk(y2, y3) << 32);
            ((GAS unsigned*)(F.ws + WS_XN8 + (size_t)m * DM))[lane_ + 64 * j] = pk4_fp8(y0, y1, y2, y3); }
    }
}
__device__ __forceinline__ void p_final(Frame& F, const Args& A) {
    const int tid_ = opaque_tid(), lane_ = tid_ & 63, wave_ = __builtin_amdgcn_readfirstlane(tid_ >> 6);
    const int gw = F.vcu * NWAVES + wave_, NGW = F.G * NWAVES;
    for (int m = gw; m < MTOK; m += NGW) {
        GAS f32x4* xr = (GAS f32x4*)(F.out + (size_t)m * DM) + lane_;
        f32x4 v[8]; float s = 0.f;
#pragma unroll
        for (int j = 0; j < 8; ++j) { v[j] = xr[64 * j]; s += (v[j].x * v[j].x + v[j].y * v[j].y) + (v[j].z * v[j].z + v[j].w * v[j].w); }
        const float rs = 1.0f / sqrtf(wave_sum(s) * (1.0f / DM) + EPS);
#pragma unroll
        for (int j = 0; j < 8; ++j) { const f32x4 gg = *((const GAS f32x4*)A.in[IN_NORM_F] + lane_ + 64 * j); xr[64 * j] = v[j] * rs * gg; }
    }
}

using pg8::Unit; using pg8::BM; using pg8::HALF;
#define EPI_ROWS_BEGIN  _Pragma("unroll") for (int ai = 0; ai < 2; ++ai) _Pragma("unroll") for (int m = 0; m < 4; ++m) { const int row = u.pm * BM + ai * HALF + wr * 64 + m * 16 + fr;
#define EPI_ROWS_END    asm volatile("" ::: "memory"); }
#define EPI_ROW(ai, m) (u.pm * BM + (ai) * HALF + wr * 64 + (m) * 16 + fr)
#define EPI_FENCE asm volatile("" ::: "memory")

struct EpiP1a {
    static constexpr int PERM = 2; static constexpr bool AFTER_DRAIN = false;
    unsigned char* ws; size_t dst;
    __device__ __forceinline__ void operator()(const f32x4 (&acc)[2][2][4][2], const Unit& u, int wr, int wc, int fr, int fq) const {
        const int pn = u.pn, col0 = pn * 256 + wc * 64 + 16 * fq;
        EPI_ROWS_BEGIN
            float s = 0.f; v4u w;
#pragma unroll
            for (int bj = 0; bj < 2; ++bj) { const f32x4 v0 = acc[ai][bj][m][0] * 0.015625f, v1 = acc[ai][bj][m][1] * 0.015625f;
                s += (v0[0] * v0[0] + v0[1] * v0[1]) + (v0[2] * v0[2] + v0[3] * v0[3]) + (v1[0] * v1[0] + v1[1] * v1[1]) + (v1[2] * v1[2] + v1[3] * v1[3]);
                w[2 * bj] = pk4_fp8(v0[0], v0[1], v0[2], v0[3]); w[2 * bj + 1] = pk4_fp8(v1[0], v1[1], v1[2], v1[3]); }
            *(v4u*)(ws + dst + (size_t)row * 1024 + col0) = w;
            s = sum_x16(s); s = sum_x32(s); if (fq == 0) ((float*)(ws + WS_SSQ))[(size_t)row * 16 + pn * 4 + wc] = s;
        EPI_ROWS_END
    }
};
struct EpiP1b {
    static constexpr bool PERM = true, AFTER_DRAIN = false;
    unsigned char* ws;
    __device__ __forceinline__ void operator()(const f32x4 (&acc)[2][2][4][2], const Unit& u, int wr, int wc, int fr, int fq) const {
        const int pn = u.pn;
        if (pn < 12) {
            bf16* base = (bf16*)(ws + WS_QM + (size_t)(pn >> 2) * U); const int col0 = (pn & 3) * 256 + wc * 32 + 8 * fq;
            EPI_ROWS_BEGIN
                bf16* rowp = base + (size_t)row * 1024 + col0;
#pragma unroll
                for (int bj = 0; bj < 2; ++bj) { const f32x4 v0 = acc[ai][bj][m][0], v1 = acc[ai][bj][m][1];
                    v4u w; w.x = cvtpk(v0[0], v0[1]); w.y = cvtpk(v0[2], v0[3]); w.z = cvtpk(v1[0], v1[1]); w.w = cvtpk(v1[2], v1[3]);
                    *(v4u*)(rowp + bj * HALF) = w; }
            EPI_ROWS_END
        } else if (wc < 2) {
#pragma unroll
            for (int ai = 0; ai < 2; ++ai) { f32x4 cs[4][2];
#pragma unroll
                for (int m = 0; m < 4; ++m) { const f32x2* rp = (const f32x2*)(ws + WS_ROPE) + seq_pos(EPI_ROW(ai, m)) * 32 + 16 * wc + 4 * fq; cs[m][0] = *(const f32x4*)rp; cs[m][1] = *(const f32x4*)(rp + 2); }
                EPI_FENCE;
#pragma unroll
                for (int m = 0; m < 4; ++m) { const f32x4 cs01 = cs[m][0], cs23 = cs[m][1]; const f32x4 a = acc[ai][0][m][0], b = acc[ai][0][m][1];
                    *(u32x2*)(ws + WS_KR + (size_t)EPI_ROW(ai, m) * 64 + 32 * wc + 8 * fq) = (u32x2){
                        pk4_fp8(a[0] * cs01[0] - a[1] * cs01[1], a[1] * cs01[0] + a[0] * cs01[1], a[2] * cs01[2] - a[3] * cs01[3], a[3] * cs01[2] + a[2] * cs01[3]),
                        pk4_fp8(b[0] * cs23[0] - b[1] * cs23[1], b[1] * cs23[0] + b[0] * cs23[1], b[2] * cs23[2] - b[3] * cs23[3], b[3] * cs23[2] + b[2] * cs23[3])};
                    EPI_FENCE; } }
        } else if (wc == 2) {
            EPI_ROWS_BEGIN
                float* gp = (float*)(ws + WS_KRG) + (size_t)row * 96 + 64 + 8 * fq;
                *(f32x4*)gp = acc[ai][0][m][0]; *(f32x4*)(gp + 4) = acc[ai][0][m][1];
            EPI_ROWS_END
        }
    }
};
struct EpiQ {
    static constexpr bool PERM = true, AFTER_DRAIN = false;
    unsigned char* ws;
    __device__ __forceinline__ void operator()(const f32x4 (&acc)[2][2][4][2], const Unit& u, int wr, int wc, int fr, int fq) const {
        const int col0 = u.pn * 256 + wc * 32 + 8 * fq;
#pragma unroll
        for (int ai = 0; ai < 2; ++ai) {
            f32x4 sq[4][2];
#pragma unroll
            for (int m = 0; m < 4; ++m) { const float* sp = (const float*)(ws + WS_SSQ) + (size_t)EPI_ROW(ai, m) * 16; sq[m][0] = *(const f32x4*)sp; sq[m][1] = *(const f32x4*)(sp + 4); }
            EPI_FENCE;
#pragma unroll
            for (int m = 0; m < 4; ++m) { const int row = EPI_ROW(ai, m); const f32x4 s0 = sq[m][0], s1 = sq[m][1];
                const float rs = 0.03125f / sqrtf(((s0[0] + s0[1]) + (s0[2] + s0[3]) + (s1[0] + s1[1]) + (s1[2] + s1[3])) * (1.0f / 512.0f) + EPS);
                bf16* rowp = (bf16*)(ws + WS_Q) + (size_t)row * NQ + col0;
#pragma unroll
                for (int bj = 0; bj < 2; ++bj) { const f32x4 v0 = acc[ai][bj][m][0] * rs, v1 = acc[ai][bj][m][1] * rs;
                    v4u w; w.x = cvtpk(v0[0], v0[1]); w.y = cvtpk(v0[2], v0[3]); w.z = cvtpk(v1[0], v1[1]); w.w = cvtpk(v1[2], v1[3]);
                    *(v4u*)(rowp + bj * HALF) = w; }
                EPI_FENCE; }
        }
    }
};
struct EpiK8 {
    static constexpr int PERM = 2; static constexpr bool AFTER_DRAIN = false;
    unsigned char* ws;
    __device__ __forceinline__ void operator()(const f32x4 (&acc)[2][2][4][2], const Unit& u, int wr, int wc, int fr, int fq) const {
        const int col0 = u.pn * 256 + wc * 64 + 16 * fq;
#pragma unroll
        for (int ai = 0; ai < 2; ++ai) {
            f32x4 sq[4][2];
#pragma unroll
            for (int m = 0; m < 4; ++m) { const float* sp = (const float*)(ws + WS_SSQ) + (size_t)EPI_ROW(ai, m) * 16 + 8; sq[m][0] = *(const f32x4*)sp; sq[m][1] = *(const f32x4*)(sp + 4); }
            EPI_FENCE;
#pragma unroll
            for (int m = 0; m < 4; ++m) { const int row = EPI_ROW(ai, m); const f32x4 s0 = sq[m][0], s1 = sq[m][1];
                const float rs = 0.03125f / sqrtf(((s0[0] + s0[1]) + (s0[2] + s0[3]) + (s1[0] + s1[1]) + (s1[2] + s1[3])) * (1.0f / 512.0f) + EPS);
                v4u w;
#pragma unroll
                for (int bj = 0; bj < 2; ++bj) { const f32x4 v0 = acc[ai][bj][m][0] * rs, v1 = acc[ai][bj][m][1] * rs;
                    w[2 * bj] = pk4_fp8(v0[0], v0[1], v0[2], v0[3]); w[2 * bj + 1] = pk4_fp8(v1[0], v1[1], v1[2], v1[3]); }
                *(v4u*)(ws + WS_K8 + (size_t)row * 1024 + col0) = w;
                EPI_FENCE; }
        }
    }
};
struct EpiVT {
    static constexpr int PERM = 2; static constexpr bool AFTER_DRAIN = false;
    unsigned char* ws;
    __device__ __forceinline__ void operator()(const f32x4 (&acc)[2][2][4][2], const Unit& u, int wr, int wc, int fr, int fq) const {
        const int tok0 = u.pn * 256 + wc * 64 + 16 * fq;
        const int J0 = 2 * fq, pos = 4 * (J0 & 3) + 16 * (J0 >> 2);
        f32x4 rq[2][2];
#pragma unroll
        for (int bj = 0; bj < 2; ++bj) { f32x4 sq[8][2];
#pragma unroll
            for (int e = 0; e < 8; ++e) { const float* sp = (const float*)(ws + WS_SSQ) + (size_t)(tok0 + 8 * bj + e) * 16 + 8; sq[e][0] = *(const f32x4*)sp; sq[e][1] = *(const f32x4*)(sp + 4); }
            EPI_FENCE;
#pragma unroll
            for (int e = 0; e < 8; ++e) { const f32x4 s0 = sq[e][0], s1 = sq[e][1];
                rq[bj][e >> 2][e & 3] = 0.03125f / sqrtf(((s0[0] + s0[1]) + (s0[2] + s0[3]) + (s1[0] + s1[1]) + (s1[2] + s1[3])) * (1.0f / 512.0f) + EPS); } }
        EPI_ROWS_BEGIN
            unsigned char* rowp = ws + WS_V8T + ((size_t)(tok0 >> 6) * 1024 + row) * 64 + pos;
            const f32x4 a0 = acc[ai][0][m][0] * rq[0][0], a1 = acc[ai][0][m][1] * rq[0][1], b0 = acc[ai][1][m][0] * rq[1][0], b1 = acc[ai][1][m][1] * rq[1][1];
            *(u32x2*)rowp = (u32x2){pk4_fp8(a0[0], a0[1], a0[2], a0[3]), pk4_fp8(b0[0], b0[1], b0[2], b0[3])};
            *(u32x2*)(rowp + 32) = (u32x2){pk4_fp8(a1[0], a1[1], a1[2], a1[3]), pk4_fp8(b1[0], b1[1], b1[2], b1[3])};
        EPI_ROWS_END
    }
};
struct EpiP2a {
    static constexpr int PERM = 2; static constexpr bool AFTER_DRAIN = false;
    unsigned char* ws; size_t sga;
    __device__ __forceinline__ void operator()(const f32x4 (&acc)[2][2][4][2], const Unit& u, int wr, int wc, int fr, int fq) const {
        const int pn = u.pn;
        if (pn < 4) {
            const int col0 = pn * 256 + wc * 64 + 16 * fq;
#pragma unroll
            for (int ai = 0; ai < 2; ++ai) { v4u ov[4][2];
#pragma unroll
              for (int m = 0; m < 4; ++m) { const bf16* orow = (const bf16*)(ws + WS_CQKV) + (size_t)EPI_ROW(ai, m) * 1024 + col0; ov[m][0] = *(const v4u*)orow; ov[m][1] = *(const v4u*)(orow + 8); }
              EPI_FENCE;
#pragma unroll
              for (int m = 0; m < 4; ++m) { const int row = EPI_ROW(ai, m); v4u w;
#pragma unroll
                for (int bj = 0; bj < 2; ++bj) { f32x4 v0 = acc[ai][bj][m][0] * 0.015625f, v1 = acc[ai][bj][m][1] * 0.015625f;
                    const v4u o = ov[m][bj];
#pragma unroll
                    for (int j = 0; j < 4; ++j) { v0[j] = 64.f * siluf_(v0[j]); v1[j] = 64.f * siluf_(v1[j]); }
                    v0[0] *= bflo(o.x); v0[1] *= bfhi(o.x); v0[2] *= bflo(o.y); v0[3] *= bfhi(o.y); v1[0] *= bflo(o.z); v1[1] *= bfhi(o.z); v1[2] *= bflo(o.w); v1[3] *= bfhi(o.w);
                    w[2 * bj] = pk4_fp8(v0[0], v0[1], v0[2], v0[3]); w[2 * bj + 1] = pk4_fp8(v1[0], v1[1], v1[2], v1[3]); }
                *(v4u*)(ws + WS_YA8 + (size_t)row * 1024 + col0) = w;
                EPI_FENCE; } }
        } else {
            const int col0 = (pn - 4) * 256 + wc * 64 + 16 * fq;
            EPI_ROWS_BEGIN
                bf16* rowp = (bf16*)(ws + sga) + (size_t)row * 2048 + col0;
#pragma unroll
                for (int bj = 0; bj < 2; ++bj) { f32x4 v0 = acc[ai][bj][m][0] * 0.015625f, v1 = acc[ai][bj][m][1] * 0.015625f;
#pragma unroll
                    for (int j = 0; j < 4; ++j) { v0[j] = sigmoidf_(v0[j]); v1[j] = sigmoidf_(v1[j]); }
                    v4u w; w.x = cvtpk(v0[0], v0[1]); w.y = cvtpk(v0[2], v0[3]); w.z = cvtpk(v1[0], v1[1]); w.w = cvtpk(v1[2], v1[3]);
                    *(v4u*)(rowp + 8 * bj) = w; }
            EPI_ROWS_END
        }
    }
};
struct EpiP2b {
    static constexpr bool PERM = true, AFTER_DRAIN = false;
    unsigned char* ws; int layer;
    __device__ __forceinline__ void operator()(const f32x4 (&acc)[2][2][4][2], const Unit& u, int wr_, int wc_, int fr_, int fq_) const {
        const int t_ = opaque_tid(), wr = t_ >> 8, wc = (t_ >> 6) & 3, fr = t_ & 15, fq = (t_ >> 4) & 3;
        const int pn = u.pn;
        if (pn < 8) {
            extern __shared__ __attribute__((aligned(16))) unsigned char lds[];
            LAS float* red = (LAS float*)((LAS unsigned char*)lds + 131072);
            const int colh = pn * 128 + wc * 32 + 8 * fq;
#pragma unroll
            for (int ai = 0; ai < 2; ++ai) { v4u ha[4], hb[4];
#pragma unroll
                for (int m = 0; m < 4; ++m) { const size_t off = (size_t)EPI_ROW(ai, m) * 1024 + colh; ha[m] = *(const v4u*)((const bf16*)(ws + WS_HFW) + off); hb[m] = *(const v4u*)((const bf16*)(ws + WS_HBW) + off); }
                EPI_FENCE;
#pragma unroll
                for (int m = 0; m < 4; ++m) { const v4u a = ha[m], b = hb[m]; float s = 0.f;
#pragma unroll
                    for (int e = 0; e < 4; ++e) { const float lo = bflo(a[e]) + bflo(b[e]), hi = bfhi(a[e]) + bfhi(b[e]); s += lo * lo + hi * hi; }
                    s = sum_x16(s); s = sum_x32(s);
                    if (fq == 0) red[(wr * 128 + ai * 64 + m * 16 + fr) * 4 + wc] = s; }
                EPI_FENCE; }
            LDS_WAIT(); __builtin_amdgcn_s_barrier(); asm volatile("" ::: "memory");
            const int t2_ = opaque_tid(), wr2 = t2_ >> 8, fr2 = t2_ & 15, colh2 = pn * 128 + ((t2_ >> 6) & 3) * 32 + 8 * ((t2_ >> 4) & 3);
#define EPI_ROW2(ai, m) (u.pm * BM + (ai) * HALF + wr2 * 64 + (m) * 16 + fr2)
            const float* gain = (const float*)(ws + WS_HG) + layer * 1024 + colh2; const f32x4 g0 = *(const f32x4*)gain, g1 = *(const f32x4*)(gain + 4);
#pragma unroll
            for (int ai = 0; ai < 2; ++ai)
#pragma unroll
              for (int mh = 0; mh < 2; ++mh) { v4u ha[2], hb[2];
#pragma unroll
                for (int mm = 0; mm < 2; ++mm) { const size_t off = (size_t)EPI_ROW2(ai, 2 * mh + mm) * 1024 + colh2; ha[mm] = *(const v4u*)((const bf16*)(ws + WS_HFW) + off); hb[mm] = *(const v4u*)((const bf16*)(ws + WS_HBW) + off); }
                EPI_FENCE;
#pragma unroll
                for (int mm = 0; mm < 2; ++mm) { const int m = 2 * mh + mm; const size_t off = (size_t)EPI_ROW2(ai, m) * 1024 + colh2;
                    const f32x4 pr = *(const LAS f32x4*)(red + (wr2 * 128 + ai * 64 + m * 16 + fr2) * 4);
                    const float rs = 1.0f / sqrtf(((pr[0] + pr[1]) + (pr[2] + pr[3])) * (1.0f / 128.0f) + EPS);
                    const v4u a = ha[mm], b = hb[mm];
                    const f32x4 o0 = acc[ai][0][m][0], o1 = acc[ai][0][m][1], z0 = acc[ai][1][m][0], z1 = acc[ai][1][m][1];
                    float y[8];
#pragma unroll
                    for (int e = 0; e < 4; ++e) { y[2 * e] = (bflo(a[e]) + bflo(b[e])) * rs; y[2 * e + 1] = (bfhi(a[e]) + bfhi(b[e])) * rs; }
#pragma unroll
                    for (int j = 0; j < 4; ++j) { y[j] *= g0[j] * sigmoidf_(o0[j]) * (z0[j] * sigmoidf_(z0[j])); y[4 + j] *= g1[j] * sigmoidf_(o1[j]) * (z1[j] * sigmoidf_(z1[j])); }
                    v4u w; w.x = cvtpk(y[0], y[1]); w.y = cvtpk(y[2], y[3]); w.z = cvtpk(y[4], y[5]); w.w = cvtpk(y[6], y[7]);
                    *(v4u*)((bf16*)(ws + WS_HFW) + off) = w;
                    EPI_FENCE; } }
        } else {
            const int col0 = (pn - 8) * 256 + wc * 32 + 8 * fq;
            EPI_ROWS_BEGIN
                bf16* rowp = (bf16*)(ws + WS_SGB) + (size_t)row * 2048 + col0;
#pragma unroll
                for (int bj = 0; bj < 2; ++bj) { f32x4 v0 = acc[ai][bj][m][0], v1 = acc[ai][bj][m][1];
#pragma unroll
                    for (int j = 0; j < 4; ++j) { v0[j] = sigmoidf_(v0[j]); v1[j] = sigmoidf_(v1[j]); }
                    v4u w; w.x = cvtpk(v0[0], v0[1]); w.y = cvtpk(v0[2], v0[3]); w.z = cvtpk(v1[0], v1[1]); w.w = cvtpk(v1[2], v1[3]);
                    *(v4u*)(rowp + bj * HALF) = w; }
            EPI_ROWS_END
        }
    }
};
struct MidMerge {
    unsigned char* ws;
    __device__ __forceinline__ void operator()(f32x4 (&acc)[2][2][4][2], const Unit& u, int wr, int wc, int fr, int fq) const {
        const int col0 = u.pn * 256 + wc * 32 + 8 * fq;
#pragma unroll
        for (int ai = 0; ai < 2; ++ai)
#pragma unroll
          for (int mh = 0; mh < 2; ++mh) {
            v4u ga[2][2], gb[2][2];
#pragma unroll
            for (int mm = 0; mm < 2; ++mm)
#pragma unroll
                for (int bj = 0; bj < 2; ++bj) { const size_t off = (size_t)EPI_ROW(ai, 2 * mh + mm) * DM + col0 + bj * HALF; ga[mm][bj] = *(const v4u*)((const bf16*)(ws + WS_SGA) + off); gb[mm][bj] = *(const v4u*)((const bf16*)(ws + WS_SGB) + off); }
            EPI_FENCE;
#pragma unroll
            for (int mm = 0; mm < 2; ++mm)
#pragma unroll
                for (int bj = 0; bj < 2; ++bj) { const int m = 2 * mh + mm; const v4u a = ga[mm][bj], b = gb[mm][bj]; float r[8];
#pragma unroll
                    for (int e = 0; e < 4; ++e) { r[2 * e] = 2048.f * bflo(b[e]) * __builtin_amdgcn_rcpf(fmaxf(bflo(a[e]), 9.094947e-13f)); r[2 * e + 1] = 2048.f * bfhi(b[e]) * __builtin_amdgcn_rcpf(fmaxf(bfhi(a[e]), 9.094947e-13f)); }
                    f32x4 v0 = acc[ai][bj][m][0], v1 = acc[ai][bj][m][1];
                    v0[0] *= r[0]; v0[1] *= r[1]; v0[2] *= r[2]; v0[3] *= r[3]; v1[0] *= r[4]; v1[1] *= r[5]; v1[2] *= r[6]; v1[3] *= r[7];
                    acc[ai][bj][m][0] = v0; acc[ai][bj][m][1] = v1; }
            EPI_FENCE;
          }
    }
};
struct EpiMerge2 {
    static constexpr bool PERM = true, AFTER_DRAIN = false;
    unsigned char* ws;
    __device__ __forceinline__ void operator()(const f32x4 (&acc)[2][2][4][2], const Unit& u, int wr, int wc, int fr, int fq) const {
        const int col0 = u.pn * 256 + wc * 32 + 8 * fq; bf16* T = (bf16*)(ws + WS_MG);
#pragma unroll
        for (int ai = 0; ai < 2; ++ai) {
            v4u gv[4][2];
#pragma unroll
            for (int m = 0; m < 4; ++m)
#pragma unroll
                for (int bj = 0; bj < 2; ++bj) gv[m][bj] = *(const v4u*)((const bf16*)(ws + WS_SGA) + (size_t)EPI_ROW(ai, m) * DM + col0 + bj * HALF);
            EPI_FENCE;
#pragma unroll
            for (int m = 0; m < 4; ++m) { const size_t off = (size_t)EPI_ROW(ai, m) * DM + col0;
#pragma unroll
                for (int bj = 0; bj < 2; ++bj) { f32x4 v0 = acc[ai][bj][m][0] * 0.00048828125f, v1 = acc[ai][bj][m][1] * 0.00048828125f; const v4u g = gv[m][bj];
                    v0[0] *= fmaxf(bflo(g.x), 9.094947e-13f); v0[1] *= fmaxf(bfhi(g.x), 9.094947e-13f); v0[2] *= fmaxf(bflo(g.y), 9.094947e-13f); v0[3] *= fmaxf(bfhi(g.y), 9.094947e-13f);
                    v1[0] *= fmaxf(bflo(g.z), 9.094947e-13f); v1[1] *= fmaxf(bfhi(g.z), 9.094947e-13f); v1[2] *= fmaxf(bflo(g.w), 9.094947e-13f); v1[3] *= fmaxf(bfhi(g.w), 9.094947e-13f);
                    v4u w; w.x = cvtpk(v0[0], v0[1]); w.y = cvtpk(v0[2], v0[3]); w.z = cvtpk(v1[0], v1[1]); w.w = cvtpk(v1[2], v1[3]);
                    *(v4u*)(T + off + bj * HALF) = w; }
                EPI_FENCE; }
        }
    }
};
template <bool LAST> struct EpiOutX {
    static constexpr bool PERM = true, AFTER_DRAIN = false;
    const float* xp; const float* xs; float* out; unsigned char* ws; const float* gn; int layer;
    __device__ __forceinline__ void operator()(f32x4 (&acc)[2][2][4][2], const Unit& u, int wr, int wc, int fr, int fq) const {
        extern __shared__ __attribute__((aligned(16))) unsigned char lds[];
        LAS float* red = (LAS float*)((LAS unsigned char*)lds + 131072);
        const int col0 = u.pn * 256 + wc * 32 + 8 * fq;
#pragma unroll
        for (int ai = 0; ai < 2; ++ai) {
            f32x4 xv[4][2][2];
#pragma unroll
            for (int m = 0; m < 4; ++m) { const int row = EPI_ROW(ai, m);
                const float* xr = (layer == 0 ? (row < MPROMPT ? xp + (size_t)row * DM : xs + (size_t)(row - MPROMPT) * DM) : out + (size_t)row * DM) + col0;
#pragma unroll
                for (int bj = 0; bj < 2; ++bj)
#pragma unroll
                    for (int n = 0; n < 2; ++n) xv[m][bj][n] = *(const f32x4*)(xr + bj * HALF + n * 4); }
            EPI_FENCE;
#pragma unroll
            for (int m = 0; m < 4; ++m) { float s = 0.f;
#pragma unroll
                for (int bj = 0; bj < 2; ++bj)
#pragma unroll
                    for (int n = 0; n < 2; ++n) { const f32x4 v = xv[m][bj][n] + acc[ai][bj][m][n]; acc[ai][bj][m][n] = v; s += (v[0] * v[0] + v[1] * v[1]) + (v[2] * v[2] + v[3] * v[3]); }
                s = sum_x16(s); s = sum_x32(s);
                if (fq == 0) red[(wr * 128 + ai * 64 + m * 16 + fr) * 4 + wc] = s; }
            EPI_FENCE;
        }
        LDS_WAIT(); __builtin_amdgcn_s_barrier(); asm volatile("" ::: "memory");
        const int t_ = opaque_tid();
        if (t_ < 256) { const int wr_t = t_ >> 7, rl = t_ & 127; const f32x4 pr = *(const LAS f32x4*)(red + (wr_t * 128 + rl) * 4);
            const int row_t = u.pm * BM + (rl >> 6) * HALF + wr_t * 64 + (rl & 63);
            __hip_atomic_store((float*)(ws + WS_SSF) + (size_t)row_t * 8 + u.pn, (pr[0] + pr[1]) + (pr[2] + pr[3]), __ATOMIC_RELAXED, __HIP_MEMORY_SCOPE_AGENT); }
        asm volatile("s_waitcnt vmcnt(0)" ::: "memory");
        __syncthreads();
        if (t_ == 0) { unsigned* cnt = (unsigned*)(ws + WS_CTL) + CW_PANEL + layer * 256 + u.pm;
            __hip_atomic_fetch_add(cnt, 1u, __ATOMIC_RELAXED, __HIP_MEMORY_SCOPE_AGENT);
            unsigned sp = 0; while (__hip_atomic_load(cnt, __ATOMIC_RELAXED, __HIP_MEMORY_SCOPE_AGENT) < 8u && ++sp < (1u << 22)) __builtin_amdgcn_s_sleep(1);
            __builtin_amdgcn_fence(__ATOMIC_ACQUIRE, "agent"); asm volatile("s_waitcnt vmcnt(0)" ::: "memory"); }
        __syncthreads();
        const int t2_ = opaque_tid(), wr2 = t2_ >> 8, fr2 = t2_ & 15, colb = u.pn * 256 + ((t2_ >> 6) & 3) * 32 + 8 * ((t2_ >> 4) & 3);
        f32x4 g[2][2];
#pragma unroll
        for (int bj = 0; bj < 2; ++bj) { g[bj][0] = *(const f32x4*)(gn + colb + bj * HALF); g[bj][1] = *(const f32x4*)(gn + colb + bj * HALF + 4); }
#pragma unroll
        for (int ai = 0; ai < 2; ++ai) { f32x4 sf[4][2];
#pragma unroll
            for (int m = 0; m < 4; ++m) { const float* sp = (const float*)(ws + WS_SSF) + (size_t)(u.pm * BM + ai * HALF + wr2 * 64 + m * 16 + fr2) * 8; sf[m][0] = *(const f32x4*)sp; sf[m][1] = *(const f32x4*)(sp + 4); }
            EPI_FENCE;
#pragma unroll
            for (int m = 0; m < 4; ++m) { const int row = u.pm * BM + ai * HALF + wr2 * 64 + m * 16 + fr2; const f32x4 a = sf[m][0], b = sf[m][1];
                const float rs = 1.0f / sqrtf((((a[0] + a[1]) + (a[2] + a[3])) + ((b[0] + b[1]) + (b[2] + b[3]))) * (1.0f / DM) + EPS);
                float* orow = out + (size_t)row * DM + colb;
#pragma unroll
                for (int bj = 0; bj < 2; ++bj) {
                    const f32x4 y0 = acc[ai][bj][m][0], y1 = acc[ai][bj][m][1]; const f32x4 n0 = y0 * rs * g[bj][0], n1 = y1 * rs * g[bj][1];
                    if constexpr (LAST) { *(f32x4*)(orow + bj * HALF) = n0; *(f32x4*)(orow + bj * HALF + 4) = n1; }
                    else { *(f32x4*)(orow + bj * HALF) = y0; *(f32x4*)(orow + bj * HALF + 4) = y1;
                        v4u w; w.x = cvtpk(n0[0], n0[1]); w.y = cvtpk(n0[2], n0[3]); w.z = cvtpk(n1[0], n1[1]); w.w = cvtpk(n1[2], n1[3]);
                        *(v4u*)((bf16*)(ws + WS_XN) + (size_t)row * DM + colb + bj * HALF) = w;
                        *(u32x2*)(ws + WS_XN8 + (size_t)row * DM + colb + bj * HALF) = (u32x2){pk4_fp8(n0[0], n0[1], n0[2], n0[3]), pk4_fp8(n1[0], n1[1], n1[2], n1[3])}; } }
                EPI_FENCE; } }
    }
};
struct EpiOut {
    static constexpr bool PERM = false, AFTER_DRAIN = false;
    const float* xp; const float* xs; float* out; int layer;
    __device__ __forceinline__ void operator()(const f32x4 (&acc)[2][2][4][2], const Unit& u, int wr, int wc, int fr, int fq) const {
        const int col0 = u.pn * 256 + wc * 32 + 4 * fq;
#pragma unroll
        for (int ai = 0; ai < 2; ++ai) {
            f32x4 xv[4][2][2];
#pragma unroll
            for (int m = 0; m < 4; ++m) { const int row = EPI_ROW(ai, m);
                const float* xr = (layer == 0 ? (row < MPROMPT ? xp + (size_t)row * DM : xs + (size_t)(row - MPROMPT) * DM) : out + (size_t)row * DM) + col0;
#pragma unroll
                for (int bj = 0; bj < 2; ++bj)
#pragma unroll
                    for (int n = 0; n < 2; ++n) xv[m][bj][n] = *(const f32x4*)(xr + bj * HALF + n * 16); }
            EPI_FENCE;
#pragma unroll
            for (int m = 0; m < 4; ++m) { float* orow = out + (size_t)EPI_ROW(ai, m) * DM + col0;
#pragma unroll
                for (int bj = 0; bj < 2; ++bj)
#pragma unroll
                    for (int n = 0; n < 2; ++n) *(f32x4*)(orow + bj * HALF + n * 16) = xv[m][bj][n] + acc[ai][bj][m][n];
                EPI_FENCE; }
        }
    }
};

namespace att8 {
constexpr int NW = 8, QBLK = 32, KVBLK = 64;
constexpr float CL2 = 0.07216878364870322f * 1.4426950408889634f;
constexpr float QSC = CL2 * 8.0f;
constexpr float BIAS = 7.0f, THR = 1.5f;
constexpr int NB = 3, SZ_KN = 64 * 128, SZ_KR = 64 * 64, SZ_VT = 128 * 64;
constexpr int OFF_KN = 0, OFF_KR = OFF_KN + NB * SZ_KN, OFF_VT = OFF_KR + NB * SZ_KR, OFF_WS = OFF_VT + NB * SZ_VT, SHM_ATTN = OFF_WS + NW * 64 * 4;
typedef int v8i __attribute__((ext_vector_type(8)));
__device__ __forceinline__ int crow(int r, int hi) { return (r & 3) + 8 * (r >> 2) + 4 * hi; }
#define SBAR8() __builtin_amdgcn_sched_barrier(0)
__device__ __forceinline__ v8i ld2x16(const char* pa, const char* pb) { const v4u a = *reinterpret_cast<const v4u*>(pa), b = *reinterpret_cast<const v4u*>(pb); return (v8i){(int)a.x, (int)a.y, (int)a.z, (int)a.w, (int)b.x, (int)b.y, (int)b.z, (int)b.w}; }
#define MFMA8S(A, B, Cc) __builtin_amdgcn_mfma_scale_f32_32x32x64_f8f6f4(A, B, Cc, 0, 0, 0, 0x7C7C7C7C, 0, 0x7F7F7F7F)
#define MFMA8(A, B, Cc) __builtin_amdgcn_mfma_scale_f32_32x32x64_f8f6f4(A, B, Cc, 0, 0, 0, 0, 0, 0)

template <int VAR = 0>
__device__ __forceinline__ void attn_unit(const bf16* __restrict__ Qn, const bf16* __restrict__ Qr, const unsigned char* __restrict__ K8, const unsigned char* __restrict__ KR8,
                                          const unsigned char* __restrict__ V8T, bf16* __restrict__ Ob, int seq, const f32x2* __restrict__ rope, int qpos0, char* lds) {
  const int tid = opaque_tid(), wid = tid >> 6, lane = tid & 63, r32 = lane & 31, hi = lane >> 5;
  const int wv = __builtin_amdgcn_readfirstlane(wid);
  float* ws = (float*)(lds + OFF_WS) + wid * 64; float* li_l = ws; float* al_l = ws + 32;
  v8i qf[3];
  { const bf16* Qw = Qn + (long)(wid * QBLK + r32) * NQ;
#pragma unroll
    for (int ks = 0; ks < 2; ++ks) {
#pragma unroll
      for (int c = 0; c < 4; ++c) { const v4u raw = *reinterpret_cast<const v4u*>(Qw + 64 * ks + 32 * hi + 8 * c);
        qf[ks][2 * c] = (int)pk4_fp8(bflo(raw.x) * QSC, bfhi(raw.x) * QSC, bflo(raw.y) * QSC, bfhi(raw.y) * QSC);
        qf[ks][2 * c + 1] = (int)pk4_fp8(bflo(raw.z) * QSC, bfhi(raw.z) * QSC, bflo(raw.w) * QSC, bfhi(raw.w) * QSC); } }
    const bf16* Rw = Qr + (long)(wid * QBLK + r32) * NQ + 32 * hi;
    const f32x2* rp = rope + (qpos0 + wid * QBLK + r32) * 32 + 16 * hi;
#pragma unroll
    for (int c = 0; c < 4; ++c) { const v4u raw = *reinterpret_cast<const v4u*>(Rw + 8 * c);
      const f32x4 cs01 = *(const f32x4*)(rp + 4 * c), cs23 = *(const f32x4*)(rp + 4 * c + 2);
      float a0, a1, a2, a3, a4, a5, a6, a7;
      { const float x1 = bflo(raw.x), x2 = bfhi(raw.x); a0 = x1 * cs01[0] - x2 * cs01[1]; a1 = x2 * cs01[0] + x1 * cs01[1]; }
      { const float x1 = bflo(raw.y), x2 = bfhi(raw.y); a2 = x1 * cs01[2] - x2 * cs01[3]; a3 = x2 * cs01[2] + x1 * cs01[3]; }
      { const float x1 = bflo(raw.z), x2 = bfhi(raw.z); a4 = x1 * cs23[0] - x2 * cs23[1]; a5 = x2 * cs23[0] + x1 * cs23[1]; }
      { const float x1 = bflo(raw.w), x2 = bfhi(raw.w); a6 = x1 * cs23[2] - x2 * cs23[3]; a7 = x2 * cs23[2] + x1 * cs23[3]; }
      qf[2][2 * c] = (int)pk4_fp8(a0 * QSC, a1 * QSC, a2 * QSC, a3 * QSC); qf[2][2 * c + 1] = (int)pk4_fp8(a4 * QSC, a5 * QSC, a6 * QSC, a7 * QSC); } }
  const int dk_key = 8 * wv + (lane >> 3), dr_key = 16 * (wv & 3) + (lane >> 2), dv_d = 16 * wv + (lane >> 2);
  const unsigned char* gk = K8 + (long)dk_key * 1024 + (((lane & 7) ^ ((dk_key >> 1) & 7)) << 4);
  const unsigned char* gr = KR8 + (long)dr_key * 64 + (((lane & 3) ^ ((dr_key >> 2) & 3)) << 4);
  const unsigned char* gv = V8T + (long)dv_d * 64 + (((lane & 3) ^ ((dv_d >> 2) & 3)) << 4);
  LAS unsigned char* ldsa = (LAS unsigned char*)lds;
#define DMA8(tk, bk, tv, bv) do { if constexpr (VAR & 8) break; \
    __builtin_amdgcn_global_load_lds((const unsigned*)(gk + (long)(tk) * (KVBLK * 1024)), (LAS unsigned*)(ldsa + OFF_KN + (bk) * SZ_KN + wv * 1024), 16, 0, 0); \
    __builtin_amdgcn_global_load_lds((const unsigned*)(gr + (long)(tk) * (KVBLK * 64)), (LAS unsigned*)(ldsa + OFF_KR + (bk) * SZ_KR + (wv & 3) * 1024), 16, 0, 0); \
    __builtin_amdgcn_global_load_lds((const unsigned*)(gv + (long)(tv) * (KVBLK * 1024)), (LAS unsigned*)(ldsa + OFF_VT + (bv) * SZ_VT + wv * 1024), 16, 0, 0); } while (0)
#define TBAR8() do { if constexpr (!(VAR & 8)) asm volatile("s_waitcnt vmcnt(3)" ::: "memory"); if constexpr (VAR & 16) break; asm volatile("s_waitcnt lgkmcnt(0)" ::: "memory"); __builtin_amdgcn_s_barrier(); asm volatile("" ::: "memory"); } while (0)
  const int g8 = (r32 >> 1) & 7, g4 = (r32 >> 2) & 3;
  const int kn0 = r32 * 128 + (((2 * hi) ^ g8) << 4), kn1 = r32 * 128 + (((2 * hi + 1) ^ g8) << 4);
  const int rv0 = r32 * 64 + (((2 * hi) ^ g4) << 4), rv1 = r32 * 64 + (((2 * hi + 1) ^ g4) << 4);
  float nm = BIAS, l_reg = 0.f;
  const f32x16 zero16 = {}; f32x16 o[4] = {};
  f32x16 nmv;
  _Pragma("unroll") for (int r = 0; r < 16; ++r) nmv[r] = nm; asm volatile("" : "+v"(nmv));
  const int NT = seq / KVBLK;
#define EXPR8(P, ra, rb) do { if constexpr (VAR & 2) break; _Pragma("unroll") for (int r = (ra); r < (rb); ++r) P[r] = __builtin_amdgcn_exp2f(P[r]); } while (0)
#define QKM8(A, B, Cc) ((VAR & 1) ? ({ f32x16 t_ = Cc; asm volatile("" : "+v"(t_) : "v"(A)); t_; }) : MFMA8S(A, B, Cc))
#define PVM8(A, B, Cc) ((VAR & 4) ? ({ f32x16 t_ = Cc; asm volatile("" : "+v"(t_) : "v"(B)); t_; }) : MFMA8(A, B, Cc))
#define CVT8(P, PK, base) _Pragma("unroll") for (int q = 0; q < 4; ++q) { int w_ = __builtin_amdgcn_cvt_pk_fp8_f32(P[4 * q], P[4 * q + 1], 0, false); w_ = __builtin_amdgcn_cvt_pk_fp8_f32(P[4 * q + 2], P[4 * q + 3], w_, true); PK[(base) + q] = w_; }
#define TRIP8(KB, VB, PKIN, PKOUT, DO_PV, FIRST) do { \
    const char* kn_ = lds + OFF_KN + (KB) * SZ_KN; const char* kr_ = lds + OFF_KR + (KB) * SZ_KR; const char* vt_ = lds + OFF_VT + (VB) * SZ_VT; \
    v8i f0 = ld2x16(kn_ + kn0, kn_ + kn1), f1 = ld2x16(kn_ + (kn0 ^ 64), kn_ + (kn1 ^ 64)), f2 = ld2x16(kr_ + rv0, kr_ + rv1); SBAR8(); \
    p0 = QKM8(f0, qf[0], nmv); f0 = ld2x16(kn_ + kn0 + 4096, kn_ + kn1 + 4096); SBAR8(); \
    p0 = QKM8(f1, qf[1], p0); f1 = ld2x16(kn_ + (kn0 ^ 64) + 4096, kn_ + (kn1 ^ 64) + 4096); SBAR8(); \
    p0 = QKM8(f2, qf[2], p0); f2 = ld2x16(kr_ + rv0 + 2048, kr_ + rv1 + 2048); SBAR8(); \
    p1 = QKM8(f0, qf[0], nmv); if constexpr (DO_PV) f0 = ld2x16(vt_ + rv0, vt_ + rv1); SBAR8(); \
    float mx0 = p0[0]; _Pragma("unroll") for (int r = 1; r < 16; ++r) mx0 = fmaxf(mx0, p0[r]); \
    EXPR8(p0, 0, 4); SBAR8(); \
    p1 = QKM8(f1, qf[1], p1); if constexpr (DO_PV) f1 = ld2x16(vt_ + rv0 + 2048, vt_ + rv1 + 2048); SBAR8(); \
    EXPR8(p0, 4, 10); SBAR8(); \
    p1 = QKM8(f2, qf[2], p1); if constexpr (DO_PV) f2 = ld2x16(vt_ + rv0 + 4096, vt_ + rv1 + 4096); SBAR8(); \
    EXPR8(p0, 10, 16); SBAR8(); \
    if constexpr (DO_PV) { o[0] = PVM8(PKIN, f0, o[0]); f0 = ld2x16(vt_ + rv0 + 6144, vt_ + rv1 + 6144); } SBAR8(); \
    float mx1 = p1[0]; _Pragma("unroll") for (int r = 1; r < 16; ++r) mx1 = fmaxf(mx1, p1[r]); \
    EXPR8(p1, 0, 4); SBAR8(); \
    if constexpr (DO_PV) o[1] = PVM8(PKIN, f1, o[1]); SBAR8(); \
    EXPR8(p1, 4, 10); SBAR8(); \
    if constexpr (DO_PV) o[2] = PVM8(PKIN, f2, o[2]); SBAR8(); \
    EXPR8(p1, 10, 16); SBAR8(); \
    if constexpr (DO_PV) o[3] = PVM8(PKIN, f0, o[3]); SBAR8(); \
    f32x2 ps2 = {p0[0], p0[1]}; _Pragma("unroll") for (int r = 2; r < 16; r += 2) ps2 += (f32x2){p0[r], p0[r + 1]}; \
    if constexpr (!(FIRST)) { CVT8(p0, PKOUT, 0); } \
    float mx = fmaxf(mx0, mx1); \
    { auto rr = __builtin_amdgcn_permlane32_swap(__float_as_uint(mx), __float_as_uint(mx), false, false); mx = fmaxf(__uint_as_float(rr[0]), __uint_as_float(rr[1])); } \
    if ((FIRST) || !__all(mx <= BIAS + THR)) { \
      const float delta = (FIRST) ? (mx - BIAS) : fmaxf(mx - BIAS, 0.f); \
      const float alpha = __builtin_amdgcn_exp2f(-delta); \
      nm -= delta; l_reg *= alpha; ps2 *= alpha; \
      _Pragma("unroll") for (int r = 0; r < 16; ++r) nmv[r] = nm; asm volatile("" : "+v"(nmv)); \
      _Pragma("unroll") for (int r = 0; r < 16; ++r) { p0[r] *= alpha; p1[r] *= alpha; } \
      CVT8(p0, PKOUT, 0); \
      if constexpr (!(FIRST)) { if (hi == 0) al_l[r32] = alpha; asm volatile("s_waitcnt lgkmcnt(0)" ::: "memory"); \
        _Pragma("unroll") for (int d = 0; d < 4; ++d) _Pragma("unroll") for (int r = 0; r < 16; ++r) o[d][r] *= al_l[crow(r, hi)]; } \
    } \
    _Pragma("unroll") for (int r = 0; r < 16; r += 2) ps2 += (f32x2){p1[r], p1[r + 1]}; \
    CVT8(p1, PKOUT, 4); \
    l_reg += ps2.x + ps2.y; } while (0)
  f32x16 p0, p1; v8i pkp, pkq;
#define TCL(t) ((t) < NT ? (t) : NT - 1)
  asm volatile("s_waitcnt vmcnt(0)" ::: "memory");
  DMA8(0, 0, 0, 0); DMA8(1, 1, 0, 0);
  TBAR8();
  DMA8(2, 2, 1, 1);
  TRIP8(0, 0, pkq, pkp, false, true);
  TBAR8();
  int kb = 1, vb = 0;
  for (int j = 1; j < NT; j += 2) {
    { const int kb2 = kb == 0 ? 2 : kb - 1, vb2 = vb == 0 ? 2 : vb - 1;
      DMA8(TCL(j + 2), kb2, TCL(j + 1), vb2);
      TRIP8(kb, vb, pkp, pkq, true, false);
      TBAR8(); vb = kb; kb = kb == 2 ? 0 : kb + 1; }
    if (j + 1 < NT) {
      const int kb2 = kb == 0 ? 2 : kb - 1, vb2 = vb == 0 ? 2 : vb - 1;
      DMA8(TCL(j + 3), kb2, TCL(j + 2), vb2);
      TRIP8(kb, vb, pkq, pkp, true, false);
      TBAR8(); vb = kb; kb = kb == 2 ? 0 : kb + 1;
    }
  }
  { const char* vt_ = lds + OFF_VT + vb * SZ_VT;
    const v8i v0_ = ld2x16(vt_ + rv0, vt_ + rv1), v1_ = ld2x16(vt_ + rv0 + 2048, vt_ + rv1 + 2048), v2_ = ld2x16(vt_ + rv0 + 4096, vt_ + rv1 + 4096), v3_ = ld2x16(vt_ + rv0 + 6144, vt_ + rv1 + 6144);
    o[0] = PVM8(pkq, v0_, o[0]); o[1] = PVM8(pkq, v1_, o[1]); o[2] = PVM8(pkq, v2_, o[2]); o[3] = PVM8(pkq, v3_, o[3]); }
#undef TCL
  { auto rr = __builtin_amdgcn_permlane32_swap(__float_as_uint(l_reg), __float_as_uint(l_reg), false, false); l_reg = __uint_as_float(rr[0]) + __uint_as_float(rr[1]); }
  if (hi == 0) li_l[r32] = l_reg; asm volatile("s_waitcnt lgkmcnt(0)" ::: "memory");
  float rli[16];
#pragma unroll
  for (int r = 0; r < 16; ++r) rli[r] = __builtin_amdgcn_rcpf(li_l[crow(r, hi)]);
  bf16* Ow = Ob + (long)(wid * QBLK) * 1024;
#pragma unroll
  for (int r = 0; r < 16; ++r) { const int orow = crow(r, hi);
#pragma unroll
    for (int d0 = 0; d0 < 4; ++d0) Ow[(long)orow * 1024 + d0 * 32 + r32] = (bf16)(cvtpk(o[d0][r] * rli[r], 0.f) & 0xffffu); }
  asm volatile("s_waitcnt vmcnt(0)" ::: "memory");
  __syncthreads();
#undef DMA8
#undef TBAR8
#undef TRIP8
#undef QKM8
#undef PVM8
#undef EXPR8
#undef CVT8
}
#undef MFMA8
}

namespace ml {
constexpr int PITCH = 288, TILE = 64 * PITCH;
constexpr int OFF_Q = 0, OFF_K = 2 * TILE, OFF_V = 4 * TILE;
constexpr int PPITCH = 144, OFF_P = 6 * TILE;
constexpr int OFF_SC = OFF_P + 64 * PPITCH;
constexpr int OFF_RSP = OFF_SC + 8 * 2 * 5 * 256;
constexpr int OFF_QN = OFF_RSP + 1024;
constexpr int OFF_NBF = OFF_QN + 256;
constexpr int OFF_CH = OFF_NBF + 512;
constexpr int LDS_END = OFF_CH + 5 * 1024;
static_assert(LDS_END <= MISC_OFF, "mLSTM LDS map");
__device__ __forceinline__ int rho(int t) { return (t & ~12) | ((t & 4) << 1) | ((t & 8) >> 1); }
typedef short v4i16_t __attribute__((ext_vector_type(4)));
__device__ __forceinline__ bf16x8 trfrag(LAS const unsigned char* tile, int tbase, int c0, int lane) {
    const int g = lane >> 4, li = lane & 15;
#if ML_FAST_TR
    const int q = li >> 2, p = li & 3;
    const s16x4 lo = __builtin_bit_cast(s16x4, __builtin_amdgcn_ds_read_tr16_b64_v4i16((LAS v4i16_t*)(tile + rho(tbase + 8 * g + q) * PITCH + (c0 + 4 * p) * 2)));
    const s16x4 hi = __builtin_bit_cast(s16x4, __builtin_amdgcn_ds_read_tr16_b64_v4i16((LAS v4i16_t*)(tile + rho(tbase + 8 * g + 4 + q) * PITCH + (c0 + 4 * p) * 2)));
    return (bf16x8){lo[0], lo[1], lo[2], lo[3], hi[0], hi[1], hi[2], hi[3]};
#else
    bf16x8 r;
#pragma unroll
    for (int i = 0; i < 8; ++i) r[i] = *(LAS const short*)(tile + rho(tbase + 8 * g + i) * PITCH + (c0 + li) * 2);
    return r;
#endif
}
__device__ __forceinline__ float logsigmoid(float x) { return fminf(x, 0.f) - log1pf(expf(-fabsf(x))); }

__device__ __forceinline__ void mlstm_item(LAS unsigned char* lds, const bf16* __restrict__ QM, const bf16* __restrict__ KM, const bf16* __restrict__ VM, const float* __restrict__ KRG, const float* __restrict__ BG,
                                           float* SCR, bf16* __restrict__ H, int row0, int S, int dir, int h) {
    const int tid = opaque_tid(), lane = tid & 63, w = __builtin_amdgcn_readfirstlane(tid >> 6), g = lane >> 4, li = lane & 15;
    const int NC = S / 64, hc = h * 128;
    const int srow = tid >> 3, scol = (tid & 7) * 16;
    LAS float* sc = (LAS float*)(lds + OFF_SC) + w * 640;
    LAS float* RSP = (LAS float*)(lds + OFF_RSP); LAS float* QNl = (LAS float*)(lds + OFF_QN);
#define ML_ROW(c, t) (dir ? (row0 + S - 1 - (64 * (c) + (t))) : (row0 + 64 * (c) + (t)))
    float* scr = SCR + ((size_t)(dir * 8 + h) * MTOK + row0) * 5;
    LAS float* CHG = (LAS float*)(lds + OFF_CH); LAS float* CHU = CHG + 256; LAS float* CHM = CHG + 512; LAS float* CHAO = CHG + 768; LAS float* CHAN = CHG + 1024;
    for (int c = w; c < NC; c += 8) {
        const float* gp = KRG + (size_t)ML_ROW(c, lane) * 96 + 64;
        const float li_ = gp[dir * 8 + h] + BG[dir * 8 + h], lf = logsigmoid(gp[16 + dir * 8 + h] + BG[16 + dir * 8 + h]);
        float bsum = lf;
#pragma unroll
        for (int o = 1; o < 64; o <<= 1) { const float v = __int_as_float(__builtin_amdgcn_ds_bpermute(((lane - o) & 63) << 2, __float_as_int(bsum))); if (lane >= o) bsum += v; }
        const float uu = li_ - bsum; float pm = uu;
#pragma unroll
        for (int o = 1; o < 64; o <<= 1) { const float v = __int_as_float(__builtin_amdgcn_ds_bpermute(((lane - o) & 63) << 2, __float_as_int(pm))); if (lane >= o) pm = fmaxf(pm, v); }
        float* sp = scr + (size_t)c * 320 + lane;
        sp[0] = uu; sp[64] = pm; sp[128] = bsum;
        if (lane == 63) { CHG[c] = bsum; CHU[c] = pm; }
    }
    __syncthreads();
    if (w == 0) {
        float m = 0.f;
        for (int c = 0; c < NC; ++c) { const float gch = CHG[c], um = CHU[c]; const float m_loc = gch + um, m_new = fmaxf(gch + m, m_loc);
            if (lane == 0) { CHM[c] = m; CHAO[c] = expf(gch + m - m_new); CHAN[c] = expf(m_loc - m_new); }
            m = m_new; }
    }
    __syncthreads();
    for (int c = w; c < NC; c += 8) {
        float* sp = scr + (size_t)c * 320 + lane;
        const float uu = sp[0], pm = sp[64], bsum = sp[128]; const float mp = CHM[c], um = CHU[c], an = CHAN[c];
        const float Mj = fmaxf(mp, pm);
        sp[64] = Mj; sp[128] = expf(uu - um) * an; sp[192] = expf(mp - Mj); sp[256] = expf(-(bsum + Mj));
    }
    asm volatile("s_waitcnt vmcnt(0)" ::: "memory");
    __syncthreads();
    f32x4 X[8]; f32x4 nst = {0.f, 0.f, 0.f, 0.f};
#pragma unroll
    for (int d = 0; d < 8; ++d) X[d] = (f32x4){0.f, 0.f, 0.f, 0.f};
    v4u stq[2], stk[2], stv[2]; float scv[5];
#define ML_LOAD(c) do { const size_t go = (size_t)ML_ROW(c, srow) * 1024 + hc + scol; \
        stq[0] = *(const v4u*)(QM + go); stq[1] = *(const v4u*)(QM + go + 8); stk[0] = *(const v4u*)(KM + go); stk[1] = *(const v4u*)(KM + go + 8); \
        stv[0] = *(const v4u*)(VM + go); stv[1] = *(const v4u*)(VM + go + 8); \
        _Pragma("unroll") for (int k_ = 0; k_ < 5; ++k_) scv[k_] = __hip_atomic_load(scr + (size_t)(c) * 320 + k_ * 64 + lane, __ATOMIC_RELAXED, __HIP_MEMORY_SCOPE_AGENT); } while (0)
#define ML_WRITE(b) do { const int lo_ = rho(srow) * PITCH + scol * 2; \
        *(LAS v4u*)(lds + OFF_Q + (b) * TILE + lo_) = stq[0]; *(LAS v4u*)(lds + OFF_Q + (b) * TILE + lo_ + 16) = stq[1]; \
        *(LAS v4u*)(lds + OFF_K + (b) * TILE + lo_) = stk[0]; *(LAS v4u*)(lds + OFF_K + (b) * TILE + lo_ + 16) = stk[1]; \
        *(LAS v4u*)(lds + OFF_V + (b) * TILE + lo_) = stv[0]; *(LAS v4u*)(lds + OFF_V + (b) * TILE + lo_ + 16) = stv[1]; \
        _Pragma("unroll") for (int k_ = 0; k_ < 5; ++k_) sc[((b) * 5 + k_) * 64 + lane] = scv[k_]; } while (0)
    ML_LOAD(0); ML_WRITE(0);
    if (tid < 64) ((LAS unsigned*)(lds + OFF_NBF))[tid] = 0u;
    for (int c = 0; c < NC; ++c) {
        const int b = c & 1;
        LAS const unsigned char* Qt = lds + OFF_Q + b * TILE; LAS const unsigned char* Kt = lds + OFF_K + b * TILE; LAS const unsigned char* Vt = lds + OFF_V + b * TILE;
        LAS const float* scb = sc + b * 320;
        { const int cn = (c + 1 < NC) ? c + 1 : c; ML_LOAD(cn); }
        const float a_old = CHAO[c];
        __syncthreads();
        {
            bf16x8 ka[2][4], qb_[2][4], na[4], nq[4];
#pragma unroll
            for (int tt = 0; tt < 2; ++tt) { const int tile = w * 2 + tt, lb = tile & 3, jb = tile >> 2;
#pragma unroll
                for (int ks = 0; ks < 4; ++ks) { ka[tt][ks] = *(LAS const bf16x8*)(Kt + rho(16 * lb + li) * PITCH + (32 * ks + 8 * g) * 2);
                    qb_[tt][ks] = *(LAS const bf16x8*)(Qt + rho(16 * jb + li) * PITCH + (32 * ks + 8 * g) * 2); } }
            { LAS const unsigned char* nb = lds + OFF_NBF + b * 256;
#pragma unroll
              for (int ks = 0; ks < 4; ++ks) { na[ks] = *(LAS const bf16x8*)(nb + (32 * ks + 8 * g) * 2); if (li != 0) na[ks] = (bf16x8){0, 0, 0, 0, 0, 0, 0, 0};
                  nq[ks] = *(LAS const bf16x8*)(Qt + rho(16 * (w & 3) + li) * PITCH + (32 * ks + 8 * g) * 2); } }
#pragma unroll
            for (int tt = 0; tt < 2; ++tt) {
                const int tile = w * 2 + tt, lb = tile & 3, jb = tile >> 2;
                const int j = 16 * jb + li, l0 = 16 * lb + 4 * g;
                f32x4 s = {0.f, 0.f, 0.f, 0.f};
#pragma unroll
                for (int ks = 0; ks < 4; ++ks) s = __builtin_amdgcn_mfma_f32_16x16x32_bf16(ka[tt][ks], qb_[tt][ks], s, 0, 0, 0);
                const f32x4 u4 = *(LAS const f32x4*)(scb + l0); const float Mj = scb[64 + j];
                float p[4]; float rs = 0.f;
#pragma unroll
                for (int r = 0; r < 4; ++r) { p[r] = (l0 + r <= j) ? s[r] * __expf(u4[r] - Mj) : 0.f; rs += p[r]; }
                *(LAS u32x2*)(lds + OFF_P + j * PPITCH + l0 * 2) = (u32x2){cvtpk(p[0], p[1]), cvtpk(p[2], p[3])};
                rs = sum_x16(rs); rs = sum_x32(rs);
                if (g == 0) RSP[j * 4 + lb] = rs;
            }
            { f32x4 s = {0.f, 0.f, 0.f, 0.f};
#pragma unroll
              for (int ks = 0; ks < 4; ++ks) s = __builtin_amdgcn_mfma_f32_16x16x32_bf16(na[ks], nq[ks], s, 0, 0, 0);
              if (g == 0) QNl[16 * (w & 3) + li] = s[0]; }
        }
        f32x4 Y[4];
        {
            bf16x8 ca[4];
#pragma unroll
            for (int ks = 0; ks < 4; ++ks) { v4u t; t.x = cvtpk(X[2 * ks][0], X[2 * ks][1]); t.y = cvtpk(X[2 * ks][2], X[2 * ks][3]); t.z = cvtpk(X[2 * ks + 1][0], X[2 * ks + 1][1]); t.w = cvtpk(X[2 * ks + 1][2], X[2 * ks + 1][3]);
                ca[ks] = __builtin_bit_cast(bf16x8, t); }
#pragma unroll
            for (int tb = 0; tb < 4; ++tb) {
                LAS const unsigned char* qrow = Qt + rho(16 * tb + li) * PITCH;
                v4u qq[4];
#pragma unroll
                for (int ks = 0; ks < 4; ++ks) { const u32x2 q0 = *(LAS const u32x2*)(qrow + (32 * ks + 4 * g) * 2), q1 = *(LAS const u32x2*)(qrow + (32 * ks + 16 + 4 * g) * 2); qq[ks] = (v4u){q0.x, q0.y, q1.x, q1.y}; }
                f32x4 y = {0.f, 0.f, 0.f, 0.f};
#pragma unroll
                for (int ks = 0; ks < 4; ++ks) y = __builtin_amdgcn_mfma_f32_16x16x32_bf16(ca[ks], __builtin_bit_cast(bf16x8, qq[ks]), y, 0, 0, 0);
                Y[tb] = y;
            }
        }
        __syncthreads();
        bf16x8 vf[2];
        vf[0] = trfrag(Vt, 0, 16 * w, lane); vf[1] = trfrag(Vt, 32, 16 * w, lane);
        {
            bf16x8 pb[4][2]; f32x4 rp[4]; float wi[4], qn[4], cl[4];
#pragma unroll
            for (int tb = 0; tb < 4; ++tb) { const int t = 16 * tb + li;
                pb[tb][0] = *(LAS const bf16x8*)(lds + OFF_P + t * PPITCH + (8 * g) * 2); pb[tb][1] = *(LAS const bf16x8*)(lds + OFF_P + t * PPITCH + (32 + 8 * g) * 2);
                rp[tb] = *(LAS const f32x4*)(RSP + t * 4); wi[tb] = scb[192 + t]; qn[tb] = QNl[t]; cl[tb] = scb[256 + t]; }
#pragma unroll
            for (int tb = 0; tb < 4; ++tb) {
                const int t = 16 * tb + li;
                f32x4 y = Y[tb] * wi[tb];
                y = __builtin_amdgcn_mfma_f32_16x16x32_bf16(vf[0], pb[tb][0], y, 0, 0, 0);
                y = __builtin_amdgcn_mfma_f32_16x16x32_bf16(vf[1], pb[tb][1], y, 0, 0, 0);
                const float den = (rp[tb][0] + rp[tb][1]) + (rp[tb][2] + rp[tb][3]) + wi[tb] * qn[tb];
                const float inv = __builtin_amdgcn_rcpf(fmaxf(fabsf(den), cl[tb]));
                const u32x2 o = {cvtpk(y[0] * inv, y[1] * inv), cvtpk(y[2] * inv, y[3] * inv)};
                *(u32x2*)(H + (size_t)ML_ROW(c, t) * 1024 + hc + 16 * w + 4 * g) = o;
            }
        }
        {
            bf16x8 vw[2]; bf16x8 wb[2];
#pragma unroll
            for (int ks = 0; ks < 2; ++ks) {
                const f32x4 w0 = *(LAS const f32x4*)(scb + 128 + 32 * ks + 8 * g), w1 = *(LAS const f32x4*)(scb + 128 + 32 * ks + 8 * g + 4);
                float wv[8] = {w0[0], w0[1], w0[2], w0[3], w1[0], w1[1], w1[2], w1[3]};
                const v4u vraw = __builtin_bit_cast(v4u, vf[ks]); v4u t, tw;
#pragma unroll
                for (int e = 0; e < 4; ++e) { t[e] = cvtpk(bflo(vraw[e]) * wv[2 * e], bfhi(vraw[e]) * wv[2 * e + 1]); tw[e] = (li == 0) ? cvtpk(wv[2 * e], wv[2 * e + 1]) : 0u; }
                vw[ks] = __builtin_bit_cast(bf16x8, t); wb[ks] = __builtin_bit_cast(bf16x8, tw);
            }
            bf16x8 kf[8][2], kn[2];
#pragma unroll
            for (int d = 0; d < 8; ++d) { kf[d][0] = trfrag(Kt, 0, 16 * d, lane); kf[d][1] = trfrag(Kt, 32, 16 * d, lane); }
            kn[0] = trfrag(Kt, 0, 16 * w, lane); kn[1] = trfrag(Kt, 32, 16 * w, lane);
#pragma unroll
            for (int d = 0; d < 8; ++d) {
                f32x4 x = X[d] * a_old;
                x = __builtin_amdgcn_mfma_f32_16x16x32_bf16(kf[d][0], vw[0], x, 0, 0, 0);
                x = __builtin_amdgcn_mfma_f32_16x16x32_bf16(kf[d][1], vw[1], x, 0, 0, 0);
                X[d] = x;
            }
            nst = nst * a_old;
            nst = __builtin_amdgcn_mfma_f32_16x16x32_bf16(kn[0], wb[0], nst, 0, 0, 0);
            nst = __builtin_amdgcn_mfma_f32_16x16x32_bf16(kn[1], wb[1], nst, 0, 0, 0);
            if (li == 0) *(LAS u32x2*)(lds + OFF_NBF + (b ^ 1) * 256 + (16 * w + 4 * g) * 2) = (u32x2){cvtpk(nst[0], nst[1]), cvtpk(nst[2], nst[3])};
        }
        ML_WRITE(b ^ 1);
    }
    __syncthreads();
#undef ML_ROW
#undef ML_LOAD
#undef ML_WRITE
}
}

constexpr int Q_ML_P = 4, Q_ML_S = 16, Q_AT_P = 128, Q_AT_S = 128, QLEN = Q_ML_P + Q_ML_S + Q_AT_P + Q_AT_S;
template <int AVAR = 0>
__device__ __forceinline__ void p_mixer(Frame& F, const float* bgl, int lq, unsigned xcc, bool ml_only = false, bool att_only = false) {
    unsigned char* ws = F.ws;
    int qsel = (int)(xcc & 7u), tried = 0;
    for (;;) {
        if (F.tid == 0) {
            int item = -1, qq = qsel, tr = tried;
            while (tr < 8) {
                const unsigned idx = __hip_atomic_fetch_add(F.ctl + CW_QUEUE + (lq * 8 + qq) * 64, 1u, __ATOMIC_RELAXED, __HIP_MEMORY_SCOPE_AGENT);
                if (idx < (unsigned)QLEN) { item = qq * 1024 + (int)idx; break; }
                qq = (qq + 1) & 7; ++tr;
            }
            F.MISC[0] = (unsigned)item; F.MISC[1] = (unsigned)qq; F.MISC[2] = (unsigned)tr;
        }
        __syncthreads();
        const int item = (int)F.MISC[0]; qsel = (int)F.MISC[1]; tried = (int)F.MISC[2];
        __syncthreads();
        if (item < 0) break;
        const int h = item >> 10, i = item & 1023;
#ifndef NO_ML
        if (i < Q_ML_P + Q_ML_S) {
            if (att_only) continue;
            int row0, S, dir;
            if (i < Q_ML_P) { row0 = (i >> 1) * SEQ_P; S = SEQ_P; dir = i & 1; }
            else { const int k = i - Q_ML_P; row0 = MPROMPT + (k >> 1) * SEQ_S; S = SEQ_S; dir = k & 1; }
            ml::mlstm_item(F.lds, (const bf16*)(ws + WS_QM), (const bf16*)(ws + WS_KM), (const bf16*)(ws + WS_VM), (const float*)(ws + WS_KRG), bgl,
                           (float*)(ws + WS_SCR), (bf16*)(ws + (dir ? WS_HBW : WS_HFW)), row0, S, dir, h);
        } else
#endif
#ifndef NO_ATT
        {
            int row0, S, qb;
            if (i < Q_ML_P + Q_ML_S + Q_AT_P) { const int k = i - (Q_ML_P + Q_ML_S); row0 = (k >> 6) * SEQ_P; S = SEQ_P; qb = k & 63; }
            else { const int k = i - (Q_ML_P + Q_ML_S + Q_AT_P); row0 = MPROMPT + (k >> 4) * SEQ_S; S = SEQ_S; qb = k & 15; }
            const size_t qrow = (size_t)(row0 + 256 * qb);
            if (ml_only) continue;
            att8::attn_unit<AVAR>((const bf16*)(ws + WS_Q) + qrow * NQ + h * 128, (const bf16*)(ws + WS_Q) + qrow * NQ + 1024 + h * 64,
                            ws + WS_K8 + (size_t)row0 * 1024 + h * 128, ws + WS_KR + (size_t)row0 * 64, ws + WS_V8T + ((size_t)(row0 >> 6) * 1024 + h * 128) * 64,
                            (bf16*)(ws + WS_CQKV) + qrow * 1024 + h * 128, S, (const f32x2*)(ws + WS_ROPE), 256 * qb, (char*)F.lds);
        }
#else
        {}
#endif
    }
}


constexpr int NPH = 1 + DEPTH * 10 + 1;
__global__ void __launch_bounds__(NWAVES * 64, 2) trunk_fwd(Args args) {
    extern __shared__ __attribute__((aligned(16))) unsigned char lds[];
    Frame F;
    F.lds = (LAS unsigned char*)lds; F.MISC = (volatile LAS unsigned*)(F.lds + MISC_OFF);
    F.tid = threadIdx.x; F.lane = F.tid & 63; F.wave = __builtin_amdgcn_readfirstlane(F.tid >> 6);
    F.G = gridDim.x; { const int bx = blockIdx.x; F.vcu = (F.G % 8 == 0) ? (bx % 8) * (F.G / 8) + bx / 8 : bx; }
    F.ws = args.ws; F.ctl = (gu32*)(args.ws + WS_CTL); F.out = args.out;
    for (int u = F.tid; u < (LDS_BYTES - MISC_OFF) / 4; u += NWAVES * 64) ((LAS unsigned*)(F.lds + MISC_OFF))[u] = 0u;
    __syncthreads();
    XcdBarrier bar; bar.bar = (unsigned*)(F.ctl + CW_BAR); bar.x = xb_xcc_id(); bar.st = F.MISC + 8;
#if !MK_PER_PHASE
    bar = xcd_barrier_post((unsigned*)(F.ctl + CW_BAR), F.MISC + 8);
#endif
    const unsigned xcc = bar.x;
    const int lo = args.ph_lo, hi = args.ph_hi;
#define IN(k) (lo <= (k) && (k) < hi)
#if MK_PER_PHASE
#define SEAM(k) do { } while (0)
#else
#define SEAM(k) do { if (IN(k) && IN((k) + 1)) xcd_barrier(bar); } while (0)
#endif
    unsigned char* ws = args.ws;
    if (IN(0)) { p_prologue(F, args); }
#if MK_PER_PHASE
    SEAM(0);
#endif
    for (int layer = 0; layer < DEPTH; ++layer) {
        const int p0 = 1 + layer * 10;
        asm volatile("" : "+s"(ws));
        F.ws = ws;
        const unsigned char* wl = ws + WS_W + (size_t)layer * LW;
        if (layer == 0 || F.G != 256) { if (IN(p0 + 0)) { p_norm(F, args, layer); } SEAM(p0 + 0); }
        if (IN(p0 + 1)) {
            { pg8::Gemm g{(const pg8::bf16_t*)(ws + WS_XN8), (const pg8::bf16_t*)(wl + W_P1A), MTOK, NP1A, DM / 2, DM / 2, DM / 2, SC_ONE, SC_M6}; pg8::StaticOrder S; S.init(MTOK, NP1A, F.G, (int)blockIdx.x);
              EpiP1a E{ws, WS_CQKV}; pg8::gemm_phase<EpiP1a, pg8::StaticOrder, true, true, true, SC_ONE, SC_M6>(F.lds, g, S, E);
            }
            { pg8::Gemm g{(const pg8::bf16_t*)(ws + WS_XN), (const pg8::bf16_t*)(wl + W_P1B), MTOK, NP1B, DM, DM, DM, SC_ONE, SC_ONE}; pg8::StaticOrder S; S.init(MTOK, NP1B, F.G, (int)blockIdx.x);
              EpiP1b E{ws}; pg8::gemm_phase<EpiP1b, pg8::StaticOrder, true, true>(F.lds, g, S, E); }
        } SEAM(p0 + 1);
        if (IN(p0 + 2)) {
            { pg8::Gemm g{(const pg8::bf16_t*)(ws + WS_CQKV), (const pg8::bf16_t*)(wl + W_UQ), MTOK, NQ, 256, 512, 256, SC_ONE, SC_M5}; pg8::StaticOrder S; S.init(MTOK, NQ, F.G, (int)blockIdx.x);
              EpiQ E{ws}; pg8::gemm_phase<EpiQ, pg8::StaticOrder, true, true, true, SC_ONE, SC_M5>(F.lds, g, S, E); }
            { pg8::Gemm g{(const pg8::bf16_t*)(ws + WS_CQKV + 512), (const pg8::bf16_t*)(wl + W_UKV), MTOK, 1024, 256, 512, 256, SC_ONE, SC_M5}; pg8::StaticOrder S; S.init(MTOK, 1024, F.G, (int)blockIdx.x);
              EpiK8 E{ws}; pg8::gemm_phase<EpiK8, pg8::StaticOrder, true, true, true, SC_ONE, SC_M5>(F.lds, g, S, E); }
            { pg8::Gemm g{(const pg8::bf16_t*)(wl + W_UKV + (size_t)1024 * 512), (const pg8::bf16_t*)(ws + WS_CQKV + 512), 1024, MTOK, 256, 256, 512, SC_M5, SC_ONE}; pg8::StaticOrder S; S.init(1024, MTOK, F.G, (int)blockIdx.x);
              EpiVT E{ws}; pg8::gemm_phase<EpiVT, pg8::StaticOrder, true, true, true, SC_M5, SC_ONE>(F.lds, g, S, E); }
        } SEAM(p0 + 2);
        if (IN(p0 + 3)) { p_mixer(F, args.in[IN_B_GATES] + layer * 32, layer, xcc); }
        SEAM(p0 + 3);
        if (IN(p0 + 4)) {
            { pg8::Gemm g{(const pg8::bf16_t*)(ws + WS_XN8), (const pg8::bf16_t*)(wl + W_P2A), MTOK, NP2A, DM / 2, DM / 2, DM / 2, SC_ONE, SC_M6}; pg8::StaticOrder S; S.init(MTOK, NP2A, F.G, (int)blockIdx.x);
              EpiP2a E{ws, WS_SGA}; pg8::gemm_phase<EpiP2a, pg8::StaticOrder, true, true, true, SC_ONE, SC_M6>(F.lds, g, S, E);
            }
            { pg8::Gemm g{(const pg8::bf16_t*)(ws + WS_XN), (const pg8::bf16_t*)(wl + W_P2B), MTOK, NP2B, DM, DM, DM, SC_ONE, SC_ONE}; pg8::StaticOrder S; S.init(MTOK, NP2B, F.G, (int)blockIdx.x);
              EpiP2b E{ws, layer}; pg8::gemm_phase<EpiP2b, pg8::StaticOrder, true, true>(F.lds, g, S, E); }
        } SEAM(p0 + 4);
        if (IN(p0 + 5)) {
            pg8::Gemm g1{(const pg8::bf16_t*)(ws + WS_HFW), (const pg8::bf16_t*)(wl + W_OB), MTOK, DM, 1024, 1024, 1024, 0x7F7F7F7F, 0x7F7F7F7F};
            pg8::Gemm g2{(const pg8::bf16_t*)(ws + WS_YA8), (const pg8::bf16_t*)(wl + W_OA), MTOK, DM, 512, 512, 512, SC_M6, SC_M5};
            pg8::StaticOrder S; S.init(MTOK, DM, F.G, (int)blockIdx.x);
            MidMerge Mm{ws}; EpiMerge2 E{ws}; pg8::gemm_chain<EpiMerge2, MidMerge, pg8::StaticOrder>(F.lds, g1, g2, S, Mm, E);
        } SEAM(p0 + 5);
        if (IN(p0 + 8)) {
            pg8::Gemm g{(const pg8::bf16_t*)(ws + WS_MG), (const pg8::bf16_t*)(wl + W_OUT), MTOK, DM, DM, DM, DM, 0x7F7F7F7F, 0x7F7F7F7F}; pg8::StaticOrder S; S.init(MTOK, DM, F.G, (int)blockIdx.x);
            if (F.G == 256) { S.wgm = 4;
                if (layer + 1 == DEPTH) { EpiOutX<true> E{args.in[IN_XP], args.in[IN_XS], F.out, ws, args.in[IN_NORM_F], layer}; pg8::gemm_phase<EpiOutX<true>, pg8::StaticOrder, true, true>(F.lds, g, S, E); }
                else { EpiOutX<false> E{args.in[IN_XP], args.in[IN_XS], F.out, ws, args.in[IN_NORM_IN] + (layer + 1) * DM, layer}; pg8::gemm_phase<EpiOutX<false>, pg8::StaticOrder, true, true>(F.lds, g, S, E); }
            } else { EpiOut E{args.in[IN_XP], args.in[IN_XS], F.out, layer}; pg8::gemm_phase<EpiOut, pg8::StaticOrder, true, true>(F.lds, g, S, E); }
        } if (layer + 1 < DEPTH || F.G != 256) SEAM(p0 + 8);
    }
    if (IN(NPH - 1) && F.G != 256) { p_final(F, args); }
#undef IN
#undef SEAM
}

extern "C" void kernel_launch(void* const* d_in, const int* in_sizes, int n_in, void* d_out, int out_size, void* d_ws, size_t ws_size, hipStream_t stream) {
    static int grid = 0;
    if (grid == 0) {
        if (n_in != 14 || in_sizes[0] != MPROMPT * DM || in_sizes[1] != MPROMPT * DM || out_size != MTOK * DM || ws_size < WS_END) {
            fprintf(stderr, "kernel_launch: shape mismatch (n_in %d, in0 %d, out %d, ws %zu, need %zu); nothing launched\n", n_in, n_in > 0 ? in_sizes[0] : -1, out_size, ws_size, (size_t)WS_END); grid = -1; return; }
        int dev = 0, cus = 0, per_cu = 0;
        if (hipGetDevice(&dev) != hipSuccess || hipDeviceGetAttribute(&cus, hipDeviceAttributeMultiprocessorCount, dev) != hipSuccess) { grid = -1; return; }
        if (hipFuncSetAttribute((const void*)trunk_fwd, hipFuncAttributeMaxDynamicSharedMemorySize, LDS_BYTES) != hipSuccess) { fprintf(stderr, "kernel_launch: hipFuncSetAttribute failed\n"); grid = -1; return; }
        if (hipOccupancyMaxActiveBlocksPerMultiprocessor(&per_cu, (const void*)trunk_fwd, NWAVES * 64, LDS_BYTES) != hipSuccess || per_cu < 1)
            fprintf(stderr, "kernel_launch: note: occupancy query reports %d workgroups per CU\n", per_cu);
        (void)hipGetLastError();
        grid = cus;
    }
    if (grid < 0) return;
    if (hipMemsetAsync((char*)d_ws + WS_CTL, 0, CTL_ZERO_BYTES, stream) != hipSuccess) return;
    Args a{};
    for (int i = 0; i < 14; ++i) a.in[i] = (const float*)d_in[i];
    a.out = (float*)d_out; a.ws = (unsigned char*)d_ws;
#if MK_PER_PHASE
    for (int p = 0; p < NPH; ++p) {
        if (p >= 1 && p < NPH - 1 && (((p - 1) % 10) == 9 || ((p - 1) % 10) == 6)) continue;
        a.ph_lo = p; a.ph_hi = p + 1;
        hipLaunchKernelGGL(trunk_fwd, dim3(grid), dim3(NWAVES * 64), LDS_BYTES, stream, a);
    }
#else
    a.ph_lo = 0; a.ph_hi = NPH;
    hipLaunchKernelGGL(trunk_fwd, dim3(grid), dim3(NWAVES * 64), LDS_BYTES, stream, a);
#endif
    const hipError_t le = hipPeekAtLastError();
    if (le != hipSuccess) fprintf(stderr, "kernel_launch: launch failed: %s\n", hipGetErrorName(le));
}
```

```cpp
#include <hip/hip_runtime.h>
#include <hip/hip_bf16.h>
#include <cstdio>
#include <cstdint>

#ifndef MK_PER_PHASE
#define MK_PER_PHASE 0
#endif
#ifndef ML_FAST_TR
#define ML_FAST_TR 1
#endif

namespace pg8 {
#define PG8_LAS __attribute__((address_space(3)))
typedef unsigned short bf16_t;
typedef short bf16x8 __attribute__((ext_vector_type(8)));
typedef float f32x4 __attribute__((ext_vector_type(4)));
typedef unsigned u32x4 __attribute__((ext_vector_type(4)));
constexpr int BM = 256, BK = 64, HALF = 128, HTB = HALF * BK * 2  , STAGE_BYTES = 8 * HTB, NXCD = 8, WGM = 8;

__host__ __device__ __forceinline__ int lds_byte(int r, int c) { const int st = (r >> 4) * 2 + (c >> 5), rr = r & 15, cc = c & 31, ob = rr * 64 + cc * 2; return st * 1024 + (ob ^ (((ob >> 9) & 1) << 5)); }
__host__ __device__ __forceinline__ void stage_rc(int b, int& R, int& C) { const int st = b / 1024, sb = b % 1024, swz = sb ^ (((sb >> 9) & 1) << 5); R = (st >> 1) * 16 + swz / 64; C = (st & 1) * 32 + (swz % 64) / 2; }
__host__ __device__ __forceinline__ int perm32(int rho) { const int n = rho >> 4, i = rho & 15; return 8 * (i >> 2) + 4 * n + (i & 3); }

__device__ __forceinline__ int fresh_tid() { int l; asm volatile("v_mbcnt_lo_u32_b32 %0, -1, 0\n\tv_mbcnt_hi_u32_b32 %0, -1, %0" : "=v"(l)); return (__builtin_amdgcn_readfirstlane((int)threadIdx.x >> 6) << 6) | l; }
struct Unit { int pm, pn; };
struct Gemm { const bf16_t* A; const bf16_t* Bt; int M, N, K, lda, ldb; int scA, scB; };
typedef int pg8_v4i __attribute__((ext_vector_type(4)));
typedef int pg8_v8i __attribute__((ext_vector_type(8)));
__device__ __forceinline__ pg8_v8i ld_frag8(const PG8_LAS unsigned char* p) {
    const bf16x8 lo = *(const PG8_LAS bf16x8*)p, hi = *(const PG8_LAS bf16x8*)(p + 16);
    return __builtin_bit_cast(pg8_v8i, __builtin_shufflevector(lo, hi, 0, 1, 2, 3, 4, 5, 6, 7, 8, 9, 10, 11, 12, 13, 14, 15)); }

struct StaticOrder {
    int nM, nN, nwg, G, c, wgm;
    __host__ __device__ void init(int M, int N, int G_, int c_) { nM = M / BM; nN = N / BM; nwg = nM * nN; G = G_; c = c_; wgm = WGM; }
    __host__ __device__ bool next(int i, Unit& u) const {
        const long L = (long)i * G + c; if (L >= nwg) return false;
        int wgid = (int)L; { const int q = nwg / NXCD, r = nwg % NXCD, xcd = wgid % NXCD, off = wgid / NXCD; wgid = (xcd < r ? xcd * (q + 1) : r * (q + 1) + (xcd - r) * q) + off; }
        const int nig = wgm * nN, gid = wgid / nig, fm = gid * wgm, gsz = (nM - fm) < wgm ? (nM - fm) : wgm;
        u.pm = fm + ((wgid % nig) % gsz); u.pn = (wgid % nig) / gsz; return true;
    }
    __device__ __forceinline__ void a_ready(const Unit&) const {}
    __device__ __forceinline__ void done(const Unit&) const {}
};

typedef float cvt_f32x2 __attribute__((ext_vector_type(2))); typedef __bf16 cvt_bf16x2 __attribute__((ext_vector_type(2)));
__device__ __forceinline__ unsigned cvt_pk_bf16(float lo, float hi) { return __builtin_bit_cast(unsigned, __builtin_convertvector((cvt_f32x2){lo, hi}, cvt_bf16x2)); }
typedef float f32x2 __attribute__((ext_vector_type(2)));
template <class Epi, class Sched, bool ALIGN_EPI = false, bool SP2 = false, bool FP8 = false, int SCA = 0x7F7F7F7F, int SCB = 0x7F7F7F7F>
__device__ __forceinline__ void gemm_phase(PG8_LAS unsigned char* lds, const Gemm g, const Sched& S, const Epi& E) {
    const int tid = fresh_tid();
    const int wid = __builtin_amdgcn_readfirstlane(tid >> 6), lane = tid & 63, wr = wid >> 2, wc = wid & 3, fr = lane & 15, fq = lane >> 4;
    const int K = g.K, nt = K / BK;
    unsigned voffA[2], voffB[2];
    { int R, C; stage_rc(tid * 16, R, C); const int Rb = Epi::PERM == 2 ? (64 * (R >> 5) + 16 * ((R & 15) >> 2) + 4 * ((R >> 4) & 1) + (R & 3)) : Epi::PERM ? ((R & ~31) + perm32(R & 31)) : R;
        voffA[0] = (unsigned)(R * g.lda + C) * 2u; voffB[0] = (unsigned)(Rb * g.ldb + C) * 2u; voffA[1] = voffA[0] + (unsigned)(64 * g.lda) * 2u; voffB[1] = voffB[0] + (unsigned)((Epi::PERM == 2 ? 128 : 64) * g.ldb) * 2u; }
    const size_t kstep = (size_t)(BK * 2);
    const size_t hstepA = (size_t)HALF * g.lda * 2, hstepB = (size_t)(Epi::PERM == 2 ? 8 : HALF) * g.ldb * 2;
    const size_t tstepA = 2 * hstepA, tstepB = (size_t)BM * g.ldb * 2;
    const unsigned ldsw = (unsigned)wid * 1024u;
    const int aoff = lds_byte(wr * 64 + fr, FP8 ? fq * 16 : fq * 8), boff = lds_byte(wc * 32 + fr, FP8 ? fq * 16 : fq * 8);
#define PG8_SA(b, h) (((b) * 2 + (h)) * HTB)
#define PG8_SB(b, h) ((4 + (b) * 2 + (h)) * HTB)
#define PG8_STAGE(bufoff, gbase, voff) do { _Pragma("unroll") for (int _i = 0; _i < 2; ++_i) \
        __builtin_amdgcn_global_load_lds((const unsigned*)((const char*)(gbase) + (voff)[_i]), (PG8_LAS unsigned*)(lds + (bufoff) + ldsw + _i * 8192), 16, 0, 0); } while (0)
#define PG8_LDA(dst, b, h) do { if constexpr (FP8) { _Pragma("unroll") for (int m = 0; m < 4; ++m) dst##8[m] = ld_frag8(lds + PG8_SA(b, h) + aoff + m * 2048); } \
        else { _Pragma("unroll") for (int m = 0; m < 4; ++m) _Pragma("unroll") for (int k = 0; k < 2; ++k) dst[m][k] = *(const PG8_LAS bf16x8*)(lds + PG8_SA(b, h) + aoff + m * 2048 + k * 1024); } } while (0)
#define PG8_LDB(dst, b, h) do { if constexpr (FP8) { _Pragma("unroll") for (int n = 0; n < 2; ++n) dst##8[n] = ld_frag8(lds + PG8_SB(b, h) + boff + n * 2048); } \
        else { _Pragma("unroll") for (int n = 0; n < 2; ++n) _Pragma("unroll") for (int k = 0; k < 2; ++k) dst[n][k] = *(const PG8_LAS bf16x8*)(lds + PG8_SB(b, h) + boff + n * 2048 + k * 1024); } } while (0)
#define PG8_CAT8(x) __builtin_shufflevector(__builtin_bit_cast(pg8_v4i, (x)[0]), __builtin_bit_cast(pg8_v4i, (x)[1]), 0, 1, 2, 3, 4, 5, 6, 7)
#define PG8_MMA(ai, bj, At, Bt) do { __builtin_amdgcn_s_setprio(1); _Pragma("unroll") for (int m = 0; m < 4; ++m) _Pragma("unroll") for (int n = 0; n < 2; ++n) { \
        if constexpr (FP8) asm volatile("v_mfma_f32_16x16x128_f8f6f4 %0, %1, %2, %0" : "+v"(acc[ai][bj][m][n]) : "v"(Bt##8[n]), "v"(At##8[m]));     \
        else { _Pragma("unroll") for (int k = 0; k < 2; ++k) acc[ai][bj][m][n] = __builtin_amdgcn_mfma_f32_16x16x32_bf16(Bt[n][k], At[m][k], acc[ai][bj][m][n], 0, 0, 0); } } __builtin_amdgcn_s_setprio(0); } while (0)
#define PG8_WAIT_V(n) asm volatile("s_waitcnt vmcnt(" #n ")" ::: "memory")
#define PG8_WAIT_L(n) asm volatile("s_waitcnt lgkmcnt(" #n ")" ::: "memory")
#define PG8_BAR __builtin_amdgcn_s_barrier()
#define PG8_SCHED __builtin_amdgcn_sched_barrier(0)
    Unit cur, nxt; int ui = 0;
    if (!S.next(0, cur)) return;
    f32x4 acc[2][2][4][2];
#pragma unroll
    for (int a = 0; a < 2; ++a)
#pragma unroll
        for (int b = 0; b < 2; ++b)
#pragma unroll
            for (int m = 0; m < 4; ++m)
#pragma unroll
                for (int n = 0; n < 2; ++n) acc[a][b][m][n] = (f32x4){0.f, 0.f, 0.f, 0.f};
    bf16x8 At[4][2], B0[2][2], B1[2][2]; pg8_v8i At8[4], B08[2], B18[2];
    const char* cA = (const char*)g.A + (size_t)cur.pm * tstepA; const char* cB = (const char*)g.Bt + (size_t)cur.pn * tstepB;
    S.a_ready(cur);
    if constexpr (SP2) {
        PG8_STAGE(PG8_SB(0, 0), cB, voffB); PG8_STAGE(PG8_SB(0, 1), cB + hstepB, voffB); PG8_STAGE(PG8_SA(0, 0), cA, voffA); PG8_STAGE(PG8_SA(0, 1), cA + hstepA, voffA);
        if (wr == 1) PG8_BAR;
        PG8_WAIT_V(2); PG8_BAR;
        PG8_STAGE(PG8_SB(1, 0), cB + kstep, voffB); PG8_STAGE(PG8_SA(1, 0), cA + kstep, voffA); PG8_STAGE(PG8_SB(1, 1), cB + hstepB + kstep, voffB);
        PG8_WAIT_V(6); PG8_BAR;
    } else {
        PG8_STAGE(PG8_SB(0, 0), cB, voffB); PG8_STAGE(PG8_SA(0, 0), cA, voffA); PG8_STAGE(PG8_SB(0, 1), cB + hstepB, voffB); PG8_STAGE(PG8_SA(0, 1), cA + hstepA, voffA);
        if (wr == 1) PG8_BAR;
        PG8_WAIT_V(4); PG8_BAR;
        PG8_STAGE(PG8_SB(1, 0), cB + kstep, voffB); PG8_STAGE(PG8_SA(1, 0), cA + kstep, voffA); PG8_STAGE(PG8_SB(1, 1), cB + hstepB + kstep, voffB);
        PG8_WAIT_V(6); PG8_BAR;
    }
    for (;;) {
        const bool has_next = S.next(ui + 1, nxt);
        const char* nA = has_next ? (const char*)g.A + (size_t)nxt.pm * tstepA : cA; const char* nB = has_next ? (const char*)g.Bt + (size_t)nxt.pn * tstepB : cB;
        _Pragma("nounroll") for (int t = 0; t < nt; t += 2) {
            const bool last = (t == nt - 2);
            const char* a1 = cA + (size_t)(t + 1) * kstep;
            const char* a2 = last ? nA : cA + (size_t)(t + 2) * kstep; const char* b2 = last ? nB : cB + (size_t)(t + 2) * kstep;
            const char* a3 = a2 + kstep; const char* b3 = b2 + kstep;
            if (last && has_next) S.a_ready(nxt);
            if constexpr (SP2) {
            PG8_LDB(B0, 0, 0); PG8_LDB(B1, 0, 1); PG8_SCHED; PG8_LDA(At, 0, 0); PG8_STAGE(PG8_SA(1, 1), a1 + hstepA, voffA);
            PG8_WAIT_V(8); PG8_WAIT_L(0); PG8_BAR; PG8_MMA(0, 0, At, B0); PG8_MMA(0, 1, At, B1); PG8_BAR; PG8_SCHED;
            PG8_LDA(At, 0, 1); PG8_STAGE(PG8_SB(0, 0), b2, voffB); PG8_STAGE(PG8_SB(0, 1), b2 + hstepB, voffB); PG8_STAGE(PG8_SA(0, 0), a2, voffA);
            PG8_WAIT_V(8); PG8_WAIT_L(0); PG8_BAR; PG8_MMA(1, 0, At, B0); PG8_MMA(1, 1, At, B1); PG8_BAR; PG8_SCHED;
            PG8_LDB(B0, 1, 0); PG8_LDB(B1, 1, 1); PG8_SCHED; PG8_LDA(At, 1, 0); PG8_STAGE(PG8_SA(0, 1), a2 + hstepA, voffA);
            PG8_WAIT_V(8); PG8_WAIT_L(0); PG8_BAR; PG8_MMA(0, 0, At, B0); PG8_MMA(0, 1, At, B1); PG8_BAR; PG8_SCHED;
            PG8_LDA(At, 1, 1); PG8_STAGE(PG8_SB(1, 0), b3, voffB); PG8_STAGE(PG8_SB(1, 1), b3 + hstepB, voffB); PG8_STAGE(PG8_SA(1, 0), a3, voffA);
            PG8_WAIT_V(8); PG8_WAIT_L(0); PG8_BAR; PG8_MMA(1, 0, At, B0); PG8_MMA(1, 1, At, B1); PG8_BAR; PG8_SCHED;
            } else {
            PG8_LDB(B0, 0, 0); PG8_SCHED; PG8_LDA(At, 0, 0); PG8_STAGE(PG8_SA(1, 1), a1 + hstepA, voffA);
            PG8_WAIT_L(8); PG8_BAR; PG8_WAIT_L(0); PG8_MMA(0, 0, At, B0); PG8_BAR; PG8_SCHED;
            PG8_LDB(B1, 0, 1); PG8_STAGE(PG8_SB(0, 0), b2, voffB);
            PG8_BAR; PG8_WAIT_L(0); PG8_MMA(0, 1, At, B1); PG8_BAR;
            PG8_LDA(At, 0, 1); PG8_STAGE(PG8_SA(0, 0), a2, voffA);
            PG8_BAR; PG8_WAIT_L(0); PG8_MMA(1, 0, At, B0); PG8_BAR; PG8_SCHED;
            PG8_STAGE(PG8_SB(0, 1), b2 + hstepB, voffB);
            PG8_WAIT_V(6); PG8_BAR; PG8_MMA(1, 1, At, B1); PG8_BAR;
            PG8_LDB(B0, 1, 0); PG8_SCHED; PG8_LDA(At, 1, 0); PG8_STAGE(PG8_SA(0, 1), a2 + hstepA, voffA);
            PG8_WAIT_L(8); PG8_BAR; PG8_WAIT_L(0); PG8_MMA(0, 0, At, B0); PG8_BAR; PG8_SCHED;
            PG8_LDB(B1, 1, 1); PG8_STAGE(PG8_SB(1, 0), b3, voffB);
            PG8_BAR; PG8_WAIT_L(0); PG8_MMA(0, 1, At, B1); PG8_BAR;
            PG8_LDA(At, 1, 1); PG8_STAGE(PG8_SA(1, 0), a3, voffA);
            PG8_BAR; PG8_WAIT_L(0); PG8_MMA(1, 0, At, B0); PG8_BAR; PG8_SCHED;
            PG8_STAGE(PG8_SB(1, 1), b3 + hstepB, voffB);
            PG8_WAIT_V(6); PG8_BAR; PG8_MMA(1, 1, At, B1); PG8_BAR;
            }
        }
        if constexpr (FP8) asm volatile("s_nop 15\n\ts_nop 15" ::: "memory");
        if constexpr (ALIGN_EPI) { if (wr == 0) PG8_BAR; }
        if constexpr (!Epi::AFTER_DRAIN) { const int t2 = fresh_tid();
            E(acc, cur, t2 >> 8, (t2 >> 6) & 3, t2 & 15, (t2 >> 4) & 3); S.done(cur); }
        if (!has_next) break;
#pragma unroll
        for (int a = 0; a < 2; ++a)
#pragma unroll
            for (int b = 0; b < 2; ++b)
#pragma unroll
                for (int m = 0; m < 4; ++m)
#pragma unroll
                    for (int n = 0; n < 2; ++n) acc[a][b][m][n] = (f32x4){0.f, 0.f, 0.f, 0.f};
        cur = nxt; cA = nA; cB = nB; ++ui;
        if constexpr (ALIGN_EPI) { if (wr == 1) PG8_BAR; }
    }
    PG8_WAIT_V(0);
    if constexpr (!ALIGN_EPI) { if (wr == 0) PG8_BAR; }
    PG8_BAR;
    if constexpr (Epi::AFTER_DRAIN) { E.fused(acc, cur, wr, wc, fr, fq, lds, wid, lane); S.done(cur); }
#undef PG8_SA
#undef PG8_SB
#undef PG8_STAGE
#undef PG8_LDA
#undef PG8_LDB
#undef PG8_MMA
#undef PG8_CAT8
#undef PG8_WAIT_V
#undef PG8_WAIT_L
#undef PG8_BAR
#undef PG8_SCHED
}

template <class Epi, class Mid, class Sched>
__device__ __forceinline__ void gemm_chain(PG8_LAS unsigned char* lds, const Gemm g1, const Gemm g2, const Sched& S, const Mid& M, const Epi& E) {
    const int tid = fresh_tid();
    const int wid = __builtin_amdgcn_readfirstlane(tid >> 6), lane = tid & 63, wr = wid >> 2, wc = wid & 3, fr = lane & 15, fq = lane >> 4;
    const int nt1 = g1.K / BK, nt2 = g2.K / BK;
    const size_t kstep = (size_t)(BK * 2);
    const size_t hA1 = (size_t)HALF * g1.lda * 2, hB1 = (size_t)HALF * g1.ldb * 2, hA2 = (size_t)HALF * g2.lda * 2, hB2 = (size_t)HALF * g2.ldb * 2;
    const unsigned ldsw = (unsigned)wid * 1024u;
#define PC_OFFS(F8, LDA_, LDB_) const int t3_ = fresh_tid(); unsigned VA[2], VB[2]; \
        { int R, C; stage_rc(t3_ * 16, R, C); const int Rb = Epi::PERM ? ((R & ~31) + perm32(R & 31)) : R; \
          VA[0] = (unsigned)(R * (LDA_) + C) * 2u; VB[0] = (unsigned)(Rb * (LDB_) + C) * 2u; VA[1] = VA[0] + (unsigned)(64 * (LDA_)) * 2u; VB[1] = VB[0] + (unsigned)(64 * (LDB_)) * 2u; } \
        const int aoff = lds_byte((t3_ >> 8) * 64 + (t3_ & 15), ((t3_ >> 4) & 3) * ((F8) ? 16 : 8)), boff = lds_byte(((t3_ >> 6) & 3) * 32 + (t3_ & 15), ((t3_ >> 4) & 3) * ((F8) ? 16 : 8));
#define PC_SA(b, h) (((b) * 2 + (h)) * HTB)
#define PC_SB(b, h) ((4 + (b) * 2 + (h)) * HTB)
#define PC_STAGE(bufoff, gbase, v0, v1) do { \
        __builtin_amdgcn_global_load_lds((const unsigned*)((const char*)(gbase) + (v0)), (PG8_LAS unsigned*)(lds + (bufoff) + ldsw), 16, 0, 0); \
        __builtin_amdgcn_global_load_lds((const unsigned*)((const char*)(gbase) + (v1)), (PG8_LAS unsigned*)(lds + (bufoff) + ldsw + 8192), 16, 0, 0); } while (0)
#define PC_LDA(F8, b, h) do { if constexpr (F8) { _Pragma("unroll") for (int m = 0; m < 4; ++m) At8[m] = ld_frag8(lds + PC_SA(b, h) + aoff + m * 2048); } \
        else { _Pragma("unroll") for (int m = 0; m < 4; ++m) _Pragma("unroll") for (int k = 0; k < 2; ++k) At[m][k] = *(const PG8_LAS bf16x8*)(lds + PC_SA(b, h) + aoff + m * 2048 + k * 1024); } } while (0)
#define PC_LDB(F8, W, b, h) do { if constexpr (F8) { _Pragma("unroll") for (int n = 0; n < 2; ++n) B##W##8[n] = ld_frag8(lds + PC_SB(b, h) + boff + n * 2048); } \
        else { _Pragma("unroll") for (int n = 0; n < 2; ++n) _Pragma("unroll") for (int k = 0; k < 2; ++k) B##W[n][k] = *(const PG8_LAS bf16x8*)(lds + PC_SB(b, h) + boff + n * 2048 + k * 1024); } } while (0)
#define PC_MMA(F8, ai, bj, W) do { __builtin_amdgcn_s_setprio(1); _Pragma("unroll") for (int m = 0; m < 4; ++m) _Pragma("unroll") for (int n = 0; n < 2; ++n) { \
        if constexpr (F8) asm volatile("v_mfma_f32_16x16x128_f8f6f4 %0, %1, %2, %0" : "+v"(acc[ai][bj][m][n]) : "v"(B##W##8[n]), "v"(At8[m])); \
        else { _Pragma("unroll") for (int k = 0; k < 2; ++k) acc[ai][bj][m][n] = __builtin_amdgcn_mfma_f32_16x16x32_bf16(B##W[n][k], At[m][k], acc[ai][bj][m][n], 0, 0, 0); } } __builtin_amdgcn_s_setprio(0); } while (0)
#define PC_WAIT_V(n) asm volatile("s_waitcnt vmcnt(" #n ")" ::: "memory")
#define PC_WAIT_L(n) asm volatile("s_waitcnt lgkmcnt(" #n ")" ::: "memory")
#define PC_BAR __builtin_amdgcn_s_barrier()
#define PC_SCHED __builtin_amdgcn_sched_barrier(0)
#define PC_KLOOP(F8, cA_, cB_, nt_, LDA_, LDB_, HA, HB, nA_, nB_, NLDA_, NLDB_, NHA, NHB) { PC_OFFS(F8, LDA_, LDB_) \
        _Pragma("nounroll") for (int t = 0; t < (nt_); t += 2) { \
            const bool last = (t == (nt_) - 2); \
            const char* a1 = (cA_) + (size_t)(t + 1) * kstep; \
            const char* a2 = last ? (nA_) : (cA_) + (size_t)(t + 2) * kstep; const char* b2 = last ? (nB_) : (cB_) + (size_t)(t + 2) * kstep; \
            const char* a3 = a2 + kstep; const char* b3 = b2 + kstep; \
            unsigned sa0 = VA[0], sa1 = VA[1], sb0 = VB[0], sb1 = VB[1]; const size_t sha = last ? (NHA) : (HA), shb = last ? (NHB) : (HB); \
            if (last) { int R, C; stage_rc(t3_ * 16, R, C); const int Rb = Epi::PERM ? ((R & ~31) + perm32(R & 31)) : R; \
                sa0 = (unsigned)(R * (NLDA_) + C) * 2u; sb0 = (unsigned)(Rb * (NLDB_) + C) * 2u; sa1 = sa0 + (unsigned)(64 * (NLDA_)) * 2u; sb1 = sb0 + (unsigned)(64 * (NLDB_)) * 2u; } \
            PC_LDB(F8, 0, 0, 0); PC_LDB(F8, 1, 0, 1); PC_SCHED; PC_LDA(F8, 0, 0); PC_STAGE(PC_SA(1, 1), a1 + (HA), VA[0], VA[1]); \
            PC_WAIT_V(8); PC_WAIT_L(0); PC_BAR; PC_MMA(F8, 0, 0, 0); PC_MMA(F8, 0, 1, 1); PC_BAR; PC_SCHED; \
            PC_LDA(F8, 0, 1); PC_STAGE(PC_SB(0, 0), b2, sb0, sb1); PC_STAGE(PC_SB(0, 1), b2 + shb, sb0, sb1); PC_STAGE(PC_SA(0, 0), a2, sa0, sa1); \
            PC_WAIT_V(8); PC_WAIT_L(0); PC_BAR; PC_MMA(F8, 1, 0, 0); PC_MMA(F8, 1, 1, 1); PC_BAR; PC_SCHED; \
            PC_LDB(F8, 0, 1, 0); PC_LDB(F8, 1, 1, 1); PC_SCHED; PC_LDA(F8, 1, 0); PC_STAGE(PC_SA(0, 1), a2 + sha, sa0, sa1); \
            PC_WAIT_V(8); PC_WAIT_L(0); PC_BAR; PC_MMA(F8, 0, 0, 0); PC_MMA(F8, 0, 1, 1); PC_BAR; PC_SCHED; \
            PC_LDA(F8, 1, 1); PC_STAGE(PC_SB(1, 0), b3, sb0, sb1); PC_STAGE(PC_SB(1, 1), b3 + shb, sb0, sb1); PC_STAGE(PC_SA(1, 0), a3, sa0, sa1); \
            PC_WAIT_V(8); PC_WAIT_L(0); PC_BAR; PC_MMA(F8, 1, 0, 0); PC_MMA(F8, 1, 1, 1); PC_BAR; PC_SCHED; \
        } }
    Unit cur, nxt; int ui = 0;
    if (!S.next(0, cur)) return;
    f32x4 acc[2][2][4][2];
#pragma unroll
    for (int a = 0; a < 2; ++a)
#pragma unroll
        for (int b = 0; b < 2; ++b)
#pragma unroll
            for (int m = 0; m < 4; ++m)
#pragma unroll
                for (int n = 0; n < 2; ++n) acc[a][b][m][n] = (f32x4){0.f, 0.f, 0.f, 0.f};
    bf16x8 At[4][2], B0[2][2], B1[2][2]; pg8_v8i At8[4], B08[2], B18[2];
    const char* c1A = (const char*)g1.A + (size_t)cur.pm * 2 * hA1; const char* c1B = (const char*)g1.Bt + (size_t)cur.pn * 2 * hB1;
    { PC_OFFS(false, g1.lda, g1.ldb) (void)aoff; (void)boff;
    PC_STAGE(PC_SB(0, 0), c1B, VB[0], VB[1]); PC_STAGE(PC_SB(0, 1), c1B + hB1, VB[0], VB[1]); PC_STAGE(PC_SA(0, 0), c1A, VA[0], VA[1]); PC_STAGE(PC_SA(0, 1), c1A + hA1, VA[0], VA[1]);
    if (wr == 1) PC_BAR;
    PC_WAIT_V(2); PC_BAR;
    PC_STAGE(PC_SB(1, 0), c1B + kstep, VB[0], VB[1]); PC_STAGE(PC_SA(1, 0), c1A + kstep, VA[0], VA[1]); PC_STAGE(PC_SB(1, 1), c1B + hB1 + kstep, VB[0], VB[1]);
    PC_WAIT_V(6); PC_BAR; }
    for (;;) {
        const bool has_next = S.next(ui + 1, nxt);
        const char* c2A = (const char*)g2.A + (size_t)cur.pm * 2 * hA2; const char* c2B = (const char*)g2.Bt + (size_t)cur.pn * 2 * hB2;
        const char* n1A = has_next ? (const char*)g1.A + (size_t)nxt.pm * 2 * hA1 : c1A; const char* n1B = has_next ? (const char*)g1.Bt + (size_t)nxt.pn * 2 * hB1 : c1B;
        PC_KLOOP(false, c1A, c1B, nt1, g1.lda, g1.ldb, hA1, hB1, c2A, c2B, g2.lda, g2.ldb, hA2, hB2)
        { const int t2 = fresh_tid(); M(acc, cur, t2 >> 8, (t2 >> 6) & 3, t2 & 15, (t2 >> 4) & 3); }
        PC_KLOOP(true, c2A, c2B, nt2, g2.lda, g2.ldb, hA2, hB2, n1A, n1B, g1.lda, g1.ldb, hA1, hB1)
        asm volatile("s_nop 15\n\ts_nop 15" ::: "memory");
        if (wr == 0) PC_BAR;
        { const int t2 = fresh_tid(); E(acc, cur, t2 >> 8, (t2 >> 6) & 3, t2 & 15, (t2 >> 4) & 3); }
        if (!has_next) break;
#pragma unroll
        for (int a = 0; a < 2; ++a)
#pragma unroll
            for (int b = 0; b < 2; ++b)
#pragma unroll
                for (int m = 0; m < 4; ++m)
#pragma unroll
                    for (int n = 0; n < 2; ++n) acc[a][b][m][n] = (f32x4){0.f, 0.f, 0.f, 0.f};
        cur = nxt; c1A = n1A; c1B = n1B; ++ui;
        if (wr == 1) PC_BAR;
    }
    PC_WAIT_V(0);
    PC_BAR;
#undef PC_SA
#undef PC_SB
#undef PC_STAGE
#undef PC_LDA
#undef PC_LDB
#undef PC_MMA
#undef PC_WAIT_V
#undef PC_WAIT_L
#undef PC_BAR
#undef PC_SCHED
#undef PC_KLOOP
#undef PC_OFFS
}
}

constexpr int DM = 2048, DEPTH = 2;
constexpr int MTOK = 65536, MPROMPT = 32768, SEQ_P = 16384, SEQ_S = 4096;
constexpr int IN_COLS = 11360;
constexpr int NP1 = 4352, NP2 = 7168, NQ = 1536, NKV = 2048;
constexpr int SRC_CQ = 0, SRC_CKV = 512, SRC_KROPE = 1024, SRC_ZA = 1088, SRC_QM = 2112, SRC_KM = 3136, SRC_VM = 4160, SRC_OM = 5184, SRC_ZM = 6208, SRC_GATES = 7232, SRC_GA = 7264, SRC_GB = 9312;
constexpr float EPS = 1e-6f;
constexpr int NWAVES = 8;

constexpr size_t MiB = 1u << 20, U = 128 * MiB;
constexpr size_t WS_XN = 0;
constexpr size_t WS_CQKV = 2 * U;
constexpr size_t WS_QM = 3 * U, WS_KM = 4 * U, WS_VM = 5 * U;
constexpr size_t WS_Q = 6 * U;
constexpr size_t WS_KN = 6 * U + U / 2 * 3, WS_V = WS_KN + U;
constexpr size_t WS_KR = WS_V + U;
constexpr size_t WS_K8 = WS_KN, WS_V8T = WS_V;
constexpr size_t WS_HFW = 10 * U, WS_HBW = 11 * U;
constexpr size_t WS_MG = 3 * U;
constexpr size_t WS_SGA = 5 * U, WS_SGB = 7 * U;
constexpr size_t WS_W = 12 * U;
constexpr int NP1A = 1024, NP1B = 3328, NP2A = 3072, NP2B = 4096;
constexpr size_t W_P1A = 0, W_P1B = W_P1A + (size_t)NP1A * DM, W_P2A = W_P1B + (size_t)NP1B * DM * 2, W_P2B = W_P2A + (size_t)NP2A * DM, W_UQ = W_P2B + (size_t)NP2B * DM * 2,
                 W_UKV = W_UQ + (size_t)NQ * 512, W_OA = W_UKV + (size_t)NKV * 512, W_OB = W_OA + (size_t)DM * 1024, W_OUT = W_OB + (size_t)DM * 1024 * 2, LW = W_OUT + (size_t)DM * DM * 2;
constexpr int SC_ONE = 0x7F7F7F7F, SC_M6 = 0x79797979, SC_M5 = 0x7A7A7A7A;
constexpr size_t WS_ROPE = WS_W + 2 * LW;
constexpr size_t WS_KRG = WS_ROPE + 4 * MiB;
constexpr size_t WS_SSQ = WS_KRG + 24 * MiB;
constexpr size_t WS_SCR = WS_SSQ + 4 * MiB;
constexpr size_t WS_RSKV = WS_SCR + 20 * MiB;
constexpr size_t WS_SSF = WS_KR + 4 * MiB;
constexpr size_t WS_HG = WS_RSKV + 512 * 1024;
constexpr size_t WS_CTL = WS_RSKV + 1 * MiB, CTL_ZERO_BYTES = 1 * MiB;
constexpr size_t WS_XN8 = WS_CTL + CTL_ZERO_BYTES;
constexpr size_t WS_YA8 = WS_XN8 + U;
constexpr size_t WS_END = WS_YA8 + U / 2;
static_assert(LW % 256 == 0 && WS_END < 2040 * MiB, "d_ws map");
constexpr int CW_BAR = 4096;
constexpr int CW_PANEL = 32768;
constexpr int CW_QUEUE = 16384;

constexpr int LDS_BYTES = 163840;
constexpr int MISC_OFF = 159744;

#define GAS __attribute__((address_space(1)))
#define LAS __attribute__((address_space(3)))
typedef unsigned short bf16;
typedef unsigned v4u __attribute__((ext_vector_type(4)));
typedef float f32x4 __attribute__((ext_vector_type(4)));
typedef short bf16x8 __attribute__((ext_vector_type(8)));
typedef GAS unsigned gu32;
typedef GAS unsigned long long gu64;
#define RLX_AGENT __ATOMIC_RELAXED, __HIP_MEMORY_SCOPE_AGENT
#define LDS_WAIT() asm volatile("s_waitcnt lgkmcnt(0)" ::: "memory")
#define VM_WAIT() asm volatile("s_waitcnt vmcnt(0)" ::: "memory")
__device__ __forceinline__ unsigned long long rt() { return __builtin_amdgcn_s_memrealtime(); }
__device__ __forceinline__ unsigned f2bf(float f) { unsigned u = __builtin_bit_cast(unsigned, f); return (u + 0x7fffu + ((u >> 16) & 1u)) >> 16; }
__device__ __forceinline__ unsigned pk2(float lo, float hi) { return f2bf(lo) | (f2bf(hi) << 16); }

#define XB_TMO      128
#define XB_XCNT(j)  (256  + 64 * (j))
#define XB_XSUB(j)  (1280 + 64 * (j))
#define XB_XGEN(j)  (2304 + 64 * (j))
#define XB_TOP      3328
#define XB_TOPGEN   3392
#define XCD_BAR_WORDS 3456
#define XB_SPIN_CAP (1u << 18)

__device__ __forceinline__ unsigned xb_ld(unsigned* p)              { return __hip_atomic_load(p, __ATOMIC_RELAXED, __HIP_MEMORY_SCOPE_AGENT); }
__device__ __forceinline__ unsigned xb_add(unsigned* p, unsigned v) { return __hip_atomic_fetch_add(p, v, __ATOMIC_RELAXED, __HIP_MEMORY_SCOPE_AGENT); }
__device__ __forceinline__ unsigned xb_xcc_id() { return (unsigned)__builtin_amdgcn_s_getreg((3 << 11) | 20) & 0xFu; }
#define XB_SPIN(cond, bar) do { unsigned _sp = 0; while (cond) { __builtin_amdgcn_s_sleep(1); \
    if ((++_sp & 255u) == 0u) { if (xb_ld(&(bar)[XB_TMO])) break; if (_sp > XB_SPIN_CAP) { atomicAdd(&(bar)[XB_TMO], 1u); break; } } } } while (0)

struct XcdBarrier {
    unsigned* bar; unsigned x;
    volatile LAS unsigned* st;
};

__device__ __forceinline__ XcdBarrier xcd_barrier_post(unsigned* bar, volatile LAS unsigned* st) {
    XcdBarrier b; b.bar = bar; b.x = xb_xcc_id(); b.st = st;
    if (threadIdx.x == 0) (void)xb_add(&bar[XB_XCNT(b.x)], 1u);
    return b;
}
__device__ __forceinline__ void xcd_barrier_complete(unsigned* bar, unsigned x, unsigned& nloc, unsigned& nx) {
    const unsigned G = gridDim.x * gridDim.y * gridDim.z;
    unsigned sum, cnt, mine, sp = 0u;
    for (;;) {
        sum = 0u; cnt = 0u; mine = 0u;
#pragma unroll
        for (unsigned j = 0; j < 16; ++j) { const unsigned c = xb_ld(&bar[XB_XCNT(j)]); sum += c; cnt += (c > 0u) ? 1u : 0u; mine = (j == x) ? c : mine; }
        if (sum == G) break;
        __builtin_amdgcn_s_sleep(1);
        if ((++sp & 255u) == 0u) { if (xb_ld(&bar[XB_TMO])) break; if (sp > XB_SPIN_CAP) { atomicAdd(&bar[XB_TMO], 1u); break; } }
    }
    nloc = mine > 0u ? mine : 1u; nx = cnt > 0u ? cnt : 1u;
}

__device__ __forceinline__ void xcd_barrier(const XcdBarrier& b) {
    asm volatile("s_waitcnt vmcnt(0)" ::: "memory");
    __syncthreads();
    if (threadIdx.x == 0) {
        unsigned* bar = b.bar;
        __builtin_amdgcn_s_waitcnt(0);
        unsigned nloc = b.st[0], nx = b.st[1];
        if (nloc == 0u) { xcd_barrier_complete(bar, b.x, nloc, nx); b.st[0] = nloc; b.st[1] = nx; }
        const unsigned old = xb_add(&bar[XB_XSUB(b.x)], 1u);
        const unsigned gen = old / nloc;
        if (old + 1u == (gen + 1u) * nloc) {
            __builtin_amdgcn_fence(__ATOMIC_RELEASE, "agent");
            asm volatile("s_waitcnt vmcnt(0)" ::: "memory");
            const unsigned og = xb_add(&bar[XB_TOP], 1u);
            const unsigned tg = og / nx;
            if (og + 1u == (tg + 1u) * nx) xb_add(&bar[XB_TOPGEN], 1u);
            else XB_SPIN(xb_ld(&bar[XB_TOPGEN]) == tg, bar);
            __builtin_amdgcn_fence(__ATOMIC_ACQUIRE, "agent");
            xb_add(&bar[XB_XGEN(b.x)], 1u);
            asm volatile("s_waitcnt vmcnt(0)" ::: "memory");
        } else {
            XB_SPIN(xb_ld(&bar[XB_XGEN(b.x)]) == gen, bar);
            __builtin_amdgcn_fence(__ATOMIC_ACQUIRE, "agent");
            asm volatile("s_waitcnt vmcnt(0)" ::: "memory");
        }
    }
    __syncthreads();
}


typedef float f32x2 __attribute__((ext_vector_type(2)));
typedef float f32x8v __attribute__((ext_vector_type(8)));
typedef unsigned u32x2 __attribute__((ext_vector_type(2)));
typedef short s16x4 __attribute__((ext_vector_type(4)));
typedef float f32x16 __attribute__((ext_vector_type(16)));

typedef float cvt_f32x2 __attribute__((ext_vector_type(2))); typedef __bf16 cvt_bf16x2 __attribute__((ext_vector_type(2)));
__device__ __forceinline__ unsigned cvtpk(float lo, float hi) { return __builtin_bit_cast(unsigned, __builtin_convertvector((cvt_f32x2){lo, hi}, cvt_bf16x2)); }
__device__ __forceinline__ float bflo(unsigned w) { return __uint_as_float(w << 16); }
__device__ __forceinline__ float bfhi(unsigned w) { return __uint_as_float(w & 0xffff0000u); }
__device__ __forceinline__ float sigmoidf_(float x) { return __builtin_amdgcn_rcpf(1.0f + __expf(-x)); }
__device__ __forceinline__ float siluf_(float x) { return x * __builtin_amdgcn_rcpf(1.0f + __expf(-x)); }
template <int K> __device__ __forceinline__ float swz_xor(float v) { return __int_as_float(__builtin_amdgcn_ds_swizzle(__float_as_int(v), 0x1F | (K << 10))); }
__device__ __forceinline__ float sum_x16(float v) { const auto rr = __builtin_amdgcn_permlane16_swap(__float_as_uint(v), __float_as_uint(v), false, false); return __uint_as_float(rr[0]) + __uint_as_float(rr[1]); }
__device__ __forceinline__ float sum_x32(float v) { const auto rr = __builtin_amdgcn_permlane32_swap(__float_as_uint(v), __float_as_uint(v), false, false); return __uint_as_float(rr[0]) + __uint_as_float(rr[1]); }
__device__ __forceinline__ float wave_sum(float v) { v += swz_xor<1>(v); v += swz_xor<2>(v); v += swz_xor<4>(v); v += swz_xor<8>(v); v = sum_x16(v); return sum_x32(v); }
__device__ __forceinline__ unsigned pk4_fp8(float a, float b, float c, float d) {
    a = __builtin_amdgcn_fmed3f(a, -448.f, 448.f); b = __builtin_amdgcn_fmed3f(b, -448.f, 448.f); c = __builtin_amdgcn_fmed3f(c, -448.f, 448.f); d = __builtin_amdgcn_fmed3f(d, -448.f, 448.f);
    int w = __builtin_amdgcn_cvt_pk_fp8_f32(a, b, 0, false); w = __builtin_amdgcn_cvt_pk_fp8_f32(c, d, w, true); return (unsigned)w; }
__device__ __forceinline__ int opaque_tid() { return pg8::fresh_tid(); }
__device__ __forceinline__ int seq_pos(int m) { return m < MPROMPT ? (m & (SEQ_P - 1)) : (m & (SEQ_S - 1)); }

struct Frame {
    LAS unsigned char* lds;
    volatile LAS unsigned* MISC;
    gu32* ctl;
    int tid, lane, wave, vcu, G;
    unsigned char* ws;
    float* out;
};
enum { IN_XP = 0, IN_XS = 1, IN_NORM_IN = 2, IN_W_IN = 3, IN_B_GATES = 4, IN_Q_A_NORM = 5, IN_W_UQ = 6, IN_KV_A_NORM = 7, IN_W_UKV = 8, IN_W_OA = 9, IN_M_HEAD_NORM = 10, IN_W_OB = 11, IN_W_OUT = 12, IN_NORM_F = 13 };
struct Args { const float* in[14]; float* out; unsigned char* ws; int ph_lo, ph_hi; };

__device__ __forceinline__ int wmap(int kind, int n) {
    if (kind == 0) {
        if (n < 3072) return SRC_QM + n;
        if (n < 3136) { const int j = n - 3072; return SRC_KROPE + (j >> 1) + 32 * (j & 1); }
        if (n < 3168) return SRC_GATES + (n - 3136);
        return -1;
    }
    if (kind == 5) return n;
    if (kind == 1) {
        if (n < 2048) { const int t = n >> 8, w = n & 255; return (w < 128 ? SRC_OM : SRC_ZM) + t * 128 + (w & 127); }
        return SRC_GB + (n - 2048);
    }
    if (kind == 6) {
        if (n < 1024) return SRC_ZA + n;
        return SRC_GA + (n - 1024);
    }
    if (kind == 2) {
        if (n < 1024) return (n >> 7) * 192 + (n & 127);
        const int j = n - 1024, h = j >> 6, jj = j & 63; return h * 192 + 128 + (jj >> 1) + 32 * (jj & 1);
    }
    if (kind == 3) {
        if (n < 1024) return (n >> 7) * 256 + (n & 127);
        const int j = n - 1024; return (j >> 7) * 256 + 128 + (j & 127);
    }
    return n;
}
__device__ __forceinline__ void transpose_item(const float* W, int K, int srcN, bf16* WT, int Ndst, int kind, const float* kgain, LAS float* scr, int item, int lane) {
    const int nblk = Ndst / 32, kb = item / nblk, nb = item % nblk, k0 = 64 * kb, n0 = 32 * nb;
    const int n = n0 + (lane & 31); const int sc = wmap(kind, n);
    const float cs = (kind == 0 && n < 1024) ? 0.08838834764831845f : 1.0f;
    float tv[32];
#pragma unroll
    for (int i = 0; i < 32; ++i) { const int kk = 2 * i + (lane >> 5);
        float v = 0.f; if (sc >= 0) { v = W[(size_t)(k0 + kk) * srcN + sc] * cs; if (kgain) v *= kgain[k0 + kk]; }
        tv[i] = v; }
#pragma unroll
    for (int i = 0; i < 32; ++i) scr[(2 * i + (lane >> 5)) * 33 + (lane & 31)] = tv[i];
    LDS_WAIT(); asm volatile("" ::: "memory");
    const int c = lane & 7;
#pragma unroll
    for (int j = 0; j < 4; ++j) { const int nn = (lane >> 3) + 8 * j; const LAS float* s = scr + (8 * c) * 33 + nn;
        v4u o; o.x = pk2(s[0 * 33], s[1 * 33]); o.y = pk2(s[2 * 33], s[3 * 33]); o.z = pk2(s[4 * 33], s[5 * 33]); o.w = pk2(s[6 * 33], s[7 * 33]);
        *(GAS v4u*)(WT + (size_t)(n0 + nn) * K + k0 + 8 * c) = o; }
    LDS_WAIT(); asm volatile("" ::: "memory");
}
__device__ __forceinline__ void transpose_item8(const float* W, int K, int srcN, unsigned char* WT, int Ndst, int kind, const float* kgain, float wscale, LAS float* scr, int item, int lane) {
    const int nblk = Ndst / 32, kb = item / nblk, nb = item % nblk, k0 = 64 * kb, n0 = 32 * nb;
    const int n = n0 + (lane & 31); const int sc = wmap(kind, n);
    float tv[32];
#pragma unroll
    for (int i = 0; i < 32; ++i) { const int kk = 2 * i + (lane >> 5);
        float v = 0.f; if (sc >= 0) { v = W[(size_t)(k0 + kk) * srcN + sc] * wscale; if (kgain) v *= kgain[k0 + kk]; }
        tv[i] = v; }
#pragma unroll
    for (int i = 0; i < 32; ++i) scr[(2 * i + (lane >> 5)) * 33 + (lane & 31)] = tv[i];
    LDS_WAIT(); asm volatile("" ::: "memory");
    const int nn = lane >> 1, kh = (lane & 1) * 32; const LAS float* s = scr + kh * 33 + nn;
#pragma unroll
    for (int c = 0; c < 2; ++c) { v4u o;
        o.x = pk4_fp8(s[(16 * c + 0) * 33], s[(16 * c + 1) * 33], s[(16 * c + 2) * 33], s[(16 * c + 3) * 33]); o.y = pk4_fp8(s[(16 * c + 4) * 33], s[(16 * c + 5) * 33], s[(16 * c + 6) * 33], s[(16 * c + 7) * 33]);
        o.z = pk4_fp8(s[(16 * c + 8) * 33], s[(16 * c + 9) * 33], s[(16 * c + 10) * 33], s[(16 * c + 11) * 33]); o.w = pk4_fp8(s[(16 * c + 12) * 33], s[(16 * c + 13) * 33], s[(16 * c + 14) * 33], s[(16 * c + 15) * 33]);
        *(GAS v4u*)(WT + (size_t)(n0 + nn) * K + k0 + kh + 16 * c) = o; }
    LDS_WAIT(); asm volatile("" ::: "memory");
}
__device__ __forceinline__ void p_prologue(Frame& F, const Args& A) {
    const int tid_ = opaque_tid(), lane_ = tid_ & 63, wave_ = __builtin_amdgcn_readfirstlane(tid_ >> 6);
    LAS float* scr = (LAS float*)(F.lds + wave_ * 16384);
    const int gw = F.vcu * NWAVES + wave_, NGW = F.G * NWAVES;
    constexpr int I_P1A = (DM / 64) * (NP1A / 32), I_P1B = (DM / 64) * (NP1B / 32), I_P2A = (DM / 64) * (NP2A / 32), I_P2B = (DM / 64) * (NP2B / 32), I_UQ = (512 / 64) * (NQ / 32),
                  I_UKV = (512 / 64) * (NKV / 32), I_OA = (1024 / 64) * (DM / 32), I_OB = I_OA, I_OUT = (DM / 64) * (DM / 32), I_LAYER = I_P1A + I_P1B + I_P2A + I_P2B + I_UQ + I_UKV + I_OA + I_OB + I_OUT;
    for (int it = gw; it < DEPTH * I_LAYER; it += NGW) {
        const int l = it / I_LAYER; int r = it - l * I_LAYER;
        unsigned char* wb = F.ws + WS_W + (size_t)l * LW;
        const float* win = A.in[IN_W_IN] + (size_t)l * DM * IN_COLS;
        if (r < I_P1A) { transpose_item8(win, DM, IN_COLS, wb + W_P1A, NP1A, 5, nullptr, 64.f, scr, r, lane_); continue; } r -= I_P1A;
        if (r < I_P1B) { transpose_item(win, DM, IN_COLS, (bf16*)(wb + W_P1B), NP1B, 0, nullptr, scr, r, lane_); continue; } r -= I_P1B;
        if (r < I_P2A) { transpose_item8(win, DM, IN_COLS, wb + W_P2A, NP2A, 6, nullptr, 64.f, scr, r, lane_); continue; } r -= I_P2A;
        if (r < I_P2B) { transpose_item(win, DM, IN_COLS, (bf16*)(wb + W_P2B), NP2B, 1, nullptr, scr, r, lane_); continue; } r -= I_P2B;
        if (r < I_UQ) { transpose_item8(A.in[IN_W_UQ] + (size_t)l * 512 * NQ, 512, NQ, wb + W_UQ, NQ, 2, A.in[IN_Q_A_NORM] + l * 512, 32.f, scr, r, lane_); continue; } r -= I_UQ;
        if (r < I_UKV) { transpose_item8(A.in[IN_W_UKV] + (size_t)l * 512 * NKV, 512, NKV, wb + W_UKV, NKV, 3, A.in[IN_KV_A_NORM] + l * 512, 32.f, scr, r, lane_); continue; } r -= I_UKV;
        if (r < I_OA) { transpose_item8(A.in[IN_W_OA] + (size_t)l * 1024 * DM, 1024, DM, wb + W_OA, DM, 4, nullptr, 32.f, scr, r, lane_); continue; } r -= I_OA;
        if (r < I_OB) { transpose_item(A.in[IN_W_OB] + (size_t)l * 1024 * DM, 1024, DM, (bf16*)(wb + W_OB), DM, 4, nullptr, scr, r, lane_); continue; } r -= I_OB;
        transpose_item(A.in[IN_W_OUT] + (size_t)l * DM * DM, DM, DM, (bf16*)(wb + W_OUT), DM, 4, nullptr, scr, r, lane_);
    }
    for (int e = F.vcu * 512 + tid_; e < DEPTH * 1024; e += F.G * 512) ((float*)(F.ws + WS_HG))[e] = A.in[IN_M_HEAD_NORM][e];
    f32x2* rope = (f32x2*)(F.ws + WS_ROPE);
    for (int e = F.vcu * 512 + tid_; e < SEQ_P * 32; e += F.G * 512) {
        const int pos = e >> 5, i = e & 31;
        const float inv = powf(10000.0f, -(float)(2 * i) / 64.0f);
        const float ang = (float)pos * inv; float s, c; sincosf(ang, &s, &c);
        rope[e] = (f32x2){c, s};
    }
}

__device__ __forceinline__ const float* x_row(Frame& F, const Args& A, int layer, int m) {
    if (layer == 0) return m < MPROMPT ? A.in[IN_XP] + (size_t)m * DM : A.in[IN_XS] + (size_t)(m - MPROMPT) * DM;
    return F.out + (size_t)m * DM;
}
__device__ __forceinline__ void p_norm(Frame& F, const Args& A, int layer) {
    const int tid_ = opaque_tid(), lane_ = tid_ & 63, wave_ = __builtin_amdgcn_readfirstlane(tid_ >> 6);
    const int gw = F.vcu * NWAVES + wave_, NGW = F.G * NWAVES;
    const float* g = A.in[IN_NORM_IN] + layer * DM; bf16* XN = (bf16*)(F.ws + WS_XN);
    for (int m = gw; m < MTOK; m += NGW) {
        const GAS f32x4* xr = (const GAS f32x4*)x_row(F, A, layer, m) + lane_;
        f32x4 v[8]; float s = 0.f;
#pragma unroll
        for (int j = 0; j < 8; ++j) { v[j] = xr[64 * j]; s += (v[j].x * v[j].x + v[j].y * v[j].y) + (v[j].z * v[j].z + v[j].w * v[j].w); }
        const float rs = 1.0f / sqrtf(wave_sum(s) * (1.0f / DM) + EPS);
        GAS unsigned long long* o8 = (GAS unsigned long long*)(XN + (size_t)m * DM) + lane_;
#pragma unroll
        for (int j = 0; j < 8; ++j) { const f32x4 gg = *((const GAS f32x4*)g + lane_ + 64 * j);
            const float y0 = v[j].x * rs * gg.x, y1 = v[j].y * rs * gg.y, y2 = v[j].z * rs * gg.z, y3 = v[j].w * rs * gg.w;
            o8[64 * j] = (unsigned long long)cvtpk(y0, y1) | ((unsigned long long)cvtpk(y2, y3) << 32);
            ((GAS unsigned*)(F.ws + WS_XN8 + (size_t)m * DM))[lane_ + 64 * j] = pk4_fp8(y0, y1, y2, y3); }
    }
}
__device__ __forceinline__ void p_final(Frame& F, const Args& A) {
    const int tid_ = opaque_tid(), lane_ = tid_ & 63, wave_ = __builtin_amdgcn_readfirstlane(tid_ >> 6);
    const int gw = F.vcu * NWAVES + wave_, NGW = F.G * NWAVES;
    for (int m = gw; m < MTOK; m += NGW) {
        GAS f32x4* xr = (GAS f32x4*)(F.out + (size_t)m * DM) + lane_;
        f32x4 v[8]; float s = 0.f;
#pragma unroll
        for (int j = 0; j < 8; ++j) { v[j] = xr[64 * j]; s += (v[j].x * v[j].x + v[j].y * v[j].y) + (v[j].z * v[j].z + v[j].w * v[j].w); }
        const float rs = 1.0f / sqrtf(wave_sum(s) * (1.0f / DM) + EPS);
#pragma unroll
        for (int j = 0; j < 8; ++j) { const f32x4 gg = *((const GAS f32x4*)A.in[IN_NORM_F] + lane_ + 64 * j); xr[64 * j] = v[j] * rs * gg; }
    }
}

using pg8::Unit; using pg8::BM; using pg8::HALF;
#define EPI_ROWS_BEGIN  _Pragma("unroll") for (int ai = 0; ai < 2; ++ai) _Pragma("unroll") for (int m = 0; m < 4; ++m) { const int row = u.pm * BM + ai * HALF + wr * 64 + m * 16 + fr;
#define EPI_ROWS_END    asm volatile("" ::: "memory"); }
#define EPI_ROW(ai, m) (u.pm * BM + (ai) * HALF + wr * 64 + (m) * 16 + fr)
#define EPI_FENCE asm volatile("" ::: "memory")

struct EpiP1a {
    static constexpr int PERM = 2; static constexpr bool AFTER_DRAIN = false;
    unsigned char* ws; size_t dst;
    __device__ __forceinline__ void operator()(const f32x4 (&acc)[2][2][4][2], const Unit& u, int wr, int wc, int fr, int fq) const {
        const int pn = u.pn, col0 = pn * 256 + wc * 64 + 16 * fq;
        EPI_ROWS_BEGIN
            float s = 0.f; v4u w;
#pragma unroll
            for (int bj = 0; bj < 2; ++bj) { const f32x4 v0 = acc[ai][bj][m][0] * 0.015625f, v1 = acc[ai][bj][m][1] * 0.015625f;
                s += (v0[0] * v0[0] + v0[1] * v0[1]) + (v0[2] * v0[2] + v0[3] * v0[3]) + (v1[0] * v1[0] + v1[1] * v1[1]) + (v1[2] * v1[2] + v1[3] * v1[3]);
                w[2 * bj] = pk4_fp8(v0[0], v0[1], v0[2], v0[3]); w[2 * bj + 1] = pk4_fp8(v1[0], v1[1], v1[2], v1[3]); }
            *(v4u*)(ws + dst + (size_t)row * 1024 + col0) = w;
            s = sum_x16(s); s = sum_x32(s); if (fq == 0) ((float*)(ws + WS_SSQ))[(size_t)row * 16 + pn * 4 + wc] = s;
        EPI_ROWS_END
    }
};
struct EpiP1b {
    static constexpr bool PERM = true, AFTER_DRAIN = false;
    unsigned char* ws;
    __device__ __forceinline__ void operator()(const f32x4 (&acc)[2][2][4][2], const Unit& u, int wr, int wc, int fr, int fq) const {
        const int pn = u.pn;
        if (pn < 12) {
            bf16* base = (bf16*)(ws + WS_QM + (size_t)(pn >> 2) * U); const int col0 = (pn & 3) * 256 + wc * 32 + 8 * fq;
            EPI_ROWS_BEGIN
                bf16* rowp = base + (size_t)row * 1024 + col0;
#pragma unroll
                for (int bj = 0; bj < 2; ++bj) { const f32x4 v0 = acc[ai][bj][m][0], v1 = acc[ai][bj][m][1];
                    v4u w; w.x = cvtpk(v0[0], v0[1]); w.y = cvtpk(v0[2], v0[3]); w.z = cvtpk(v1[0], v1[1]); w.w = cvtpk(v1[2], v1[3]);
                    *(v4u*)(rowp + bj * HALF) = w; }
            EPI_ROWS_END
        } else if (wc < 2) {
#pragma unroll
            for (int ai = 0; ai < 2; ++ai) { f32x4 cs[4][2];
#pragma unroll
                for (int m = 0; m < 4; ++m) { const f32x2* rp = (const f32x2*)(ws + WS_ROPE) + seq_pos(EPI_ROW(ai, m)) * 32 + 16 * wc + 4 * fq; cs[m][0] = *(const f32x4*)rp; cs[m][1] = *(const f32x4*)(rp + 2); }
                EPI_FENCE;
#pragma unroll
                for (int m = 0; m < 4; ++m) { const f32x4 cs01 = cs[m][0], cs23 = cs[m][1]; const f32x4 a = acc[ai][0][m][0], b = acc[ai][0][m][1];
                    *(u32x2*)(ws + WS_KR + (size_t)EPI_ROW(ai, m) * 64 + 32 * wc + 8 * fq) = (u32x2){
                        pk4_fp8(a[0] * cs01[0] - a[1] * cs01[1], a[1] * cs01[0] + a[0] * cs01[1], a[2] * cs01[2] - a[3] * cs01[3], a[3] * cs01[2] + a[2] * cs01[3]),
                        pk4_fp8(b[0] * cs23[0] - b[1] * cs23[1], b[1] * cs23[0] + b[0] * cs23[1], b[2] * cs23[2] - b[3] * cs23[3], b[3] * cs23[2] + b[2] * cs23[3])};
                    EPI_FENCE; } }
        } else if (wc == 2) {
            EPI_ROWS_BEGIN
                float* gp = (float*)(ws + WS_KRG) + (size_t)row * 96 + 64 + 8 * fq;
                *(f32x4*)gp = acc[ai][0][m][0]; *(f32x4*)(gp + 4) = acc[ai][0][m][1];
            EPI_ROWS_END
        }
    }
};
struct EpiQ {
    static constexpr bool PERM = true, AFTER_DRAIN = false;
    unsigned char* ws;
    __device__ __forceinline__ void operator()(const f32x4 (&acc)[2][2][4][2], const Unit& u, int wr, int wc, int fr, int fq) const {
        const int col0 = u.pn * 256 + wc * 32 + 8 * fq;
#pragma unroll
        for (int ai = 0; ai < 2; ++ai) {
            f32x4 sq[4][2];
#pragma unroll
            for (int m = 0; m < 4; ++m) { const float* sp = (const float*)(ws + WS_SSQ) + (size_t)EPI_ROW(ai, m) * 16; sq[m][0] = *(const f32x4*)sp; sq[m][1] = *(const f32x4*)(sp + 4); }
            EPI_FENCE;
#pragma unroll
            for (int m = 0; m < 4; ++m) { const int row = EPI_ROW(ai, m); const f32x4 s0 = sq[m][0], s1 = sq[m][1];
                const float rs = 0.03125f / sqrtf(((s0[0] + s0[1]) + (s0[2] + s0[3]) + (s1[0] + s1[1]) + (s1[2] + s1[3])) * (1.0f / 512.0f) + EPS);
                bf16* rowp = (bf16*)(ws + WS_Q) + (size_t)row * NQ + col0;
#pragma unroll
                for (int bj = 0; bj < 2; ++bj) { const f32x4 v0 = acc[ai][bj][m][0] * rs, v1 = acc[ai][bj][m][1] * rs;
                    v4u w; w.x = cvtpk(v0[0], v0[1]); w.y = cvtpk(v0[2], v0[3]); w.z = cvtpk(v1[0], v1[1]); w.w = cvtpk(v1[2], v1[3]);
                    *(v4u*)(rowp + bj * HALF) = w; }
                EPI_FENCE; }
        }
    }
};
struct EpiK8 {
    static constexpr int PERM = 2; static constexpr bool AFTER_DRAIN = false;
    unsigned char* ws;
    __device__ __forceinline__ void operator()(const f32x4 (&acc)[2][2][4][2], const Unit& u, int wr, int wc, int fr, int fq) const {
        const int col0 = u.pn * 256 + wc * 64 + 16 * fq;
#pragma unroll
        for (int ai = 0; ai < 2; ++ai) {
            f32x4 sq[4][2];
#pragma unroll
            for (int m = 0; m < 4; ++m) { const float* sp = (const float*)(ws + WS_SSQ) + (size_t)EPI_ROW(ai, m) * 16 + 8; sq[m][0] = *(const f32x4*)sp; sq[m][1] = *(const f32x4*)(sp + 4); }
            EPI_FENCE;
#pragma unroll
            for (int m = 0; m < 4; ++m) { const int row = EPI_ROW(ai, m); const f32x4 s0 = sq[m][0], s1 = sq[m][1];
                const float rs = 0.03125f / sqrtf(((s0[0] + s0[1]) + (s0[2] + s0[3]) + (s1[0] + s1[1]) + (s1[2] + s1[3])) * (1.0f / 512.0f) + EPS);
                v4u w;
#pragma unroll
                for (int bj = 0; bj < 2; ++bj) { const f32x4 v0 = acc[ai][bj][m][0] * rs, v1 = acc[ai][bj][m][1] * rs;
                    w[2 * bj] = pk4_fp8(v0[0], v0[1], v0[2], v0[3]); w[2 * bj + 1] = pk4_fp8(v1[0], v1[1], v1[2], v1[3]); }
                *(v4u*)(ws + WS_K8 + (size_t)row * 1024 + col0) = w;
                EPI_FENCE; }
        }
    }
};
struct EpiVT {
    static constexpr int PERM = 2; static constexpr bool AFTER_DRAIN = false;
    unsigned char* ws;
    __device__ __forceinline__ void operator()(const f32x4 (&acc)[2][2][4][2], const Unit& u, int wr, int wc, int fr, int fq) const {
        const int tok0 = u.pn * 256 + wc * 64 + 16 * fq;
        const int J0 = 2 * fq, pos = 4 * (J0 & 3) + 16 * (J0 >> 2);
        f32x4 rq[2][2];
#pragma unroll
        for (int bj = 0; bj < 2; ++bj) { f32x4 sq[8][2];
#pragma unroll
            for (int e = 0; e < 8; ++e) { const float* sp = (const float*)(ws + WS_SSQ) + (size_t)(tok0 + 8 * bj + e) * 16 + 8; sq[e][0] = *(const f32x4*)sp; sq[e][1] = *(const f32x4*)(sp + 4); }
            EPI_FENCE;
#pragma unroll
            for (int e = 0; e < 8; ++e) { const f32x4 s0 = sq[e][0], s1 = sq[e][1];
                rq[bj][e >> 2][e & 3] = 0.03125f / sqrtf(((s0[0] + s0[1]) + (s0[2] + s0[3]) + (s1[0] + s1[1]) + (s1[2] + s1[3])) * (1.0f / 512.0f) + EPS); } }
        EPI_ROWS_BEGIN
            unsigned char* rowp = ws + WS_V8T + ((size_t)(tok0 >> 6) * 1024 + row) * 64 + pos;
            const f32x4 a0 = acc[ai][0][m][0] * rq[0][0], a1 = acc[ai][0][m][1] * rq[0][1], b0 = acc[ai][1][m][0] * rq[1][0], b1 = acc[ai][1][m][1] * rq[1][1];
            *(u32x2*)rowp = (u32x2){pk4_fp8(a0[0], a0[1], a0[2], a0[3]), pk4_fp8(b0[0], b0[1], b0[2], b0[3])};
            *(u32x2*)(rowp + 32) = (u32x2){pk4_fp8(a1[0], a1[1], a1[2], a1[3]), pk4_fp8(b1[0], b1[1], b1[2], b1[3])};
        EPI_ROWS_END
    }
};
struct EpiP2a {
    static constexpr int PERM = 2; static constexpr bool AFTER_DRAIN = false;
    unsigned char* ws; size_t sga;
    __device__ __forceinline__ void operator()(const f32x4 (&acc)[2][2][4][2], const Unit& u, int wr, int wc, int fr, int fq) const {
        const int pn = u.pn;
        if (pn < 4) {
            const int col0 = pn * 256 + wc * 64 + 16 * fq;
#pragma unroll
            for (int ai = 0; ai < 2; ++ai) { v4u ov[4][2];
#pragma unroll
              for (int m = 0; m < 4; ++m) { const bf16* orow = (const bf16*)(ws + WS_CQKV) + (size_t)EPI_ROW(ai, m) * 1024 + col0; ov[m][0] = *(const v4u*)orow; ov[m][1] = *(const v4u*)(orow + 8); }
              EPI_FENCE;
#pragma unroll
              for (int m = 0; m < 4; ++m) { const int row = EPI_ROW(ai, m); v4u w;
#pragma unroll
                for (int bj = 0; bj < 2; ++bj) { f32x4 v0 = acc[ai][bj][m][0] * 0.015625f, v1 = acc[ai][bj][m][1] * 0.015625f;
                    const v4u o = ov[m][bj];
#pragma unroll
                    for (int j = 0; j < 4; ++j) { v0[j] = 64.f * siluf_(v0[j]); v1[j] = 64.f * siluf_(v1[j]); }
                    v0[0] *= bflo(o.x); v0[1] *= bfhi(o.x); v0[2] *= bflo(o.y); v0[3] *= bfhi(o.y); v1[0] *= bflo(o.z); v1[1] *= bfhi(o.z); v1[2] *= bflo(o.w); v1[3] *= bfhi(o.w);
                    w[2 * bj] = pk4_fp8(v0[0], v0[1], v0[2], v0[3]); w[2 * bj + 1] = pk4_fp8(v1[0], v1[1], v1[2], v1[3]); }
                *(v4u*)(ws + WS_YA8 + (size_t)row * 1024 + col0) = w;
                EPI_FENCE; } }
        } else {
            const int col0 = (pn - 4) * 256 + wc * 64 + 16 * fq;
            EPI_ROWS_BEGIN
                bf16* rowp = (bf16*)(ws + sga) + (size_t)row * 2048 + col0;
#pragma unroll
                for (int bj = 0; bj < 2; ++bj) { f32x4 v0 = acc[ai][bj][m][0] * 0.015625f, v1 = acc[ai][bj][m][1] * 0.015625f;
#pragma unroll
                    for (int j = 0; j < 4; ++j) { v0[j] = sigmoidf_(v0[j]); v1[j] = sigmoidf_(v1[j]); }
                    v4u w; w.x = cvtpk(v0[0], v0[1]); w.y = cvtpk(v0[2], v0[3]); w.z = cvtpk(v1[0], v1[1]); w.w = cvtpk(v1[2], v1[3]);
                    *(v4u*)(rowp + 8 * bj) = w; }
            EPI_ROWS_END
        }
    }
};
struct EpiP2b {
    static constexpr bool PERM = true, AFTER_DRAIN = false;
    unsigned char* ws; int layer;
    __device__ __forceinline__ void operator()(const f32x4 (&acc)[2][2][4][2], const Unit& u, int wr_, int wc_, int fr_, int fq_) const {
        const int t_ = opaque_tid(), wr = t_ >> 8, wc = (t_ >> 6) & 3, fr = t_ & 15, fq = (t_ >> 4) & 3;
        const int pn = u.pn;
        if (pn < 8) {
            extern __shared__ __attribute__((aligned(16))) unsigned char lds[];
            LAS float* red = (LAS float*)((LAS unsigned char*)lds + 131072);
            const int colh = pn * 128 + wc * 32 + 8 * fq;
#pragma unroll
            for (int ai = 0; ai < 2; ++ai) { v4u ha[4], hb[4];
#pragma unroll
                for (int m = 0; m < 4; ++m) { const size_t off = (size_t)EPI_ROW(ai, m) * 1024 + colh; ha[m] = *(const v4u*)((const bf16*)(ws + WS_HFW) + off); hb[m] = *(const v4u*)((const bf16*)(ws + WS_HBW) + off); }
                EPI_FENCE;
#pragma unroll
                for (int m = 0; m < 4; ++m) { const v4u a = ha[m], b = hb[m]; float s = 0.f;
#pragma unroll
                    for (int e = 0; e < 4; ++e) { const float lo = bflo(a[e]) + bflo(b[e]), hi = bfhi(a[e]) + bfhi(b[e]); s += lo * lo + hi * hi; }
                    s = sum_x16(s); s = sum_x32(s);
                    if (fq == 0) red[(wr * 128 + ai * 64 + m * 16 + fr) * 4 + wc] = s; }
                EPI_FENCE; }
            LDS_WAIT(); __builtin_amdgcn_s_barrier(); asm volatile("" ::: "memory");
            const int t2_ = opaque_tid(), wr2 = t2_ >> 8, fr2 = t2_ & 15, colh2 = pn * 128 + ((t2_ >> 6) & 3) * 32 + 8 * ((t2_ >> 4) & 3);
#define EPI_ROW2(ai, m) (u.pm * BM + (ai) * HALF + wr2 * 64 + (m) * 16 + fr2)
            const float* gain = (const float*)(ws + WS_HG) + layer * 1024 + colh2; const f32x4 g0 = *(const f32x4*)gain, g1 = *(const f32x4*)(gain + 4);
#pragma unroll
            for (int ai = 0; ai < 2; ++ai)
#pragma unroll
              for (int mh = 0; mh < 2; ++mh) { v4u ha[2], hb[2];
#pragma unroll
                for (int mm = 0; mm < 2; ++mm) { const size_t off = (size_t)EPI_ROW2(ai, 2 * mh + mm) * 1024 + colh2; ha[mm] = *(const v4u*)((const bf16*)(ws + WS_HFW) + off); hb[mm] = *(const v4u*)((const bf16*)(ws + WS_HBW) + off); }
                EPI_FENCE;
#pragma unroll
                for (int mm = 0; mm < 2; ++mm) { const int m = 2 * mh + mm; const size_t off = (size_t)EPI_ROW2(ai, m) * 1024 + colh2;
                    const f32x4 pr = *(const LAS f32x4*)(red + (wr2 * 128 + ai * 64 + m * 16 + fr2) * 4);
                    const float rs = 1.0f / sqrtf(((pr[0] + pr[1]) + (pr[2] + pr[3])) * (1.0f / 128.0f) + EPS);
                    const v4u a = ha[mm], b = hb[mm];
                    const f32x4 o0 = acc[ai][0][m][0], o1 = acc[ai][0][m][1], z0 = acc[ai][1][m][0], z1 = acc[ai][1][m][1];
                    float y[8];
#pragma unroll
                    for (int e = 0; e < 4; ++e) { y[2 * e] = (bflo(a[e]) + bflo(b[e])) * rs; y[2 * e + 1] = (bfhi(a[e]) + bfhi(b[e])) * rs; }
#pragma unroll
                    for (int j = 0; j < 4; ++j) { y[j] *= g0[j] * sigmoidf_(o0[j]) * (z0[j] * sigmoidf_(z0[j])); y[4 + j] *= g1[j] * sigmoidf_(o1[j]) * (z1[j] * sigmoidf_(z1[j])); }
                    v4u w; w.x = cvtpk(y[0], y[1]); w.y = cvtpk(y[2], y[3]); w.z = cvtpk(y[4], y[5]); w.w = cvtpk(y[6], y[7]);
                    *(v4u*)((bf16*)(ws + WS_HFW) + off) = w;
                    EPI_FENCE; } }
        } else {
            const int col0 = (pn - 8) * 256 + wc * 32 + 8 * fq;
            EPI_ROWS_BEGIN
                bf16* rowp = (bf16*)(ws + WS_SGB) + (size_t)row * 2048 + col0;
#pragma unroll
                for (int bj = 0; bj < 2; ++bj) { f32x4 v0 = acc[ai][bj][m][0], v1 = acc[ai][bj][m][1];
#pragma unroll
                    for (int j = 0; j < 4; ++j) { v0[j] = sigmoidf_(v0[j]); v1[j] = sigmoidf_(v1[j]); }
                    v4u w; w.x = cvtpk(v0[0], v0[1]); w.y = cvtpk(v0[2], v0[3]); w.z = cvtpk(v1[0], v1[1]); w.w = cvtpk(v1[2], v1[3]);
                    *(v4u*)(rowp + bj * HALF) = w; }
            EPI_ROWS_END
        }
    }
};
struct MidMerge {
    unsigned char* ws;
    __device__ __forceinline__ void operator()(f32x4 (&acc)[2][2][4][2], const Unit& u, int wr, int wc, int fr, int fq) const {
        const int col0 = u.pn * 256 + wc * 32 + 8 * fq;
#pragma unroll
        for (int ai = 0; ai < 2; ++ai)
#pragma unroll
          for (int mh = 0; mh < 2; ++mh) {
            v4u ga[2][2], gb[2][2];
#pragma unroll
            for (int mm = 0; mm < 2; ++mm)
#pragma unroll
                for (int bj = 0; bj < 2; ++bj) { const size_t off = (size_t)EPI_ROW(ai, 2 * mh + mm) * DM + col0 + bj * HALF; ga[mm][bj] = *(const v4u*)((const bf16*)(ws + WS_SGA) + off); gb[mm][bj] = *(const v4u*)((const bf16*)(ws + WS_SGB) + off); }
            EPI_FENCE;
#pragma unroll
            for (int mm = 0; mm < 2; ++mm)
#pragma unroll
                for (int bj = 0; bj < 2; ++bj) { const int m = 2 * mh + mm; const v4u a = ga[mm][bj], b = gb[mm][bj]; float r[8];
#pragma unroll
                    for (int e = 0; e < 4; ++e) { r[2 * e] = 2048.f * bflo(b[e]) * __builtin_amdgcn_rcpf(fmaxf(bflo(a[e]), 9.094947e-13f)); r[2 * e + 1] = 2048.f * bfhi(b[e]) * __builtin_amdgcn_rcpf(fmaxf(bfhi(a[e]), 9.094947e-13f)); }
                    f32x4 v0 = acc[ai][bj][m][0], v1 = acc[ai][bj][m][1];
                    v0[0] *= r[0]; v0[1] *= r[1]; v0[2] *= r[2]; v0[3] *= r[3]; v1[0] *= r[4]; v1[1] *= r[5]; v1[2] *= r[6]; v1[3] *= r[7];
                    acc[ai][bj][m][0] = v0; acc[ai][bj][m][1] = v1; }
            EPI_FENCE;
          }
    }
};
struct EpiMerge2 {
    static constexpr bool PERM = true, AFTER_DRAIN = false;
    unsigned char* ws;
    __device__ __forceinline__ void operator()(const f32x4 (&acc)[2][2][4][2], const Unit& u, int wr, int wc, int fr, int fq) const {
        const int col0 = u.pn * 256 + wc * 32 + 8 * fq; bf16* T = (bf16*)(ws + WS_MG);
#pragma unroll
        for (int ai = 0; ai < 2; ++ai) {
            v4u gv[4][2];
#pragma unroll
            for (int m = 0; m < 4; ++m)
#pragma unroll
                for (int bj = 0; bj < 2; ++bj) gv[m][bj] = *(const v4u*)((const bf16*)(ws + WS_SGA) + (size_t)EPI_ROW(ai, m) * DM + col0 + bj * HALF);
            EPI_FENCE;
#pragma unroll
            for (int m = 0; m < 4; ++m) { const size_t off = (size_t)EPI_ROW(ai, m) * DM + col0;
#pragma unroll
                for (int bj = 0; bj < 2; ++bj) { f32x4 v0 = acc[ai][bj][m][0] * 0.00048828125f, v1 = acc[ai][bj][m][1] * 0.00048828125f; const v4u g = gv[m][bj];
                    v0[0] *= fmaxf(bflo(g.x), 9.094947e-13f); v0[1] *= fmaxf(bfhi(g.x), 9.094947e-13f); v0[2] *= fmaxf(bflo(g.y), 9.094947e-13f); v0[3] *= fmaxf(bfhi(g.y), 9.094947e-13f);
                    v1[0] *= fmaxf(bflo(g.z), 9.094947e-13f); v1[1] *= fmaxf(bfhi(g.z), 9.094947e-13f); v1[2] *= fmaxf(bflo(g.w), 9.094947e-13f); v1[3] *= fmaxf(bfhi(g.w), 9.094947e-13f);
                    v4u w; w.x = cvtpk(v0[0], v0[1]); w.y = cvtpk(v0[2], v0[3]); w.z = cvtpk(v1[0], v1[1]); w.w = cvtpk(v1[2], v1[3]);
                    *(v4u*)(T + off + bj * HALF) = w; }
                EPI_FENCE; }
        }
    }
};
template <bool LAST> struct EpiOutX {
    static constexpr bool PERM = true, AFTER_DRAIN = false;
    const float* xp; const float* xs; float* out; unsigned char* ws; const float* gn; int layer;
    __device__ __forceinline__ void operator()(f32x4 (&acc)[2][2][4][2], const Unit& u, int wr, int wc, int fr, int fq) const {
        extern __shared__ __attribute__((aligned(16))) unsigned char lds[];
        LAS float* red = (LAS float*)((LAS unsigned char*)lds + 131072);
        const int col0 = u.pn * 256 + wc * 32 + 8 * fq;
#pragma unroll
        for (int ai = 0; ai < 2; ++ai) {
            f32x4 xv[4][2][2];
#pragma unroll
            for (int m = 0; m < 4; ++m) { const int row = EPI_ROW(ai, m);
                const float* xr = (layer == 0 ? (row < MPROMPT ? xp + (size_t)row * DM : xs + (size_t)(row - MPROMPT) * DM) : out + (size_t)row * DM) + col0;
#pragma unroll
                for (int bj = 0; bj < 2; ++bj)
#pragma unroll
                    for (int n = 0; n < 2; ++n) xv[m][bj][n] = *(const f32x4*)(xr + bj * HALF + n * 4); }
            EPI_FENCE;
#pragma unroll
            for (int m = 0; m < 4; ++m) { float s = 0.f;
#pragma unroll
                for (int bj = 0; bj < 2; ++bj)
#pragma unroll
                    for (int n = 0; n < 2; ++n) { const f32x4 v = xv[m][bj][n] + acc[ai][bj][m][n]; acc[ai][bj][m][n] = v; s += (v[0] * v[0] + v[1] * v[1]) + (v[2] * v[2] + v[3] * v[3]); }
                s = sum_x16(s); s = sum_x32(s);
                if (fq == 0) red[(wr * 128 + ai * 64 + m * 16 + fr) * 4 + wc] = s; }
            EPI_FENCE;
        }
        LDS_WAIT(); __builtin_amdgcn_s_barrier(); asm volatile("" ::: "memory");
        const int t_ = opaque_tid();
        if (t_ < 256) { const int wr_t = t_ >> 7, rl = t_ & 127; const f32x4 pr = *(const LAS f32x4*)(red + (wr_t * 128 + rl) * 4);
            const int row_t = u.pm * BM + (rl >> 6) * HALF + wr_t * 64 + (rl & 63);
            __hip_atomic_store((float*)(ws + WS_SSF) + (size_t)row_t * 8 + u.pn, (pr[0] + pr[1]) + (pr[2] + pr[3]), __ATOMIC_RELAXED, __HIP_MEMORY_SCOPE_AGENT); }
        asm volatile("s_waitcnt vmcnt(0)" ::: "memory");
        __syncthreads();
        if (t_ == 0) { unsigned* cnt = (unsigned*)(ws + WS_CTL) + CW_PANEL + layer * 256 + u.pm;
            __hip_atomic_fetch_add(cnt, 1u, __ATOMIC_RELAXED, __HIP_MEMORY_SCOPE_AGENT);
            unsigned sp = 0; while (__hip_atomic_load(cnt, __ATOMIC_RELAXED, __HIP_MEMORY_SCOPE_AGENT) < 8u && ++sp < (1u << 22)) __builtin_amdgcn_s_sleep(1);
            __builtin_amdgcn_fence(__ATOMIC_ACQUIRE, "agent"); asm volatile("s_waitcnt vmcnt(0)" ::: "memory"); }
        __syncthreads();
        const int t2_ = opaque_tid(), wr2 = t2_ >> 8, fr2 = t2_ & 15, colb = u.pn * 256 + ((t2_ >> 6) & 3) * 32 + 8 * ((t2_ >> 4) & 3);
        f32x4 g[2][2];
#pragma unroll
        for (int bj = 0; bj < 2; ++bj) { g[bj][0] = *(const f32x4*)(gn + colb + bj * HALF); g[bj][1] = *(const f32x4*)(gn + colb + bj * HALF + 4); }
#pragma unroll
        for (int ai = 0; ai < 2; ++ai) { f32x4 sf[4][2];
#pragma unroll
            for (int m = 0; m < 4; ++m) { const float* sp = (const float*)(ws + WS_SSF) + (size_t)(u.pm * BM + ai * HALF + wr2 * 64 + m * 16 + fr2) * 8; sf[m][0] = *(const f32x4*)sp; sf[m][1] = *(const f32x4*)(sp + 4); }
            EPI_FENCE;
#pragma unroll
            for (int m = 0; m < 4; ++m) { const int row = u.pm * BM + ai * HALF + wr2 * 64 + m * 16 + fr2; const f32x4 a = sf[m][0], b = sf[m][1];
                const float rs = 1.0f / sqrtf((((a[0] + a[1]) + (a[2] + a[3])) + ((b[0] + b[1]) + (b[2] + b[3]))) * (1.0f / DM) + EPS);
                float* orow = out + (size_t)row * DM + colb;
#pragma unroll
                for (int bj = 0; bj < 2; ++bj) {
                    const f32x4 y0 = acc[ai][bj][m][0], y1 = acc[ai][bj][m][1]; const f32x4 n0 = y0 * rs * g[bj][0], n1 = y1 * rs * g[bj][1];
                    if constexpr (LAST) { *(f32x4*)(orow + bj * HALF) = n0; *(f32x4*)(orow + bj * HALF + 4) = n1; }
                    else { *(f32x4*)(orow + bj * HALF) = y0; *(f32x4*)(orow + bj * HALF + 4) = y1;
                        v4u w; w.x = cvtpk(n0[0], n0[1]); w.y = cvtpk(n0[2], n0[3]); w.z = cvtpk(n1[0], n1[1]); w.w = cvtpk(n1[2], n1[3]);
                        *(v4u*)((bf16*)(ws + WS_XN) + (size_t)row * DM + colb + bj * HALF) = w;
                        *(u32x2*)(ws + WS_XN8 + (size_t)row * DM + colb + bj * HALF) = (u32x2){pk4_fp8(n0[0], n0[1], n0[2], n0[3]), pk4_fp8(n1[0], n1[1], n1[2], n1[3])}; } }
                EPI_FENCE; } }
    }
};
struct EpiOut {
    static constexpr bool PERM = false, AFTER_DRAIN = false;
    const float* xp; const float* xs; float* out; int layer;
    __device__ __forceinline__ void operator()(const f32x4 (&acc)[2][2][4][2], const Unit& u, int wr, int wc, int fr, int fq) const {
        const int col0 = u.pn * 256 + wc * 32 + 4 * fq;
#pragma unroll
        for (int ai = 0; ai < 2; ++ai) {
            f32x4 xv[4][2][2];
#pragma unroll
            for (int m = 0; m < 4; ++m) { const int row = EPI_ROW(ai, m);
                const float* xr = (layer == 0 ? (row < MPROMPT ? xp + (size_t)row * DM : xs + (size_t)(row - MPROMPT) * DM) : out + (size_t)row * DM) + col0;
#pragma unroll
                for (int bj = 0; bj < 2; ++bj)
#pragma unroll
                    for (int n = 0; n < 2; ++n) xv[m][bj][n] = *(const f32x4*)(xr + bj * HALF + n * 16); }
            EPI_FENCE;
#pragma unroll
            for (int m = 0; m < 4; ++m) { float* orow = out + (size_t)EPI_ROW(ai, m) * DM + col0;
#pragma unroll
                for (int bj = 0; bj < 2; ++bj)
#pragma unroll
                    for (int n = 0; n < 2; ++n) *(f32x4*)(orow + bj * HALF + n * 16) = xv[m][bj][n] + acc[ai][bj][m][n];
                EPI_FENCE; }
        }
    }
};

namespace att8 {
constexpr int NW = 8, QBLK = 32, KVBLK = 64;
constexpr float CL2 = 0.07216878364870322f * 1.4426950408889634f;
constexpr float QSC = CL2 * 8.0f;
constexpr float BIAS = 7.0f, THR = 1.5f;
constexpr int NB = 3, SZ_KN = 64 * 128, SZ_KR = 64 * 64, SZ_VT = 128 * 64;
constexpr int OFF_KN = 0, OFF_KR = OFF_KN + NB * SZ_KN, OFF_VT = OFF_KR + NB * SZ_KR, OFF_WS = OFF_VT + NB * SZ_VT, SHM_ATTN = OFF_WS + NW * 64 * 4;
typedef int v8i __attribute__((ext_vector_type(8)));
__device__ __forceinline__ int crow(int r, int hi) { return (r & 3) + 8 * (r >> 2) + 4 * hi; }
#define SBAR8() __builtin_amdgcn_sched_barrier(0)
__device__ __forceinline__ v8i ld2x16(const char* pa, const char* pb) { const v4u a = *reinterpret_cast<const v4u*>(pa), b = *reinterpret_cast<const v4u*>(pb); return (v8i){(int)a.x, (int)a.y, (int)a.z, (int)a.w, (int)b.x, (int)b.y, (int)b.z, (int)b.w}; }
#define MFMA8S(A, B, Cc) __builtin_amdgcn_mfma_scale_f32_32x32x64_f8f6f4(A, B, Cc, 0, 0, 0, 0x7C7C7C7C, 0, 0x7F7F7F7F)
#define MFMA8(A, B, Cc) __builtin_amdgcn_mfma_scale_f32_32x32x64_f8f6f4(A, B, Cc, 0, 0, 0, 0, 0, 0)

template <int VAR = 0>
__device__ __forceinline__ void attn_unit(const bf16* __restrict__ Qn, const bf16* __restrict__ Qr, const unsigned char* __restrict__ K8, const unsigned char* __restrict__ KR8,
                                          const unsigned char* __restrict__ V8T, bf16* __restrict__ Ob, int seq, const f32x2* __restrict__ rope, int qpos0, char* lds) {
  const int tid = opaque_tid(), wid = tid >> 6, lane = tid & 63, r32 = lane & 31, hi = lane >> 5;
  const int wv = __builtin_amdgcn_readfirstlane(wid);
  float* ws = (float*)(lds + OFF_WS) + wid * 64; float* li_l = ws; float* al_l = ws + 32;
  v8i qf[3];
  { const bf16* Qw = Qn + (long)(wid * QBLK + r32) * NQ;
#pragma unroll
    for (int ks = 0; ks < 2; ++ks) {
#pragma unroll
      for (int c = 0; c < 4; ++c) { const v4u raw = *reinterpret_cast<const v4u*>(Qw + 64 * ks + 32 * hi + 8 * c);
        qf[ks][2 * c] = (int)pk4_fp8(bflo(raw.x) * QSC, bfhi(raw.x) * QSC, bflo(raw.y) * QSC, bfhi(raw.y) * QSC);
        qf[ks][2 * c + 1] = (int)pk4_fp8(bflo(raw.z) * QSC, bfhi(raw.z) * QSC, bflo(raw.w) * QSC, bfhi(raw.w) * QSC); } }
    const bf16* Rw = Qr + (long)(wid * QBLK + r32) * NQ + 32 * hi;
    const f32x2* rp = rope + (qpos0 + wid * QBLK + r32) * 32 + 16 * hi;
#pragma unroll
    for (int c = 0; c < 4; ++c) { const v4u raw = *reinterpret_cast<const v4u*>(Rw + 8 * c);
      const f32x4 cs01 = *(const f32x4*)(rp + 4 * c), cs23 = *(const f32x4*)(rp + 4 * c + 2);
      float a0, a1, a2, a3, a4, a5, a6, a7;
      { const float x1 = bflo(raw.x), x2 = bfhi(raw.x); a0 = x1 * cs01[0] - x2 * cs01[1]; a1 = x2 * cs01[0] + x1 * cs01[1]; }
      { const float x1 = bflo(raw.y), x2 = bfhi(raw.y); a2 = x1 * cs01[2] - x2 * cs01[3]; a3 = x2 * cs01[2] + x1 * cs01[3]; }
      { const float x1 = bflo(raw.z), x2 = bfhi(raw.z); a4 = x1 * cs23[0] - x2 * cs23[1]; a5 = x2 * cs23[0] + x1 * cs23[1]; }
      { const float x1 = bflo(raw.w), x2 = bfhi(raw.w); a6 = x1 * cs23[2] - x2 * cs23[3]; a7 = x2 * cs23[2] + x1 * cs23[3]; }
      qf[2][2 * c] = (int)pk4_fp8(a0 * QSC, a1 * QSC, a2 * QSC, a3 * QSC); qf[2][2 * c + 1] = (int)pk4_fp8(a4 * QSC, a5 * QSC, a6 * QSC, a7 * QSC); } }
  const int dk_key = 8 * wv + (lane >> 3), dr_key = 16 * (wv & 3) + (lane >> 2), dv_d = 16 * wv + (lane >> 2);
  const unsigned char* gk = K8 + (long)dk_key * 1024 + (((lane & 7) ^ ((dk_key >> 1) & 7)) << 4);
  const unsigned char* gr = KR8 + (long)dr_key * 64 + (((lane & 3) ^ ((dr_key >> 2) & 3)) << 4);
  const unsigned char* gv = V8T + (long)dv_d * 64 + (((lane & 3) ^ ((dv_d >> 2) & 3)) << 4);
  LAS unsigned char* ldsa = (LAS unsigned char*)lds;
#define DMA8(tk, bk, tv, bv) do { if constexpr (VAR & 8) break; \
    __builtin_amdgcn_global_load_lds((const unsigned*)(gk + (long)(tk) * (KVBLK * 1024)), (LAS unsigned*)(ldsa + OFF_KN + (bk) * SZ_KN + wv * 1024), 16, 0, 0); \
    __builtin_amdgcn_global_load_lds((const unsigned*)(gr + (long)(tk) * (KVBLK * 64)), (LAS unsigned*)(ldsa + OFF_KR + (bk) * SZ_KR + (wv & 3) * 1024), 16, 0, 0); \
    __builtin_amdgcn_global_load_lds((const unsigned*)(gv + (long)(tv) * (KVBLK * 1024)), (LAS unsigned*)(ldsa + OFF_VT + (bv) * SZ_VT + wv * 1024), 16, 0, 0); } while (0)
#define TBAR8() do { if constexpr (!(VAR & 8)) asm volatile("s_waitcnt vmcnt(3)" ::: "memory"); if constexpr (VAR & 16) break; asm volatile("s_waitcnt lgkmcnt(0)" ::: "memory"); __builtin_amdgcn_s_barrier(); asm volatile("" ::: "memory"); } while (0)
  const int g8 = (r32 >> 1) & 7, g4 = (r32 >> 2) & 3;
  const int kn0 = r32 * 128 + (((2 * hi) ^ g8) << 4), kn1 = r32 * 128 + (((2 * hi + 1) ^ g8) << 4);
  const int rv0 = r32 * 64 + (((2 * hi) ^ g4) << 4), rv1 = r32 * 64 + (((2 * hi + 1) ^ g4) << 4);
  float nm = BIAS, l_reg = 0.f;
  const f32x16 zero16 = {}; f32x16 o[4] = {};
  f32x16 nmv;
  _Pragma("unroll") for (int r = 0; r < 16; ++r) nmv[r] = nm; asm volatile("" : "+v"(nmv));
  const int NT = seq / KVBLK;
#define EXPR8(P, ra, rb) do { if constexpr (VAR & 2) break; _Pragma("unroll") for (int r = (ra); r < (rb); ++r) P[r] = __builtin_amdgcn_exp2f(P[r]); } while (0)
#define QKM8(A, B, Cc) ((VAR & 1) ? ({ f32x16 t_ = Cc; asm volatile("" : "+v"(t_) : "v"(A)); t_; }) : MFMA8S(A, B, Cc))
#define PVM8(A, B, Cc) ((VAR & 4) ? ({ f32x16 t_ = Cc; asm volatile("" : "+v"(t_) : "v"(B)); t_; }) : MFMA8(A, B, Cc))
#define CVT8(P, PK, base) _Pragma("unroll") for (int q = 0; q < 4; ++q) { int w_ = __builtin_amdgcn_cvt_pk_fp8_f32(P[4 * q], P[4 * q + 1], 0, false); w_ = __builtin_amdgcn_cvt_pk_fp8_f32(P[4 * q + 2], P[4 * q + 3], w_, true); PK[(base) + q] = w_; }
#define TRIP8(KB, VB, PKIN, PKOUT, DO_PV, FIRST) do { \
    const char* kn_ = lds + OFF_KN + (KB) * SZ_KN; const char* kr_ = lds + OFF_KR + (KB) * SZ_KR; const char* vt_ = lds + OFF_VT + (VB) * SZ_VT; \
    v8i f0 = ld2x16(kn_ + kn0, kn_ + kn1), f1 = ld2x16(kn_ + (kn0 ^ 64), kn_ + (kn1 ^ 64)), f2 = ld2x16(kr_ + rv0, kr_ + rv1); SBAR8(); \
    p0 = QKM8(f0, qf[0], nmv); f0 = ld2x16(kn_ + kn0 + 4096, kn_ + kn1 + 4096); SBAR8(); \
    p0 = QKM8(f1, qf[1], p0); f1 = ld2x16(kn_ + (kn0 ^ 64) + 4096, kn_ + (kn1 ^ 64) + 4096); SBAR8(); \
    p0 = QKM8(f2, qf[2], p0); f2 = ld2x16(kr_ + rv0 + 2048, kr_ + rv1 + 2048); SBAR8(); \
    p1 = QKM8(f0, qf[0], nmv); if constexpr (DO_PV) f0 = ld2x16(vt_ + rv0, vt_ + rv1); SBAR8(); \
    float mx0 = p0[0]; _Pragma("unroll") for (int r = 1; r < 16; ++r) mx0 = fmaxf(mx0, p0[r]); \
    EXPR8(p0, 0, 4); SBAR8(); \
    p1 = QKM8(f1, qf[1], p1); if constexpr (DO_PV) f1 = ld2x16(vt_ + rv0 + 2048, vt_ + rv1 + 2048); SBAR8(); \
    EXPR8(p0, 4, 10); SBAR8(); \
    p1 = QKM8(f2, qf[2], p1); if constexpr (DO_PV) f2 = ld2x16(vt_ + rv0 + 4096, vt_ + rv1 + 4096); SBAR8(); \
    EXPR8(p0, 10, 16); SBAR8(); \
    if constexpr (DO_PV) { o[0] = PVM8(PKIN, f0, o[0]); f0 = ld2x16(vt_ + rv0 + 6144, vt_ + rv1 + 6144); } SBAR8(); \
    f32x2 ps2 = {p0[0], p0[1]}; _Pragma("unroll") for (int r = 2; r < 16; r += 2) ps2 += (f32x2){p0[r], p0[r + 1]}; \
    if constexpr (!(FIRST)) { CVT8(p0, PKOUT, 0); } SBAR8(); \
    float mx1 = p1[0]; _Pragma("unroll") for (int r = 1; r < 16; ++r) mx1 = fmaxf(mx1, p1[r]); \
    EXPR8(p1, 0, 4); SBAR8(); \
    if constexpr (DO_PV) o[1] = PVM8(PKIN, f1, o[1]); SBAR8(); \
    EXPR8(p1, 4, 10); SBAR8(); \
    if constexpr (DO_PV) o[2] = PVM8(PKIN, f2, o[2]); SBAR8(); \
    EXPR8(p1, 10, 16); SBAR8(); \
    if constexpr (DO_PV) o[3] = PVM8(PKIN, f0, o[3]); SBAR8(); \
    float mx = fmaxf(mx0, mx1); \
    if ((FIRST) || !__all(mx <= BIAS + THR)) {                                  \
      { auto rr = __builtin_amdgcn_permlane32_swap(__float_as_uint(mx), __float_as_uint(mx), false, false); mx = fmaxf(__uint_as_float(rr[0]), __uint_as_float(rr[1])); } \
      const float delta = (FIRST) ? (mx - BIAS) : fmaxf(mx - BIAS, 0.f); \
      const float alpha = __builtin_amdgcn_exp2f(-delta); \
      nm -= delta; l_reg *= alpha; ps2 *= alpha; \
      _Pragma("unroll") for (int r = 0; r < 16; ++r) nmv[r] = nm; asm volatile("" : "+v"(nmv)); \
      _Pragma("unroll") for (int r = 0; r < 16; ++r) { p0[r] *= alpha; p1[r] *= alpha; } \
      CVT8(p0, PKOUT, 0); \
      if constexpr (!(FIRST)) { if (hi == 0) al_l[r32] = alpha; asm volatile("s_waitcnt lgkmcnt(0)" ::: "memory"); \
        _Pragma("unroll") for (int d = 0; d < 4; ++d) _Pragma("unroll") for (int r = 0; r < 16; ++r) o[d][r] *= al_l[crow(r, hi)]; } \
    } \
    _Pragma("unroll") for (int r = 0; r < 16; r += 2) ps2 += (f32x2){p1[r], p1[r + 1]}; \
    CVT8(p1, PKOUT, 4); \
    l_reg += ps2.x + ps2.y; } while (0)
  f32x16 p0, p1; v8i pkp, pkq;
#define TCL(t) ((t) < NT ? (t) : NT - 1)
  asm volatile("s_waitcnt vmcnt(0)" ::: "memory");
  DMA8(0, 0, 0, 0); DMA8(1, 1, 0, 0);
  TBAR8();
  DMA8(2, 2, 1, 1);
  TRIP8(0, 0, pkq, pkp, false, true);
  TBAR8();
  int kb = 1, vb = 0;
  for (int j = 1; j < NT; j += 2) {
    { const int kb2 = kb == 0 ? 2 : kb - 1, vb2 = vb == 0 ? 2 : vb - 1;
      DMA8(TCL(j + 2), kb2, TCL(j + 1), vb2);
      TRIP8(kb, vb, pkp, pkq, true, false);
      TBAR8(); vb = kb; kb = kb == 2 ? 0 : kb + 1; }
    if (j + 1 < NT) {
      const int kb2 = kb == 0 ? 2 : kb - 1, vb2 = vb == 0 ? 2 : vb - 1;
      DMA8(TCL(j + 3), kb2, TCL(j + 2), vb2);
      TRIP8(kb, vb, pkq, pkp, true, false);
      TBAR8(); vb = kb; kb = kb == 2 ? 0 : kb + 1;
    }
  }
  { const char* vt_ = lds + OFF_VT + vb * SZ_VT;
    const v8i v0_ = ld2x16(vt_ + rv0, vt_ + rv1), v1_ = ld2x16(vt_ + rv0 + 2048, vt_ + rv1 + 2048), v2_ = ld2x16(vt_ + rv0 + 4096, vt_ + rv1 + 4096), v3_ = ld2x16(vt_ + rv0 + 6144, vt_ + rv1 + 6144);
    o[0] = PVM8(pkq, v0_, o[0]); o[1] = PVM8(pkq, v1_, o[1]); o[2] = PVM8(pkq, v2_, o[2]); o[3] = PVM8(pkq, v3_, o[3]); }
#undef TCL
  { auto rr = __builtin_amdgcn_permlane32_swap(__float_as_uint(l_reg), __float_as_uint(l_reg), false, false); l_reg = __uint_as_float(rr[0]) + __uint_as_float(rr[1]); }
  if (hi == 0) li_l[r32] = l_reg; asm volatile("s_waitcnt lgkmcnt(0)" ::: "memory");
  float rli[16];
#pragma unroll
  for (int r = 0; r < 16; ++r) rli[r] = __builtin_amdgcn_rcpf(li_l[crow(r, hi)]);
  bf16* Ow = Ob + (long)(wid * QBLK) * 1024;
#pragma unroll
  for (int r = 0; r < 16; ++r) { const int orow = crow(r, hi);
#pragma unroll
    for (int d0 = 0; d0 < 4; ++d0) Ow[(long)orow * 1024 + d0 * 32 + r32] = (bf16)(cvtpk(o[d0][r] * rli[r], 0.f) & 0xffffu); }
  asm volatile("s_waitcnt vmcnt(0)" ::: "memory");
  __syncthreads();
#undef DMA8
#undef TBAR8
#undef TRIP8
#undef QKM8
#undef PVM8
#undef EXPR8
#undef CVT8
}
#undef MFMA8
}

namespace ml {
constexpr int PITCH = 288, TILE = 64 * PITCH;
constexpr int OFF_Q = 0, OFF_K = 2 * TILE, OFF_V = 4 * TILE;
constexpr int PPITCH = 144, OFF_P = 6 * TILE;
constexpr int OFF_SC = OFF_P + 64 * PPITCH;
constexpr int OFF_RSP = OFF_SC + 8 * 2 * 5 * 256;
constexpr int OFF_QN = OFF_RSP + 1024;
constexpr int OFF_NBF = OFF_QN + 256;
constexpr int OFF_CH = OFF_NBF + 512;
constexpr int LDS_END = OFF_CH + 5 * 1024;
static_assert(LDS_END <= MISC_OFF, "mLSTM LDS map");
__device__ __forceinline__ int rho(int t) { return (t & ~12) | ((t & 4) << 1) | ((t & 8) >> 1); }
typedef short v4i16_t __attribute__((ext_vector_type(4)));
__device__ __forceinline__ bf16x8 trfrag(LAS const unsigned char* tile, int tbase, int c0, int lane) {
    const int g = lane >> 4, li = lane & 15;
#if ML_FAST_TR
    const int q = li >> 2, p = li & 3;
    const s16x4 lo = __builtin_bit_cast(s16x4, __builtin_amdgcn_ds_read_tr16_b64_v4i16((LAS v4i16_t*)(tile + rho(tbase + 8 * g + q) * PITCH + (c0 + 4 * p) * 2)));
    const s16x4 hi = __builtin_bit_cast(s16x4, __builtin_amdgcn_ds_read_tr16_b64_v4i16((LAS v4i16_t*)(tile + rho(tbase + 8 * g + 4 + q) * PITCH + (c0 + 4 * p) * 2)));
    return (bf16x8){lo[0], lo[1], lo[2], lo[3], hi[0], hi[1], hi[2], hi[3]};
#else
    bf16x8 r;
#pragma unroll
    for (int i = 0; i < 8; ++i) r[i] = *(LAS const short*)(tile + rho(tbase + 8 * g + i) * PITCH + (c0 + li) * 2);
    return r;
#endif
}
__device__ __forceinline__ float logsigmoid(float x) { return fminf(x, 0.f) - log1pf(expf(-fabsf(x))); }

__device__ __forceinline__ void mlstm_item(LAS unsigned char* lds, const bf16* __restrict__ QM, const bf16* __restrict__ KM, const bf16* __restrict__ VM, const float* __restrict__ KRG, const float* __restrict__ BG,
                                           float* SCR, bf16* __restrict__ H, int row0, int S, int dir, int h) {
    const int tid = opaque_tid(), lane = tid & 63, w = __builtin_amdgcn_readfirstlane(tid >> 6), g = lane >> 4, li = lane & 15;
    const int NC = S / 64, hc = h * 128;
    const int srow = tid >> 3, scol = (tid & 7) * 16;
    LAS float* sc = (LAS float*)(lds + OFF_SC) + w * 640;
    LAS float* RSP = (LAS float*)(lds + OFF_RSP); LAS float* QNl = (LAS float*)(lds + OFF_QN);
#define ML_ROW(c, t) (dir ? (row0 + S - 1 - (64 * (c) + (t))) : (row0 + 64 * (c) + (t)))
    float* scr = SCR + ((size_t)(dir * 8 + h) * MTOK + row0) * 5;
    LAS float* CHG = (LAS float*)(lds + OFF_CH); LAS float* CHU = CHG + 256; LAS float* CHM = CHG + 512; LAS float* CHAO = CHG + 768; LAS float* CHAN = CHG + 1024;
    for (int c = w; c < NC; c += 8) {
        const float* gp = KRG + (size_t)ML_ROW(c, lane) * 96 + 64;
        const float li_ = gp[dir * 8 + h] + BG[dir * 8 + h], lf = logsigmoid(gp[16 + dir * 8 + h] + BG[16 + dir * 8 + h]);
        float bsum = lf;
#pragma unroll
        for (int o = 1; o < 64; o <<= 1) { const float v = __int_as_float(__builtin_amdgcn_ds_bpermute(((lane - o) & 63) << 2, __float_as_int(bsum))); if (lane >= o) bsum += v; }
        const float uu = li_ - bsum; float pm = uu;
#pragma unroll
        for (int o = 1; o < 64; o <<= 1) { const float v = __int_as_float(__builtin_amdgcn_ds_bpermute(((lane - o) & 63) << 2, __float_as_int(pm))); if (lane >= o) pm = fmaxf(pm, v); }
        float* sp = scr + (size_t)c * 320 + lane;
        sp[0] = uu; sp[64] = pm; sp[128] = bsum;
        if (lane == 63) { CHG[c] = bsum; CHU[c] = pm; }
    }
    __syncthreads();
    if (w == 0) {
        float m = 0.f;
        for (int c = 0; c < NC; ++c) { const float gch = CHG[c], um = CHU[c]; const float m_loc = gch + um, m_new = fmaxf(gch + m, m_loc);
            if (lane == 0) { CHM[c] = m; CHAO[c] = expf(gch + m - m_new); CHAN[c] = expf(m_loc - m_new); }
            m = m_new; }
    }
    __syncthreads();
    for (int c = w; c < NC; c += 8) {
        float* sp = scr + (size_t)c * 320 + lane;
        const float uu = sp[0], pm = sp[64], bsum = sp[128]; const float mp = CHM[c], um = CHU[c], an = CHAN[c];
        const float Mj = fmaxf(mp, pm);
        sp[64] = Mj; sp[128] = expf(uu - um) * an; sp[192] = expf(mp - Mj); sp[256] = expf(-(bsum + Mj));
    }
    asm volatile("s_waitcnt vmcnt(0)" ::: "memory");
    __syncthreads();
    f32x4 X[8]; f32x4 nst = {0.f, 0.f, 0.f, 0.f};
#pragma unroll
    for (int d = 0; d < 8; ++d) X[d] = (f32x4){0.f, 0.f, 0.f, 0.f};
    v4u stq[2], stk[2], stv[2]; float scv[5];
#define ML_LOAD(c) do { const size_t go = (size_t)ML_ROW(c, srow) * 1024 + hc + scol; \
        stq[0] = *(const v4u*)(QM + go); stq[1] = *(const v4u*)(QM + go + 8); stk[0] = *(const v4u*)(KM + go); stk[1] = *(const v4u*)(KM + go + 8); \
        stv[0] = *(const v4u*)(VM + go); stv[1] = *(const v4u*)(VM + go + 8); \
        _Pragma("unroll") for (int k_ = 0; k_ < 5; ++k_) scv[k_] = __hip_atomic_load(scr + (size_t)(c) * 320 + k_ * 64 + lane, __ATOMIC_RELAXED, __HIP_MEMORY_SCOPE_AGENT); } while (0)
#define ML_WRITE(b) do { const int lo_ = rho(srow) * PITCH + scol * 2; \
        *(LAS v4u*)(lds + OFF_Q + (b) * TILE + lo_) = stq[0]; *(LAS v4u*)(lds + OFF_Q + (b) * TILE + lo_ + 16) = stq[1]; \
        *(LAS v4u*)(lds + OFF_K + (b) * TILE + lo_) = stk[0]; *(LAS v4u*)(lds + OFF_K + (b) * TILE + lo_ + 16) = stk[1]; \
        *(LAS v4u*)(lds + OFF_V + (b) * TILE + lo_) = stv[0]; *(LAS v4u*)(lds + OFF_V + (b) * TILE + lo_ + 16) = stv[1]; \
        _Pragma("unroll") for (int k_ = 0; k_ < 5; ++k_) sc[((b) * 5 + k_) * 64 + lane] = scv[k_]; } while (0)
    ML_LOAD(0); ML_WRITE(0);
    if (tid < 64) ((LAS unsigned*)(lds + OFF_NBF))[tid] = 0u;
    for (int c = 0; c < NC; ++c) {
        const int b = c & 1;
        LAS const unsigned char* Qt = lds + OFF_Q + b * TILE; LAS const unsigned char* Kt = lds + OFF_K + b * TILE; LAS const unsigned char* Vt = lds + OFF_V + b * TILE;
        LAS const float* scb = sc + b * 320;
        { const int cn = (c + 1 < NC) ? c + 1 : c; ML_LOAD(cn); }
        const float a_old = CHAO[c];
        __syncthreads();
        {
            bf16x8 ka[2][4], qb_[2][4], na[4], nq[4];
#pragma unroll
            for (int tt = 0; tt < 2; ++tt) { const int tile = w * 2 + tt, lb = tile & 3, jb = tile >> 2;
#pragma unroll
                for (int ks = 0; ks < 4; ++ks) { ka[tt][ks] = *(LAS const bf16x8*)(Kt + rho(16 * lb + li) * PITCH + (32 * ks + 8 * g) * 2);
                    qb_[tt][ks] = *(LAS const bf16x8*)(Qt + rho(16 * jb + li) * PITCH + (32 * ks + 8 * g) * 2); } }
            { LAS const unsigned char* nb = lds + OFF_NBF + b * 256;
#pragma unroll
              for (int ks = 0; ks < 4; ++ks) { na[ks] = *(LAS const bf16x8*)(nb + (32 * ks + 8 * g) * 2); if (li != 0) na[ks] = (bf16x8){0, 0, 0, 0, 0, 0, 0, 0};
                  nq[ks] = *(LAS const bf16x8*)(Qt + rho(16 * (w & 3) + li) * PITCH + (32 * ks + 8 * g) * 2); } }
#pragma unroll
            for (int tt = 0; tt < 2; ++tt) {
                const int tile = w * 2 + tt, lb = tile & 3, jb = tile >> 2;
                const int j = 16 * jb + li, l0 = 16 * lb + 4 * g;
                f32x4 s = {0.f, 0.f, 0.f, 0.f};
#pragma unroll
                for (int ks = 0; ks < 4; ++ks) s = __builtin_amdgcn_mfma_f32_16x16x32_bf16(ka[tt][ks], qb_[tt][ks], s, 0, 0, 0);
                const f32x4 u4 = *(LAS const f32x4*)(scb + l0); const float Mj = scb[64 + j];
                float p[4]; float rs = 0.f;
#pragma unroll
                for (int r = 0; r < 4; ++r) { p[r] = (l0 + r <= j) ? s[r] * __expf(u4[r] - Mj) : 0.f; rs += p[r]; }
                *(LAS u32x2*)(lds + OFF_P + j * PPITCH + l0 * 2) = (u32x2){cvtpk(p[0], p[1]), cvtpk(p[2], p[3])};
                rs = sum_x16(rs); rs = sum_x32(rs);
                if (g == 0) RSP[j * 4 + lb] = rs;
            }
            { f32x4 s = {0.f, 0.f, 0.f, 0.f};
#pragma unroll
              for (int ks = 0; ks < 4; ++ks) s = __builtin_amdgcn_mfma_f32_16x16x32_bf16(na[ks], nq[ks], s, 0, 0, 0);
              if (g == 0) QNl[16 * (w & 3) + li] = s[0]; }
        }
        f32x4 Y[4];
        {
            bf16x8 ca[4];
#pragma unroll
            for (int ks = 0; ks < 4; ++ks) { v4u t; t.x = cvtpk(X[2 * ks][0], X[2 * ks][1]); t.y = cvtpk(X[2 * ks][2], X[2 * ks][3]); t.z = cvtpk(X[2 * ks + 1][0], X[2 * ks + 1][1]); t.w = cvtpk(X[2 * ks + 1][2], X[2 * ks + 1][3]);
                ca[ks] = __builtin_bit_cast(bf16x8, t); }
#pragma unroll
            for (int tb = 0; tb < 4; ++tb) {
                LAS const unsigned char* qrow = Qt + rho(16 * tb + li) * PITCH;
                v4u qq[4];
#pragma unroll
                for (int ks = 0; ks < 4; ++ks) { const u32x2 q0 = *(LAS const u32x2*)(qrow + (32 * ks + 4 * g) * 2), q1 = *(LAS const u32x2*)(qrow + (32 * ks + 16 + 4 * g) * 2); qq[ks] = (v4u){q0.x, q0.y, q1.x, q1.y}; }
                f32x4 y = {0.f, 0.f, 0.f, 0.f};
#pragma unroll
                for (int ks = 0; ks < 4; ++ks) y = __builtin_amdgcn_mfma_f32_16x16x32_bf16(ca[ks], __builtin_bit_cast(bf16x8, qq[ks]), y, 0, 0, 0);
                Y[tb] = y;
            }
        }
        __syncthreads();
        bf16x8 vf[2];
        vf[0] = trfrag(Vt, 0, 16 * w, lane); vf[1] = trfrag(Vt, 32, 16 * w, lane);
        {
            bf16x8 pb[4][2]; f32x4 rp[4]; float wi[4], qn[4], cl[4];
#pragma unroll
            for (int tb = 0; tb < 4; ++tb) { const int t = 16 * tb + li;
                pb[tb][0] = *(LAS const bf16x8*)(lds + OFF_P + t * PPITCH + (8 * g) * 2); pb[tb][1] = *(LAS const bf16x8*)(lds + OFF_P + t * PPITCH + (32 + 8 * g) * 2);
                rp[tb] = *(LAS const f32x4*)(RSP + t * 4); wi[tb] = scb[192 + t]; qn[tb] = QNl[t]; cl[tb] = scb[256 + t]; }
#pragma unroll
            for (int tb = 0; tb < 4; ++tb) {
                const int t = 16 * tb + li;
                f32x4 y = Y[tb] * wi[tb];
                y = __builtin_amdgcn_mfma_f32_16x16x32_bf16(vf[0], pb[tb][0], y, 0, 0, 0);
                y = __builtin_amdgcn_mfma_f32_16x16x32_bf16(vf[1], pb[tb][1], y, 0, 0, 0);
                const float den = (rp[tb][0] + rp[tb][1]) + (rp[tb][2] + rp[tb][3]) + wi[tb] * qn[tb];
                const float inv = __builtin_amdgcn_rcpf(fmaxf(fabsf(den), cl[tb]));
                const u32x2 o = {cvtpk(y[0] * inv, y[1] * inv), cvtpk(y[2] * inv, y[3] * inv)};
                *(u32x2*)(H + (size_t)ML_ROW(c, t) * 1024 + hc + 16 * w + 4 * g) = o;
            }
        }
        {
            bf16x8 vw[2]; bf16x8 wb[2];
#pragma unroll
            for (int ks = 0; ks < 2; ++ks) {
                const f32x4 w0 = *(LAS const f32x4*)(scb + 128 + 32 * ks + 8 * g), w1 = *(LAS const f32x4*)(scb + 128 + 32 * ks + 8 * g + 4);
                float wv[8] = {w0[0], w0[1], w0[2], w0[3], w1[0], w1[1], w1[2], w1[3]};
                const v4u vraw = __builtin_bit_cast(v4u, vf[ks]); v4u t, tw;
#pragma unroll
                for (int e = 0; e < 4; ++e) { t[e] = cvtpk(bflo(vraw[e]) * wv[2 * e], bfhi(vraw[e]) * wv[2 * e + 1]); tw[e] = (li == 0) ? cvtpk(wv[2 * e], wv[2 * e + 1]) : 0u; }
                vw[ks] = __builtin_bit_cast(bf16x8, t); wb[ks] = __builtin_bit_cast(bf16x8, tw);
            }
            bf16x8 kf[8][2], kn[2];
#pragma unroll
            for (int d = 0; d < 8; ++d) { kf[d][0] = trfrag(Kt, 0, 16 * d, lane); kf[d][1] = trfrag(Kt, 32, 16 * d, lane); }
            kn[0] = trfrag(Kt, 0, 16 * w, lane); kn[1] = trfrag(Kt, 32, 16 * w, lane);
#pragma unroll
            for (int d = 0; d < 8; ++d) {
                f32x4 x = X[d] * a_old;
                x = __builtin_amdgcn_mfma_f32_16x16x32_bf16(kf[d][0], vw[0], x, 0, 0, 0);
                x = __builtin_amdgcn_mfma_f32_16x16x32_bf16(kf[d][1], vw[1], x, 0, 0, 0);
                X[d] = x;
            }
            nst = nst * a_old;
            nst = __builtin_amdgcn_mfma_f32_16x16x32_bf16(kn[0], wb[0], nst, 0, 0, 0);
            nst = __builtin_amdgcn_mfma_f32_16x16x32_bf16(kn[1], wb[1], nst, 0, 0, 0);
            if (li == 0) *(LAS u32x2*)(lds + OFF_NBF + (b ^ 1) * 256 + (16 * w + 4 * g) * 2) = (u32x2){cvtpk(nst[0], nst[1]), cvtpk(nst[2], nst[3])};
        }
        ML_WRITE(b ^ 1);
    }
    __syncthreads();
#undef ML_ROW
#undef ML_LOAD
#undef ML_WRITE
}
}

constexpr int Q_ML_P = 4, Q_ML_S = 16, Q_AT_P = 128, Q_AT_S = 128, QLEN = Q_ML_P + Q_ML_S + Q_AT_P + Q_AT_S;
template <int AVAR = 0>
__device__ __forceinline__ void p_mixer(Frame& F, const float* bgl, int lq, unsigned xcc, bool ml_only = false, bool att_only = false) {
    unsigned char* ws = F.ws;
    int qsel = (int)(xcc & 7u), tried = 0;
    for (;;) {
        if (F.tid == 0) {
            int item = -1, qq = qsel, tr = tried;
            while (tr < 8) {
                const unsigned idx = __hip_atomic_fetch_add(F.ctl + CW_QUEUE + (lq * 8 + qq) * 64, 1u, __ATOMIC_RELAXED, __HIP_MEMORY_SCOPE_AGENT);
                if (idx < (unsigned)QLEN) { item = qq * 1024 + (int)idx; break; }
                qq = (qq + 1) & 7; ++tr;
            }
            F.MISC[0] = (unsigned)item; F.MISC[1] = (unsigned)qq; F.MISC[2] = (unsigned)tr;
        }
        __syncthreads();
        const int item = (int)F.MISC[0]; qsel = (int)F.MISC[1]; tried = (int)F.MISC[2];
        __syncthreads();
        if (item < 0) break;
        const int h = item >> 10, i = item & 1023;
#ifndef NO_ML
        if (i < Q_ML_P + Q_ML_S) {
            if (att_only) continue;
            int row0, S, dir;
            if (i < Q_ML_P) { row0 = (i >> 1) * SEQ_P; S = SEQ_P; dir = i & 1; }
            else { const int k = i - Q_ML_P; row0 = MPROMPT + (k >> 1) * SEQ_S; S = SEQ_S; dir = k & 1; }
            ml::mlstm_item(F.lds, (const bf16*)(ws + WS_QM), (const bf16*)(ws + WS_KM), (const bf16*)(ws + WS_VM), (const float*)(ws + WS_KRG), bgl,
                           (float*)(ws + WS_SCR), (bf16*)(ws + (dir ? WS_HBW : WS_HFW)), row0, S, dir, h);
        } else
#endif
#ifndef NO_ATT
        {
            int row0, S, qb;
            if (i < Q_ML_P + Q_ML_S + Q_AT_P) { const int k = i - (Q_ML_P + Q_ML_S); row0 = (k >> 6) * SEQ_P; S = SEQ_P; qb = k & 63; }
            else { const int k = i - (Q_ML_P + Q_ML_S + Q_AT_P); row0 = MPROMPT + (k >> 4) * SEQ_S; S = SEQ_S; qb = k & 15; }
            const size_t qrow = (size_t)(row0 + 256 * qb);
            if (ml_only) continue;
            att8::attn_unit<AVAR>((const bf16*)(ws + WS_Q) + qrow * NQ + h * 128, (const bf16*)(ws + WS_Q) + qrow * NQ + 1024 + h * 64,
                            ws + WS_K8 + (size_t)row0 * 1024 + h * 128, ws + WS_KR + (size_t)row0 * 64, ws + WS_V8T + ((size_t)(row0 >> 6) * 1024 + h * 128) * 64,
                            (bf16*)(ws + WS_CQKV) + qrow * 1024 + h * 128, S, (const f32x2*)(ws + WS_ROPE), 256 * qb, (char*)F.lds);
        }
#else
        {}
#endif
    }
}


constexpr int NPH = 1 + DEPTH * 10 + 1;
__global__ void __launch_bounds__(NWAVES * 64, 2) trunk_fwd(Args args) {
    extern __shared__ __attribute__((aligned(16))) unsigned char lds[];
    Frame F;
    F.lds = (LAS unsigned char*)lds; F.MISC = (volatile LAS unsigned*)(F.lds + MISC_OFF);
    F.tid = threadIdx.x; F.lane = F.tid & 63; F.wave = __builtin_amdgcn_readfirstlane(F.tid >> 6);
    F.G = gridDim.x; { const int bx = blockIdx.x; F.vcu = (F.G % 8 == 0) ? (bx % 8) * (F.G / 8) + bx / 8 : bx; }
    F.ws = args.ws; F.ctl = (gu32*)(args.ws + WS_CTL); F.out = args.out;
    for (int u = F.tid; u < (LDS_BYTES - MISC_OFF) / 4; u += NWAVES * 64) ((LAS unsigned*)(F.lds + MISC_OFF))[u] = 0u;
    __syncthreads();
    XcdBarrier bar; bar.bar = (unsigned*)(F.ctl + CW_BAR); bar.x = xb_xcc_id(); bar.st = F.MISC + 8;
#if !MK_PER_PHASE
    bar = xcd_barrier_post((unsigned*)(F.ctl + CW_BAR), F.MISC + 8);
#endif
    const unsigned xcc = bar.x;
    const int lo = args.ph_lo, hi = args.ph_hi;
#define IN(k) (lo <= (k) && (k) < hi)
#if MK_PER_PHASE
#define SEAM(k) do { } while (0)
#else
#define SEAM(k) do { if (IN(k) && IN((k) + 1)) xcd_barrier(bar); } while (0)
#endif
    unsigned char* ws = args.ws;
    if (IN(0)) { p_prologue(F, args); }
#if MK_PER_PHASE
    SEAM(0);
#endif
    for (int layer = 0; layer < DEPTH; ++layer) {
        const int p0 = 1 + layer * 10;
        asm volatile("" : "+s"(ws));
        F.ws = ws;
        const unsigned char* wl = ws + WS_W + (size_t)layer * LW;
        if (layer == 0 || F.G != 256) { if (IN(p0 + 0)) { p_norm(F, args, layer); } SEAM(p0 + 0); }
        if (IN(p0 + 1)) {
            { pg8::Gemm g{(const pg8::bf16_t*)(ws + WS_XN8), (const pg8::bf16_t*)(wl + W_P1A), MTOK, NP1A, DM / 2, DM / 2, DM / 2, SC_ONE, SC_M6}; pg8::StaticOrder S; S.init(MTOK, NP1A, F.G, (int)blockIdx.x);
              EpiP1a E{ws, WS_CQKV}; pg8::gemm_phase<EpiP1a, pg8::StaticOrder, true, true, true, SC_ONE, SC_M6>(F.lds, g, S, E);
            }
            { pg8::Gemm g{(const pg8::bf16_t*)(ws + WS_XN), (const pg8::bf16_t*)(wl + W_P1B), MTOK, NP1B, DM, DM, DM, SC_ONE, SC_ONE}; pg8::StaticOrder S; S.init(MTOK, NP1B, F.G, (int)blockIdx.x);
              EpiP1b E{ws}; pg8::gemm_phase<EpiP1b, pg8::StaticOrder, true, true>(F.lds, g, S, E); }
        } SEAM(p0 + 1);
        if (IN(p0 + 2)) {
            { pg8::Gemm g{(const pg8::bf16_t*)(ws + WS_CQKV), (const pg8::bf16_t*)(wl + W_UQ), MTOK, NQ, 256, 512, 256, SC_ONE, SC_M5}; pg8::StaticOrder S; S.init(MTOK, NQ, F.G, (int)blockIdx.x);
              EpiQ E{ws}; pg8::gemm_phase<EpiQ, pg8::StaticOrder, true, true, true, SC_ONE, SC_M5>(F.lds, g, S, E); }
            { pg8::Gemm g{(const pg8::bf16_t*)(ws + WS_CQKV + 512), (const pg8::bf16_t*)(wl + W_UKV), MTOK, 1024, 256, 512, 256, SC_ONE, SC_M5}; pg8::StaticOrder S; S.init(MTOK, 1024, F.G, (int)blockIdx.x);
              EpiK8 E{ws}; pg8::gemm_phase<EpiK8, pg8::StaticOrder, true, true, true, SC_ONE, SC_M5>(F.lds, g, S, E); }
            { pg8::Gemm g{(const pg8::bf16_t*)(wl + W_UKV + (size_t)1024 * 512), (const pg8::bf16_t*)(ws + WS_CQKV + 512), 1024, MTOK, 256, 256, 512, SC_M5, SC_ONE}; pg8::StaticOrder S; S.init(1024, MTOK, F.G, (int)blockIdx.x);
              EpiVT E{ws}; pg8::gemm_phase<EpiVT, pg8::StaticOrder, true, true, true, SC_M5, SC_ONE>(F.lds, g, S, E); }
        } SEAM(p0 + 2);
        if (IN(p0 + 3)) { p_mixer(F, args.in[IN_B_GATES] + layer * 32, layer, xcc); }
        SEAM(p0 + 3);
        if (IN(p0 + 4)) {
            { pg8::Gemm g{(const pg8::bf16_t*)(ws + WS_XN8), (const pg8::bf16_t*)(wl + W_P2A), MTOK, NP2A, DM / 2, DM / 2, DM / 2, SC_ONE, SC_M6}; pg8::StaticOrder S; S.init(MTOK, NP2A, F.G, (int)blockIdx.x);
              EpiP2a E{ws, WS_SGA}; pg8::gemm_phase<EpiP2a, pg8::StaticOrder, true, true, true, SC_ONE, SC_M6>(F.lds, g, S, E);
            }
            { pg8::Gemm g{(const pg8::bf16_t*)(ws + WS_XN), (const pg8::bf16_t*)(wl + W_P2B), MTOK, NP2B, DM, DM, DM, SC_ONE, SC_ONE}; pg8::StaticOrder S; S.init(MTOK, NP2B, F.G, (int)blockIdx.x);
              EpiP2b E{ws, layer}; pg8::gemm_phase<EpiP2b, pg8::StaticOrder, true, true>(F.lds, g, S, E); }
        } SEAM(p0 + 4);
        if (IN(p0 + 5)) {
            pg8::Gemm g1{(const pg8::bf16_t*)(ws + WS_HFW), (const pg8::bf16_t*)(wl + W_OB), MTOK, DM, 1024, 1024, 1024, 0x7F7F7F7F, 0x7F7F7F7F};
            pg8::Gemm g2{(const pg8::bf16_t*)(ws + WS_YA8), (const pg8::bf16_t*)(wl + W_OA), MTOK, DM, 512, 512, 512, SC_M6, SC_M5};
            pg8::StaticOrder S; S.init(MTOK, DM, F.G, (int)blockIdx.x);
            MidMerge Mm{ws}; EpiMerge2 E{ws}; pg8::gemm_chain<EpiMerge2, MidMerge, pg8::StaticOrder>(F.lds, g1, g2, S, Mm, E);
        } SEAM(p0 + 5);
        if (IN(p0 + 8)) {
            pg8::Gemm g{(const pg8::bf16_t*)(ws + WS_MG), (const pg8::bf16_t*)(wl + W_OUT), MTOK, DM, DM, DM, DM, 0x7F7F7F7F, 0x7F7F7F7F}; pg8::StaticOrder S; S.init(MTOK, DM, F.G, (int)blockIdx.x);
            if (F.G == 256) { S.wgm = 4;
                if (layer + 1 == DEPTH) { EpiOutX<true> E{args.in[IN_XP], args.in[IN_XS], F.out, ws, args.in[IN_NORM_F], layer}; pg8::gemm_phase<EpiOutX<true>, pg8::StaticOrder, true, true>(F.lds, g, S, E); }
                else { EpiOutX<false> E{args.in[IN_XP], args.in[IN_XS], F.out, ws, args.in[IN_NORM_IN] + (layer + 1) * DM, layer}; pg8::gemm_phase<EpiOutX<false>, pg8::StaticOrder, true, true>(F.lds, g, S, E); }
            } else { EpiOut E{args.in[IN_XP], args.in[IN_XS], F.out, layer}; pg8::gemm_phase<EpiOut, pg8::StaticOrder, true, true>(F.lds, g, S, E); }
        } if (layer + 1 < DEPTH || F.G != 256) SEAM(p0 + 8);
    }
    if (IN(NPH - 1) && F.G != 256) { p_final(F, args); }
#undef IN
#undef SEAM
}

extern "C" void kernel_launch(void* const* d_in, const int* in_sizes, int n_in, void* d_out, int out_size, void* d_ws, size_t ws_size, hipStream_t stream) {
    static int grid = 0;
    if (grid == 0) {
        if (n_in != 14 || in_sizes[0] != MPROMPT * DM || in_sizes[1] != MPROMPT * DM || out_size != MTOK * DM || ws_size < WS_END) {
            fprintf(stderr, "kernel_launch: shape mismatch (n_in %d, in0 %d, out %d, ws %zu, need %zu); nothing launched\n", n_in, n_in > 0 ? in_sizes[0] : -1, out_size, ws_size, (size_t)WS_END); grid = -1; return; }
        int dev = 0, cus = 0, per_cu = 0;
        if (hipGetDevice(&dev) != hipSuccess || hipDeviceGetAttribute(&cus, hipDeviceAttributeMultiprocessorCount, dev) != hipSuccess) { grid = -1; return; }
        if (hipFuncSetAttribute((const void*)trunk_fwd, hipFuncAttributeMaxDynamicSharedMemorySize, LDS_BYTES) != hipSuccess) { fprintf(stderr, "kernel_launch: hipFuncSetAttribute failed\n"); grid = -1; return; }
        if (hipOccupancyMaxActiveBlocksPerMultiprocessor(&per_cu, (const void*)trunk_fwd, NWAVES * 64, LDS_BYTES) != hipSuccess || per_cu < 1)
            fprintf(stderr, "kernel_launch: note: occupancy query reports %d workgroups per CU\n", per_cu);
        (void)hipGetLastError();
        grid = cus;
    }
    if (grid < 0) return;
    if (hipMemsetAsync((char*)d_ws + WS_CTL, 0, CTL_ZERO_BYTES, stream) != hipSuccess) return;
    Args a{};
    for (int i = 0; i < 14; ++i) a.in[i] = (const float*)d_in[i];
    a.out = (float*)d_out; a.ws = (unsigned char*)d_ws;
#if MK_PER_PHASE
    for (int p = 0; p < NPH; ++p) {
        if (p >= 1 && p < NPH - 1 && (((p - 1) % 10) == 9 || ((p - 1) % 10) == 6)) continue;
        a.ph_lo = p; a.ph_hi = p + 1;
        hipLaunchKernelGGL(trunk_fwd, dim3(grid), dim3(NWAVES * 64), LDS_BYTES, stream, a);
    }
#else
    a.ph_lo = 0; a.ph_hi = NPH;
    hipLaunchKernelGGL(trunk_fwd, dim3(grid), dim3(NWAVES * 64), LDS_BYTES, stream, a);
#endif
    const hipError_t le = hipPeekAtLastError();
    if (le != hipSuccess) fprintf(stderr, "kernel_launch: launch failed: %s\n", hipGetErrorName(le));
}
```

```cpp
#include <hip/hip_runtime.h>
#include <hip/hip_bf16.h>
#include <cstdio>
#include <cstdint>

#ifndef MK_PER_PHASE
#define MK_PER_PHASE 0
#endif
#ifndef ML_FAST_TR
#define ML_FAST_TR 1
#endif

namespace pg8 {
#define PG8_LAS __attribute__((address_space(3)))
typedef unsigned short bf16_t;
typedef short bf16x8 __attribute__((ext_vector_type(8)));
typedef float f32x4 __attribute__((ext_vector_type(4)));
typedef unsigned u32x4 __attribute__((ext_vector_type(4)));
constexpr int BM = 256, BK = 64, HALF = 128, HTB = HALF * BK * 2  , STAGE_BYTES = 8 * HTB, NXCD = 8, WGM = 8;

__host__ __device__ __forceinline__ int lds_byte(int r, int c) { const int st = (r >> 4) * 2 + (c >> 5), rr = r & 15, cc = c & 31, ob = rr * 64 + cc * 2; return st * 1024 + (ob ^ (((ob >> 9) & 1) << 5)); }
__host__ __device__ __forceinline__ void stage_rc(int b, int& R, int& C) { const int st = b / 1024, sb = b % 1024, swz = sb ^ (((sb >> 9) & 1) << 5); R = (st >> 1) * 16 + swz / 64; C = (st & 1) * 32 + (swz % 64) / 2; }
__host__ __device__ __forceinline__ int perm32(int rho) { const int n = rho >> 4, i = rho & 15; return 8 * (i >> 2) + 4 * n + (i & 3); }

__device__ __forceinline__ int fresh_tid() { int l; asm volatile("v_mbcnt_lo_u32_b32 %0, -1, 0\n\tv_mbcnt_hi_u32_b32 %0, -1, %0" : "=v"(l)); return (__builtin_amdgcn_readfirstlane((int)threadIdx.x >> 6) << 6) | l; }
struct Unit { int pm, pn; };
struct Gemm { const bf16_t* A; const bf16_t* Bt; int M, N, K, lda, ldb; int scA, scB; };
typedef int pg8_v4i __attribute__((ext_vector_type(4)));
typedef int pg8_v8i __attribute__((ext_vector_type(8)));
__device__ __forceinline__ pg8_v8i ld_frag8(const PG8_LAS unsigned char* p) {
    const bf16x8 lo = *(const PG8_LAS bf16x8*)p, hi = *(const PG8_LAS bf16x8*)(p + 16);
    return __builtin_bit_cast(pg8_v8i, __builtin_shufflevector(lo, hi, 0, 1, 2, 3, 4, 5, 6, 7, 8, 9, 10, 11, 12, 13, 14, 15)); }

struct StaticOrder {
    int nM, nN, nwg, G, c, wgm;
    __host__ __device__ void init(int M, int N, int G_, int c_) { nM = M / BM; nN = N / BM; nwg = nM * nN; G = G_; c = c_; wgm = WGM; }
    __host__ __device__ bool next(int i, Unit& u) const {
        const long L = (long)i * G + c; if (L >= nwg) return false;
        int wgid = (int)L; { const int q = nwg / NXCD, r = nwg % NXCD, xcd = wgid % NXCD, off = wgid / NXCD; wgid = (xcd < r ? xcd * (q + 1) : r * (q + 1) + (xcd - r) * q) + off; }
        const int nig = wgm * nN, gid = wgid / nig, fm = gid * wgm, gsz = (nM - fm) < wgm ? (nM - fm) : wgm;
        u.pm = fm + ((wgid % nig) % gsz); u.pn = (wgid % nig) / gsz; return true;
    }
    __device__ __forceinline__ void a_ready(const Unit&) const {}
    __device__ __forceinline__ void done(const Unit&) const {}
};

typedef float cvt_f32x2 __attribute__((ext_vector_type(2))); typedef __bf16 cvt_bf16x2 __attribute__((ext_vector_type(2)));
__device__ __forceinline__ unsigned cvt_pk_bf16(float lo, float hi) { return __builtin_bit_cast(unsigned, __builtin_convertvector((cvt_f32x2){lo, hi}, cvt_bf16x2)); }
typedef float f32x2 __attribute__((ext_vector_type(2)));
template <class Epi, class Sched, bool ALIGN_EPI = false, bool SP2 = false, bool FP8 = false, int SCA = 0x7F7F7F7F, int SCB = 0x7F7F7F7F>
__device__ __forceinline__ void gemm_phase(PG8_LAS unsigned char* lds, const Gemm g, const Sched& S, const Epi& E) {
    const int tid = fresh_tid();
    const int wid = __builtin_amdgcn_readfirstlane(tid >> 6), lane = tid & 63, wr = wid >> 2, wc = wid & 3, fr = lane & 15, fq = lane >> 4;
    const int K = g.K, nt = K / BK;
    unsigned voffA[2], voffB[2];
    { int R, C; stage_rc(tid * 16, R, C); const int Rb = Epi::PERM == 2 ? (64 * (R >> 5) + 16 * ((R & 15) >> 2) + 4 * ((R >> 4) & 1) + (R & 3)) : Epi::PERM ? ((R & ~31) + perm32(R & 31)) : R;
        voffA[0] = (unsigned)(R * g.lda + C) * 2u; voffB[0] = (unsigned)(Rb * g.ldb + C) * 2u; voffA[1] = voffA[0] + (unsigned)(64 * g.lda) * 2u; voffB[1] = voffB[0] + (unsigned)((Epi::PERM == 2 ? 128 : 64) * g.ldb) * 2u; }
    const size_t kstep = (size_t)(BK * 2);
    const size_t hstepA = (size_t)HALF * g.lda * 2, hstepB = (size_t)(Epi::PERM == 2 ? 8 : HALF) * g.ldb * 2;
    const size_t tstepA = 2 * hstepA, tstepB = (size_t)BM * g.ldb * 2;
    const unsigned ldsw = (unsigned)wid * 1024u;
    const int aoff = lds_byte(wr * 64 + fr, FP8 ? fq * 16 : fq * 8), boff = lds_byte(wc * 32 + fr, FP8 ? fq * 16 : fq * 8);
#define PG8_SA(b, h) (((b) * 2 + (h)) * HTB)
#define PG8_SB(b, h) ((4 + (b) * 2 + (h)) * HTB)
#define PG8_STAGE(bufoff, gbase, voff) do { _Pragma("unroll") for (int _i = 0; _i < 2; ++_i) \
        __builtin_amdgcn_global_load_lds((const unsigned*)((const char*)(gbase) + (voff)[_i]), (PG8_LAS unsigned*)(lds + (bufoff) + ldsw + _i * 8192), 16, 0, 0); } while (0)
#define PG8_LDA(dst, b, h) do { if constexpr (FP8) { _Pragma("unroll") for (int m = 0; m < 4; ++m) dst##8[m] = ld_frag8(lds + PG8_SA(b, h) + aoff + m * 2048); } \
        else { _Pragma("unroll") for (int m = 0; m < 4; ++m) _Pragma("unroll") for (int k = 0; k < 2; ++k) dst[m][k] = *(const PG8_LAS bf16x8*)(lds + PG8_SA(b, h) + aoff + m * 2048 + k * 1024); } } while (0)
#define PG8_LDB(dst, b, h) do { if constexpr (FP8) { _Pragma("unroll") for (int n = 0; n < 2; ++n) dst##8[n] = ld_frag8(lds + PG8_SB(b, h) + boff + n * 2048); } \
        else { _Pragma("unroll") for (int n = 0; n < 2; ++n) _Pragma("unroll") for (int k = 0; k < 2; ++k) dst[n][k] = *(const PG8_LAS bf16x8*)(lds + PG8_SB(b, h) + boff + n * 2048 + k * 1024); } } while (0)
#define PG8_CAT8(x) __builtin_shufflevector(__builtin_bit_cast(pg8_v4i, (x)[0]), __builtin_bit_cast(pg8_v4i, (x)[1]), 0, 1, 2, 3, 4, 5, 6, 7)
#define PG8_MMA(ai, bj, At, Bt) do { __builtin_amdgcn_s_setprio(1); _Pragma("unroll") for (int m = 0; m < 4; ++m) _Pragma("unroll") for (int n = 0; n < 2; ++n) { \
        if constexpr (FP8) asm volatile("v_mfma_f32_16x16x128_f8f6f4 %0, %1, %2, %0" : "+v"(acc[ai][bj][m][n]) : "v"(Bt##8[n]), "v"(At##8[m]));     \
        else { _Pragma("unroll") for (int k = 0; k < 2; ++k) acc[ai][bj][m][n] = __builtin_amdgcn_mfma_f32_16x16x32_bf16(Bt[n][k], At[m][k], acc[ai][bj][m][n], 0, 0, 0); } } __builtin_amdgcn_s_setprio(0); } while (0)
#define PG8_WAIT_V(n) asm volatile("s_waitcnt vmcnt(" #n ")" ::: "memory")
#define PG8_WAIT_L(n) asm volatile("s_waitcnt lgkmcnt(" #n ")" ::: "memory")
#define PG8_BAR __builtin_amdgcn_s_barrier()
#define PG8_SCHED __builtin_amdgcn_sched_barrier(0)
    Unit cur, nxt; int ui = 0;
    if (!S.next(0, cur)) return;
    f32x4 acc[2][2][4][2];
#pragma unroll
    for (int a = 0; a < 2; ++a)
#pragma unroll
        for (int b = 0; b < 2; ++b)
#pragma unroll
            for (int m = 0; m < 4; ++m)
#pragma unroll
                for (int n = 0; n < 2; ++n) acc[a][b][m][n] = (f32x4){0.f, 0.f, 0.f, 0.f};
    bf16x8 At[4][2], B0[2][2], B1[2][2]; pg8_v8i At8[4], B08[2], B18[2];
    const char* cA = (const char*)g.A + (size_t)cur.pm * tstepA; const char* cB = (const char*)g.Bt + (size_t)cur.pn * tstepB;
    S.a_ready(cur);
    if constexpr (SP2) {
        PG8_STAGE(PG8_SB(0, 0), cB, voffB); PG8_STAGE(PG8_SB(0, 1), cB + hstepB, voffB); PG8_STAGE(PG8_SA(0, 0), cA, voffA); PG8_STAGE(PG8_SA(0, 1), cA + hstepA, voffA);
        if (wr == 1) PG8_BAR;
        PG8_WAIT_V(2); PG8_BAR;
        PG8_STAGE(PG8_SB(1, 0), cB + kstep, voffB); PG8_STAGE(PG8_SA(1, 0), cA + kstep, voffA); PG8_STAGE(PG8_SB(1, 1), cB + hstepB + kstep, voffB);
        PG8_WAIT_V(6); PG8_BAR;
    } else {
        PG8_STAGE(PG8_SB(0, 0), cB, voffB); PG8_STAGE(PG8_SA(0, 0), cA, voffA); PG8_STAGE(PG8_SB(0, 1), cB + hstepB, voffB); PG8_STAGE(PG8_SA(0, 1), cA + hstepA, voffA);
        if (wr == 1) PG8_BAR;
        PG8_WAIT_V(4); PG8_BAR;
        PG8_STAGE(PG8_SB(1, 0), cB + kstep, voffB); PG8_STAGE(PG8_SA(1, 0), cA + kstep, voffA); PG8_STAGE(PG8_SB(1, 1), cB + hstepB + kstep, voffB);
        PG8_WAIT_V(6); PG8_BAR;
    }
    for (;;) {
        const bool has_next = S.next(ui + 1, nxt);
        const char* nA = has_next ? (const char*)g.A + (size_t)nxt.pm * tstepA : cA; const char* nB = has_next ? (const char*)g.Bt + (size_t)nxt.pn * tstepB : cB;
        _Pragma("nounroll") for (int t = 0; t < nt; t += 2) {
            const bool last = (t == nt - 2);
            const char* a1 = cA + (size_t)(t + 1) * kstep;
            const char* a2 = last ? nA : cA + (size_t)(t + 2) * kstep; const char* b2 = last ? nB : cB + (size_t)(t + 2) * kstep;
            const char* a3 = a2 + kstep; const char* b3 = b2 + kstep;
            if (last && has_next) S.a_ready(nxt);
            if constexpr (SP2) {
            PG8_LDB(B0, 0, 0); PG8_LDB(B1, 0, 1); PG8_SCHED; PG8_LDA(At, 0, 0); PG8_STAGE(PG8_SA(1, 1), a1 + hstepA, voffA);
            PG8_WAIT_V(8); PG8_WAIT_L(0); PG8_BAR; PG8_MMA(0, 0, At, B0); PG8_MMA(0, 1, At, B1); PG8_BAR; PG8_SCHED;
            PG8_LDA(At, 0, 1); PG8_STAGE(PG8_SB(0, 0), b2, voffB); PG8_STAGE(PG8_SB(0, 1), b2 + hstepB, voffB); PG8_STAGE(PG8_SA(0, 0), a2, voffA);
            PG8_WAIT_V(8); PG8_WAIT_L(0); PG8_BAR; PG8_MMA(1, 0, At, B0); PG8_MMA(1, 1, At, B1); PG8_BAR; PG8_SCHED;
            PG8_LDB(B0, 1, 0); PG8_LDB(B1, 1, 1); PG8_SCHED; PG8_LDA(At, 1, 0); PG8_STAGE(PG8_SA(0, 1), a2 + hstepA, voffA);
            PG8_WAIT_V(8); PG8_WAIT_L(0); PG8_BAR; PG8_MMA(0, 0, At, B0); PG8_MMA(0, 1, At, B1); PG8_BAR; PG8_SCHED;
            PG8_LDA(At, 1, 1); PG8_STAGE(PG8_SB(1, 0), b3, voffB); PG8_STAGE(PG8_SB(1, 1), b3 + hstepB, voffB); PG8_STAGE(PG8_SA(1, 0), a3, voffA);
            PG8_WAIT_V(8); PG8_WAIT_L(0); PG8_BAR; PG8_MMA(1, 0, At, B0); PG8_MMA(1, 1, At, B1); PG8_BAR; PG8_SCHED;
            } else {
            PG8_LDB(B0, 0, 0); PG8_SCHED; PG8_LDA(At, 0, 0); PG8_STAGE(PG8_SA(1, 1), a1 + hstepA, voffA);
            PG8_WAIT_L(8); PG8_BAR; PG8_WAIT_L(0); PG8_MMA(0, 0, At, B0); PG8_BAR; PG8_SCHED;
            PG8_LDB(B1, 0, 1); PG8_STAGE(PG8_SB(0, 0), b2, voffB);
            PG8_BAR; PG8_WAIT_L(0); PG8_MMA(0, 1, At, B1); PG8_BAR;
            PG8_LDA(At, 0, 1); PG8_STAGE(PG8_SA(0, 0), a2, voffA);
            PG8_BAR; PG8_WAIT_L(0); PG8_MMA(1, 0, At, B0); PG8_BAR; PG8_SCHED;
            PG8_STAGE(PG8_SB(0, 1), b2 + hstepB, voffB);
            PG8_WAIT_V(6); PG8_BAR; PG8_MMA(1, 1, At, B1); PG8_BAR;
            PG8_LDB(B0, 1, 0); PG8_SCHED; PG8_LDA(At, 1, 0); PG8_STAGE(PG8_SA(0, 1), a2 + hstepA, voffA);
            PG8_WAIT_L(8); PG8_BAR; PG8_WAIT_L(0); PG8_MMA(0, 0, At, B0); PG8_BAR; PG8_SCHED;
            PG8_LDB(B1, 1, 1); PG8_STAGE(PG8_SB(1, 0), b3, voffB);
            PG8_BAR; PG8_WAIT_L(0); PG8_MMA(0, 1, At, B1); PG8_BAR;
            PG8_LDA(At, 1, 1); PG8_STAGE(PG8_SA(1, 0), a3, voffA);
            PG8_BAR; PG8_WAIT_L(0); PG8_MMA(1, 0, At, B0); PG8_BAR; PG8_SCHED;
            PG8_STAGE(PG8_SB(1, 1), b3 + hstepB, voffB);
            PG8_WAIT_V(6); PG8_BAR; PG8_MMA(1, 1, At, B1); PG8_BAR;
            }
        }
        if constexpr (FP8) asm volatile("s_nop 15\n\ts_nop 15" ::: "memory");
        if constexpr (ALIGN_EPI) { if (wr == 0) PG8_BAR; }
        if constexpr (!Epi::AFTER_DRAIN) { const int t2 = fresh_tid();
            E(acc, cur, t2 >> 8, (t2 >> 6) & 3, t2 & 15, (t2 >> 4) & 3); S.done(cur); }
        if (!has_next) break;
#pragma unroll
        for (int a = 0; a < 2; ++a)
#pragma unroll
            for (int b = 0; b < 2; ++b)
#pragma unroll
                for (int m = 0; m < 4; ++m)
#pragma unroll
                    for (int n = 0; n < 2; ++n) acc[a][b][m][n] = (f32x4){0.f, 0.f, 0.f, 0.f};
        cur = nxt; cA = nA; cB = nB; ++ui;
        if constexpr (ALIGN_EPI) { if (wr == 1) PG8_BAR; }
    }
    PG8_WAIT_V(0);
    if constexpr (!ALIGN_EPI) { if (wr == 0) PG8_BAR; }
    PG8_BAR;
    if constexpr (Epi::AFTER_DRAIN) { E.fused(acc, cur, wr, wc, fr, fq, lds, wid, lane); S.done(cur); }
#undef PG8_SA
#undef PG8_SB
#undef PG8_STAGE
#undef PG8_LDA
#undef PG8_LDB
#undef PG8_MMA
#undef PG8_CAT8
#undef PG8_WAIT_V
#undef PG8_WAIT_L
#undef PG8_BAR
#undef PG8_SCHED
}

template <class Epi, class Mid, class Sched>
__device__ __forceinline__ void gemm_chain(PG8_LAS unsigned char* lds, const Gemm g1, const Gemm g2, const Sched& S, const Mid& M, const Epi& E) {
    const int tid = fresh_tid();
    const int wid = __builtin_amdgcn_readfirstlane(tid >> 6), lane = tid & 63, wr = wid >> 2, wc = wid & 3, fr = lane & 15, fq = lane >> 4;
    const int nt1 = g1.K / BK, nt2 = g2.K / BK;
    const size_t kstep = (size_t)(BK * 2);
    const size_t hA1 = (size_t)HALF * g1.lda * 2, hB1 = (size_t)HALF * g1.ldb * 2, hA2 = (size_t)HALF * g2.lda * 2, hB2 = (size_t)HALF * g2.ldb * 2;
    const unsigned ldsw = (unsigned)wid * 1024u;
#define PC_OFFS(F8, LDA_, LDB_) const int t3_ = fresh_tid(); unsigned VA[2], VB[2]; \
        { int R, C; stage_rc(t3_ * 16, R, C); const int Rb = Epi::PERM ? ((R & ~31) + perm32(R & 31)) : R; \
          VA[0] = (unsigned)(R * (LDA_) + C) * 2u; VB[0] = (unsigned)(Rb * (LDB_) + C) * 2u; VA[1] = VA[0] + (unsigned)(64 * (LDA_)) * 2u; VB[1] = VB[0] + (unsigned)(64 * (LDB_)) * 2u; } \
        const int aoff = lds_byte((t3_ >> 8) * 64 + (t3_ & 15), ((t3_ >> 4) & 3) * ((F8) ? 16 : 8)), boff = lds_byte(((t3_ >> 6) & 3) * 32 + (t3_ & 15), ((t3_ >> 4) & 3) * ((F8) ? 16 : 8));
#define PC_SA(b, h) (((b) * 2 + (h)) * HTB)
#define PC_SB(b, h) ((4 + (b) * 2 + (h)) * HTB)
#define PC_STAGE(bufoff, gbase, v0, v1) do { \
        __builtin_amdgcn_global_load_lds((const unsigned*)((const char*)(gbase) + (v0)), (PG8_LAS unsigned*)(lds + (bufoff) + ldsw), 16, 0, 0); \
        __builtin_amdgcn_global_load_lds((const unsigned*)((const char*)(gbase) + (v1)), (PG8_LAS unsigned*)(lds + (bufoff) + ldsw + 8192), 16, 0, 0); } while (0)
#define PC_LDA(F8, b, h) do { if constexpr (F8) { _Pragma("unroll") for (int m = 0; m < 4; ++m) At8[m] = ld_frag8(lds + PC_SA(b, h) + aoff + m * 2048); } \
        else { _Pragma("unroll") for (int m = 0; m < 4; ++m) _Pragma("unroll") for (int k = 0; k < 2; ++k) At[m][k] = *(const PG8_LAS bf16x8*)(lds + PC_SA(b, h) + aoff + m * 2048 + k * 1024); } } while (0)
#define PC_LDB(F8, W, b, h) do { if constexpr (F8) { _Pragma("unroll") for (int n = 0; n < 2; ++n) B##W##8[n] = ld_frag8(lds + PC_SB(b, h) + boff + n * 2048); } \
        else { _Pragma("unroll") for (int n = 0; n < 2; ++n) _Pragma("unroll") for (int k = 0; k < 2; ++k) B##W[n][k] = *(const PG8_LAS bf16x8*)(lds + PC_SB(b, h) + boff + n * 2048 + k * 1024); } } while (0)
#define PC_MMA(F8, ai, bj, W) do { __builtin_amdgcn_s_setprio(1); _Pragma("unroll") for (int m = 0; m < 4; ++m) _Pragma("unroll") for (int n = 0; n < 2; ++n) { \
        if constexpr (F8) asm volatile("v_mfma_f32_16x16x128_f8f6f4 %0, %1, %2, %0" : "+v"(acc[ai][bj][m][n]) : "v"(B##W##8[n]), "v"(At8[m])); \
        else { _Pragma("unroll") for (int k = 0; k < 2; ++k) acc[ai][bj][m][n] = __builtin_amdgcn_mfma_f32_16x16x32_bf16(B##W[n][k], At[m][k], acc[ai][bj][m][n], 0, 0, 0); } } __builtin_amdgcn_s_setprio(0); } while (0)
#define PC_WAIT_V(n) asm volatile("s_waitcnt vmcnt(" #n ")" ::: "memory")
#define PC_WAIT_L(n) asm volatile("s_waitcnt lgkmcnt(" #n ")" ::: "memory")
#define PC_BAR __builtin_amdgcn_s_barrier()
#define PC_SCHED __builtin_amdgcn_sched_barrier(0)
#define PC_KLOOP(F8, cA_, cB_, nt_, LDA_, LDB_, HA, HB, nA_, nB_, NLDA_, NLDB_, NHA, NHB) { PC_OFFS(F8, LDA_, LDB_) \
        _Pragma("nounroll") for (int t = 0; t < (nt_); t += 2) { \
            const bool last = (t == (nt_) - 2); \
            const char* a1 = (cA_) + (size_t)(t + 1) * kstep; \
            const char* a2 = last ? (nA_) : (cA_) + (size_t)(t + 2) * kstep; const char* b2 = last ? (nB_) : (cB_) + (size_t)(t + 2) * kstep; \
            const char* a3 = a2 + kstep; const char* b3 = b2 + kstep; \
            unsigned sa0 = VA[0], sa1 = VA[1], sb0 = VB[0], sb1 = VB[1]; const size_t sha = last ? (NHA) : (HA), shb = last ? (NHB) : (HB); \
            if (last) { int R, C; stage_rc(t3_ * 16, R, C); const int Rb = Epi::PERM ? ((R & ~31) + perm32(R & 31)) : R; \
                sa0 = (unsigned)(R * (NLDA_) + C) * 2u; sb0 = (unsigned)(Rb * (NLDB_) + C) * 2u; sa1 = sa0 + (unsigned)(64 * (NLDA_)) * 2u; sb1 = sb0 + (unsigned)(64 * (NLDB_)) * 2u; } \
            PC_LDB(F8, 0, 0, 0); PC_LDB(F8, 1, 0, 1); PC_SCHED; PC_LDA(F8, 0, 0); PC_STAGE(PC_SA(1, 1), a1 + (HA), VA[0], VA[1]); \
            PC_WAIT_V(8); PC_WAIT_L(0); PC_BAR; PC_MMA(F8, 0, 0, 0); PC_MMA(F8, 0, 1, 1); PC_BAR; PC_SCHED; \
            PC_LDA(F8, 0, 1); PC_STAGE(PC_SB(0, 0), b2, sb0, sb1); PC_STAGE(PC_SB(0, 1), b2 + shb, sb0, sb1); PC_STAGE(PC_SA(0, 0), a2, sa0, sa1); \
            PC_WAIT_V(8); PC_WAIT_L(0); PC_BAR; PC_MMA(F8, 1, 0, 0); PC_MMA(F8, 1, 1, 1); PC_BAR; PC_SCHED; \
            PC_LDB(F8, 0, 1, 0); PC_LDB(F8, 1, 1, 1); PC_SCHED; PC_LDA(F8, 1, 0); PC_STAGE(PC_SA(0, 1), a2 + sha, sa0, sa1); \
            PC_WAIT_V(8); PC_WAIT_L(0); PC_BAR; PC_MMA(F8, 0, 0, 0); PC_MMA(F8, 0, 1, 1); PC_BAR; PC_SCHED; \
            PC_LDA(F8, 1, 1); PC_STAGE(PC_SB(1, 0), b3, sb0, sb1); PC_STAGE(PC_SB(1, 1), b3 + shb, sb0, sb1); PC_STAGE(PC_SA(1, 0), a3, sa0, sa1); \
            PC_WAIT_V(8); PC_WAIT_L(0); PC_BAR; PC_MMA(F8, 1, 0, 0); PC_MMA(F8, 1, 1, 1); PC_BAR; PC_SCHED; \
        } }
    Unit cur, nxt; int ui = 0;
    if (!S.next(0, cur)) return;
    f32x4 acc[2][2][4][2];
#pragma unroll
    for (int a = 0; a < 2; ++a)
#pragma unroll
        for (int b = 0; b < 2; ++b)
#pragma unroll
            for (int m = 0; m < 4; ++m)
#pragma unroll
                for (int n = 0; n < 2; ++n) acc[a][b][m][n] = (f32x4){0.f, 0.f, 0.f, 0.f};
    bf16x8 At[4][2], B0[2][2], B1[2][2]; pg8_v8i At8[4], B08[2], B18[2];
    const char* c1A = (const char*)g1.A + (size_t)cur.pm * 2 * hA1; const char* c1B = (const char*)g1.Bt + (size_t)cur.pn * 2 * hB1;
    { PC_OFFS(false, g1.lda, g1.ldb) (void)aoff; (void)boff;
    PC_STAGE(PC_SB(0, 0), c1B, VB[0], VB[1]); PC_STAGE(PC_SB(0, 1), c1B + hB1, VB[0], VB[1]); PC_STAGE(PC_SA(0, 0), c1A, VA[0], VA[1]); PC_STAGE(PC_SA(0, 1), c1A + hA1, VA[0], VA[1]);
    if (wr == 1) PC_BAR;
    PC_WAIT_V(2); PC_BAR;
    PC_STAGE(PC_SB(1, 0), c1B + kstep, VB[0], VB[1]); PC_STAGE(PC_SA(1, 0), c1A + kstep, VA[0], VA[1]); PC_STAGE(PC_SB(1, 1), c1B + hB1 + kstep, VB[0], VB[1]);
    PC_WAIT_V(6); PC_BAR; }
    for (;;) {
        const bool has_next = S.next(ui + 1, nxt);
        const char* c2A = (const char*)g2.A + (size_t)cur.pm * 2 * hA2; const char* c2B = (const char*)g2.Bt + (size_t)cur.pn * 2 * hB2;
        const char* n1A = has_next ? (const char*)g1.A + (size_t)nxt.pm * 2 * hA1 : c1A; const char* n1B = has_next ? (const char*)g1.Bt + (size_t)nxt.pn * 2 * hB1 : c1B;
        PC_KLOOP(false, c1A, c1B, nt1, g1.lda, g1.ldb, hA1, hB1, c2A, c2B, g2.lda, g2.ldb, hA2, hB2)
        { const int t2 = fresh_tid(); M(acc, cur, t2 >> 8, (t2 >> 6) & 3, t2 & 15, (t2 >> 4) & 3); }
        PC_KLOOP(true, c2A, c2B, nt2, g2.lda, g2.ldb, hA2, hB2, n1A, n1B, g1.lda, g1.ldb, hA1, hB1)
        asm volatile("s_nop 15\n\ts_nop 15" ::: "memory");
        if (wr == 0) PC_BAR;
        { const int t2 = fresh_tid(); E(acc, cur, t2 >> 8, (t2 >> 6) & 3, t2 & 15, (t2 >> 4) & 3); }
        if (!has_next) break;
#pragma unroll
        for (int a = 0; a < 2; ++a)
#pragma unroll
            for (int b = 0; b < 2; ++b)
#pragma unroll
                for (int m = 0; m < 4; ++m)
#pragma unroll
                    for (int n = 0; n < 2; ++n) acc[a][b][m][n] = (f32x4){0.f, 0.f, 0.f, 0.f};
        cur = nxt; c1A = n1A; c1B = n1B; ++ui;
        if (wr == 1) PC_BAR;
    }
    PC_WAIT_V(0);
    PC_BAR;
#undef PC_SA
#undef PC_SB
#undef PC_STAGE
#undef PC_LDA
#undef PC_LDB
#undef PC_MMA
#undef PC_WAIT_V
#undef PC_WAIT_L
#undef PC_BAR
#undef PC_SCHED
#undef PC_KLOOP
#undef PC_OFFS
}
}

constexpr int DM = 2048, DEPTH = 2;
constexpr int MTOK = 65536, MPROMPT = 32768, SEQ_P = 16384, SEQ_S = 4096;
constexpr int IN_COLS = 11360;
constexpr int NP1 = 4352, NP2 = 7168, NQ = 1536, NKV = 2048;
constexpr int SRC_CQ = 0, SRC_CKV = 512, SRC_KROPE = 1024, SRC_ZA = 1088, SRC_QM = 2112, SRC_KM = 3136, SRC_VM = 4160, SRC_OM = 5184, SRC_ZM = 6208, SRC_GATES = 7232, SRC_GA = 7264, SRC_GB = 9312;
constexpr float EPS = 1e-6f;
constexpr int NWAVES = 8;

constexpr size_t MiB = 1u << 20, U = 128 * MiB;
constexpr size_t WS_XN = 0;
constexpr size_t WS_CQKV = 2 * U;
constexpr size_t WS_QM = 3 * U, WS_KM = 4 * U, WS_VM = 5 * U;
constexpr size_t WS_Q = 6 * U;
constexpr size_t WS_KN = 6 * U + U / 2 * 3, WS_V = WS_KN + U;
constexpr size_t WS_KR = WS_V + U;
constexpr size_t WS_K8 = WS_KN, WS_V8T = WS_V;
constexpr size_t WS_HFW = 10 * U, WS_HBW = 11 * U;
constexpr size_t WS_MG = 3 * U;
constexpr size_t WS_SGA = 5 * U, WS_SGB = 7 * U;
constexpr size_t WS_W = 12 * U;
constexpr int NP1A = 1024, NP1B = 3328, NP2A = 3072, NP2B = 4096;
constexpr size_t W_P1A = 0, W_P1B = W_P1A + (size_t)NP1A * DM, W_P2A = W_P1B + (size_t)NP1B * DM * 2, W_P2B = W_P2A + (size_t)NP2A * DM, W_UQ = W_P2B + (size_t)NP2B * DM * 2,
                 W_UKV = W_UQ + (size_t)NQ * 512, W_OA = W_UKV + (size_t)NKV * 512, W_OB = W_OA + (size_t)DM * 1024, W_OUT = W_OB + (size_t)DM * 1024 * 2, LW = W_OUT + (size_t)DM * DM * 2;
constexpr int SC_ONE = 0x7F7F7F7F, SC_M6 = 0x79797979, SC_M5 = 0x7A7A7A7A;
constexpr size_t WS_ROPE = WS_W + 2 * LW;
constexpr size_t WS_KRG = WS_ROPE + 4 * MiB;
constexpr size_t WS_SSQ = WS_KRG + 24 * MiB;
constexpr size_t WS_SCR = WS_SSQ + 4 * MiB;
constexpr size_t WS_RSKV = WS_SCR + 20 * MiB;
constexpr size_t WS_SSF = WS_KR + 4 * MiB;
constexpr size_t WS_HG = WS_RSKV + 512 * 1024;
constexpr size_t WS_CTL = WS_RSKV + 1 * MiB, CTL_ZERO_BYTES = 1 * MiB;
constexpr size_t WS_XN8 = WS_CTL + CTL_ZERO_BYTES;
constexpr size_t WS_YA8 = WS_XN8 + U;
constexpr size_t WS_END = WS_YA8 + U / 2;
static_assert(LW % 256 == 0 && WS_END < 2040 * MiB, "d_ws map");
constexpr int CW_BAR = 4096;
constexpr int CW_PANEL = 32768;
constexpr int CW_QUEUE = 16384;

constexpr int LDS_BYTES = 163840;
constexpr int MISC_OFF = 159744;

#define GAS __attribute__((address_space(1)))
#define LAS __attribute__((address_space(3)))
typedef unsigned short bf16;
typedef unsigned v4u __attribute__((ext_vector_type(4)));
typedef float f32x4 __attribute__((ext_vector_type(4)));
typedef short bf16x8 __attribute__((ext_vector_type(8)));
typedef GAS unsigned gu32;
typedef GAS unsigned long long gu64;
#define RLX_AGENT __ATOMIC_RELAXED, __HIP_MEMORY_SCOPE_AGENT
#define LDS_WAIT() asm volatile("s_waitcnt lgkmcnt(0)" ::: "memory")
#define VM_WAIT() asm volatile("s_waitcnt vmcnt(0)" ::: "memory")
__device__ __forceinline__ unsigned long long rt() { return __builtin_amdgcn_s_memrealtime(); }
__device__ __forceinline__ unsigned f2bf(float f) { unsigned u = __builtin_bit_cast(unsigned, f); return (u + 0x7fffu + ((u >> 16) & 1u)) >> 16; }
__device__ __forceinline__ unsigned pk2(float lo, float hi) { return f2bf(lo) | (f2bf(hi) << 16); }

#define XB_TMO      128
#define XB_XCNT(j)  (256  + 64 * (j))
#define XB_XSUB(j)  (1280 + 64 * (j))
#define XB_XGEN(j)  (2304 + 64 * (j))
#define XB_TOP      3328
#define XB_TOPGEN   3392
#define XCD_BAR_WORDS 3456
#define XB_SPIN_CAP (1u << 18)

__device__ __forceinline__ unsigned xb_ld(unsigned* p)              { return __hip_atomic_load(p, __ATOMIC_RELAXED, __HIP_MEMORY_SCOPE_AGENT); }
__device__ __forceinline__ unsigned xb_add(unsigned* p, unsigned v) { return __hip_atomic_fetch_add(p, v, __ATOMIC_RELAXED, __HIP_MEMORY_SCOPE_AGENT); }
__device__ __forceinline__ unsigned xb_xcc_id() { return (unsigned)__builtin_amdgcn_s_getreg((3 << 11) | 20) & 0xFu; }
#define XB_SPIN(cond, bar) do { unsigned _sp = 0; while (cond) { __builtin_amdgcn_s_sleep(1); \
    if ((++_sp & 255u) == 0u) { if (xb_ld(&(bar)[XB_TMO])) break; if (_sp > XB_SPIN_CAP) { atomicAdd(&(bar)[XB_TMO], 1u); break; } } } } while (0)

struct XcdBarrier {
    unsigned* bar; unsigned x;
    volatile LAS unsigned* st;
};

__device__ __forceinline__ XcdBarrier xcd_barrier_post(unsigned* bar, volatile LAS unsigned* st) {
    XcdBarrier b; b.bar = bar; b.x = xb_xcc_id(); b.st = st;
    if (threadIdx.x == 0) (void)xb_add(&bar[XB_XCNT(b.x)], 1u);
    return b;
}
__device__ __forceinline__ void xcd_barrier_complete(unsigned* bar, unsigned x, unsigned& nloc, unsigned& nx) {
    const unsigned G = gridDim.x * gridDim.y * gridDim.z;
    unsigned sum, cnt, mine, sp = 0u;
    for (;;) {
        sum = 0u; cnt = 0u; mine = 0u;
#pragma unroll
        for (unsigned j = 0; j < 16; ++j) { const unsigned c = xb_ld(&bar[XB_XCNT(j)]); sum += c; cnt += (c > 0u) ? 1u : 0u; mine = (j == x) ? c : mine; }
        if (sum == G) break;
        __builtin_amdgcn_s_sleep(1);
        if ((++sp & 255u) == 0u) { if (xb_ld(&bar[XB_TMO])) break; if (sp > XB_SPIN_CAP) { atomicAdd(&bar[XB_TMO], 1u); break; } }
    }
    nloc = mine > 0u ? mine : 1u; nx = cnt > 0u ? cnt : 1u;
}

__device__ __forceinline__ void xcd_barrier(const XcdBarrier& b) {
    asm volatile("s_waitcnt vmcnt(0)" ::: "memory");
    __syncthreads();
    if (threadIdx.x == 0) {
        unsigned* bar = b.bar;
        __builtin_amdgcn_s_waitcnt(0);
        unsigned nloc = b.st[0], nx = b.st[1];
        if (nloc == 0u) { xcd_barrier_complete(bar, b.x, nloc, nx); b.st[0] = nloc; b.st[1] = nx; }
        const unsigned old = xb_add(&bar[XB_XSUB(b.x)], 1u);
        const unsigned gen = old / nloc;
        if (old + 1u == (gen + 1u) * nloc) {
            __builtin_amdgcn_fence(__ATOMIC_RELEASE, "agent");
            asm volatile("s_waitcnt vmcnt(0)" ::: "memory");
            const unsigned og = xb_add(&bar[XB_TOP], 1u);
            const unsigned tg = og / nx;
            if (og + 1u == (tg + 1u) * nx) xb_add(&bar[XB_TOPGEN], 1u);
            else XB_SPIN(xb_ld(&bar[XB_TOPGEN]) == tg, bar);
            __builtin_amdgcn_fence(__ATOMIC_ACQUIRE, "agent");
            xb_add(&bar[XB_XGEN(b.x)], 1u);
            asm volatile("s_waitcnt vmcnt(0)" ::: "memory");
        } else {
            XB_SPIN(xb_ld(&bar[XB_XGEN(b.x)]) == gen, bar);
            __builtin_amdgcn_fence(__ATOMIC_ACQUIRE, "agent");
            asm volatile("s_waitcnt vmcnt(0)" ::: "memory");
        }
    }
    __syncthreads();
}


typedef float f32x2 __attribute__((ext_vector_type(2)));
typedef float f32x8v __attribute__((ext_vector_type(8)));
typedef unsigned u32x2 __attribute__((ext_vector_type(2)));
typedef short s16x4 __attribute__((ext_vector_type(4)));
typedef float f32x16 __attribute__((ext_vector_type(16)));

typedef float cvt_f32x2 __attribute__((ext_vector_type(2))); typedef __bf16 cvt_bf16x2 __attribute__((ext_vector_type(2)));
__device__ __forceinline__ unsigned cvtpk(float lo, float hi) { return __builtin_bit_cast(unsigned, __builtin_convertvector((cvt_f32x2){lo, hi}, cvt_bf16x2)); }
__device__ __forceinline__ float bflo(unsigned w) { return __uint_as_float(w << 16); }
__device__ __forceinline__ float bfhi(unsigned w) { return __uint_as_float(w & 0xffff0000u); }
__device__ __forceinline__ float sigmoidf_(float x) { return __builtin_amdgcn_rcpf(1.0f + __expf(-x)); }
__device__ __forceinline__ float siluf_(float x) { return x * __builtin_amdgcn_rcpf(1.0f + __expf(-x)); }
template <int K> __device__ __forceinline__ float swz_xor(float v) { return __int_as_float(__builtin_amdgcn_ds_swizzle(__float_as_int(v), 0x1F | (K << 10))); }
__device__ __forceinline__ float sum_x16(float v) { const auto rr = __builtin_amdgcn_permlane16_swap(__float_as_uint(v), __float_as_uint(v), false, false); return __uint_as_float(rr[0]) + __uint_as_float(rr[1]); }
__device__ __forceinline__ float sum_x32(float v) { const auto rr = __builtin_amdgcn_permlane32_swap(__float_as_uint(v), __float_as_uint(v), false, false); return __uint_as_float(rr[0]) + __uint_as_float(rr[1]); }
__device__ __forceinline__ float wave_sum(float v) { v += swz_xor<1>(v); v += swz_xor<2>(v); v += swz_xor<4>(v); v += swz_xor<8>(v); v = sum_x16(v); return sum_x32(v); }
__device__ __forceinline__ unsigned pk4_fp8(float a, float b, float c, float d) {
    a = __builtin_amdgcn_fmed3f(a, -448.f, 448.f); b = __builtin_amdgcn_fmed3f(b, -448.f, 448.f); c = __builtin_amdgcn_fmed3f(c, -448.f, 448.f); d = __builtin_amdgcn_fmed3f(d, -448.f, 448.f);
    int w = __builtin_amdgcn_cvt_pk_fp8_f32(a, b, 0, false); w = __builtin_amdgcn_cvt_pk_fp8_f32(c, d, w, true); return (unsigned)w; }
__device__ __forceinline__ int opaque_tid() { return pg8::fresh_tid(); }
__device__ __forceinline__ int seq_pos(int m) { return m < MPROMPT ? (m & (SEQ_P - 1)) : (m & (SEQ_S - 1)); }

struct Frame {
    LAS unsigned char* lds;
    volatile LAS unsigned* MISC;
    gu32* ctl;
    int tid, lane, wave, vcu, G;
    unsigned char* ws;
    float* out;
};
enum { IN_XP = 0, IN_XS = 1, IN_NORM_IN = 2, IN_W_IN = 3, IN_B_GATES = 4, IN_Q_A_NORM = 5, IN_W_UQ = 6, IN_KV_A_NORM = 7, IN_W_UKV = 8, IN_W_OA = 9, IN_M_HEAD_NORM = 10, IN_W_OB = 11, IN_W_OUT = 12, IN_NORM_F = 13 };
struct Args { const float* in[14]; float* out; unsigned char* ws; int ph_lo, ph_hi; };

__device__ __forceinline__ int wmap(int kind, int n) {
    if (kind == 0) {
        if (n < 3072) return SRC_QM + n;
        if (n < 3136) { const int j = n - 3072; return SRC_KROPE + (j >> 1) + 32 * (j & 1); }
        if (n < 3168) return SRC_GATES + (n - 3136);
        return -1;
    }
    if (kind == 5) return n;
    if (kind == 1) {
        if (n < 2048) { const int t = n >> 8, w = n & 255; return (w < 128 ? SRC_OM : SRC_ZM) + t * 128 + (w & 127); }
        return SRC_GB + (n - 2048);
    }
    if (kind == 6) {
        if (n < 1024) return SRC_ZA + n;
        return SRC_GA + (n - 1024);
    }
    if (kind == 2) {
        if (n < 1024) return (n >> 7) * 192 + (n & 127);
        const int j = n - 1024, h = j >> 6, jj = j & 63; return h * 192 + 128 + (jj >> 1) + 32 * (jj & 1);
    }
    if (kind == 3) {
        if (n < 1024) return (n >> 7) * 256 + (n & 127);
        const int j = n - 1024; return (j >> 7) * 256 + 128 + (j & 127);
    }
    return n;
}
__device__ __forceinline__ void transpose_item(const float* W, int K, int srcN, bf16* WT, int Ndst, int kind, const float* kgain, LAS float* scr, int item, int lane) {
    const int nblk = Ndst / 32, kb = item / nblk, nb = item % nblk, k0 = 64 * kb, n0 = 32 * nb;
    const int n = n0 + (lane & 31); const int sc = wmap(kind, n);
    const float cs = (kind == 0 && n < 1024) ? 0.08838834764831845f : 1.0f;
    float tv[32];
#pragma unroll
    for (int i = 0; i < 32; ++i) { const int kk = 2 * i + (lane >> 5);
        float v = 0.f; if (sc >= 0) { v = W[(size_t)(k0 + kk) * srcN + sc] * cs; if (kgain) v *= kgain[k0 + kk]; }
        tv[i] = v; }
#pragma unroll
    for (int i = 0; i < 32; ++i) scr[(2 * i + (lane >> 5)) * 33 + (lane & 31)] = tv[i];
    LDS_WAIT(); asm volatile("" ::: "memory");
    const int c = lane & 7;
#pragma unroll
    for (int j = 0; j < 4; ++j) { const int nn = (lane >> 3) + 8 * j; const LAS float* s = scr + (8 * c) * 33 + nn;
        v4u o; o.x = pk2(s[0 * 33], s[1 * 33]); o.y = pk2(s[2 * 33], s[3 * 33]); o.z = pk2(s[4 * 33], s[5 * 33]); o.w = pk2(s[6 * 33], s[7 * 33]);
        *(GAS v4u*)(WT + (size_t)(n0 + nn) * K + k0 + 8 * c) = o; }
    LDS_WAIT(); asm volatile("" ::: "memory");
}
__device__ __forceinline__ void transpose_item8(const float* W, int K, int srcN, unsigned char* WT, int Ndst, int kind, const float* kgain, float wscale, LAS float* scr, int item, int lane) {
    const int nblk = Ndst / 32, kb = item / nblk, nb = item % nblk, k0 = 64 * kb, n0 = 32 * nb;
    const int n = n0 + (lane & 31); const int sc = wmap(kind, n);
    float tv[32];
#pragma unroll
    for (int i = 0; i < 32; ++i) { const int kk = 2 * i + (lane >> 5);
        float v = 0.f; if (sc >= 0) { v = W[(size_t)(k0 + kk) * srcN + sc] * wscale; if (kgain) v *= kgain[k0 + kk]; }
        tv[i] = v; }
#pragma unroll
    for (int i = 0; i < 32; ++i) scr[(2 * i + (lane >> 5)) * 33 + (lane & 31)] = tv[i];
    LDS_WAIT(); asm volatile("" ::: "memory");
    const int nn = lane >> 1, kh = (lane & 1) * 32; const LAS float* s = scr + kh * 33 + nn;
#pragma unroll
    for (int c = 0; c < 2; ++c) { v4u o;
        o.x = pk4_fp8(s[(16 * c + 0) * 33], s[(16 * c + 1) * 33], s[(16 * c + 2) * 33], s[(16 * c + 3) * 33]); o.y = pk4_fp8(s[(16 * c + 4) * 33], s[(16 * c + 5) * 33], s[(16 * c + 6) * 33], s[(16 * c + 7) * 33]);
        o.z = pk4_fp8(s[(16 * c + 8) * 33], s[(16 * c + 9) * 33], s[(16 * c + 10) * 33], s[(16 * c + 11) * 33]); o.w = pk4_fp8(s[(16 * c + 12) * 33], s[(16 * c + 13) * 33], s[(16 * c + 14) * 33], s[(16 * c + 15) * 33]);
        *(GAS v4u*)(WT + (size_t)(n0 + nn) * K + k0 + kh + 16 * c) = o; }
    LDS_WAIT(); asm volatile("" ::: "memory");
}
__device__ __forceinline__ void p_prologue(Frame& F, const Args& A) {
    const int tid_ = opaque_tid(), lane_ = tid_ & 63, wave_ = __builtin_amdgcn_readfirstlane(tid_ >> 6);
    LAS float* scr = (LAS float*)(F.lds + wave_ * 16384);
    const int gw = F.vcu * NWAVES + wave_, NGW = F.G * NWAVES;
    constexpr int I_P1A = (DM / 64) * (NP1A / 32), I_P1B = (DM / 64) * (NP1B / 32), I_P2A = (DM / 64) * (NP2A / 32), I_P2B = (DM / 64) * (NP2B / 32), I_UQ = (512 / 64) * (NQ / 32),
                  I_UKV = (512 / 64) * (NKV / 32), I_OA = (1024 / 64) * (DM / 32), I_OB = I_OA, I_OUT = (DM / 64) * (DM / 32), I_LAYER = I_P1A + I_P1B + I_P2A + I_P2B + I_UQ + I_UKV + I_OA + I_OB + I_OUT;
    for (int it = gw; it < DEPTH * I_LAYER; it += NGW) {
        const int l = it / I_LAYER; int r = it - l * I_LAYER;
        unsigned char* wb = F.ws + WS_W + (size_t)l * LW;
        const float* win = A.in[IN_W_IN] + (size_t)l * DM * IN_COLS;
        if (r < I_P1A) { transpose_item8(win, DM, IN_COLS, wb + W_P1A, NP1A, 5, nullptr, 64.f, scr, r, lane_); continue; } r -= I_P1A;
        if (r < I_P1B) { transpose_item(win, DM, IN_COLS, (bf16*)(wb + W_P1B), NP1B, 0, nullptr, scr, r, lane_); continue; } r -= I_P1B;
        if (r < I_P2A) { transpose_item8(win, DM, IN_COLS, wb + W_P2A, NP2A, 6, nullptr, 64.f, scr, r, lane_); continue; } r -= I_P2A;
        if (r < I_P2B) { transpose_item(win, DM, IN_COLS, (bf16*)(wb + W_P2B), NP2B, 1, nullptr, scr, r, lane_); continue; } r -= I_P2B;
        if (r < I_UQ) { transpose_item8(A.in[IN_W_UQ] + (size_t)l * 512 * NQ, 512, NQ, wb + W_UQ, NQ, 2, A.in[IN_Q_A_NORM] + l * 512, 32.f, scr, r, lane_); continue; } r -= I_UQ;
        if (r < I_UKV) { transpose_item8(A.in[IN_W_UKV] + (size_t)l * 512 * NKV, 512, NKV, wb + W_UKV, NKV, 3, A.in[IN_KV_A_NORM] + l * 512, 32.f, scr, r, lane_); continue; } r -= I_UKV;
        if (r < I_OA) { transpose_item8(A.in[IN_W_OA] + (size_t)l * 1024 * DM, 1024, DM, wb + W_OA, DM, 4, nullptr, 32.f, scr, r, lane_); continue; } r -= I_OA;
        if (r < I_OB) { transpose_item(A.in[IN_W_OB] + (size_t)l * 1024 * DM, 1024, DM, (bf16*)(wb + W_OB), DM, 4, nullptr, scr, r, lane_); continue; } r -= I_OB;
        transpose_item(A.in[IN_W_OUT] + (size_t)l * DM * DM, DM, DM, (bf16*)(wb + W_OUT), DM, 4, nullptr, scr, r, lane_);
    }
    for (int e = F.vcu * 512 + tid_; e < DEPTH * 1024; e += F.G * 512) ((float*)(F.ws + WS_HG))[e] = A.in[IN_M_HEAD_NORM][e];
    f32x2* rope = (f32x2*)(F.ws + WS_ROPE);
    for (int e = F.vcu * 512 + tid_; e < SEQ_P * 32; e += F.G * 512) {
        const int pos = e >> 5, i = e & 31;
        const float inv = powf(10000.0f, -(float)(2 * i) / 64.0f);
        const float ang = (float)pos * inv; float s, c; sincosf(ang, &s, &c);
        rope[e] = (f32x2){c, s};
    }
}

__device__ __forceinline__ const float* x_row(Frame& F, const Args& A, int layer, int m) {
    if (layer == 0) return m < MPROMPT ? A.in[IN_XP] + (size_t)m * DM : A.in[IN_XS] + (size_t)(m - MPROMPT) * DM;
    return F.out + (size_t)m * DM;
}
__device__ __forceinline__ void p_norm(Frame& F, const Args& A, int layer) {
    const int tid_ = opaque_tid(), lane_ = tid_ & 63, wave_ = __builtin_amdgcn_readfirstlane(tid_ >> 6);
    const int gw = F.vcu * NWAVES + wave_, NGW = F.G * NWAVES;
    const float* g = A.in[IN_NORM_IN] + layer * DM; bf16* XN = (bf16*)(F.ws + WS_XN);
    for (int m = gw; m < MTOK; m += NGW) {
        const GAS f32x4* xr = (const GAS f32x4*)x_row(F, A, layer, m) + lane_;
        f32x4 v[8]; float s = 0.f;
#pragma unroll
        for (int j = 0; j < 8; ++j) { v[j] = xr[64 * j]; s += (v[j].x * v[j].x + v[j].y * v[j].y) + (v[j].z * v[j].z + v[j].w * v[j].w); }
        const float rs = 1.0f / sqrtf(wave_sum(s) * (1.0f / DM) + EPS);
        GAS unsigned long long* o8 = (GAS unsigned long long*)(XN + (size_t)m * DM) + lane_;
#pragma unroll
        for (int j = 0; j < 8; ++j) { const f32x4 gg = *((const GAS f32x4*)g + lane_ + 64 * j);
            const float y0 = v[j].x * rs * gg.x, y1 = v[j].y * rs * gg.y, y2 = v[j].z * rs * gg.z, y3 = v[j].w * rs * gg.w;
            o8[64 * j] = (unsigned long long)cvtpk(y0, y1) | ((unsigned long long)cvtpk(y2, y3) << 32);
            ((GAS unsigned*)(F.ws + WS_XN8 + (size_t)m * DM))[lane_ + 64 * j] = pk4_fp8(y0, y1, y2, y3); }
    }
}
__device__ __forceinline__ void p_final(Frame& F, const Args& A) {
    const int tid_ = opaque_tid(), lane_ = tid_ & 63, wave_ = __builtin_amdgcn_readfirstlane(tid_ >> 6);
    const int gw = F.vcu * NWAVES + wave_, NGW = F.G * NWAVES;
    for (int m = gw; m < MTOK; m += NGW) {
        GAS f32x4* xr = (GAS f32x4*)(F.out + (size_t)m * DM) + lane_;
        f32x4 v[8]; float s = 0.f;
#pragma unroll
        for (int j = 0; j < 8; ++j) { v[j] = xr[64 * j]; s += (v[j].x * v[j].x + v[j].y * v[j].y) + (v[j].z * v[j].z + v[j].w * v[j].w); }
        const float rs = 1.0f / sqrtf(wave_sum(s) * (1.0f / DM) + EPS);
#pragma unroll
        for (int j = 0; j < 8; ++j) { const f32x4 gg = *((const GAS f32x4*)A.in[IN_NORM_F] + lane_ + 64 * j); xr[64 * j] = v[j] * rs * gg; }
    }
}

using pg8::Unit; using pg8::BM; using pg8::HALF;
#define EPI_ROWS_BEGIN  _Pragma("unroll") for (int ai = 0; ai < 2; ++ai) _Pragma("unroll") for (int m = 0; m < 4; ++m) { const int row = u.pm * BM + ai * HALF + wr * 64 + m * 16 + fr;
#define EPI_ROWS_END    asm volatile("" ::: "memory"); }
#define EPI_ROW(ai, m) (u.pm * BM + (ai) * HALF + wr * 64 + (m) * 16 + fr)
#define EPI_FENCE asm volatile("" ::: "memory")

struct EpiP1a {
    static constexpr int PERM = 2; static constexpr bool AFTER_DRAIN = false;
    unsigned char* ws; size_t dst;
    __device__ __forceinline__ void operator()(const f32x4 (&acc)[2][2][4][2], const Unit& u, int wr, int wc, int fr, int fq) const {
        const int pn = u.pn, col0 = pn * 256 + wc * 64 + 16 * fq;
        EPI_ROWS_BEGIN
            float s = 0.f; v4u w;
#pragma unroll
            for (int bj = 0; bj < 2; ++bj) { const f32x4 v0 = acc[ai][bj][m][0] * 0.015625f, v1 = acc[ai][bj][m][1] * 0.015625f;
                s += (v0[0] * v0[0] + v0[1] * v0[1]) + (v0[2] * v0[2] + v0[3] * v0[3]) + (v1[0] * v1[0] + v1[1] * v1[1]) + (v1[2] * v1[2] + v1[3] * v1[3]);
                w[2 * bj] = pk4_fp8(v0[0], v0[1], v0[2], v0[3]); w[2 * bj + 1] = pk4_fp8(v1[0], v1[1], v1[2], v1[3]); }
            *(v4u*)(ws + dst + (size_t)row * 1024 + col0) = w;
            s = sum_x16(s); s = sum_x32(s); if (fq == 0) ((float*)(ws + WS_SSQ))[(size_t)row * 16 + pn * 4 + wc] = s;
        EPI_ROWS_END
    }
};
struct EpiP1b {
    static constexpr bool PERM = true, AFTER_DRAIN = false;
    unsigned char* ws;
    __device__ __forceinline__ void operator()(const f32x4 (&acc)[2][2][4][2], const Unit& u, int wr, int wc, int fr, int fq) const {
        const int pn = u.pn;
        if (pn < 12) {
            bf16* base = (bf16*)(ws + WS_QM + (size_t)(pn >> 2) * U); const int col0 = (pn & 3) * 256 + wc * 32 + 8 * fq;
            EPI_ROWS_BEGIN
                bf16* rowp = base + (size_t)row * 1024 + col0;
#pragma unroll
                for (int bj = 0; bj < 2; ++bj) { const f32x4 v0 = acc[ai][bj][m][0], v1 = acc[ai][bj][m][1];
                    v4u w; w.x = cvtpk(v0[0], v0[1]); w.y = cvtpk(v0[2], v0[3]); w.z = cvtpk(v1[0], v1[1]); w.w = cvtpk(v1[2], v1[3]);
                    *(v4u*)(rowp + bj * HALF) = w; }
            EPI_ROWS_END
        } else if (wc < 2) {
#pragma unroll
            for (int ai = 0; ai < 2; ++ai) { f32x4 cs[4][2];
#pragma unroll
                for (int m = 0; m < 4; ++m) { const f32x2* rp = (const f32x2*)(ws + WS_ROPE) + seq_pos(EPI_ROW(ai, m)) * 32 + 16 * wc + 4 * fq; cs[m][0] = *(const f32x4*)rp; cs[m][1] = *(const f32x4*)(rp + 2); }
                EPI_FENCE;
#pragma unroll
                for (int m = 0; m < 4; ++m) { const f32x4 cs01 = cs[m][0], cs23 = cs[m][1]; const f32x4 a = acc[ai][0][m][0], b = acc[ai][0][m][1];
                    *(u32x2*)(ws + WS_KR + (size_t)EPI_ROW(ai, m) * 64 + 32 * wc + 8 * fq) = (u32x2){
                        pk4_fp8(a[0] * cs01[0] - a[1] * cs01[1], a[1] * cs01[0] + a[0] * cs01[1], a[2] * cs01[2] - a[3] * cs01[3], a[3] * cs01[2] + a[2] * cs01[3]),
                        pk4_fp8(b[0] * cs23[0] - b[1] * cs23[1], b[1] * cs23[0] + b[0] * cs23[1], b[2] * cs23[2] - b[3] * cs23[3], b[3] * cs23[2] + b[2] * cs23[3])};
                    EPI_FENCE; } }
        } else if (wc == 2) {
            EPI_ROWS_BEGIN
                float* gp = (float*)(ws + WS_KRG) + (size_t)row * 96 + 64 + 8 * fq;
                *(f32x4*)gp = acc[ai][0][m][0]; *(f32x4*)(gp + 4) = acc[ai][0][m][1];
            EPI_ROWS_END
        }
    }
};
struct EpiQ {
    static constexpr bool PERM = true, AFTER_DRAIN = false;
    unsigned char* ws;
    __device__ __forceinline__ void operator()(const f32x4 (&acc)[2][2][4][2], const Unit& u, int wr, int wc, int fr, int fq) const {
        const int col0 = u.pn * 256 + wc * 32 + 8 * fq;
#pragma unroll
        for (int ai = 0; ai < 2; ++ai) {
            f32x4 sq[4][2];
#pragma unroll
            for (int m = 0; m < 4; ++m) { const float* sp = (const float*)(ws + WS_SSQ) + (size_t)EPI_ROW(ai, m) * 16; sq[m][0] = *(const f32x4*)sp; sq[m][1] = *(const f32x4*)(sp + 4); }
            EPI_FENCE;
#pragma unroll
            for (int m = 0; m < 4; ++m) { const int row = EPI_ROW(ai, m); const f32x4 s0 = sq[m][0], s1 = sq[m][1];
                const float rs = 0.03125f / sqrtf(((s0[0] + s0[1]) + (s0[2] + s0[3]) + (s1[0] + s1[1]) + (s1[2] + s1[3])) * (1.0f / 512.0f) + EPS);
                bf16* rowp = (bf16*)(ws + WS_Q) + (size_t)row * NQ + col0;
#pragma unroll
                for (int bj = 0; bj < 2; ++bj) { const f32x4 v0 = acc[ai][bj][m][0] * rs, v1 = acc[ai][bj][m][1] * rs;
                    v4u w; w.x = cvtpk(v0[0], v0[1]); w.y = cvtpk(v0[2], v0[3]); w.z = cvtpk(v1[0], v1[1]); w.w = cvtpk(v1[2], v1[3]);
                    *(v4u*)(rowp + bj * HALF) = w; }
                EPI_FENCE; }
        }
    }
};
struct EpiK8 {
    static constexpr int PERM = 2; static constexpr bool AFTER_DRAIN = false;
    unsigned char* ws;
    __device__ __forceinline__ void operator()(const f32x4 (&acc)[2][2][4][2], const Unit& u, int wr, int wc, int fr, int fq) const {
        const int col0 = u.pn * 256 + wc * 64 + 16 * fq;
#pragma unroll
        for (int ai = 0; ai < 2; ++ai) {
            f32x4 sq[4][2];
#pragma unroll
            for (int m = 0; m < 4; ++m) { const float* sp = (const float*)(ws + WS_SSQ) + (size_t)EPI_ROW(ai, m) * 16 + 8; sq[m][0] = *(const f32x4*)sp; sq[m][1] = *(const f32x4*)(sp + 4); }
            EPI_FENCE;
#pragma unroll
            for (int m = 0; m < 4; ++m) { const int row = EPI_ROW(ai, m); const f32x4 s0 = sq[m][0], s1 = sq[m][1];
                const float rs = 0.03125f / sqrtf(((s0[0] + s0[1]) + (s0[2] + s0[3]) + (s1[0] + s1[1]) + (s1[2] + s1[3])) * (1.0f / 512.0f) + EPS);
                v4u w;
#pragma unroll
                for (int bj = 0; bj < 2; ++bj) { const f32x4 v0 = acc[ai][bj][m][0] * rs, v1 = acc[ai][bj][m][1] * rs;
                    w[2 * bj] = pk4_fp8(v0[0], v0[1], v0[2], v0[3]); w[2 * bj + 1] = pk4_fp8(v1[0], v1[1], v1[2], v1[3]); }
                *(v4u*)(ws + WS_K8 + (size_t)row * 1024 + col0) = w;
                EPI_FENCE; }
        }
    }
};
struct EpiVT {
    static constexpr int PERM = 2; static constexpr bool AFTER_DRAIN = false;
    unsigned char* ws;
    __device__ __forceinline__ void operator()(const f32x4 (&acc)[2][2][4][2], const Unit& u, int wr, int wc, int fr, int fq) const {
        const int tok0 = u.pn * 256 + wc * 64 + 16 * fq;
        const int J0 = 2 * fq, pos = 4 * (J0 & 3) + 16 * (J0 >> 2);
        f32x4 rq[2][2];
#pragma unroll
        for (int bj = 0; bj < 2; ++bj) { f32x4 sq[8][2];
#pragma unroll
            for (int e = 0; e < 8; ++e) { const float* sp = (const float*)(ws + WS_SSQ) + (size_t)(tok0 + 8 * bj + e) * 16 + 8; sq[e][0] = *(const f32x4*)sp; sq[e][1] = *(const f32x4*)(sp + 4); }
            EPI_FENCE;
#pragma unroll
            for (int e = 0; e < 8; ++e) { const f32x4 s0 = sq[e][0], s1 = sq[e][1];
                rq[bj][e >> 2][e & 3] = 0.03125f / sqrtf(((s0[0] + s0[1]) + (s0[2] + s0[3]) + (s1[0] + s1[1]) + (s1[2] + s1[3])) * (1.0f / 512.0f) + EPS); } }
        EPI_ROWS_BEGIN
            unsigned char* rowp = ws + WS_V8T + ((size_t)(tok0 >> 6) * 1024 + row) * 64 + pos;
            const f32x4 a0 = acc[ai][0][m][0] * rq[0][0], a1 = acc[ai][0][m][1] * rq[0][1], b0 = acc[ai][1][m][0] * rq[1][0], b1 = acc[ai][1][m][1] * rq[1][1];
            *(u32x2*)rowp = (u32x2){pk4_fp8(a0[0], a0[1], a0[2], a0[3]), pk4_fp8(b0[0], b0[1], b0[2], b0[3])};
            *(u32x2*)(rowp + 32) = (u32x2){pk4_fp8(a1[0], a1[1], a1[2], a1[3]), pk4_fp8(b1[0], b1[1], b1[2], b1[3])};
        EPI_ROWS_END
    }
};
struct EpiP2a {
    static constexpr int PERM = 2; static constexpr bool AFTER_DRAIN = false;
    unsigned char* ws; size_t sga;
    __device__ __forceinline__ void operator()(const f32x4 (&acc)[2][2][4][2], const Unit& u, int wr, int wc, int fr, int fq) const {
        const int pn = u.pn;
        if (pn < 4) {
            const int col0 = pn * 256 + wc * 64 + 16 * fq;
#pragma unroll
            for (int ai = 0; ai < 2; ++ai) { v4u ov[4][2];
#pragma unroll
              for (int m = 0; m < 4; ++m) { const bf16* orow = (const bf16*)(ws + WS_CQKV) + (size_t)EPI_ROW(ai, m) * 1024 + col0; ov[m][0] = *(const v4u*)orow; ov[m][1] = *(const v4u*)(orow + 8); }
              EPI_FENCE;
#pragma unroll
              for (int m = 0; m < 4; ++m) { const int row = EPI_ROW(ai, m); v4u w;
#pragma unroll
                for (int bj = 0; bj < 2; ++bj) { f32x4 v0 = acc[ai][bj][m][0] * 0.015625f, v1 = acc[ai][bj][m][1] * 0.015625f;
                    const v4u o = ov[m][bj];
#pragma unroll
                    for (int j = 0; j < 4; ++j) { v0[j] = 64.f * siluf_(v0[j]); v1[j] = 64.f * siluf_(v1[j]); }
                    v0[0] *= bflo(o.x); v0[1] *= bfhi(o.x); v0[2] *= bflo(o.y); v0[3] *= bfhi(o.y); v1[0] *= bflo(o.z); v1[1] *= bfhi(o.z); v1[2] *= bflo(o.w); v1[3] *= bfhi(o.w);
                    w[2 * bj] = pk4_fp8(v0[0], v0[1], v0[2], v0[3]); w[2 * bj + 1] = pk4_fp8(v1[0], v1[1], v1[2], v1[3]); }
                *(v4u*)(ws + WS_YA8 + (size_t)row * 1024 + col0) = w;
                EPI_FENCE; } }
        } else {
            const int col0 = (pn - 4) * 256 + wc * 64 + 16 * fq;
            EPI_ROWS_BEGIN
                bf16* rowp = (bf16*)(ws + sga) + (size_t)row * 2048 + col0;
#pragma unroll
                for (int bj = 0; bj < 2; ++bj) { f32x4 v0 = acc[ai][bj][m][0] * 0.015625f, v1 = acc[ai][bj][m][1] * 0.015625f;
#pragma unroll
                    for (int j = 0; j < 4; ++j) { v0[j] = sigmoidf_(v0[j]); v1[j] = sigmoidf_(v1[j]); }
                    v4u w; w.x = cvtpk(v0[0], v0[1]); w.y = cvtpk(v0[2], v0[3]); w.z = cvtpk(v1[0], v1[1]); w.w = cvtpk(v1[2], v1[3]);
                    *(v4u*)(rowp + 8 * bj) = w; }
            EPI_ROWS_END
        }
    }
};
struct EpiP2b {
    static constexpr bool PERM = true, AFTER_DRAIN = false;
    unsigned char* ws; int layer;
    __device__ __forceinline__ void operator()(const f32x4 (&acc)[2][2][4][2], const Unit& u, int wr_, int wc_, int fr_, int fq_) const {
        const int t_ = opaque_tid(), wr = t_ >> 8, wc = (t_ >> 6) & 3, fr = t_ & 15, fq = (t_ >> 4) & 3;
        const int pn = u.pn;
        if (pn < 8) {
            extern __shared__ __attribute__((aligned(16))) unsigned char lds[];
            LAS float* red = (LAS float*)((LAS unsigned char*)lds + 131072);
            const int colh = pn * 128 + wc * 32 + 8 * fq;
#pragma unroll
            for (int ai = 0; ai < 2; ++ai) { v4u ha[4], hb[4];
#pragma unroll
                for (int m = 0; m < 4; ++m) { const size_t off = (size_t)EPI_ROW(ai, m) * 1024 + colh; ha[m] = *(const v4u*)((const bf16*)(ws + WS_HFW) + off); hb[m] = *(const v4u*)((const bf16*)(ws + WS_HBW) + off); }
                EPI_FENCE;
#pragma unroll
                for (int m = 0; m < 4; ++m) { const v4u a = ha[m], b = hb[m]; float s = 0.f;
#pragma unroll
                    for (int e = 0; e < 4; ++e) { const float lo = bflo(a[e]) + bflo(b[e]), hi = bfhi(a[e]) + bfhi(b[e]); s += lo * lo + hi * hi; }
                    s = sum_x16(s); s = sum_x32(s);
                    if (fq == 0) red[(wr * 128 + ai * 64 + m * 16 + fr) * 4 + wc] = s; }
                EPI_FENCE; }
            LDS_WAIT(); __builtin_amdgcn_s_barrier(); asm volatile("" ::: "memory");
            const int t2_ = opaque_tid(), wr2 = t2_ >> 8, fr2 = t2_ & 15, colh2 = pn * 128 + ((t2_ >> 6) & 3) * 32 + 8 * ((t2_ >> 4) & 3);
#define EPI_ROW2(ai, m) (u.pm * BM + (ai) * HALF + wr2 * 64 + (m) * 16 + fr2)
            const float* gain = (const float*)(ws + WS_HG) + layer * 1024 + colh2; const f32x4 g0 = *(const f32x4*)gain, g1 = *(const f32x4*)(gain + 4);
#pragma unroll
            for (int ai = 0; ai < 2; ++ai)
#pragma unroll
              for (int mh = 0; mh < 2; ++mh) { v4u ha[2], hb[2];
#pragma unroll
                for (int mm = 0; mm < 2; ++mm) { const size_t off = (size_t)EPI_ROW2(ai, 2 * mh + mm) * 1024 + colh2; ha[mm] = *(const v4u*)((const bf16*)(ws + WS_HFW) + off); hb[mm] = *(const v4u*)((const bf16*)(ws + WS_HBW) + off); }
                EPI_FENCE;
#pragma unroll
                for (int mm = 0; mm < 2; ++mm) { const int m = 2 * mh + mm; const size_t off = (size_t)EPI_ROW2(ai, m) * 1024 + colh2;
                    const f32x4 pr = *(const LAS f32x4*)(red + (wr2 * 128 + ai * 64 + m * 16 + fr2) * 4);
                    const float rs = 1.0f / sqrtf(((pr[0] + pr[1]) + (pr[2] + pr[3])) * (1.0f / 128.0f) + EPS);
                    const v4u a = ha[mm], b = hb[mm];
                    const f32x4 o0 = acc[ai][0][m][0], o1 = acc[ai][0][m][1], z0 = acc[ai][1][m][0], z1 = acc[ai][1][m][1];
                    float y[8];
#pragma unroll
                    for (int e = 0; e < 4; ++e) { y[2 * e] = (bflo(a[e]) + bflo(b[e])) * rs; y[2 * e + 1] = (bfhi(a[e]) + bfhi(b[e])) * rs; }
#pragma unroll
                    for (int j = 0; j < 4; ++j) { y[j] *= g0[j] * sigmoidf_(o0[j]) * (z0[j] * sigmoidf_(z0[j])); y[4 + j] *= g1[j] * sigmoidf_(o1[j]) * (z1[j] * sigmoidf_(z1[j])); }
                    v4u w; w.x = cvtpk(y[0], y[1]); w.y = cvtpk(y[2], y[3]); w.z = cvtpk(y[4], y[5]); w.w = cvtpk(y[6], y[7]);
                    *(v4u*)((bf16*)(ws + WS_HFW) + off) = w;
                    EPI_FENCE; } }
        } else {
            const int col0 = (pn - 8) * 256 + wc * 32 + 8 * fq;
            EPI_ROWS_BEGIN
                bf16* rowp = (bf16*)(ws + WS_SGB) + (size_t)row * 2048 + col0;
#pragma unroll
                for (int bj = 0; bj < 2; ++bj) { f32x4 v0 = acc[ai][bj][m][0], v1 = acc[ai][bj][m][1];
#pragma unroll
                    for (int j = 0; j < 4; ++j) { v0[j] = sigmoidf_(v0[j]); v1[j] = sigmoidf_(v1[j]); }
                    v4u w; w.x = cvtpk(v0[0], v0[1]); w.y = cvtpk(v0[2], v0[3]); w.z = cvtpk(v1[0], v1[1]); w.w = cvtpk(v1[2], v1[3]);
                    *(v4u*)(rowp + bj * HALF) = w; }
            EPI_ROWS_END
        }
    }
};
struct MidMerge {
    unsigned char* ws;
    __device__ __forceinline__ void operator()(f32x4 (&acc)[2][2][4][2], const Unit& u, int wr, int wc, int fr, int fq) const {
        const int col0 = u.pn * 256 + wc * 32 + 8 * fq;
#pragma unroll
        for (int ai = 0; ai < 2; ++ai)
#pragma unroll
          for (int mh = 0; mh < 2; ++mh) {
            v4u ga[2][2], gb[2][2];
#pragma unroll
            for (int mm = 0; mm < 2; ++mm)
#pragma unroll
                for (int bj = 0; bj < 2; ++bj) { const size_t off = (size_t)EPI_ROW(ai, 2 * mh + mm) * DM + col0 + bj * HALF; ga[mm][bj] = *(const v4u*)((const bf16*)(ws + WS_SGA) + off); gb[mm][bj] = *(const v4u*)((const bf16*)(ws + WS_SGB) + off); }
            EPI_FENCE;
#pragma unroll
            for (int mm = 0; mm < 2; ++mm)
#pragma unroll
                for (int bj = 0; bj < 2; ++bj) { const int m = 2 * mh + mm; const v4u a = ga[mm][bj], b = gb[mm][bj]; float r[8];
#pragma unroll
                    for (int e = 0; e < 4; ++e) { r[2 * e] = 2048.f * bflo(b[e]) * __builtin_amdgcn_rcpf(fmaxf(bflo(a[e]), 9.094947e-13f)); r[2 * e + 1] = 2048.f * bfhi(b[e]) * __builtin_amdgcn_rcpf(fmaxf(bfhi(a[e]), 9.094947e-13f)); }
                    f32x4 v0 = acc[ai][bj][m][0], v1 = acc[ai][bj][m][1];
                    v0[0] *= r[0]; v0[1] *= r[1]; v0[2] *= r[2]; v0[3] *= r[3]; v1[0] *= r[4]; v1[1] *= r[5]; v1[2] *= r[6]; v1[3] *= r[7];
                    acc[ai][bj][m][0] = v0; acc[ai][bj][m][1] = v1; }
            EPI_FENCE;
          }
    }
};
struct EpiMerge2 {
    static constexpr bool PERM = true, AFTER_DRAIN = false;
    unsigned char* ws;
    __device__ __forceinline__ void operator()(const f32x4 (&acc)[2][2][4][2], const Unit& u, int wr, int wc, int fr, int fq) const {
        const int col0 = u.pn * 256 + wc * 32 + 8 * fq; bf16* T = (bf16*)(ws + WS_MG);
#pragma unroll
        for (int ai = 0; ai < 2; ++ai) {
            v4u gv[4][2];
#pragma unroll
            for (int m = 0; m < 4; ++m)
#pragma unroll
                for (int bj = 0; bj < 2; ++bj) gv[m][bj] = *(const v4u*)((const bf16*)(ws + WS_SGA) + (size_t)EPI_ROW(ai, m) * DM + col0 + bj * HALF);
            EPI_FENCE;
#pragma unroll
            for (int m = 0; m < 4; ++m) { const size_t off = (size_t)EPI_ROW(ai, m) * DM + col0;
#pragma unroll
                for (int bj = 0; bj < 2; ++bj) { f32x4 v0 = acc[ai][bj][m][0] * 0.00048828125f, v1 = acc[ai][bj][m][1] * 0.00048828125f; const v4u g = gv[m][bj];
                    v0[0] *= fmaxf(bflo(g.x), 9.094947e-13f); v0[1] *= fmaxf(bfhi(g.x), 9.094947e-13f); v0[2] *= fmaxf(bflo(g.y), 9.094947e-13f); v0[3] *= fmaxf(bfhi(g.y), 9.094947e-13f);
                    v1[0] *= fmaxf(bflo(g.z), 9.094947e-13f); v1[1] *= fmaxf(bfhi(g.z), 9.094947e-13f); v1[2] *= fmaxf(bflo(g.w), 9.094947e-13f); v1[3] *= fmaxf(bfhi(g.w), 9.094947e-13f);
                    v4u w; w.x = cvtpk(v0[0], v0[1]); w.y = cvtpk(v0[2], v0[3]); w.z = cvtpk(v1[0], v1[1]); w.w = cvtpk(v1[2], v1[3]);
                    *(v4u*)(T + off + bj * HALF) = w; }
                EPI_FENCE; }
        }
    }
};
template <bool LAST> struct EpiOutX {
    static constexpr bool PERM = true, AFTER_DRAIN = false;
    const float* xp; const float* xs; float* out; unsigned char* ws; const float* gn; int layer;
    __device__ __forceinline__ void operator()(f32x4 (&acc)[2][2][4][2], const Unit& u, int wr, int wc, int fr, int fq) const {
        extern __shared__ __attribute__((aligned(16))) unsigned char lds[];
        LAS float* red = (LAS float*)((LAS unsigned char*)lds + 131072);
        const int col0 = u.pn * 256 + wc * 32 + 8 * fq;
#pragma unroll
        for (int ai = 0; ai < 2; ++ai) {
            f32x4 xv[4][2][2];
#pragma unroll
            for (int m = 0; m < 4; ++m) { const int row = EPI_ROW(ai, m);
                const float* xr = (layer == 0 ? (row < MPROMPT ? xp + (size_t)row * DM : xs + (size_t)(row - MPROMPT) * DM) : out + (size_t)row * DM) + col0;
#pragma unroll
                for (int bj = 0; bj < 2; ++bj)
#pragma unroll
                    for (int n = 0; n < 2; ++n) xv[m][bj][n] = *(const f32x4*)(xr + bj * HALF + n * 4); }
            EPI_FENCE;
#pragma unroll
            for (int m = 0; m < 4; ++m) { float s = 0.f;
#pragma unroll
                for (int bj = 0; bj < 2; ++bj)
#pragma unroll
                    for (int n = 0; n < 2; ++n) { const f32x4 v = xv[m][bj][n] + acc[ai][bj][m][n]; acc[ai][bj][m][n] = v; s += (v[0] * v[0] + v[1] * v[1]) + (v[2] * v[2] + v[3] * v[3]); }
                s = sum_x16(s); s = sum_x32(s);
                if (fq == 0) red[(wr * 128 + ai * 64 + m * 16 + fr) * 4 + wc] = s; }
            EPI_FENCE;
        }
        LDS_WAIT(); __builtin_amdgcn_s_barrier(); asm volatile("" ::: "memory");
        const int t_ = opaque_tid();
        if (t_ < 256) { const int wr_t = t_ >> 7, rl = t_ & 127; const f32x4 pr = *(const LAS f32x4*)(red + (wr_t * 128 + rl) * 4);
            const int row_t = u.pm * BM + (rl >> 6) * HALF + wr_t * 64 + (rl & 63);
            __hip_atomic_store((float*)(ws + WS_SSF) + (size_t)row_t * 8 + u.pn, (pr[0] + pr[1]) + (pr[2] + pr[3]), __ATOMIC_RELAXED, __HIP_MEMORY_SCOPE_AGENT); }
        asm volatile("s_waitcnt vmcnt(0)" ::: "memory");
        __syncthreads();
        if (t_ == 0) { unsigned* cnt = (unsigned*)(ws + WS_CTL) + CW_PANEL + layer * 256 + u.pm;
            __hip_atomic_fetch_add(cnt, 1u, __ATOMIC_RELAXED, __HIP_MEMORY_SCOPE_AGENT);
            unsigned sp = 0; while (__hip_atomic_load(cnt, __ATOMIC_RELAXED, __HIP_MEMORY_SCOPE_AGENT) < 8u && ++sp < (1u << 22)) __builtin_amdgcn_s_sleep(1);
            __builtin_amdgcn_fence(__ATOMIC_ACQUIRE, "agent"); asm volatile("s_waitcnt vmcnt(0)" ::: "memory"); }
        __syncthreads();
        const int t2_ = opaque_tid(), wr2 = t2_ >> 8, fr2 = t2_ & 15, colb = u.pn * 256 + ((t2_ >> 6) & 3) * 32 + 8 * ((t2_ >> 4) & 3);
        f32x4 g[2][2];
#pragma unroll
        for (int bj = 0; bj < 2; ++bj) { g[bj][0] = *(const f32x4*)(gn + colb + bj * HALF); g[bj][1] = *(const f32x4*)(gn + colb + bj * HALF + 4); }
#pragma unroll
        for (int ai = 0; ai < 2; ++ai) { f32x4 sf[4][2];
#pragma unroll
            for (int m = 0; m < 4; ++m) { const float* sp = (const float*)(ws + WS_SSF) + (size_t)(u.pm * BM + ai * HALF + wr2 * 64 + m * 16 + fr2) * 8; sf[m][0] = *(const f32x4*)sp; sf[m][1] = *(const f32x4*)(sp + 4); }
            EPI_FENCE;
#pragma unroll
            for (int m = 0; m < 4; ++m) { const int row = u.pm * BM + ai * HALF + wr2 * 64 + m * 16 + fr2; const f32x4 a = sf[m][0], b = sf[m][1];
                const float rs = 1.0f / sqrtf((((a[0] + a[1]) + (a[2] + a[3])) + ((b[0] + b[1]) + (b[2] + b[3]))) * (1.0f / DM) + EPS);
                float* orow = out + (size_t)row * DM + colb;
#pragma unroll
                for (int bj = 0; bj < 2; ++bj) {
                    const f32x4 y0 = acc[ai][bj][m][0], y1 = acc[ai][bj][m][1]; const f32x4 n0 = y0 * rs * g[bj][0], n1 = y1 * rs * g[bj][1];
                    if constexpr (LAST) { *(f32x4*)(orow + bj * HALF) = n0; *(f32x4*)(orow + bj * HALF + 4) = n1; }
                    else { *(f32x4*)(orow + bj * HALF) = y0; *(f32x4*)(orow + bj * HALF + 4) = y1;
                        v4u w; w.x = cvtpk(n0[0], n0[1]); w.y = cvtpk(n0[2], n0[3]); w.z = cvtpk(n1[0], n1[1]); w.w = cvtpk(n1[2], n1[3]);
                        *(v4u*)((bf16*)(ws + WS_XN) + (size_t)row * DM + colb + bj * HALF) = w;
                        *(u32x2*)(ws + WS_XN8 + (size_t)row * DM + colb + bj * HALF) = (u32x2){pk4_fp8(n0[0], n0[1], n0[2], n0[3]), pk4_fp8(n1[0], n1[1], n1[2], n1[3])}; } }
                EPI_FENCE; } }
    }
};
struct EpiOut {
    static constexpr bool PERM = false, AFTER_DRAIN = false;
    const float* xp; const float* xs; float* out; int layer;
    __device__ __forceinline__ void operator()(const f32x4 (&acc)[2][2][4][2], const Unit& u, int wr, int wc, int fr, int fq) const {
        const int col0 = u.pn * 256 + wc * 32 + 4 * fq;
#pragma unroll
        for (int ai = 0; ai < 2; ++ai) {
            f32x4 xv[4][2][2];
#pragma unroll
            for (int m = 0; m < 4; ++m) { const int row = EPI_ROW(ai, m);
                const float* xr = (layer == 0 ? (row < MPROMPT ? xp + (size_t)row * DM : xs + (size_t)(row - MPROMPT) * DM) : out + (size_t)row * DM) + col0;
#pragma unroll
                for (int bj = 0; bj < 2; ++bj)
#pragma unroll
                    for (int n = 0; n < 2; ++n) xv[m][bj][n] = *(const f32x4*)(xr + bj * HALF + n * 16); }
            EPI_FENCE;
#pragma unroll
            for (int m = 0; m < 4; ++m) { float* orow = out + (size_t)EPI_ROW(ai, m) * DM + col0;
#pragma unroll
                for (int bj = 0; bj < 2; ++bj)
#pragma unroll
                    for (int n = 0; n < 2; ++n) *(f32x4*)(orow + bj * HALF + n * 16) = xv[m][bj][n] + acc[ai][bj][m][n];
                EPI_FENCE; }
        }
    }
};

namespace att8 {
constexpr int NW = 8, QBLK = 32, KVBLK = 64;
constexpr float CL2 = 0.07216878364870322f * 1.4426950408889634f;
constexpr float QSC = CL2 * 8.0f;
constexpr float BIAS = 7.0f, THR = 1.5f;
constexpr int NB = 3, SZ_KN = 64 * 128, SZ_KR = 64 * 64, SZ_VT = 128 * 64;
constexpr int OFF_KN = 0, OFF_KR = OFF_KN + NB * SZ_KN, OFF_VT = OFF_KR + NB * SZ_KR, OFF_WS = OFF_VT + NB * SZ_VT, SHM_ATTN = OFF_WS + NW * 64 * 4;
typedef int v8i __attribute__((ext_vector_type(8)));
__device__ __forceinline__ int crow(int r, int hi) { return (r & 3) + 8 * (r >> 2) + 4 * hi; }
#define SBAR8() __builtin_amdgcn_sched_barrier(0)
__device__ __forceinline__ v8i ld2x16(const char* pa, const char* pb) { const v4u a = *reinterpret_cast<const v4u*>(pa), b = *reinterpret_cast<const v4u*>(pb); return (v8i){(int)a.x, (int)a.y, (int)a.z, (int)a.w, (int)b.x, (int)b.y, (int)b.z, (int)b.w}; }
#define MFMA8S(A, B, Cc) __builtin_amdgcn_mfma_scale_f32_32x32x64_f8f6f4(A, B, Cc, 0, 0, 0, 0x7C7C7C7C, 0, 0x7F7F7F7F)
#define MFMA8(A, B, Cc) __builtin_amdgcn_mfma_scale_f32_32x32x64_f8f6f4(A, B, Cc, 0, 0, 0, 0, 0, 0)

template <int VAR = 0>
__device__ __forceinline__ void attn_unit(const bf16* __restrict__ Qn, const bf16* __restrict__ Qr, const unsigned char* __restrict__ K8, const unsigned char* __restrict__ KR8,
                                          const unsigned char* __restrict__ V8T, bf16* __restrict__ Ob, int seq, const f32x2* __restrict__ rope, int qpos0, char* lds) {
  const int tid = opaque_tid(), wid = tid >> 6, lane = tid & 63, r32 = lane & 31, hi = lane >> 5;
  const int wv = __builtin_amdgcn_readfirstlane(wid);
  float* ws = (float*)(lds + OFF_WS) + wid * 64; float* li_l = ws; float* al_l = ws + 32;
  v8i qf[3];
  { const bf16* Qw = Qn + (long)(wid * QBLK + r32) * NQ;
#pragma unroll
    for (int ks = 0; ks < 2; ++ks) {
#pragma unroll
      for (int c = 0; c < 4; ++c) { const v4u raw = *reinterpret_cast<const v4u*>(Qw + 64 * ks + 32 * hi + 8 * c);
        qf[ks][2 * c] = (int)pk4_fp8(bflo(raw.x) * QSC, bfhi(raw.x) * QSC, bflo(raw.y) * QSC, bfhi(raw.y) * QSC);
        qf[ks][2 * c + 1] = (int)pk4_fp8(bflo(raw.z) * QSC, bfhi(raw.z) * QSC, bflo(raw.w) * QSC, bfhi(raw.w) * QSC); } }
    const bf16* Rw = Qr + (long)(wid * QBLK + r32) * NQ + 32 * hi;
    const f32x2* rp = rope + (qpos0 + wid * QBLK + r32) * 32 + 16 * hi;
#pragma unroll
    for (int c = 0; c < 4; ++c) { const v4u raw = *reinterpret_cast<const v4u*>(Rw + 8 * c);
      const f32x4 cs01 = *(const f32x4*)(rp + 4 * c), cs23 = *(const f32x4*)(rp + 4 * c + 2);
      float a0, a1, a2, a3, a4, a5, a6, a7;
      { const float x1 = bflo(raw.x), x2 = bfhi(raw.x); a0 = x1 * cs01[0] - x2 * cs01[1]; a1 = x2 * cs01[0] + x1 * cs01[1]; }
      { const float x1 = bflo(raw.y), x2 = bfhi(raw.y); a2 = x1 * cs01[2] - x2 * cs01[3]; a3 = x2 * cs01[2] + x1 * cs01[3]; }
      { const float x1 = bflo(raw.z), x2 = bfhi(raw.z); a4 = x1 * cs23[0] - x2 * cs23[1]; a5 = x2 * cs23[0] + x1 * cs23[1]; }
      { const float x1 = bflo(raw.w), x2 = bfhi(raw.w); a6 = x1 * cs23[2] - x2 * cs23[3]; a7 = x2 * cs23[2] + x1 * cs23[3]; }
      qf[2][2 * c] = (int)pk4_fp8(a0 * QSC, a1 * QSC, a2 * QSC, a3 * QSC); qf[2][2 * c + 1] = (int)pk4_fp8(a4 * QSC, a5 * QSC, a6 * QSC, a7 * QSC); } }
  const int dk_key = 8 * wv + (lane >> 3), dr_key = 16 * (wv & 3) + (lane >> 2), dv_d = 16 * wv + (lane >> 2);
  const unsigned char* gk = K8 + (long)dk_key * 1024 + (((lane & 7) ^ ((dk_key >> 1) & 7)) << 4);
  const unsigned char* gr = KR8 + (long)dr_key * 64 + (((lane & 3) ^ ((dr_key >> 2) & 3)) << 4);
  const unsigned char* gv = V8T + (long)dv_d * 64 + (((lane & 3) ^ ((dv_d >> 2) & 3)) << 4);
  LAS unsigned char* ldsa = (LAS unsigned char*)lds;
#define DMA8(tk, bk, tv, bv) do { if constexpr (VAR & 8) break; \
    __builtin_amdgcn_global_load_lds((const unsigned*)(gk + (long)(tk) * (KVBLK * 1024)), (LAS unsigned*)(ldsa + OFF_KN + (bk) * SZ_KN + wv * 1024), 16, 0, 0); \
    __builtin_amdgcn_global_load_lds((const unsigned*)(gr + (long)(tk) * (KVBLK * 64)), (LAS unsigned*)(ldsa + OFF_KR + (bk) * SZ_KR + (wv & 3) * 1024), 16, 0, 0); \
    __builtin_amdgcn_global_load_lds((const unsigned*)(gv + (long)(tv) * (KVBLK * 1024)), (LAS unsigned*)(ldsa + OFF_VT + (bv) * SZ_VT + wv * 1024), 16, 0, 0); } while (0)
#define TBAR8() do { if constexpr (!(VAR & 8)) asm volatile("s_waitcnt vmcnt(3)" ::: "memory"); if constexpr (VAR & 16) break; asm volatile("s_waitcnt lgkmcnt(0)" ::: "memory"); __builtin_amdgcn_s_barrier(); asm volatile("" ::: "memory"); } while (0)
  const int g8 = (r32 >> 1) & 7, g4 = (r32 >> 2) & 3;
  const int kn0 = r32 * 128 + (((2 * hi) ^ g8) << 4), kn1 = r32 * 128 + (((2 * hi + 1) ^ g8) << 4);
  const int rv0 = r32 * 64 + (((2 * hi) ^ g4) << 4), rv1 = r32 * 64 + (((2 * hi + 1) ^ g4) << 4);
  float nm = BIAS, l_reg = 0.f;
  const f32x16 zero16 = {}; f32x16 o[4] = {};
  f32x16 nmv;
  _Pragma("unroll") for (int r = 0; r < 16; ++r) nmv[r] = nm; asm volatile("" : "+v"(nmv));
  const int NT = seq / KVBLK;
#define EXPR8(P, ra, rb) do { if constexpr (VAR & 2) break; _Pragma("unroll") for (int r = (ra); r < (rb); ++r) P[r] = __builtin_amdgcn_exp2f(P[r]); } while (0)
#define QKM8(A, B, Cc) ((VAR & 1) ? ({ f32x16 t_ = Cc; asm volatile("" : "+v"(t_) : "v"(A)); t_; }) : MFMA8S(A, B, Cc))
#define PVM8(A, B, Cc) ((VAR & 4) ? ({ f32x16 t_ = Cc; asm volatile("" : "+v"(t_) : "v"(B)); t_; }) : MFMA8(A, B, Cc))
#define CVT8(P, PK, base) _Pragma("unroll") for (int q = 0; q < 4; ++q) { int w_ = __builtin_amdgcn_cvt_pk_fp8_f32(P[4 * q], P[4 * q + 1], 0, false); w_ = __builtin_amdgcn_cvt_pk_fp8_f32(P[4 * q + 2], P[4 * q + 3], w_, true); PK[(base) + q] = w_; }
#define TRIP8(KB, VB, PKIN, PKOUT, DO_PV, FIRST) do { \
    const char* kn_ = lds + OFF_KN + (KB) * SZ_KN; const char* kr_ = lds + OFF_KR + (KB) * SZ_KR; const char* vt_ = lds + OFF_VT + (VB) * SZ_VT; \
    v8i f0 = ld2x16(kn_ + kn0, kn_ + kn1), f1 = ld2x16(kn_ + (kn0 ^ 64), kn_ + (kn1 ^ 64)), f2 = ld2x16(kr_ + rv0, kr_ + rv1); SBAR8(); \
    p0 = QKM8(f0, qf[0], nmv); f0 = ld2x16(kn_ + kn0 + 4096, kn_ + kn1 + 4096); SBAR8(); \
    p0 = QKM8(f1, qf[1], p0); f1 = ld2x16(kn_ + (kn0 ^ 64) + 4096, kn_ + (kn1 ^ 64) + 4096); SBAR8(); \
    p0 = QKM8(f2, qf[2], p0); f2 = ld2x16(kr_ + rv0 + 2048, kr_ + rv1 + 2048); SBAR8(); \
    p1 = QKM8(f0, qf[0], nmv); if constexpr (DO_PV) f0 = ld2x16(vt_ + rv0, vt_ + rv1); SBAR8(); \
    float mx0 = p0[0]; _Pragma("unroll") for (int r = 1; r < 16; ++r) mx0 = fmaxf(mx0, p0[r]); \
    EXPR8(p0, 0, 4); SBAR8(); \
    p1 = QKM8(f1, qf[1], p1); if constexpr (DO_PV) f1 = ld2x16(vt_ + rv0 + 2048, vt_ + rv1 + 2048); SBAR8(); \
    EXPR8(p0, 4, 10); SBAR8(); \
    p1 = QKM8(f2, qf[2], p1); if constexpr (DO_PV) f2 = ld2x16(vt_ + rv0 + 4096, vt_ + rv1 + 4096); SBAR8(); \
    EXPR8(p0, 10, 16); SBAR8(); \
    if constexpr (DO_PV) { o[0] = PVM8(PKIN, f0, o[0]); f0 = ld2x16(vt_ + rv0 + 6144, vt_ + rv1 + 6144); } SBAR8(); \
    f32x2 ps2 = {p0[0], p0[1]}; _Pragma("unroll") for (int r = 2; r < 16; r += 2) ps2 += (f32x2){p0[r], p0[r + 1]}; \
    if constexpr (!(FIRST)) { CVT8(p0, PKOUT, 0); } SBAR8(); \
    float mx1 = p1[0]; _Pragma("unroll") for (int r = 1; r < 16; ++r) mx1 = fmaxf(mx1, p1[r]); \
    EXPR8(p1, 0, 4); SBAR8(); \
    if constexpr (DO_PV) o[1] = PVM8(PKIN, f1, o[1]); SBAR8(); \
    EXPR8(p1, 4, 10); SBAR8(); \
    if constexpr (DO_PV) o[2] = PVM8(PKIN, f2, o[2]); SBAR8(); \
    EXPR8(p1, 10, 16); SBAR8(); \
    if constexpr (DO_PV) o[3] = PVM8(PKIN, f0, o[3]); SBAR8(); \
    float mx = fmaxf(mx0, mx1); \
    if ((FIRST) || !__all(mx <= BIAS + THR)) {                                  \
      { auto rr = __builtin_amdgcn_permlane32_swap(__float_as_uint(mx), __float_as_uint(mx), false, false); mx = fmaxf(__uint_as_float(rr[0]), __uint_as_float(rr[1])); } \
      const float delta = (FIRST) ? (mx - BIAS) : fmaxf(mx - BIAS, 0.f); \
      const float alpha = __builtin_amdgcn_exp2f(-delta); \
      nm -= delta; l_reg *= alpha; ps2 *= alpha; \
      _Pragma("unroll") for (int r = 0; r < 16; ++r) nmv[r] = nm; asm volatile("" : "+v"(nmv)); \
      _Pragma("unroll") for (int r = 0; r < 16; ++r) { p0[r] *= alpha; p1[r] *= alpha; } \
      CVT8(p0, PKOUT, 0); \
      if constexpr (!(FIRST)) { if (hi == 0) al_l[r32] = alpha; asm volatile("s_waitcnt lgkmcnt(0)" ::: "memory"); \
        _Pragma("unroll") for (int d = 0; d < 4; ++d) _Pragma("unroll") for (int r = 0; r < 16; ++r) o[d][r] *= al_l[crow(r, hi)]; } \
    } \
    _Pragma("unroll") for (int r = 0; r < 16; r += 2) ps2 += (f32x2){p1[r], p1[r + 1]}; \
    CVT8(p1, PKOUT, 4); \
    l_reg += ps2.x + ps2.y; } while (0)
  f32x16 p0, p1; v8i pkp, pkq;
#define TCL(t) ((t) < NT ? (t) : NT - 1)
  asm volatile("s_waitcnt vmcnt(0)" ::: "memory");
  DMA8(0, 0, 0, 0); DMA8(1, 1, 0, 0);
  TBAR8();
  DMA8(2, 2, 1, 1);
  TRIP8(0, 0, pkq, pkp, false, true);
  TBAR8();
#define STEP8(jj, M, PIN, POUT) do { DMA8(TCL((jj) + 2), ((M) + 2) % 3, TCL((jj) + 1), ((M) + 1) % 3); TRIP8((M), ((M) + 2) % 3, PIN, POUT, true, false); TBAR8(); } while (0)
  constexpr int vb = 0;
  { int j = 1;
    for (; j + 5 < NT; j += 6) {
      STEP8(j, 1, pkp, pkq); STEP8(j + 1, 2, pkq, pkp); STEP8(j + 2, 0, pkp, pkq); STEP8(j + 3, 1, pkq, pkp); STEP8(j + 4, 2, pkp, pkq); STEP8(j + 5, 0, pkq, pkp);
    }
    STEP8(j, 1, pkp, pkq); STEP8(j + 1, 2, pkq, pkp); STEP8(j + 2, 0, pkp, pkq);
  }
  { const char* vt_ = lds + OFF_VT + vb * SZ_VT;
    const v8i v0_ = ld2x16(vt_ + rv0, vt_ + rv1), v1_ = ld2x16(vt_ + rv0 + 2048, vt_ + rv1 + 2048), v2_ = ld2x16(vt_ + rv0 + 4096, vt_ + rv1 + 4096), v3_ = ld2x16(vt_ + rv0 + 6144, vt_ + rv1 + 6144);
    o[0] = PVM8(pkq, v0_, o[0]); o[1] = PVM8(pkq, v1_, o[1]); o[2] = PVM8(pkq, v2_, o[2]); o[3] = PVM8(pkq, v3_, o[3]); }
#undef TCL
  { auto rr = __builtin_amdgcn_permlane32_swap(__float_as_uint(l_reg), __float_as_uint(l_reg), false, false); l_reg = __uint_as_float(rr[0]) + __uint_as_float(rr[1]); }
  if (hi == 0) li_l[r32] = l_reg; asm volatile("s_waitcnt lgkmcnt(0)" ::: "memory");
  float rli[16];
#pragma unroll
  for (int r = 0; r < 16; ++r) rli[r] = __builtin_amdgcn_rcpf(li_l[crow(r, hi)]);
  bf16* Ow = Ob + (long)(wid * QBLK) * 1024;
#pragma unroll
  for (int r = 0; r < 16; ++r) { const int orow = crow(r, hi);
#pragma unroll
    for (int d0 = 0; d0 < 4; ++d0) Ow[(long)orow * 1024 + d0 * 32 + r32] = (bf16)(cvtpk(o[d0][r] * rli[r], 0.f) & 0xffffu); }
  asm volatile("s_waitcnt vmcnt(0)" ::: "memory");
  __syncthreads();
#undef DMA8
#undef TBAR8
#undef TRIP8
#undef QKM8
#undef PVM8
#undef EXPR8
#undef CVT8
}
#undef MFMA8
}

namespace ml {
constexpr int PITCH = 288, TILE = 64 * PITCH;
constexpr int OFF_Q = 0, OFF_K = 2 * TILE, OFF_V = 4 * TILE;
constexpr int PPITCH = 144, OFF_P = 6 * TILE;
constexpr int OFF_SC = OFF_P + 64 * PPITCH;
constexpr int OFF_RSP = OFF_SC + 8 * 2 * 5 * 256;
constexpr int OFF_QN = OFF_RSP + 1024;
constexpr int OFF_NBF = OFF_QN + 256;
constexpr int OFF_CH = OFF_NBF + 512;
constexpr int LDS_END = OFF_CH + 5 * 1024;
static_assert(LDS_END <= MISC_OFF, "mLSTM LDS map");
__device__ __forceinline__ int rho(int t) { return (t & ~12) | ((t & 4) << 1) | ((t & 8) >> 1); }
typedef short v4i16_t __attribute__((ext_vector_type(4)));
__device__ __forceinline__ bf16x8 trfrag(LAS const unsigned char* tile, int tbase, int c0, int lane) {
    const int g = lane >> 4, li = lane & 15;
#if ML_FAST_TR
    const int q = li >> 2, p = li & 3;
    const s16x4 lo = __builtin_bit_cast(s16x4, __builtin_amdgcn_ds_read_tr16_b64_v4i16((LAS v4i16_t*)(tile + rho(tbase + 8 * g + q) * PITCH + (c0 + 4 * p) * 2)));
    const s16x4 hi = __builtin_bit_cast(s16x4, __builtin_amdgcn_ds_read_tr16_b64_v4i16((LAS v4i16_t*)(tile + rho(tbase + 8 * g + 4 + q) * PITCH + (c0 + 4 * p) * 2)));
    return (bf16x8){lo[0], lo[1], lo[2], lo[3], hi[0], hi[1], hi[2], hi[3]};
#else
    bf16x8 r;
#pragma unroll
    for (int i = 0; i < 8; ++i) r[i] = *(LAS const short*)(tile + rho(tbase + 8 * g + i) * PITCH + (c0 + li) * 2);
    return r;
#endif
}
__device__ __forceinline__ float logsigmoid(float x) { return fminf(x, 0.f) - log1pf(expf(-fabsf(x))); }

__device__ __forceinline__ void mlstm_item(LAS unsigned char* lds, const bf16* __restrict__ QM, const bf16* __restrict__ KM, const bf16* __restrict__ VM, const float* __restrict__ KRG, const float* __restrict__ BG,
                                           float* SCR, bf16* __restrict__ H, int row0, int S, int dir, int h) {
    const int tid = opaque_tid(), lane = tid & 63, w = __builtin_amdgcn_readfirstlane(tid >> 6), g = lane >> 4, li = lane & 15;
    const int NC = S / 64, hc = h * 128;
    const int srow = tid >> 3, scol = (tid & 7) * 16;
    LAS float* sc = (LAS float*)(lds + OFF_SC) + w * 640;
    LAS float* RSP = (LAS float*)(lds + OFF_RSP); LAS float* QNl = (LAS float*)(lds + OFF_QN);
#define ML_ROW(c, t) (dir ? (row0 + S - 1 - (64 * (c) + (t))) : (row0 + 64 * (c) + (t)))
    float* scr = SCR + ((size_t)(dir * 8 + h) * MTOK + row0) * 5;
    LAS float* CHG = (LAS float*)(lds + OFF_CH); LAS float* CHU = CHG + 256; LAS float* CHM = CHG + 512; LAS float* CHAO = CHG + 768; LAS float* CHAN = CHG + 1024;
    for (int c = w; c < NC; c += 8) {
        const float* gp = KRG + (size_t)ML_ROW(c, lane) * 96 + 64;
        const float li_ = gp[dir * 8 + h] + BG[dir * 8 + h], lf = logsigmoid(gp[16 + dir * 8 + h] + BG[16 + dir * 8 + h]);
        float bsum = lf;
#pragma unroll
        for (int o = 1; o < 64; o <<= 1) { const float v = __int_as_float(__builtin_amdgcn_ds_bpermute(((lane - o) & 63) << 2, __float_as_int(bsum))); if (lane >= o) bsum += v; }
        const float uu = li_ - bsum; float pm = uu;
#pragma unroll
        for (int o = 1; o < 64; o <<= 1) { const float v = __int_as_float(__builtin_amdgcn_ds_bpermute(((lane - o) & 63) << 2, __float_as_int(pm))); if (lane >= o) pm = fmaxf(pm, v); }
        float* sp = scr + (size_t)c * 320 + lane;
        sp[0] = uu; sp[64] = pm; sp[128] = bsum;
        if (lane == 63) { CHG[c] = bsum; CHU[c] = pm; }
    }
    __syncthreads();
    if (w == 0) {
        float m = 0.f;
        for (int c = 0; c < NC; ++c) { const float gch = CHG[c], um = CHU[c]; const float m_loc = gch + um, m_new = fmaxf(gch + m, m_loc);
            if (lane == 0) { CHM[c] = m; CHAO[c] = expf(gch + m - m_new); CHAN[c] = expf(m_loc - m_new); }
            m = m_new; }
    }
    __syncthreads();
    for (int c = w; c < NC; c += 8) {
        float* sp = scr + (size_t)c * 320 + lane;
        const float uu = sp[0], pm = sp[64], bsum = sp[128]; const float mp = CHM[c], um = CHU[c], an = CHAN[c];
        const float Mj = fmaxf(mp, pm);
        sp[64] = Mj; sp[128] = expf(uu - um) * an; sp[192] = expf(mp - Mj); sp[256] = expf(-(bsum + Mj));
    }
    asm volatile("s_waitcnt vmcnt(0)" ::: "memory");
    __syncthreads();
    f32x4 X[8]; f32x4 nst = {0.f, 0.f, 0.f, 0.f};
#pragma unroll
    for (int d = 0; d < 8; ++d) X[d] = (f32x4){0.f, 0.f, 0.f, 0.f};
    v4u stq[2], stk[2], stv[2]; float scv[5];
#define ML_LOAD(c) do { const size_t go = (size_t)ML_ROW(c, srow) * 1024 + hc + scol; \
        stq[0] = *(const v4u*)(QM + go); stq[1] = *(const v4u*)(QM + go + 8); stk[0] = *(const v4u*)(KM + go); stk[1] = *(const v4u*)(KM + go + 8); \
        stv[0] = *(const v4u*)(VM + go); stv[1] = *(const v4u*)(VM + go + 8); \
        _Pragma("unroll") for (int k_ = 0; k_ < 5; ++k_) scv[k_] = __hip_atomic_load(scr + (size_t)(c) * 320 + k_ * 64 + lane, __ATOMIC_RELAXED, __HIP_MEMORY_SCOPE_AGENT); } while (0)
#define ML_WRITE(b) do { const int lo_ = rho(srow) * PITCH + scol * 2; \
        *(LAS v4u*)(lds + OFF_Q + (b) * TILE + lo_) = stq[0]; *(LAS v4u*)(lds + OFF_Q + (b) * TILE + lo_ + 16) = stq[1]; \
        *(LAS v4u*)(lds + OFF_K + (b) * TILE + lo_) = stk[0]; *(LAS v4u*)(lds + OFF_K + (b) * TILE + lo_ + 16) = stk[1]; \
        *(LAS v4u*)(lds + OFF_V + (b) * TILE + lo_) = stv[0]; *(LAS v4u*)(lds + OFF_V + (b) * TILE + lo_ + 16) = stv[1]; \
        _Pragma("unroll") for (int k_ = 0; k_ < 5; ++k_) sc[((b) * 5 + k_) * 64 + lane] = scv[k_]; } while (0)
    ML_LOAD(0); ML_WRITE(0);
    if (tid < 64) ((LAS unsigned*)(lds + OFF_NBF))[tid] = 0u;
    for (int c = 0; c < NC; ++c) {
        const int b = c & 1;
        LAS const unsigned char* Qt = lds + OFF_Q + b * TILE; LAS const unsigned char* Kt = lds + OFF_K + b * TILE; LAS const unsigned char* Vt = lds + OFF_V + b * TILE;
        LAS const float* scb = sc + b * 320;
        { const int cn = (c + 1 < NC) ? c + 1 : c; ML_LOAD(cn); }
        const float a_old = CHAO[c];
        __syncthreads();
        {
            bf16x8 ka[2][4], qb_[2][4], na[4], nq[4];
#pragma unroll
            for (int tt = 0; tt < 2; ++tt) { const int tile = w * 2 + tt, lb = tile & 3, jb = tile >> 2;
#pragma unroll
                for (int ks = 0; ks < 4; ++ks) { ka[tt][ks] = *(LAS const bf16x8*)(Kt + rho(16 * lb + li) * PITCH + (32 * ks + 8 * g) * 2);
                    qb_[tt][ks] = *(LAS const bf16x8*)(Qt + rho(16 * jb + li) * PITCH + (32 * ks + 8 * g) * 2); } }
            { LAS const unsigned char* nb = lds + OFF_NBF + b * 256;
#pragma unroll
              for (int ks = 0; ks < 4; ++ks) { na[ks] = *(LAS const bf16x8*)(nb + (32 * ks + 8 * g) * 2); if (li != 0) na[ks] = (bf16x8){0, 0, 0, 0, 0, 0, 0, 0};
                  nq[ks] = *(LAS const bf16x8*)(Qt + rho(16 * (w & 3) + li) * PITCH + (32 * ks + 8 * g) * 2); } }
#pragma unroll
            for (int tt = 0; tt < 2; ++tt) {
                const int tile = w * 2 + tt, lb = tile & 3, jb = tile >> 2;
                const int j = 16 * jb + li, l0 = 16 * lb + 4 * g;
                f32x4 s = {0.f, 0.f, 0.f, 0.f};
#pragma unroll
                for (int ks = 0; ks < 4; ++ks) s = __builtin_amdgcn_mfma_f32_16x16x32_bf16(ka[tt][ks], qb_[tt][ks], s, 0, 0, 0);
                const f32x4 u4 = *(LAS const f32x4*)(scb + l0); const float Mj = scb[64 + j];
                float p[4]; float rs = 0.f;
#pragma unroll
                for (int r = 0; r < 4; ++r) { p[r] = (l0 + r <= j) ? s[r] * __expf(u4[r] - Mj) : 0.f; rs += p[r]; }
                *(LAS u32x2*)(lds + OFF_P + j * PPITCH + l0 * 2) = (u32x2){cvtpk(p[0], p[1]), cvtpk(p[2], p[3])};
                rs = sum_x16(rs); rs = sum_x32(rs);
                if (g == 0) RSP[j * 4 + lb] = rs;
            }
            { f32x4 s = {0.f, 0.f, 0.f, 0.f};
#pragma unroll
              for (int ks = 0; ks < 4; ++ks) s = __builtin_amdgcn_mfma_f32_16x16x32_bf16(na[ks], nq[ks], s, 0, 0, 0);
              if (g == 0) QNl[16 * (w & 3) + li] = s[0]; }
        }
        f32x4 Y[4];
        {
            bf16x8 ca[4];
#pragma unroll
            for (int ks = 0; ks < 4; ++ks) { v4u t; t.x = cvtpk(X[2 * ks][0], X[2 * ks][1]); t.y = cvtpk(X[2 * ks][2], X[2 * ks][3]); t.z = cvtpk(X[2 * ks + 1][0], X[2 * ks + 1][1]); t.w = cvtpk(X[2 * ks + 1][2], X[2 * ks + 1][3]);
                ca[ks] = __builtin_bit_cast(bf16x8, t); }
#pragma unroll
            for (int tb = 0; tb < 4; ++tb) {
                LAS const unsigned char* qrow = Qt + rho(16 * tb + li) * PITCH;
                v4u qq[4];
#pragma unroll
                for (int ks = 0; ks < 4; ++ks) { const u32x2 q0 = *(LAS const u32x2*)(qrow + (32 * ks + 4 * g) * 2), q1 = *(LAS const u32x2*)(qrow + (32 * ks + 16 + 4 * g) * 2); qq[ks] = (v4u){q0.x, q0.y, q1.x, q1.y}; }
                f32x4 y = {0.f, 0.f, 0.f, 0.f};
#pragma unroll
                for (int ks = 0; ks < 4; ++ks) y = __builtin_amdgcn_mfma_f32_16x16x32_bf16(ca[ks], __builtin_bit_cast(bf16x8, qq[ks]), y, 0, 0, 0);
                Y[tb] = y;
            }
        }
        __syncthreads();
        bf16x8 vf[2];
        vf[0] = trfrag(Vt, 0, 16 * w, lane); vf[1] = trfrag(Vt, 32, 16 * w, lane);
        {
            bf16x8 pb[4][2]; f32x4 rp[4]; float wi[4], qn[4], cl[4];
#pragma unroll
            for (int tb = 0; tb < 4; ++tb) { const int t = 16 * tb + li;
                pb[tb][0] = *(LAS const bf16x8*)(lds + OFF_P + t * PPITCH + (8 * g) * 2); pb[tb][1] = *(LAS const bf16x8*)(lds + OFF_P + t * PPITCH + (32 + 8 * g) * 2);
                rp[tb] = *(LAS const f32x4*)(RSP + t * 4); wi[tb] = scb[192 + t]; qn[tb] = QNl[t]; cl[tb] = scb[256 + t]; }
#pragma unroll
            for (int tb = 0; tb < 4; ++tb) {
                const int t = 16 * tb + li;
                f32x4 y = Y[tb] * wi[tb];
                y = __builtin_amdgcn_mfma_f32_16x16x32_bf16(vf[0], pb[tb][0], y, 0, 0, 0);
                y = __builtin_amdgcn_mfma_f32_16x16x32_bf16(vf[1], pb[tb][1], y, 0, 0, 0);
                const float den = (rp[tb][0] + rp[tb][1]) + (rp[tb][2] + rp[tb][3]) + wi[tb] * qn[tb];
                const float inv = __builtin_amdgcn_rcpf(fmaxf(fabsf(den), cl[tb]));
                const u32x2 o = {cvtpk(y[0] * inv, y[1] * inv), cvtpk(y[2] * inv, y[3] * inv)};
                *(u32x2*)(H + (size_t)ML_ROW(c, t) * 1024 + hc + 16 * w + 4 * g) = o;
            }
        }
        {
            bf16x8 vw[2]; bf16x8 wb[2];
#pragma unroll
            for (int ks = 0; ks < 2; ++ks) {
                const f32x4 w0 = *(LAS const f32x4*)(scb + 128 + 32 * ks + 8 * g), w1 = *(LAS const f32x4*)(scb + 128 + 32 * ks + 8 * g + 4);
                float wv[8] = {w0[0], w0[1], w0[2], w0[3], w1[0], w1[1], w1[2], w1[3]};
                const v4u vraw = __builtin_bit_cast(v4u, vf[ks]); v4u t, tw;
#pragma unroll
                for (int e = 0; e < 4; ++e) { t[e] = cvtpk(bflo(vraw[e]) * wv[2 * e], bfhi(vraw[e]) * wv[2 * e + 1]); tw[e] = (li == 0) ? cvtpk(wv[2 * e], wv[2 * e + 1]) : 0u; }
                vw[ks] = __builtin_bit_cast(bf16x8, t); wb[ks] = __builtin_bit_cast(bf16x8, tw);
            }
            bf16x8 kf[8][2], kn[2];
#pragma unroll
            for (int d = 0; d < 8; ++d) { kf[d][0] = trfrag(Kt, 0, 16 * d, lane); kf[d][1] = trfrag(Kt, 32, 16 * d, lane); }
            kn[0] = trfrag(Kt, 0, 16 * w, lane); kn[1] = trfrag(Kt, 32, 16 * w, lane);
#pragma unroll
            for (int d = 0; d < 8; ++d) {
                f32x4 x = X[d] * a_old;
                x = __builtin_amdgcn_mfma_f32_16x16x32_bf16(kf[d][0], vw[0], x, 0, 0, 0);
                x = __builtin_amdgcn_mfma_f32_16x16x32_bf16(kf[d][1], vw[1], x, 0, 0, 0);
                X[d] = x;
            }
            nst = nst * a_old;
            nst = __builtin_amdgcn_mfma_f32_16x16x32_bf16(kn[0], wb[0], nst, 0, 0, 0);
            nst = __builtin_amdgcn_mfma_f32_16x16x32_bf16(kn[1], wb[1], nst, 0, 0, 0);
            if (li == 0) *(LAS u32x2*)(lds + OFF_NBF + (b ^ 1) * 256 + (16 * w + 4 * g) * 2) = (u32x2){cvtpk(nst[0], nst[1]), cvtpk(nst[2], nst[3])};
        }
        ML_WRITE(b ^ 1);
    }
    __syncthreads();
#undef ML_ROW
#undef ML_LOAD
#undef ML_WRITE
}
}

constexpr int Q_ML_P = 4, Q_ML_S = 16, Q_AT_P = 128, Q_AT_S = 128, QLEN = Q_ML_P + Q_ML_S + Q_AT_P + Q_AT_S;
template <int AVAR = 0>
__device__ __forceinline__ void p_mixer(Frame& F, const float* bgl, int lq, unsigned xcc, bool ml_only = false, bool att_only = false) {
    unsigned char* ws = F.ws;
    int qsel = (int)(xcc & 7u), tried = 0;
    for (;;) {
        if (F.tid == 0) {
            int item = -1, qq = qsel, tr = tried;
            while (tr < 8) {
                const unsigned idx = __hip_atomic_fetch_add(F.ctl + CW_QUEUE + (lq * 8 + qq) * 64, 1u, __ATOMIC_RELAXED, __HIP_MEMORY_SCOPE_AGENT);
                if (idx < (unsigned)QLEN) { item = qq * 1024 + (int)idx; break; }
                qq = (qq + 1) & 7; ++tr;
            }
            F.MISC[0] = (unsigned)item; F.MISC[1] = (unsigned)qq; F.MISC[2] = (unsigned)tr;
        }
        __syncthreads();
        const int item = (int)F.MISC[0]; qsel = (int)F.MISC[1]; tried = (int)F.MISC[2];
        __syncthreads();
        if (item < 0) break;
        const int h = item >> 10, i = item & 1023;
#ifndef NO_ML
        if (i < Q_ML_P + Q_ML_S) {
            if (att_only) continue;
            int row0, S, dir;
            if (i < Q_ML_P) { row0 = (i >> 1) * SEQ_P; S = SEQ_P; dir = i & 1; }
            else { const int k = i - Q_ML_P; row0 = MPROMPT + (k >> 1) * SEQ_S; S = SEQ_S; dir = k & 1; }
            ml::mlstm_item(F.lds, (const bf16*)(ws + WS_QM), (const bf16*)(ws + WS_KM), (const bf16*)(ws + WS_VM), (const float*)(ws + WS_KRG), bgl,
                           (float*)(ws + WS_SCR), (bf16*)(ws + (dir ? WS_HBW : WS_HFW)), row0, S, dir, h);
        } else
#endif
#ifndef NO_ATT
        {
            int row0, S, qb;
            if (i < Q_ML_P + Q_ML_S + Q_AT_P) { const int k = i - (Q_ML_P + Q_ML_S); row0 = (k >> 6) * SEQ_P; S = SEQ_P; qb = k & 63; }
            else { const int k = i - (Q_ML_P + Q_ML_S + Q_AT_P); row0 = MPROMPT + (k >> 4) * SEQ_S; S = SEQ_S; qb = k & 15; }
            const size_t qrow = (size_t)(row0 + 256 * qb);
            if (ml_only) continue;
            att8::attn_unit<AVAR>((const bf16*)(ws + WS_Q) + qrow * NQ + h * 128, (const bf16*)(ws + WS_Q) + qrow * NQ + 1024 + h * 64,
                            ws + WS_K8 + (size_t)row0 * 1024 + h * 128, ws + WS_KR + (size_t)row0 * 64, ws + WS_V8T + ((size_t)(row0 >> 6) * 1024 + h * 128) * 64,
                            (bf16*)(ws + WS_CQKV) + qrow * 1024 + h * 128, S, (const f32x2*)(ws + WS_ROPE), 256 * qb, (char*)F.lds);
        }
#else
        {}
#endif
    }
}


constexpr int NPH = 1 + DEPTH * 10 + 1;
__global__ void __launch_bounds__(NWAVES * 64, 2) trunk_fwd(Args args) {
    extern __shared__ __attribute__((aligned(16))) unsigned char lds[];
    Frame F;
    F.lds = (LAS unsigned char*)lds; F.MISC = (volatile LAS unsigned*)(F.lds + MISC_OFF);
    F.tid = threadIdx.x; F.lane = F.tid & 63; F.wave = __builtin_amdgcn_readfirstlane(F.tid >> 6);
    F.G = gridDim.x; { const int bx = blockIdx.x; F.vcu = (F.G % 8 == 0) ? (bx % 8) * (F.G / 8) + bx / 8 : bx; }
    F.ws = args.ws; F.ctl = (gu32*)(args.ws + WS_CTL); F.out = args.out;
    for (int u = F.tid; u < (LDS_BYTES - MISC_OFF) / 4; u += NWAVES * 64) ((LAS unsigned*)(F.lds + MISC_OFF))[u] = 0u;
    __syncthreads();
    XcdBarrier bar; bar.bar = (unsigned*)(F.ctl + CW_BAR); bar.x = xb_xcc_id(); bar.st = F.MISC + 8;
#if !MK_PER_PHASE
    bar = xcd_barrier_post((unsigned*)(F.ctl + CW_BAR), F.MISC + 8);
#endif
    const unsigned xcc = bar.x;
    const int lo = args.ph_lo, hi = args.ph_hi;
#define IN(k) (lo <= (k) && (k) < hi)
#if MK_PER_PHASE
#define SEAM(k) do { } while (0)
#else
#define SEAM(k) do { if (IN(k) && IN((k) + 1)) xcd_barrier(bar); } while (0)
#endif
    unsigned char* ws = args.ws;
    if (IN(0)) { p_prologue(F, args); }
#if MK_PER_PHASE
    SEAM(0);
#endif
    for (int layer = 0; layer < DEPTH; ++layer) {
        const int p0 = 1 + layer * 10;
        asm volatile("" : "+s"(ws));
        F.ws = ws;
        const unsigned char* wl = ws + WS_W + (size_t)layer * LW;
        if (layer == 0 || F.G != 256) { if (IN(p0 + 0)) { p_norm(F, args, layer); } SEAM(p0 + 0); }
        if (IN(p0 + 1)) {
            { pg8::Gemm g{(const pg8::bf16_t*)(ws + WS_XN8), (const pg8::bf16_t*)(wl + W_P1A), MTOK, NP1A, DM / 2, DM / 2, DM / 2, SC_ONE, SC_M6}; pg8::StaticOrder S; S.init(MTOK, NP1A, F.G, (int)blockIdx.x);
              EpiP1a E{ws, WS_CQKV}; pg8::gemm_phase<EpiP1a, pg8::StaticOrder, true, true, true, SC_ONE, SC_M6>(F.lds, g, S, E);
            }
            { pg8::Gemm g{(const pg8::bf16_t*)(ws + WS_XN), (const pg8::bf16_t*)(wl + W_P1B), MTOK, NP1B, DM, DM, DM, SC_ONE, SC_ONE}; pg8::StaticOrder S; S.init(MTOK, NP1B, F.G, (int)blockIdx.x);
              EpiP1b E{ws}; pg8::gemm_phase<EpiP1b, pg8::StaticOrder, true, true>(F.lds, g, S, E); }
        } SEAM(p0 + 1);
        if (IN(p0 + 2)) {
            { pg8::Gemm g{(const pg8::bf16_t*)(ws + WS_CQKV), (const pg8::bf16_t*)(wl + W_UQ), MTOK, NQ, 256, 512, 256, SC_ONE, SC_M5}; pg8::StaticOrder S; S.init(MTOK, NQ, F.G, (int)blockIdx.x);
              EpiQ E{ws}; pg8::gemm_phase<EpiQ, pg8::StaticOrder, true, true, true, SC_ONE, SC_M5>(F.lds, g, S, E); }
            { pg8::Gemm g{(const pg8::bf16_t*)(ws + WS_CQKV + 512), (const pg8::bf16_t*)(wl + W_UKV), MTOK, 1024, 256, 512, 256, SC_ONE, SC_M5}; pg8::StaticOrder S; S.init(MTOK, 1024, F.G, (int)blockIdx.x);
              EpiK8 E{ws}; pg8::gemm_phase<EpiK8, pg8::StaticOrder, true, true, true, SC_ONE, SC_M5>(F.lds, g, S, E); }
            { pg8::Gemm g{(const pg8::bf16_t*)(wl + W_UKV + (size_t)1024 * 512), (const pg8::bf16_t*)(ws + WS_CQKV + 512), 1024, MTOK, 256, 256, 512, SC_M5, SC_ONE}; pg8::StaticOrder S; S.init(1024, MTOK, F.G, (int)blockIdx.x);
              EpiVT E{ws}; pg8::gemm_phase<EpiVT, pg8::StaticOrder, true, true, true, SC_M5, SC_ONE>(F.lds, g, S, E); }
        } SEAM(p0 + 2);
        if (IN(p0 + 3)) { p_mixer(F, args.in[IN_B_GATES] + layer * 32, layer, xcc); }
        SEAM(p0 + 3);
        if (IN(p0 + 4)) {
            { pg8::Gemm g{(const pg8::bf16_t*)(ws + WS_XN8), (const pg8::bf16_t*)(wl + W_P2A), MTOK, NP2A, DM / 2, DM / 2, DM / 2, SC_ONE, SC_M6}; pg8::StaticOrder S; S.init(MTOK, NP2A, F.G, (int)blockIdx.x);
              EpiP2a E{ws, WS_SGA}; pg8::gemm_phase<EpiP2a, pg8::StaticOrder, true, true, true, SC_ONE, SC_M6>(F.lds, g, S, E);
            }
            { pg8::Gemm g{(const pg8::bf16_t*)(ws + WS_XN), (const pg8::bf16_t*)(wl + W_P2B), MTOK, NP2B, DM, DM, DM, SC_ONE, SC_ONE}; pg8::StaticOrder S; S.init(MTOK, NP2B, F.G, (int)blockIdx.x);
              EpiP2b E{ws, layer}; pg8::gemm_phase<EpiP2b, pg8::StaticOrder, true, true>(F.lds, g, S, E); }
        } SEAM(p0 + 4);
        if (IN(p0 + 5)) {
            pg8::Gemm g1{(const pg8::bf16_t*)(ws + WS_HFW), (const pg8::bf16_t*)(wl + W_OB), MTOK, DM, 1024, 1024, 1024, 0x7F7F7F7F, 0x7F7F7F7F};
            pg8::Gemm g2{(const pg8::bf16_t*)(ws + WS_YA8), (const pg8::bf16_t*)(wl + W_OA), MTOK, DM, 512, 512, 512, SC_M6, SC_M5};
            pg8::StaticOrder S; S.init(MTOK, DM, F.G, (int)blockIdx.x);
            MidMerge Mm{ws}; EpiMerge2 E{ws}; pg8::gemm_chain<EpiMerge2, MidMerge, pg8::StaticOrder>(F.lds, g1, g2, S, Mm, E);
        } SEAM(p0 + 5);
        if (IN(p0 + 8)) {
            pg8::Gemm g{(const pg8::bf16_t*)(ws + WS_MG), (const pg8::bf16_t*)(wl + W_OUT), MTOK, DM, DM, DM, DM, 0x7F7F7F7F, 0x7F7F7F7F}; pg8::StaticOrder S; S.init(MTOK, DM, F.G, (int)blockIdx.x);
            if (F.G == 256) { S.wgm = 4;
                if (layer + 1 == DEPTH) { EpiOutX<true> E{args.in[IN_XP], args.in[IN_XS], F.out, ws, args.in[IN_NORM_F], layer}; pg8::gemm_phase<EpiOutX<true>, pg8::StaticOrder, true, true>(F.lds, g, S, E); }
                else { EpiOutX<false> E{args.in[IN_XP], args.in[IN_XS], F.out, ws, args.in[IN_NORM_IN] + (layer + 1) * DM, layer}; pg8::gemm_phase<EpiOutX<false>, pg8::StaticOrder, true, true>(F.lds, g, S, E); }
            } else { EpiOut E{args.in[IN_XP], args.in[IN_XS], F.out, layer}; pg8::gemm_phase<EpiOut, pg8::StaticOrder, true, true>(F.lds, g, S, E); }
        } if (layer + 1 < DEPTH || F.G != 256) SEAM(p0 + 8);
    }
    if (IN(NPH - 1) && F.G != 256) { p_final(F, args); }
#undef IN
#undef SEAM
}

extern "C" void kernel_launch(void* const* d_in, const int* in_sizes, int n_in, void* d_out, int out_size, void* d_ws, size_t ws_size, hipStream_t stream) {
    static int grid = 0;
    if (grid == 0) {
        if (n_in != 14 || in_sizes[0] != MPROMPT * DM || in_sizes[1] != MPROMPT * DM || out_size != MTOK * DM || ws_size < WS_END) {
            fprintf(stderr, "kernel_launch: shape mismatch (n_in %d, in0 %d, out %d, ws %zu, need %zu); nothing launched\n", n_in, n_in > 0 ? in_sizes[0] : -1, out_size, ws_size, (size_t)WS_END); grid = -1; return; }
        int dev = 0, cus = 0, per_cu = 0;
        if (hipGetDevice(&dev) != hipSuccess || hipDeviceGetAttribute(&cus, hipDeviceAttributeMultiprocessorCount, dev) != hipSuccess) { grid = -1; return; }
        if (hipFuncSetAttribute((const void*)trunk_fwd, hipFuncAttributeMaxDynamicSharedMemorySize, LDS_BYTES) != hipSuccess) { fprintf(stderr, "kernel_launch: hipFuncSetAttribute failed\n"); grid = -1; return; }
        if (hipOccupancyMaxActiveBlocksPerMultiprocessor(&per_cu, (const void*)trunk_fwd, NWAVES * 64, LDS_BYTES) != hipSuccess || per_cu < 1)
            fprintf(stderr, "kernel_launch: note: occupancy query reports %d workgroups per CU\n", per_cu);
        (void)hipGetLastError();
        grid = cus;
    }
    if (grid < 0) return;
    if (hipMemsetAsync((char*)d_ws + WS_CTL, 0, CTL_ZERO_BYTES, stream) != hipSuccess) return;
    Args a{};
    for (int i = 0; i < 14; ++i) a.in[i] = (const float*)d_in[i];
    a.out = (float*)d_out; a.ws = (unsigned char*)d_ws;
#if MK_PER_PHASE
    for (int p = 0; p < NPH; ++p) {
        if (p >= 1 && p < NPH - 1 && (((p - 1) % 10) == 9 || ((p - 1) % 10) == 6)) continue;
        a.ph_lo = p; a.ph_hi = p + 1;
        hipLaunchKernelGGL(trunk_fwd, dim3(grid), dim3(NWAVES * 64), LDS_BYTES, stream, a);
    }
#else
    a.ph_lo = 0; a.ph_hi = NPH;
    hipLaunchKernelGGL(trunk_fwd, dim3(grid), dim3(NWAVES * 64), LDS_BYTES, stream, a);
#endif
    const hipError_t le = hipPeekAtLastError();
    if (le != hipSuccess) fprintf(stderr, "kernel_launch: launch failed: %s\n", hipGetErrorName(le));
}
```

```cpp
#include <hip/hip_runtime.h>
#include <hip/hip_bf16.h>
#include <cstdio>
#include <cstdint>

#ifndef MK_PER_PHASE
#define MK_PER_PHASE 0
#endif
#ifndef ML_FAST_TR
#define ML_FAST_TR 1
#endif

namespace pg8 {
#define PG8_LAS __attribute__((address_space(3)))
typedef unsigned short bf16_t;
typedef short bf16x8 __attribute__((ext_vector_type(8)));
typedef float f32x4 __attribute__((ext_vector_type(4)));
typedef unsigned u32x4 __attribute__((ext_vector_type(4)));
constexpr int BM = 256, BK = 64, HALF = 128, HTB = HALF * BK * 2  , STAGE_BYTES = 8 * HTB, NXCD = 8, WGM = 8;

__host__ __device__ __forceinline__ int lds_byte(int r, int c) { const int st = (r >> 4) * 2 + (c >> 5), rr = r & 15, cc = c & 31, ob = rr * 64 + cc * 2; return st * 1024 + (ob ^ (((ob >> 9) & 1) << 5)); }
__host__ __device__ __forceinline__ void stage_rc(int b, int& R, int& C) { const int st = b / 1024, sb = b % 1024, swz = sb ^ (((sb >> 9) & 1) << 5); R = (st >> 1) * 16 + swz / 64; C = (st & 1) * 32 + (swz % 64) / 2; }
__host__ __device__ __forceinline__ int perm32(int rho) { const int n = rho >> 4, i = rho & 15; return 8 * (i >> 2) + 4 * n + (i & 3); }

__device__ __forceinline__ int fresh_tid() { int l; asm volatile("v_mbcnt_lo_u32_b32 %0, -1, 0\n\tv_mbcnt_hi_u32_b32 %0, -1, %0" : "=v"(l)); return (__builtin_amdgcn_readfirstlane((int)threadIdx.x >> 6) << 6) | l; }
struct Unit { int pm, pn; };
struct Gemm { const bf16_t* A; const bf16_t* Bt; int M, N, K, lda, ldb; int scA, scB; };
typedef int pg8_v4i __attribute__((ext_vector_type(4)));
typedef int pg8_v8i __attribute__((ext_vector_type(8)));
__device__ __forceinline__ pg8_v8i ld_frag8(const PG8_LAS unsigned char* p) {
    const bf16x8 lo = *(const PG8_LAS bf16x8*)p, hi = *(const PG8_LAS bf16x8*)(p + 16);
    return __builtin_bit_cast(pg8_v8i, __builtin_shufflevector(lo, hi, 0, 1, 2, 3, 4, 5, 6, 7, 8, 9, 10, 11, 12, 13, 14, 15)); }

struct StaticOrder {
    int nM, nN, nwg, G, c, wgm;
    __host__ __device__ void init(int M, int N, int G_, int c_) { nM = M / BM; nN = N / BM; nwg = nM * nN; G = G_; c = c_; wgm = WGM; }
    __host__ __device__ bool next(int i, Unit& u) const {
        const long L = (long)i * G + c; if (L >= nwg) return false;
        int wgid = (int)L; { const int q = nwg / NXCD, r = nwg % NXCD, xcd = wgid % NXCD, off = wgid / NXCD; wgid = (xcd < r ? xcd * (q + 1) : r * (q + 1) + (xcd - r) * q) + off; }
        const int nig = wgm * nN, gid = wgid / nig, fm = gid * wgm, gsz = (nM - fm) < wgm ? (nM - fm) : wgm;
        u.pm = fm + ((wgid % nig) % gsz); u.pn = (wgid % nig) / gsz; return true;
    }
    __device__ __forceinline__ void a_ready(const Unit&) const {}
    __device__ __forceinline__ void done(const Unit&) const {}
};

typedef float cvt_f32x2 __attribute__((ext_vector_type(2))); typedef __bf16 cvt_bf16x2 __attribute__((ext_vector_type(2)));
__device__ __forceinline__ unsigned cvt_pk_bf16(float lo, float hi) { return __builtin_bit_cast(unsigned, __builtin_convertvector((cvt_f32x2){lo, hi}, cvt_bf16x2)); }
typedef float f32x2 __attribute__((ext_vector_type(2)));
template <class Epi, class Sched, bool ALIGN_EPI = false, bool SP2 = false, bool FP8 = false, int SCA = 0x7F7F7F7F, int SCB = 0x7F7F7F7F>
__device__ __forceinline__ void gemm_phase(PG8_LAS unsigned char* lds, const Gemm g, const Sched& S, const Epi& E) {
    const int tid = fresh_tid();
    const int wid = __builtin_amdgcn_readfirstlane(tid >> 6), lane = tid & 63, wr = wid >> 2, wc = wid & 3, fr = lane & 15, fq = lane >> 4;
    const int K = g.K, nt = K / BK;
    unsigned voffA[2], voffB[2];
    { int R, C; stage_rc(tid * 16, R, C); const int Rb = Epi::PERM == 2 ? (64 * (R >> 5) + 16 * ((R & 15) >> 2) + 4 * ((R >> 4) & 1) + (R & 3)) : Epi::PERM ? ((R & ~31) + perm32(R & 31)) : R;
        voffA[0] = (unsigned)(R * g.lda + C) * 2u; voffB[0] = (unsigned)(Rb * g.ldb + C) * 2u; voffA[1] = voffA[0] + (unsigned)(64 * g.lda) * 2u; voffB[1] = voffB[0] + (unsigned)((Epi::PERM == 2 ? 128 : 64) * g.ldb) * 2u; }
    const size_t kstep = (size_t)(BK * 2);
    const size_t hstepA = (size_t)HALF * g.lda * 2, hstepB = (size_t)(Epi::PERM == 2 ? 8 : HALF) * g.ldb * 2;
    const size_t tstepA = 2 * hstepA, tstepB = (size_t)BM * g.ldb * 2;
    const unsigned ldsw = (unsigned)wid * 1024u;
    const int aoff = lds_byte(wr * 64 + fr, FP8 ? fq * 16 : fq * 8), boff = lds_byte(wc * 32 + fr, FP8 ? fq * 16 : fq * 8);
#define PG8_SA(b, h) (((b) * 2 + (h)) * HTB)
#define PG8_SB(b, h) ((4 + (b) * 2 + (h)) * HTB)
#define PG8_STAGE(bufoff, gbase, voff) do { _Pragma("unroll") for (int _i = 0; _i < 2; ++_i) \
        __builtin_amdgcn_global_load_lds((const unsigned*)((const char*)(gbase) + (voff)[_i]), (PG8_LAS unsigned*)(lds + (bufoff) + ldsw + _i * 8192), 16, 0, 0); } while (0)
#define PG8_LDA(dst, b, h) do { if constexpr (FP8) { _Pragma("unroll") for (int m = 0; m < 4; ++m) dst##8[m] = ld_frag8(lds + PG8_SA(b, h) + aoff + m * 2048); } \
        else { _Pragma("unroll") for (int m = 0; m < 4; ++m) _Pragma("unroll") for (int k = 0; k < 2; ++k) dst[m][k] = *(const PG8_LAS bf16x8*)(lds + PG8_SA(b, h) + aoff + m * 2048 + k * 1024); } } while (0)
#define PG8_LDB(dst, b, h) do { if constexpr (FP8) { _Pragma("unroll") for (int n = 0; n < 2; ++n) dst##8[n] = ld_frag8(lds + PG8_SB(b, h) + boff + n * 2048); } \
        else { _Pragma("unroll") for (int n = 0; n < 2; ++n) _Pragma("unroll") for (int k = 0; k < 2; ++k) dst[n][k] = *(const PG8_LAS bf16x8*)(lds + PG8_SB(b, h) + boff + n * 2048 + k * 1024); } } while (0)
#define PG8_CAT8(x) __builtin_shufflevector(__builtin_bit_cast(pg8_v4i, (x)[0]), __builtin_bit_cast(pg8_v4i, (x)[1]), 0, 1, 2, 3, 4, 5, 6, 7)
#define PG8_MMA(ai, bj, At, Bt) do { __builtin_amdgcn_s_setprio(1); _Pragma("unroll") for (int m = 0; m < 4; ++m) _Pragma("unroll") for (int n = 0; n < 2; ++n) { \
        if constexpr (FP8) asm volatile("v_mfma_f32_16x16x128_f8f6f4 %0, %1, %2, %0" : "+v"(acc[ai][bj][m][n]) : "v"(Bt##8[n]), "v"(At##8[m]));     \
        else { _Pragma("unroll") for (int k = 0; k < 2; ++k) acc[ai][bj][m][n] = __builtin_amdgcn_mfma_f32_16x16x32_bf16(Bt[n][k], At[m][k], acc[ai][bj][m][n], 0, 0, 0); } } __builtin_amdgcn_s_setprio(0); } while (0)
#define PG8_WAIT_V(n) asm volatile("s_waitcnt vmcnt(" #n ")" ::: "memory")
#define PG8_WAIT_L(n) asm volatile("s_waitcnt lgkmcnt(" #n ")" ::: "memory")
#define PG8_BAR __builtin_amdgcn_s_barrier()
#define PG8_SCHED __builtin_amdgcn_sched_barrier(0)
    Unit cur, nxt; int ui = 0;
    if (!S.next(0, cur)) return;
    f32x4 acc[2][2][4][2];
#pragma unroll
    for (int a = 0; a < 2; ++a)
#pragma unroll
        for (int b = 0; b < 2; ++b)
#pragma unroll
            for (int m = 0; m < 4; ++m)
#pragma unroll
                for (int n = 0; n < 2; ++n) acc[a][b][m][n] = (f32x4){0.f, 0.f, 0.f, 0.f};
    bf16x8 At[4][2], B0[2][2], B1[2][2]; pg8_v8i At8[4], B08[2], B18[2];
    const char* cA = (const char*)g.A + (size_t)cur.pm * tstepA; const char* cB = (const char*)g.Bt + (size_t)cur.pn * tstepB;
    S.a_ready(cur);
    if constexpr (SP2) {
        PG8_STAGE(PG8_SB(0, 0), cB, voffB); PG8_STAGE(PG8_SB(0, 1), cB + hstepB, voffB); PG8_STAGE(PG8_SA(0, 0), cA, voffA); PG8_STAGE(PG8_SA(0, 1), cA + hstepA, voffA);
        if (wr == 1) PG8_BAR;
        PG8_WAIT_V(2); PG8_BAR;
        PG8_STAGE(PG8_SB(1, 0), cB + kstep, voffB); PG8_STAGE(PG8_SA(1, 0), cA + kstep, voffA); PG8_STAGE(PG8_SB(1, 1), cB + hstepB + kstep, voffB);
        PG8_WAIT_V(6); PG8_BAR;
    } else {
        PG8_STAGE(PG8_SB(0, 0), cB, voffB); PG8_STAGE(PG8_SA(0, 0), cA, voffA); PG8_STAGE(PG8_SB(0, 1), cB + hstepB, voffB); PG8_STAGE(PG8_SA(0, 1), cA + hstepA, voffA);
        if (wr == 1) PG8_BAR;
        PG8_WAIT_V(4); PG8_BAR;
        PG8_STAGE(PG8_SB(1, 0), cB + kstep, voffB); PG8_STAGE(PG8_SA(1, 0), cA + kstep, voffA); PG8_STAGE(PG8_SB(1, 1), cB + hstepB + kstep, voffB);
        PG8_WAIT_V(6); PG8_BAR;
    }
    for (;;) {
        const bool has_next = S.next(ui + 1, nxt);
        const char* nA = has_next ? (const char*)g.A + (size_t)nxt.pm * tstepA : cA; const char* nB = has_next ? (const char*)g.Bt + (size_t)nxt.pn * tstepB : cB;
        _Pragma("nounroll") for (int t = 0; t < nt; t += 2) {
            const bool last = (t == nt - 2);
            const char* a1 = cA + (size_t)(t + 1) * kstep;
            const char* a2 = last ? nA : cA + (size_t)(t + 2) * kstep; const char* b2 = last ? nB : cB + (size_t)(t + 2) * kstep;
            const char* a3 = a2 + kstep; const char* b3 = b2 + kstep;
            if (last && has_next) S.a_ready(nxt);
            if constexpr (SP2) {
            PG8_LDB(B0, 0, 0); PG8_LDB(B1, 0, 1); PG8_SCHED; PG8_LDA(At, 0, 0); PG8_STAGE(PG8_SA(1, 1), a1 + hstepA, voffA);
            PG8_WAIT_V(8); PG8_WAIT_L(0); PG8_BAR; PG8_MMA(0, 0, At, B0); PG8_MMA(0, 1, At, B1); PG8_BAR; PG8_SCHED;
            PG8_LDA(At, 0, 1); PG8_STAGE(PG8_SB(0, 0), b2, voffB); PG8_STAGE(PG8_SB(0, 1), b2 + hstepB, voffB); PG8_STAGE(PG8_SA(0, 0), a2, voffA);
            PG8_WAIT_V(8); PG8_WAIT_L(0); PG8_BAR; PG8_MMA(1, 0, At, B0); PG8_MMA(1, 1, At, B1); PG8_BAR; PG8_SCHED;
            PG8_LDB(B0, 1, 0); PG8_LDB(B1, 1, 1); PG8_SCHED; PG8_LDA(At, 1, 0); PG8_STAGE(PG8_SA(0, 1), a2 + hstepA, voffA);
            PG8_WAIT_V(8); PG8_WAIT_L(0); PG8_BAR; PG8_MMA(0, 0, At, B0); PG8_MMA(0, 1, At, B1); PG8_BAR; PG8_SCHED;
            PG8_LDA(At, 1, 1); PG8_STAGE(PG8_SB(1, 0), b3, voffB); PG8_STAGE(PG8_SB(1, 1), b3 + hstepB, voffB); PG8_STAGE(PG8_SA(1, 0), a3, voffA);
            PG8_WAIT_V(8); PG8_WAIT_L(0); PG8_BAR; PG8_MMA(1, 0, At, B0); PG8_MMA(1, 1, At, B1); PG8_BAR; PG8_SCHED;
            } else {
            PG8_LDB(B0, 0, 0); PG8_SCHED; PG8_LDA(At, 0, 0); PG8_STAGE(PG8_SA(1, 1), a1 + hstepA, voffA);
            PG8_WAIT_L(8); PG8_BAR; PG8_WAIT_L(0); PG8_MMA(0, 0, At, B0); PG8_BAR; PG8_SCHED;
            PG8_LDB(B1, 0, 1); PG8_STAGE(PG8_SB(0, 0), b2, voffB);
            PG8_BAR; PG8_WAIT_L(0); PG8_MMA(0, 1, At, B1); PG8_BAR;
            PG8_LDA(At, 0, 1); PG8_STAGE(PG8_SA(0, 0), a2, voffA);
            PG8_BAR; PG8_WAIT_L(0); PG8_MMA(1, 0, At, B0); PG8_BAR; PG8_SCHED;
            PG8_STAGE(PG8_SB(0, 1), b2 + hstepB, voffB);
            PG8_WAIT_V(6); PG8_BAR; PG8_MMA(1, 1, At, B1); PG8_BAR;
            PG8_LDB(B0, 1, 0); PG8_SCHED; PG8_LDA(At, 1, 0); PG8_STAGE(PG8_SA(0, 1), a2 + hstepA, voffA);
            PG8_WAIT_L(8); PG8_BAR; PG8_WAIT_L(0); PG8_MMA(0, 0, At, B0); PG8_BAR; PG8_SCHED;
            PG8_LDB(B1, 1, 1); PG8_STAGE(PG8_SB(1, 0), b3, voffB);
            PG8_BAR; PG8_WAIT_L(0); PG8_MMA(0, 1, At, B1); PG8_BAR;
            PG8_LDA(At, 1, 1); PG8_STAGE(PG8_SA(1, 0), a3, voffA);
            PG8_BAR; PG8_WAIT_L(0); PG8_MMA(1, 0, At, B0); PG8_BAR; PG8_SCHED;
            PG8_STAGE(PG8_SB(1, 1), b3 + hstepB, voffB);
            PG8_WAIT_V(6); PG8_BAR; PG8_MMA(1, 1, At, B1); PG8_BAR;
            }
        }
        if constexpr (FP8) asm volatile("s_nop 15\n\ts_nop 15" ::: "memory");
        if constexpr (ALIGN_EPI) { if (wr == 0) PG8_BAR; }
        if constexpr (!Epi::AFTER_DRAIN) { const int t2 = fresh_tid();
            E(acc, cur, t2 >> 8, (t2 >> 6) & 3, t2 & 15, (t2 >> 4) & 3); S.done(cur); }
        if (!has_next) break;
#pragma unroll
        for (int a = 0; a < 2; ++a)
#pragma unroll
            for (int b = 0; b < 2; ++b)
#pragma unroll
                for (int m = 0; m < 4; ++m)
#pragma unroll
                    for (int n = 0; n < 2; ++n) acc[a][b][m][n] = (f32x4){0.f, 0.f, 0.f, 0.f};
        cur = nxt; cA = nA; cB = nB; ++ui;
        if constexpr (ALIGN_EPI) { if (wr == 1) PG8_BAR; }
    }
    PG8_WAIT_V(0);
    if constexpr (!ALIGN_EPI) { if (wr == 0) PG8_BAR; }
    PG8_BAR;
    if constexpr (Epi::AFTER_DRAIN) { E.fused(acc, cur, wr, wc, fr, fq, lds, wid, lane); S.done(cur); }
#undef PG8_SA
#undef PG8_SB
#undef PG8_STAGE
#undef PG8_LDA
#undef PG8_LDB
#undef PG8_MMA
#undef PG8_CAT8
#undef PG8_WAIT_V
#undef PG8_WAIT_L
#undef PG8_BAR
#undef PG8_SCHED
}

template <class Epi, class Mid, class Sched>
__device__ __forceinline__ void gemm_chain(PG8_LAS unsigned char* lds, const Gemm g1, const Gemm g2, const Sched& S, const Mid& M, const Epi& E) {
    const int tid = fresh_tid();
    const int wid = __builtin_amdgcn_readfirstlane(tid >> 6), lane = tid & 63, wr = wid >> 2, wc = wid & 3, fr = lane & 15, fq = lane >> 4;
    const int nt1 = g1.K / BK, nt2 = g2.K / BK;
    const size_t kstep = (size_t)(BK * 2);
    const size_t hA1 = (size_t)HALF * g1.lda * 2, hB1 = (size_t)HALF * g1.ldb * 2, hA2 = (size_t)HALF * g2.lda * 2, hB2 = (size_t)HALF * g2.ldb * 2;
    const unsigned ldsw = (unsigned)wid * 1024u;
#define PC_OFFS(F8, LDA_, LDB_) const int t3_ = fresh_tid(); unsigned VA[2], VB[2]; \
        { int R, C; stage_rc(t3_ * 16, R, C); const int Rb = Epi::PERM ? ((R & ~31) + perm32(R & 31)) : R; \
          VA[0] = (unsigned)(R * (LDA_) + C) * 2u; VB[0] = (unsigned)(Rb * (LDB_) + C) * 2u; VA[1] = VA[0] + (unsigned)(64 * (LDA_)) * 2u; VB[1] = VB[0] + (unsigned)(64 * (LDB_)) * 2u; } \
        const int aoff = lds_byte((t3_ >> 8) * 64 + (t3_ & 15), ((t3_ >> 4) & 3) * ((F8) ? 16 : 8)), boff = lds_byte(((t3_ >> 6) & 3) * 32 + (t3_ & 15), ((t3_ >> 4) & 3) * ((F8) ? 16 : 8));
#define PC_SA(b, h) (((b) * 2 + (h)) * HTB)
#define PC_SB(b, h) ((4 + (b) * 2 + (h)) * HTB)
#define PC_STAGE(bufoff, gbase, v0, v1) do { \
        __builtin_amdgcn_global_load_lds((const unsigned*)((const char*)(gbase) + (v0)), (PG8_LAS unsigned*)(lds + (bufoff) + ldsw), 16, 0, 0); \
        __builtin_amdgcn_global_load_lds((const unsigned*)((const char*)(gbase) + (v1)), (PG8_LAS unsigned*)(lds + (bufoff) + ldsw + 8192), 16, 0, 0); } while (0)
#define PC_LDA(F8, b, h) do { if constexpr (F8) { _Pragma("unroll") for (int m = 0; m < 4; ++m) At8[m] = ld_frag8(lds + PC_SA(b, h) + aoff + m * 2048); } \
        else { _Pragma("unroll") for (int m = 0; m < 4; ++m) _Pragma("unroll") for (int k = 0; k < 2; ++k) At[m][k] = *(const PG8_LAS bf16x8*)(lds + PC_SA(b, h) + aoff + m * 2048 + k * 1024); } } while (0)
#define PC_LDB(F8, W, b, h) do { if constexpr (F8) { _Pragma("unroll") for (int n = 0; n < 2; ++n) B##W##8[n] = ld_frag8(lds + PC_SB(b, h) + boff + n * 2048); } \
        else { _Pragma("unroll") for (int n = 0; n < 2; ++n) _Pragma("unroll") for (int k = 0; k < 2; ++k) B##W[n][k] = *(const PG8_LAS bf16x8*)(lds + PC_SB(b, h) + boff + n * 2048 + k * 1024); } } while (0)
#define PC_MMA(F8, ai, bj, W) do { __builtin_amdgcn_s_setprio(1); _Pragma("unroll") for (int m = 0; m < 4; ++m) _Pragma("unroll") for (int n = 0; n < 2; ++n) { \
        if constexpr (F8) asm volatile("v_mfma_f32_16x16x128_f8f6f4 %0, %1, %2, %0" : "+v"(acc[ai][bj][m][n]) : "v"(B##W##8[n]), "v"(At8[m])); \
        else { _Pragma("unroll") for (int k = 0; k < 2; ++k) acc[ai][bj][m][n] = __builtin_amdgcn_mfma_f32_16x16x32_bf16(B##W[n][k], At[m][k], acc[ai][bj][m][n], 0, 0, 0); } } __builtin_amdgcn_s_setprio(0); } while (0)
#define PC_WAIT_V(n) asm volatile("s_waitcnt vmcnt(" #n ")" ::: "memory")
#define PC_WAIT_L(n) asm volatile("s_waitcnt lgkmcnt(" #n ")" ::: "memory")
#define PC_BAR __builtin_amdgcn_s_barrier()
#define PC_SCHED __builtin_amdgcn_sched_barrier(0)
#define PC_KLOOP(F8, cA_, cB_, nt_, LDA_, LDB_, HA, HB, nA_, nB_, NLDA_, NLDB_, NHA, NHB) { PC_OFFS(F8, LDA_, LDB_) \
        _Pragma("nounroll") for (int t = 0; t < (nt_); t += 2) { \
            const bool last = (t == (nt_) - 2); \
            const char* a1 = (cA_) + (size_t)(t + 1) * kstep; \
            const char* a2 = last ? (nA_) : (cA_) + (size_t)(t + 2) * kstep; const char* b2 = last ? (nB_) : (cB_) + (size_t)(t + 2) * kstep; \
            const char* a3 = a2 + kstep; const char* b3 = b2 + kstep; \
            unsigned sa0 = VA[0], sa1 = VA[1], sb0 = VB[0], sb1 = VB[1]; const size_t sha = last ? (NHA) : (HA), shb = last ? (NHB) : (HB); \
            if (last) { int R, C; stage_rc(t3_ * 16, R, C); const int Rb = Epi::PERM ? ((R & ~31) + perm32(R & 31)) : R; \
                sa0 = (unsigned)(R * (NLDA_) + C) * 2u; sb0 = (unsigned)(Rb * (NLDB_) + C) * 2u; sa1 = sa0 + (unsigned)(64 * (NLDA_)) * 2u; sb1 = sb0 + (unsigned)(64 * (NLDB_)) * 2u; } \
            PC_LDB(F8, 0, 0, 0); PC_LDB(F8, 1, 0, 1); PC_SCHED; PC_LDA(F8, 0, 0); PC_STAGE(PC_SA(1, 1), a1 + (HA), VA[0], VA[1]); \
            PC_WAIT_V(8); PC_WAIT_L(0); PC_BAR; PC_MMA(F8, 0, 0, 0); PC_MMA(F8, 0, 1, 1); PC_BAR; PC_SCHED; \
            PC_LDA(F8, 0, 1); PC_STAGE(PC_SB(0, 0), b2, sb0, sb1); PC_STAGE(PC_SB(0, 1), b2 + shb, sb0, sb1); PC_STAGE(PC_SA(0, 0), a2, sa0, sa1); \
            PC_WAIT_V(8); PC_WAIT_L(0); PC_BAR; PC_MMA(F8, 1, 0, 0); PC_MMA(F8, 1, 1, 1); PC_BAR; PC_SCHED; \
            PC_LDB(F8, 0, 1, 0); PC_LDB(F8, 1, 1, 1); PC_SCHED; PC_LDA(F8, 1, 0); PC_STAGE(PC_SA(0, 1), a2 + sha, sa0, sa1); \
            PC_WAIT_V(8); PC_WAIT_L(0); PC_BAR; PC_MMA(F8, 0, 0, 0); PC_MMA(F8, 0, 1, 1); PC_BAR; PC_SCHED; \
            PC_LDA(F8, 1, 1); PC_STAGE(PC_SB(1, 0), b3, sb0, sb1); PC_STAGE(PC_SB(1, 1), b3 + shb, sb0, sb1); PC_STAGE(PC_SA(1, 0), a3, sa0, sa1); \
            PC_WAIT_V(8); PC_WAIT_L(0); PC_BAR; PC_MMA(F8, 1, 0, 0); PC_MMA(F8, 1, 1, 1); PC_BAR; PC_SCHED; \
        } }
    Unit cur, nxt; int ui = 0;
    if (!S.next(0, cur)) return;
    f32x4 acc[2][2][4][2];
#pragma unroll
    for (int a = 0; a < 2; ++a)
#pragma unroll
        for (int b = 0; b < 2; ++b)
#pragma unroll
            for (int m = 0; m < 4; ++m)
#pragma unroll
                for (int n = 0; n < 2; ++n) acc[a][b][m][n] = (f32x4){0.f, 0.f, 0.f, 0.f};
    bf16x8 At[4][2], B0[2][2], B1[2][2]; pg8_v8i At8[4], B08[2], B18[2];
    const char* c1A = (const char*)g1.A + (size_t)cur.pm * 2 * hA1; const char* c1B = (const char*)g1.Bt + (size_t)cur.pn * 2 * hB1;
    { PC_OFFS(false, g1.lda, g1.ldb) (void)aoff; (void)boff;
    PC_STAGE(PC_SB(0, 0), c1B, VB[0], VB[1]); PC_STAGE(PC_SB(0, 1), c1B + hB1, VB[0], VB[1]); PC_STAGE(PC_SA(0, 0), c1A, VA[0], VA[1]); PC_STAGE(PC_SA(0, 1), c1A + hA1, VA[0], VA[1]);
    if (wr == 1) PC_BAR;
    PC_WAIT_V(2); PC_BAR;
    PC_STAGE(PC_SB(1, 0), c1B + kstep, VB[0], VB[1]); PC_STAGE(PC_SA(1, 0), c1A + kstep, VA[0], VA[1]); PC_STAGE(PC_SB(1, 1), c1B + hB1 + kstep, VB[0], VB[1]);
    PC_WAIT_V(6); PC_BAR; }
    for (;;) {
        const bool has_next = S.next(ui + 1, nxt);
        const char* c2A = (const char*)g2.A + (size_t)cur.pm * 2 * hA2; const char* c2B = (const char*)g2.Bt + (size_t)cur.pn * 2 * hB2;
        const char* n1A = has_next ? (const char*)g1.A + (size_t)nxt.pm * 2 * hA1 : c1A; const char* n1B = has_next ? (const char*)g1.Bt + (size_t)nxt.pn * 2 * hB1 : c1B;
        PC_KLOOP(false, c1A, c1B, nt1, g1.lda, g1.ldb, hA1, hB1, c2A, c2B, g2.lda, g2.ldb, hA2, hB2)
        { const int t2 = fresh_tid(); M(acc, cur, t2 >> 8, (t2 >> 6) & 3, t2 & 15, (t2 >> 4) & 3); }
        PC_KLOOP(true, c2A, c2B, nt2, g2.lda, g2.ldb, hA2, hB2, n1A, n1B, g1.lda, g1.ldb, hA1, hB1)
        asm volatile("s_nop 15\n\ts_nop 15" ::: "memory");
        if (wr == 0) PC_BAR;
        { const int t2 = fresh_tid(); E(acc, cur, t2 >> 8, (t2 >> 6) & 3, t2 & 15, (t2 >> 4) & 3); }
        if (!has_next) break;
#pragma unroll
        for (int a = 0; a < 2; ++a)
#pragma unroll
            for (int b = 0; b < 2; ++b)
#pragma unroll
                for (int m = 0; m < 4; ++m)
#pragma unroll
                    for (int n = 0; n < 2; ++n) acc[a][b][m][n] = (f32x4){0.f, 0.f, 0.f, 0.f};
        cur = nxt; c1A = n1A; c1B = n1B; ++ui;
        if (wr == 1) PC_BAR;
    }
    PC_WAIT_V(0);
    PC_BAR;
#undef PC_SA
#undef PC_SB
#undef PC_STAGE
#undef PC_LDA
#undef PC_LDB
#undef PC_MMA
#undef PC_WAIT_V
#undef PC_WAIT_L
#undef PC_BAR
#undef PC_SCHED
#undef PC_KLOOP
#undef PC_OFFS
}
}

constexpr int DM = 2048, DEPTH = 2;
constexpr int MTOK = 65536, MPROMPT = 32768, SEQ_P = 16384, SEQ_S = 4096;
constexpr int IN_COLS = 11360;
constexpr int NP1 = 4352, NP2 = 7168, NQ = 1536, NKV = 2048;
constexpr int SRC_CQ = 0, SRC_CKV = 512, SRC_KROPE = 1024, SRC_ZA = 1088, SRC_QM = 2112, SRC_KM = 3136, SRC_VM = 4160, SRC_OM = 5184, SRC_ZM = 6208, SRC_GATES = 7232, SRC_GA = 7264, SRC_GB = 9312;
constexpr float EPS = 1e-6f;
constexpr int NWAVES = 8;

constexpr size_t MiB = 1u << 20, U = 128 * MiB;
constexpr size_t WS_XN = 0;
constexpr size_t WS_CQKV = 2 * U;
constexpr size_t WS_QM = 3 * U, WS_KM = 4 * U, WS_VM = 5 * U;
constexpr size_t WS_Q = 6 * U;
constexpr size_t WS_KN = 6 * U + U / 2 * 3, WS_V = WS_KN + U;
constexpr size_t WS_KR = WS_V + U;
constexpr size_t WS_K8 = WS_KN, WS_V8T = WS_V;
constexpr size_t WS_HFW = 10 * U, WS_HBW = 11 * U;
constexpr size_t WS_MG = 3 * U;
constexpr size_t WS_SGA = 5 * U, WS_SGB = 7 * U;
constexpr size_t WS_W = 12 * U;
constexpr int NP1A = 1024, NP1B = 3328, NP2A = 3072, NP2B = 4096;
constexpr size_t W_P1A = 0, W_P1B = W_P1A + (size_t)NP1A * DM, W_P2A = W_P1B + (size_t)NP1B * DM * 2, W_P2B = W_P2A + (size_t)NP2A * DM, W_UQ = W_P2B + (size_t)NP2B * DM * 2,
                 W_UKV = W_UQ + (size_t)NQ * 512, W_OA = W_UKV + (size_t)NKV * 512, W_OB = W_OA + (size_t)DM * 1024, W_OUT = W_OB + (size_t)DM * 1024 * 2, LW = W_OUT + (size_t)DM * DM * 2;
constexpr int SC_ONE = 0x7F7F7F7F, SC_M6 = 0x79797979, SC_M5 = 0x7A7A7A7A;
constexpr size_t WS_ROPE = WS_W + 2 * LW;
constexpr size_t WS_KRG = WS_ROPE + 4 * MiB;
constexpr size_t WS_SSQ = WS_KRG + 24 * MiB;
constexpr size_t WS_SCR = WS_SSQ + 4 * MiB;
constexpr size_t WS_RSKV = WS_SCR + 20 * MiB;
constexpr size_t WS_SSF = WS_KR + 4 * MiB;
constexpr size_t WS_HG = WS_RSKV + 512 * 1024;
constexpr size_t WS_CTL = WS_RSKV + 1 * MiB, CTL_ZERO_BYTES = 1 * MiB;
constexpr size_t WS_XN8 = WS_CTL + CTL_ZERO_BYTES;
constexpr size_t WS_YA8 = WS_XN8 + U;
constexpr size_t WS_END = WS_YA8 + U / 2;
static_assert(LW % 256 == 0 && WS_END < 2040 * MiB, "d_ws map");
constexpr int CW_BAR = 4096;
constexpr int CW_PANEL = 32768;
constexpr int CW_QUEUE = 16384;

constexpr int LDS_BYTES = 163840;
constexpr int MISC_OFF = 159744;

#define GAS __attribute__((address_space(1)))
#define LAS __attribute__((address_space(3)))
typedef unsigned short bf16;
typedef unsigned v4u __attribute__((ext_vector_type(4)));
typedef float f32x4 __attribute__((ext_vector_type(4)));
typedef short bf16x8 __attribute__((ext_vector_type(8)));
typedef GAS unsigned gu32;
typedef GAS unsigned long long gu64;
#define RLX_AGENT __ATOMIC_RELAXED, __HIP_MEMORY_SCOPE_AGENT
#define LDS_WAIT() asm volatile("s_waitcnt lgkmcnt(0)" ::: "memory")
#define VM_WAIT() asm volatile("s_waitcnt vmcnt(0)" ::: "memory")
__device__ __forceinline__ unsigned long long rt() { return __builtin_amdgcn_s_memrealtime(); }
__device__ __forceinline__ unsigned f2bf(float f) { unsigned u = __builtin_bit_cast(unsigned, f); return (u + 0x7fffu + ((u >> 16) & 1u)) >> 16; }
__device__ __forceinline__ unsigned pk2(float lo, float hi) { return f2bf(lo) | (f2bf(hi) << 16); }

#define XB_TMO      128
#define XB_XCNT(j)  (256  + 64 * (j))
#define XB_XSUB(j)  (1280 + 64 * (j))
#define XB_XGEN(j)  (2304 + 64 * (j))
#define XB_TOP      3328
#define XB_TOPGEN   3392
#define XCD_BAR_WORDS 3456
#define XB_SPIN_CAP (1u << 18)

__device__ __forceinline__ unsigned xb_ld(unsigned* p)              { return __hip_atomic_load(p, __ATOMIC_RELAXED, __HIP_MEMORY_SCOPE_AGENT); }
__device__ __forceinline__ unsigned xb_add(unsigned* p, unsigned v) { return __hip_atomic_fetch_add(p, v, __ATOMIC_RELAXED, __HIP_MEMORY_SCOPE_AGENT); }
__device__ __forceinline__ unsigned xb_xcc_id() { return (unsigned)__builtin_amdgcn_s_getreg((3 << 11) | 20) & 0xFu; }
#define XB_SPIN(cond, bar) do { unsigned _sp = 0; while (cond) { __builtin_amdgcn_s_sleep(1); \
    if ((++_sp & 255u) == 0u) { if (xb_ld(&(bar)[XB_TMO])) break; if (_sp > XB_SPIN_CAP) { atomicAdd(&(bar)[XB_TMO], 1u); break; } } } } while (0)

struct XcdBarrier {
    unsigned* bar; unsigned x;
    volatile LAS unsigned* st;
};

__device__ __forceinline__ XcdBarrier xcd_barrier_post(unsigned* bar, volatile LAS unsigned* st) {
    XcdBarrier b; b.bar = bar; b.x = xb_xcc_id(); b.st = st;
    if (threadIdx.x == 0) (void)xb_add(&bar[XB_XCNT(b.x)], 1u);
    return b;
}
__device__ __forceinline__ void xcd_barrier_complete(unsigned* bar, unsigned x, unsigned& nloc, unsigned& nx) {
    const unsigned G = gridDim.x * gridDim.y * gridDim.z;
    unsigned sum, cnt, mine, sp = 0u;
    for (;;) {
        sum = 0u; cnt = 0u; mine = 0u;
#pragma unroll
        for (unsigned j = 0; j < 16; ++j) { const unsigned c = xb_ld(&bar[XB_XCNT(j)]); sum += c; cnt += (c > 0u) ? 1u : 0u; mine = (j == x) ? c : mine; }
        if (sum == G) break;
        __builtin_amdgcn_s_sleep(1);
        if ((++sp & 255u) == 0u) { if (xb_ld(&bar[XB_TMO])) break; if (sp > XB_SPIN_CAP) { atomicAdd(&bar[XB_TMO], 1u); break; } }
    }
    nloc = mine > 0u ? mine : 1u; nx = cnt > 0u ? cnt : 1u;
}

__device__ __forceinline__ void xcd_barrier(const XcdBarrier& b) {
    asm volatile("s_waitcnt vmcnt(0)" ::: "memory");
    __syncthreads();
    if (threadIdx.x == 0) {
        unsigned* bar = b.bar;
        __builtin_amdgcn_s_waitcnt(0);
        unsigned nloc = b.st[0], nx = b.st[1];
        if (nloc == 0u) { xcd_barrier_complete(bar, b.x, nloc, nx); b.st[0] = nloc; b.st[1] = nx; }
        const unsigned old = xb_add(&bar[XB_XSUB(b.x)], 1u);
        const unsigned gen = old / nloc;
        if (old + 1u == (gen + 1u) * nloc) {
            __builtin_amdgcn_fence(__ATOMIC_RELEASE, "agent");
            asm volatile("s_waitcnt vmcnt(0)" ::: "memory");
            const unsigned og = xb_add(&bar[XB_TOP], 1u);
            const unsigned tg = og / nx;
            if (og + 1u == (tg + 1u) * nx) xb_add(&bar[XB_TOPGEN], 1u);
            else XB_SPIN(xb_ld(&bar[XB_TOPGEN]) == tg, bar);
            __builtin_amdgcn_fence(__ATOMIC_ACQUIRE, "agent");
            xb_add(&bar[XB_XGEN(b.x)], 1u);
            asm volatile("s_waitcnt vmcnt(0)" ::: "memory");
        } else {
            XB_SPIN(xb_ld(&bar[XB_XGEN(b.x)]) == gen, bar);
            __builtin_amdgcn_fence(__ATOMIC_ACQUIRE, "agent");
            asm volatile("s_waitcnt vmcnt(0)" ::: "memory");
        }
    }
    __syncthreads();
}


typedef float f32x2 __attribute__((ext_vector_type(2)));
typedef float f32x8v __attribute__((ext_vector_type(8)));
typedef unsigned u32x2 __attribute__((ext_vector_type(2)));
typedef short s16x4 __attribute__((ext_vector_type(4)));
typedef float f32x16 __attribute__((ext_vector_type(16)));

typedef float cvt_f32x2 __attribute__((ext_vector_type(2))); typedef __bf16 cvt_bf16x2 __attribute__((ext_vector_type(2)));
__device__ __forceinline__ unsigned cvtpk(float lo, float hi) { return __builtin_bit_cast(unsigned, __builtin_convertvector((cvt_f32x2){lo, hi}, cvt_bf16x2)); }
__device__ __forceinline__ float bflo(unsigned w) { return __uint_as_float(w << 16); }
__device__ __forceinline__ float bfhi(unsigned w) { return __uint_as_float(w & 0xffff0000u); }
__device__ __forceinline__ float sigmoidf_(float x) { return __builtin_amdgcn_rcpf(1.0f + __expf(-x)); }
__device__ __forceinline__ float siluf_(float x) { return x * __builtin_amdgcn_rcpf(1.0f + __expf(-x)); }
template <int K> __device__ __forceinline__ float swz_xor(float v) { return __int_as_float(__builtin_amdgcn_ds_swizzle(__float_as_int(v), 0x1F | (K << 10))); }
__device__ __forceinline__ float sum_x16(float v) { const auto rr = __builtin_amdgcn_permlane16_swap(__float_as_uint(v), __float_as_uint(v), false, false); return __uint_as_float(rr[0]) + __uint_as_float(rr[1]); }
__device__ __forceinline__ float sum_x32(float v) { const auto rr = __builtin_amdgcn_permlane32_swap(__float_as_uint(v), __float_as_uint(v), false, false); return __uint_as_float(rr[0]) + __uint_as_float(rr[1]); }
__device__ __forceinline__ float wave_sum(float v) { v += swz_xor<1>(v); v += swz_xor<2>(v); v += swz_xor<4>(v); v += swz_xor<8>(v); v = sum_x16(v); return sum_x32(v); }
__device__ __forceinline__ unsigned pk4_fp8(float a, float b, float c, float d) {
    a = __builtin_amdgcn_fmed3f(a, -448.f, 448.f); b = __builtin_amdgcn_fmed3f(b, -448.f, 448.f); c = __builtin_amdgcn_fmed3f(c, -448.f, 448.f); d = __builtin_amdgcn_fmed3f(d, -448.f, 448.f);
    int w = __builtin_amdgcn_cvt_pk_fp8_f32(a, b, 0, false); w = __builtin_amdgcn_cvt_pk_fp8_f32(c, d, w, true); return (unsigned)w; }
__device__ __forceinline__ int opaque_tid() { return pg8::fresh_tid(); }
__device__ __forceinline__ int seq_pos(int m) { return m < MPROMPT ? (m & (SEQ_P - 1)) : (m & (SEQ_S - 1)); }

struct Frame {
    LAS unsigned char* lds;
    volatile LAS unsigned* MISC;
    gu32* ctl;
    int tid, lane, wave, vcu, G;
    unsigned char* ws;
    float* out;
};
enum { IN_XP = 0, IN_XS = 1, IN_NORM_IN = 2, IN_W_IN = 3, IN_B_GATES = 4, IN_Q_A_NORM = 5, IN_W_UQ = 6, IN_KV_A_NORM = 7, IN_W_UKV = 8, IN_W_OA = 9, IN_M_HEAD_NORM = 10, IN_W_OB = 11, IN_W_OUT = 12, IN_NORM_F = 13 };
struct Args { const float* in[14]; float* out; unsigned char* ws; int ph_lo, ph_hi; };

__device__ __forceinline__ int wmap(int kind, int n) {
    if (kind == 0) {
        if (n < 3072) return SRC_QM + n;
        if (n < 3136) { const int j = n - 3072; return SRC_KROPE + (j >> 1) + 32 * (j & 1); }
        if (n < 3168) return SRC_GATES + (n - 3136);
        return -1;
    }
    if (kind == 5) return n;
    if (kind == 1) {
        if (n < 2048) { const int t = n >> 8, w = n & 255; return (w < 128 ? SRC_OM : SRC_ZM) + t * 128 + (w & 127); }
        return SRC_GB + (n - 2048);
    }
    if (kind == 6) {
        if (n < 1024) return SRC_ZA + n;
        return SRC_GA + (n - 1024);
    }
    if (kind == 2) {
        if (n < 1024) return (n >> 7) * 192 + (n & 127);
        const int j = n - 1024, h = j >> 6, jj = j & 63; return h * 192 + 128 + (jj >> 1) + 32 * (jj & 1);
    }
    if (kind == 3) {
        if (n < 1024) return (n >> 7) * 256 + (n & 127);
        const int j = n - 1024; return (j >> 7) * 256 + 128 + (j & 127);
    }
    return n;
}
__device__ __forceinline__ void transpose_item(const float* W, int K, int srcN, bf16* WT, int Ndst, int kind, const float* kgain, LAS float* scr, int item, int lane) {
    const int nblk = Ndst / 32, kb = item / nblk, nb = item % nblk, k0 = 64 * kb, n0 = 32 * nb;
    const int n = n0 + (lane & 31); const int sc = wmap(kind, n);
    const float cs = (kind == 0 && n < 1024) ? 0.08838834764831845f : 1.0f;
    float tv[32];
#pragma unroll
    for (int i = 0; i < 32; ++i) { const int kk = 2 * i + (lane >> 5);
        float v = 0.f; if (sc >= 0) { v = W[(size_t)(k0 + kk) * srcN + sc] * cs; if (kgain) v *= kgain[k0 + kk]; }
        tv[i] = v; }
#pragma unroll
    for (int i = 0; i < 32; ++i) scr[(2 * i + (lane >> 5)) * 33 + (lane & 31)] = tv[i];
    LDS_WAIT(); asm volatile("" ::: "memory");
    const int c = lane & 7;
#pragma unroll
    for (int j = 0; j < 4; ++j) { const int nn = (lane >> 3) + 8 * j; const LAS float* s = scr + (8 * c) * 33 + nn;
        v4u o; o.x = pk2(s[0 * 33], s[1 * 33]); o.y = pk2(s[2 * 33], s[3 * 33]); o.z = pk2(s[4 * 33], s[5 * 33]); o.w = pk2(s[6 * 33], s[7 * 33]);
        *(GAS v4u*)(WT + (size_t)(n0 + nn) * K + k0 + 8 * c) = o; }
    LDS_WAIT(); asm volatile("" ::: "memory");
}
__device__ __forceinline__ void transpose_item8(const float* W, int K, int srcN, unsigned char* WT, int Ndst, int kind, const float* kgain, float wscale, LAS float* scr, int item, int lane) {
    const int nblk = Ndst / 32, kb = item / nblk, nb = item % nblk, k0 = 64 * kb, n0 = 32 * nb;
    const int n = n0 + (lane & 31); const int sc = wmap(kind, n);
    float tv[32];
#pragma unroll
    for (int i = 0; i < 32; ++i) { const int kk = 2 * i + (lane >> 5);
        float v = 0.f; if (sc >= 0) { v = W[(size_t)(k0 + kk) * srcN + sc] * wscale; if (kgain) v *= kgain[k0 + kk]; }
        tv[i] = v; }
#pragma unroll
    for (int i = 0; i < 32; ++i) scr[(2 * i + (lane >> 5)) * 33 + (lane & 31)] = tv[i];
    LDS_WAIT(); asm volatile("" ::: "memory");
    const int nn = lane >> 1, kh = (lane & 1) * 32; const LAS float* s = scr + kh * 33 + nn;
#pragma unroll
    for (int c = 0; c < 2; ++c) { v4u o;
        o.x = pk4_fp8(s[(16 * c + 0) * 33], s[(16 * c + 1) * 33], s[(16 * c + 2) * 33], s[(16 * c + 3) * 33]); o.y = pk4_fp8(s[(16 * c + 4) * 33], s[(16 * c + 5) * 33], s[(16 * c + 6) * 33], s[(16 * c + 7) * 33]);
        o.z = pk4_fp8(s[(16 * c + 8) * 33], s[(16 * c + 9) * 33], s[(16 * c + 10) * 33], s[(16 * c + 11) * 33]); o.w = pk4_fp8(s[(16 * c + 12) * 33], s[(16 * c + 13) * 33], s[(16 * c + 14) * 33], s[(16 * c + 15) * 33]);
        *(GAS v4u*)(WT + (size_t)(n0 + nn) * K + k0 + kh + 16 * c) = o; }
    LDS_WAIT(); asm volatile("" ::: "memory");
}
__device__ __forceinline__ void p_prologue(Frame& F, const Args& A) {
    const int tid_ = opaque_tid(), lane_ = tid_ & 63, wave_ = __builtin_amdgcn_readfirstlane(tid_ >> 6);
    LAS float* scr = (LAS float*)(F.lds + wave_ * 16384);
    const int gw = F.vcu * NWAVES + wave_, NGW = F.G * NWAVES;
    constexpr int I_P1A = (DM / 64) * (NP1A / 32), I_P1B = (DM / 64) * (NP1B / 32), I_P2A = (DM / 64) * (NP2A / 32), I_P2B = (DM / 64) * (NP2B / 32), I_UQ = (512 / 64) * (NQ / 32),
                  I_UKV = (512 / 64) * (NKV / 32), I_OA = (1024 / 64) * (DM / 32), I_OB = I_OA, I_OUT = (DM / 64) * (DM / 32), I_LAYER = I_P1A + I_P1B + I_P2A + I_P2B + I_UQ + I_UKV + I_OA + I_OB + I_OUT;
    for (int it = gw; it < DEPTH * I_LAYER; it += NGW) {
        const int l = it / I_LAYER; int r = it - l * I_LAYER;
        unsigned char* wb = F.ws + WS_W + (size_t)l * LW;
        const float* win = A.in[IN_W_IN] + (size_t)l * DM * IN_COLS;
        if (r < I_P1A) { transpose_item8(win, DM, IN_COLS, wb + W_P1A, NP1A, 5, nullptr, 64.f, scr, r, lane_); continue; } r -= I_P1A;
        if (r < I_P1B) { transpose_item(win, DM, IN_COLS, (bf16*)(wb + W_P1B), NP1B, 0, nullptr, scr, r, lane_); continue; } r -= I_P1B;
        if (r < I_P2A) { transpose_item8(win, DM, IN_COLS, wb + W_P2A, NP2A, 6, nullptr, 64.f, scr, r, lane_); continue; } r -= I_P2A;
        if (r < I_P2B) { transpose_item(win, DM, IN_COLS, (bf16*)(wb + W_P2B), NP2B, 1, nullptr, scr, r, lane_); continue; } r -= I_P2B;
        if (r < I_UQ) { transpose_item8(A.in[IN_W_UQ] + (size_t)l * 512 * NQ, 512, NQ, wb + W_UQ, NQ, 2, A.in[IN_Q_A_NORM] + l * 512, 32.f, scr, r, lane_); continue; } r -= I_UQ;
        if (r < I_UKV) { transpose_item8(A.in[IN_W_UKV] + (size_t)l * 512 * NKV, 512, NKV, wb + W_UKV, NKV, 3, A.in[IN_KV_A_NORM] + l * 512, 32.f, scr, r, lane_); continue; } r -= I_UKV;
        if (r < I_OA) { transpose_item8(A.in[IN_W_OA] + (size_t)l * 1024 * DM, 1024, DM, wb + W_OA, DM, 4, nullptr, 32.f, scr, r, lane_); continue; } r -= I_OA;
        if (r < I_OB) { transpose_item(A.in[IN_W_OB] + (size_t)l * 1024 * DM, 1024, DM, (bf16*)(wb + W_OB), DM, 4, nullptr, scr, r, lane_); continue; } r -= I_OB;
        transpose_item(A.in[IN_W_OUT] + (size_t)l * DM * DM, DM, DM, (bf16*)(wb + W_OUT), DM, 4, nullptr, scr, r, lane_);
    }
    for (int e = F.vcu * 512 + tid_; e < DEPTH * 1024; e += F.G * 512) ((float*)(F.ws + WS_HG))[e] = A.in[IN_M_HEAD_NORM][e];
    f32x2* rope = (f32x2*)(F.ws + WS_ROPE);
    for (int e = F.vcu * 512 + tid_; e < SEQ_P * 32; e += F.G * 512) {
        const int pos = e >> 5, i = e & 31;
        const float inv = powf(10000.0f, -(float)(2 * i) / 64.0f);
        const float ang = (float)pos * inv; float s, c; sincosf(ang, &s, &c);
        rope[e] = (f32x2){c, s};
    }
}

__device__ __forceinline__ const float* x_row(Frame& F, const Args& A, int layer, int m) {
    if (layer == 0) return m < MPROMPT ? A.in[IN_XP] + (size_t)m * DM : A.in[IN_XS] + (size_t)(m - MPROMPT) * DM;
    return F.out + (size_t)m * DM;
}
__device__ __forceinline__ void p_norm(Frame& F, const Args& A, int layer) {
    const int tid_ = opaque_tid(), lane_ = tid_ & 63, wave_ = __builtin_amdgcn_readfirstlane(tid_ >> 6);
    const int gw = F.vcu * NWAVES + wave_, NGW = F.G * NWAVES;
    const float* g = A.in[IN_NORM_IN] + layer * DM; bf16* XN = (bf16*)(F.ws + WS_XN);
    for (int m = gw; m < MTOK; m += NGW) {
        const GAS f32x4* xr = (const GAS f32x4*)x_row(F, A, layer, m) + lane_;
        f32x4 v[8]; float s = 0.f;
#pragma unroll
        for (int j = 0; j < 8; ++j) { v[j] = xr[64 * j]; s += (v[j].x * v[j].x + v[j].y * v[j].y) + (v[j].z * v[j].z + v[j].w * v[j].w); }
        const float rs = 1.0f / sqrtf(wave_sum(s) * (1.0f / DM) + EPS);
        GAS unsigned long long* o8 = (GAS unsigned long long*)(XN + (size_t)m * DM) + lane_;
#pragma unroll
        for (int j = 0; j < 8; ++j) { const f32x4 gg = *((const GAS f32x4*)g + lane_ + 64 * j);
            const float y0 = v[j].x * rs * gg.x, y1 = v[j].y * rs * gg.y, y2 = v[j].z * rs * gg.z, y3 = v[j].w * rs * gg.w;
            o8[64 * j] = (unsigned long long)cvtpk(y0, y1) | ((unsigned long long)cvtpk(y2, y3) << 32);
            ((GAS unsigned*)(F.ws + WS_XN8 + (size_t)m * DM))[lane_ + 64 * j] = pk4_fp8(y0, y1, y2, y3); }
    }
}
__device__ __forceinline__ void p_final(Frame& F, const Args& A) {
    const int tid_ = opaque_tid(), lane_ = tid_ & 63, wave_ = __builtin_amdgcn_readfirstlane(tid_ >> 6);
    const int gw = F.vcu * NWAVES + wave_, NGW = F.G * NWAVES;
    for (int m = gw; m < MTOK; m += NGW) {
        GAS f32x4* xr = (GAS f32x4*)(F.out + (size_t)m * DM) + lane_;
        f32x4 v[8]; float s = 0.f;
#pragma unroll
        for (int j = 0; j < 8; ++j) { v[j] = xr[64 * j]; s += (v[j].x * v[j].x + v[j].y * v[j].y) + (v[j].z * v[j].z + v[j].w * v[j].w); }
        const float rs = 1.0f / sqrtf(wave_sum(s) * (1.0f / DM) + EPS);
#pragma unroll
        for (int j = 0; j < 8; ++j) { const f32x4 gg = *((const GAS f32x4*)A.in[IN_NORM_F] + lane_ + 64 * j); xr[64 * j] = v[j] * rs * gg; }
    }
}

using pg8::Unit; using pg8::BM; using pg8::HALF;
#define EPI_ROWS_BEGIN  _Pragma("unroll") for (int ai = 0; ai < 2; ++ai) _Pragma("unroll") for (int m = 0; m < 4; ++m) { const int row = u.pm * BM + ai * HALF + wr * 64 + m * 16 + fr;
#define EPI_ROWS_END    asm volatile("" ::: "memory"); }
#define EPI_ROW(ai, m) (u.pm * BM + (ai) * HALF + wr * 64 + (m) * 16 + fr)
#define EPI_FENCE asm volatile("" ::: "memory")

struct EpiP1a {
    static constexpr int PERM = 2; static constexpr bool AFTER_DRAIN = false;
    unsigned char* ws; size_t dst;
    __device__ __forceinline__ void operator()(const f32x4 (&acc)[2][2][4][2], const Unit& u, int wr, int wc, int fr, int fq) const {
        const int pn = u.pn, col0 = pn * 256 + wc * 64 + 16 * fq;
        EPI_ROWS_BEGIN
            float s = 0.f; v4u w;
#pragma unroll
            for (int bj = 0; bj < 2; ++bj) { const f32x4 v0 = acc[ai][bj][m][0] * 0.015625f, v1 = acc[ai][bj][m][1] * 0.015625f;
                s += (v0[0] * v0[0] + v0[1] * v0[1]) + (v0[2] * v0[2] + v0[3] * v0[3]) + (v1[0] * v1[0] + v1[1] * v1[1]) + (v1[2] * v1[2] + v1[3] * v1[3]);
                w[2 * bj] = pk4_fp8(v0[0], v0[1], v0[2], v0[3]); w[2 * bj + 1] = pk4_fp8(v1[0], v1[1], v1[2], v1[3]); }
            *(v4u*)(ws + dst + (size_t)row * 1024 + col0) = w;
            s = sum_x16(s); s = sum_x32(s); if (fq == 0) ((float*)(ws + WS_SSQ))[(size_t)row * 16 + pn * 4 + wc] = s;
        EPI_ROWS_END
    }
};
struct EpiP1b {
    static constexpr bool PERM = true, AFTER_DRAIN = false;
    unsigned char* ws;
    __device__ __forceinline__ void operator()(const f32x4 (&acc)[2][2][4][2], const Unit& u, int wr, int wc, int fr, int fq) const {
        const int pn = u.pn;
        if (pn < 12) {
            bf16* base = (bf16*)(ws + WS_QM + (size_t)(pn >> 2) * U); const int col0 = (pn & 3) * 256 + wc * 32 + 8 * fq;
            EPI_ROWS_BEGIN
                bf16* rowp = base + (size_t)row * 1024 + col0;
#pragma unroll
                for (int bj = 0; bj < 2; ++bj) { const f32x4 v0 = acc[ai][bj][m][0], v1 = acc[ai][bj][m][1];
                    v4u w; w.x = cvtpk(v0[0], v0[1]); w.y = cvtpk(v0[2], v0[3]); w.z = cvtpk(v1[0], v1[1]); w.w = cvtpk(v1[2], v1[3]);
                    *(v4u*)(rowp + bj * HALF) = w; }
            EPI_ROWS_END
        } else if (wc < 2) {
#pragma unroll
            for (int ai = 0; ai < 2; ++ai) { f32x4 cs[4][2];
#pragma unroll
                for (int m = 0; m < 4; ++m) { const f32x2* rp = (const f32x2*)(ws + WS_ROPE) + seq_pos(EPI_ROW(ai, m)) * 32 + 16 * wc + 4 * fq; cs[m][0] = *(const f32x4*)rp; cs[m][1] = *(const f32x4*)(rp + 2); }
                EPI_FENCE;
#pragma unroll
                for (int m = 0; m < 4; ++m) { const f32x4 cs01 = cs[m][0], cs23 = cs[m][1]; const f32x4 a = acc[ai][0][m][0], b = acc[ai][0][m][1];
                    *(u32x2*)(ws + WS_KR + (size_t)EPI_ROW(ai, m) * 64 + 32 * wc + 8 * fq) = (u32x2){
                        pk4_fp8(a[0] * cs01[0] - a[1] * cs01[1], a[1] * cs01[0] + a[0] * cs01[1], a[2] * cs01[2] - a[3] * cs01[3], a[3] * cs01[2] + a[2] * cs01[3]),
                        pk4_fp8(b[0] * cs23[0] - b[1] * cs23[1], b[1] * cs23[0] + b[0] * cs23[1], b[2] * cs23[2] - b[3] * cs23[3], b[3] * cs23[2] + b[2] * cs23[3])};
                    EPI_FENCE; } }
        } else if (wc == 2) {
            EPI_ROWS_BEGIN
                float* gp = (float*)(ws + WS_KRG) + (size_t)row * 96 + 64 + 8 * fq;
                *(f32x4*)gp = acc[ai][0][m][0]; *(f32x4*)(gp + 4) = acc[ai][0][m][1];
            EPI_ROWS_END
        }
    }
};
struct EpiQ {
    static constexpr bool PERM = true, AFTER_DRAIN = false;
    unsigned char* ws;
    __device__ __forceinline__ void operator()(const f32x4 (&acc)[2][2][4][2], const Unit& u, int wr, int wc, int fr, int fq) const {
        const int col0 = u.pn * 256 + wc * 32 + 8 * fq;
#pragma unroll
        for (int ai = 0; ai < 2; ++ai) {
            f32x4 sq[4][2];
#pragma unroll
            for (int m = 0; m < 4; ++m) { const float* sp = (const float*)(ws + WS_SSQ) + (size_t)EPI_ROW(ai, m) * 16; sq[m][0] = *(const f32x4*)sp; sq[m][1] = *(const f32x4*)(sp + 4); }
            EPI_FENCE;
#pragma unroll
            for (int m = 0; m < 4; ++m) { const int row = EPI_ROW(ai, m); const f32x4 s0 = sq[m][0], s1 = sq[m][1];
                const float rs = 0.03125f / sqrtf(((s0[0] + s0[1]) + (s0[2] + s0[3]) + (s1[0] + s1[1]) + (s1[2] + s1[3])) * (1.0f / 512.0f) + EPS);
                bf16* rowp = (bf16*)(ws + WS_Q) + (size_t)row * NQ + col0;
#pragma unroll
                for (int bj = 0; bj < 2; ++bj) { const f32x4 v0 = acc[ai][bj][m][0] * rs, v1 = acc[ai][bj][m][1] * rs;
                    v4u w; w.x = cvtpk(v0[0], v0[1]); w.y = cvtpk(v0[2], v0[3]); w.z = cvtpk(v1[0], v1[1]); w.w = cvtpk(v1[2], v1[3]);
                    *(v4u*)(rowp + bj * HALF) = w; }
                EPI_FENCE; }
        }
    }
};
struct EpiK8 {
    static constexpr int PERM = 2; static constexpr bool AFTER_DRAIN = false;
    unsigned char* ws;
    __device__ __forceinline__ void operator()(const f32x4 (&acc)[2][2][4][2], const Unit& u, int wr, int wc, int fr, int fq) const {
        const int col0 = u.pn * 256 + wc * 64 + 16 * fq;
#pragma unroll
        for (int ai = 0; ai < 2; ++ai) {
            f32x4 sq[4][2];
#pragma unroll
            for (int m = 0; m < 4; ++m) { const float* sp = (const float*)(ws + WS_SSQ) + (size_t)EPI_ROW(ai, m) * 16 + 8; sq[m][0] = *(const f32x4*)sp; sq[m][1] = *(const f32x4*)(sp + 4); }
            EPI_FENCE;
#pragma unroll
            for (int m = 0; m < 4; ++m) { const int row = EPI_ROW(ai, m); const f32x4 s0 = sq[m][0], s1 = sq[m][1];
                const float rs = 0.03125f / sqrtf(((s0[0] + s0[1]) + (s0[2] + s0[3]) + (s1[0] + s1[1]) + (s1[2] + s1[3])) * (1.0f / 512.0f) + EPS);
                v4u w;
#pragma unroll
                for (int bj = 0; bj < 2; ++bj) { const f32x4 v0 = acc[ai][bj][m][0] * rs, v1 = acc[ai][bj][m][1] * rs;
                    w[2 * bj] = pk4_fp8(v0[0], v0[1], v0[2], v0[3]); w[2 * bj + 1] = pk4_fp8(v1[0], v1[1], v1[2], v1[3]); }
                *(v4u*)(ws + WS_K8 + (size_t)row * 1024 + col0) = w;
                EPI_FENCE; }
        }
    }
};
struct EpiVT {
    static constexpr int PERM = 2; static constexpr bool AFTER_DRAIN = false;
    unsigned char* ws;
    __device__ __forceinline__ void operator()(const f32x4 (&acc)[2][2][4][2], const Unit& u, int wr, int wc, int fr, int fq) const {
        const int tok0 = u.pn * 256 + wc * 64 + 16 * fq;
        const int J0 = 2 * fq, pos = 4 * (J0 & 3) + 16 * (J0 >> 2);
        f32x4 rq[2][2];
#pragma unroll
        for (int bj = 0; bj < 2; ++bj) { f32x4 sq[8][2];
#pragma unroll
            for (int e = 0; e < 8; ++e) { const float* sp = (const float*)(ws + WS_SSQ) + (size_t)(tok0 + 8 * bj + e) * 16 + 8; sq[e][0] = *(const f32x4*)sp; sq[e][1] = *(const f32x4*)(sp + 4); }
            EPI_FENCE;
#pragma unroll
            for (int e = 0; e < 8; ++e) { const f32x4 s0 = sq[e][0], s1 = sq[e][1];
                rq[bj][e >> 2][e & 3] = 0.03125f / sqrtf(((s0[0] + s0[1]) + (s0[2] + s0[3]) + (s1[0] + s1[1]) + (s1[2] + s1[3])) * (1.0f / 512.0f) + EPS); } }
        EPI_ROWS_BEGIN
            unsigned char* rowp = ws + WS_V8T + ((size_t)(tok0 >> 6) * 1024 + row) * 64 + pos;
            const f32x4 a0 = acc[ai][0][m][0] * rq[0][0], a1 = acc[ai][0][m][1] * rq[0][1], b0 = acc[ai][1][m][0] * rq[1][0], b1 = acc[ai][1][m][1] * rq[1][1];
            *(u32x2*)rowp = (u32x2){pk4_fp8(a0[0], a0[1], a0[2], a0[3]), pk4_fp8(b0[0], b0[1], b0[2], b0[3])};
            *(u32x2*)(rowp + 32) = (u32x2){pk4_fp8(a1[0], a1[1], a1[2], a1[3]), pk4_fp8(b1[0], b1[1], b1[2], b1[3])};
        EPI_ROWS_END
    }
};
struct EpiP2a {
    static constexpr int PERM = 2; static constexpr bool AFTER_DRAIN = false;
    unsigned char* ws; size_t sga;
    __device__ __forceinline__ void operator()(const f32x4 (&acc)[2][2][4][2], const Unit& u, int wr, int wc, int fr, int fq) const {
        const int pn = u.pn;
        if (pn < 4) {
            const int col0 = pn * 256 + wc * 64 + 16 * fq;
#pragma unroll
            for (int ai = 0; ai < 2; ++ai) { v4u ov[4][2];
#pragma unroll
              for (int m = 0; m < 4; ++m) { const bf16* orow = (const bf16*)(ws + WS_CQKV) + (size_t)EPI_ROW(ai, m) * 1024 + col0; ov[m][0] = *(const v4u*)orow; ov[m][1] = *(const v4u*)(orow + 8); }
              EPI_FENCE;
#pragma unroll
              for (int m = 0; m < 4; ++m) { const int row = EPI_ROW(ai, m); v4u w;
#pragma unroll
                for (int bj = 0; bj < 2; ++bj) { f32x4 v0 = acc[ai][bj][m][0] * 0.015625f, v1 = acc[ai][bj][m][1] * 0.015625f;
                    const v4u o = ov[m][bj];
#pragma unroll
                    for (int j = 0; j < 4; ++j) { v0[j] = 64.f * siluf_(v0[j]); v1[j] = 64.f * siluf_(v1[j]); }
                    v0[0] *= bflo(o.x); v0[1] *= bfhi(o.x); v0[2] *= bflo(o.y); v0[3] *= bfhi(o.y); v1[0] *= bflo(o.z); v1[1] *= bfhi(o.z); v1[2] *= bflo(o.w); v1[3] *= bfhi(o.w);
                    w[2 * bj] = pk4_fp8(v0[0], v0[1], v0[2], v0[3]); w[2 * bj + 1] = pk4_fp8(v1[0], v1[1], v1[2], v1[3]); }
                *(v4u*)(ws + WS_YA8 + (size_t)row * 1024 + col0) = w;
                EPI_FENCE; } }
        } else {
            const int col0 = (pn - 4) * 256 + wc * 64 + 16 * fq;
            EPI_ROWS_BEGIN
                bf16* rowp = (bf16*)(ws + sga) + (size_t)row * 2048 + col0;
#pragma unroll
                for (int bj = 0; bj < 2; ++bj) { f32x4 v0 = acc[ai][bj][m][0] * 0.015625f, v1 = acc[ai][bj][m][1] * 0.015625f;
#pragma unroll
                    for (int j = 0; j < 4; ++j) { v0[j] = sigmoidf_(v0[j]); v1[j] = sigmoidf_(v1[j]); }
                    v4u w; w.x = cvtpk(v0[0], v0[1]); w.y = cvtpk(v0[2], v0[3]); w.z = cvtpk(v1[0], v1[1]); w.w = cvtpk(v1[2], v1[3]);
                    *(v4u*)(rowp + 8 * bj) = w; }
            EPI_ROWS_END
        }
    }
};
struct EpiP2b {
    static constexpr bool PERM = true, AFTER_DRAIN = false;
    unsigned char* ws; int layer;
    __device__ __forceinline__ void operator()(const f32x4 (&acc)[2][2][4][2], const Unit& u, int wr_, int wc_, int fr_, int fq_) const {
        const int t_ = opaque_tid(), wr = t_ >> 8, wc = (t_ >> 6) & 3, fr = t_ & 15, fq = (t_ >> 4) & 3;
        const int pn = u.pn;
        if (pn < 8) {
            extern __shared__ __attribute__((aligned(16))) unsigned char lds[];
            LAS float* red = (LAS float*)((LAS unsigned char*)lds + 131072);
            const int colh = pn * 128 + wc * 32 + 8 * fq;
#pragma unroll
            for (int ai = 0; ai < 2; ++ai) { v4u ha[4], hb[4];
#pragma unroll
                for (int m = 0; m < 4; ++m) { const size_t off = (size_t)EPI_ROW(ai, m) * 1024 + colh; ha[m] = *(const v4u*)((const bf16*)(ws + WS_HFW) + off); hb[m] = *(const v4u*)((const bf16*)(ws + WS_HBW) + off); }
                EPI_FENCE;
#pragma unroll
                for (int m = 0; m < 4; ++m) { const v4u a = ha[m], b = hb[m]; float s = 0.f;
#pragma unroll
                    for (int e = 0; e < 4; ++e) { const float lo = bflo(a[e]) + bflo(b[e]), hi = bfhi(a[e]) + bfhi(b[e]); s += lo * lo + hi * hi; }
                    s = sum_x16(s); s = sum_x32(s);
                    if (fq == 0) red[(wr * 128 + ai * 64 + m * 16 + fr) * 4 + wc] = s; }
                EPI_FENCE; }
            LDS_WAIT(); __builtin_amdgcn_s_barrier(); asm volatile("" ::: "memory");
            const int t2_ = opaque_tid(), wr2 = t2_ >> 8, fr2 = t2_ & 15, colh2 = pn * 128 + ((t2_ >> 6) & 3) * 32 + 8 * ((t2_ >> 4) & 3);
#define EPI_ROW2(ai, m) (u.pm * BM + (ai) * HALF + wr2 * 64 + (m) * 16 + fr2)
            const float* gain = (const float*)(ws + WS_HG) + layer * 1024 + colh2; const f32x4 g0 = *(const f32x4*)gain, g1 = *(const f32x4*)(gain + 4);
#pragma unroll
            for (int ai = 0; ai < 2; ++ai)
#pragma unroll
              for (int mh = 0; mh < 2; ++mh) { v4u ha[2], hb[2];
#pragma unroll
                for (int mm = 0; mm < 2; ++mm) { const size_t off = (size_t)EPI_ROW2(ai, 2 * mh + mm) * 1024 + colh2; ha[mm] = *(const v4u*)((const bf16*)(ws + WS_HFW) + off); hb[mm] = *(const v4u*)((const bf16*)(ws + WS_HBW) + off); }
                EPI_FENCE;
#pragma unroll
                for (int mm = 0; mm < 2; ++mm) { const int m = 2 * mh + mm; const size_t off = (size_t)EPI_ROW2(ai, m) * 1024 + colh2;
                    const f32x4 pr = *(const LAS f32x4*)(red + (wr2 * 128 + ai * 64 + m * 16 + fr2) * 4);
                    const float rs = 1.0f / sqrtf(((pr[0] + pr[1]) + (pr[2] + pr[3])) * (1.0f / 128.0f) + EPS);
                    const v4u a = ha[mm], b = hb[mm];
                    const f32x4 o0 = acc[ai][0][m][0], o1 = acc[ai][0][m][1], z0 = acc[ai][1][m][0], z1 = acc[ai][1][m][1];
                    float y[8];
#pragma unroll
                    for (int e = 0; e < 4; ++e) { y[2 * e] = (bflo(a[e]) + bflo(b[e])) * rs; y[2 * e + 1] = (bfhi(a[e]) + bfhi(b[e])) * rs; }
#pragma unroll
                    for (int j = 0; j < 4; ++j) { y[j] *= g0[j] * sigmoidf_(o0[j]) * (z0[j] * sigmoidf_(z0[j])); y[4 + j] *= g1[j] * sigmoidf_(o1[j]) * (z1[j] * sigmoidf_(z1[j])); }
                    v4u w; w.x = cvtpk(y[0], y[1]); w.y = cvtpk(y[2], y[3]); w.z = cvtpk(y[4], y[5]); w.w = cvtpk(y[6], y[7]);
                    *(v4u*)((bf16*)(ws + WS_HFW) + off) = w;
                    EPI_FENCE; } }
        } else {
            const int col0 = (pn - 8) * 256 + wc * 32 + 8 * fq;
            EPI_ROWS_BEGIN
                bf16* rowp = (bf16*)(ws + WS_SGB) + (size_t)row * 2048 + col0;
#pragma unroll
                for (int bj = 0; bj < 2; ++bj) { f32x4 v0 = acc[ai][bj][m][0], v1 = acc[ai][bj][m][1];
#pragma unroll
                    for (int j = 0; j < 4; ++j) { v0[j] = sigmoidf_(v0[j]); v1[j] = sigmoidf_(v1[j]); }
                    v4u w; w.x = cvtpk(v0[0], v0[1]); w.y = cvtpk(v0[2], v0[3]); w.z = cvtpk(v1[0], v1[1]); w.w = cvtpk(v1[2], v1[3]);
                    *(v4u*)(rowp + bj * HALF) = w; }
            EPI_ROWS_END
        }
    }
};
struct MidMerge {
    unsigned char* ws;
    __device__ __forceinline__ void operator()(f32x4 (&acc)[2][2][4][2], const Unit& u, int wr, int wc, int fr, int fq) const {
        const int col0 = u.pn * 256 + wc * 32 + 8 * fq;
#pragma unroll
        for (int ai = 0; ai < 2; ++ai)
#pragma unroll
          for (int mh = 0; mh < 2; ++mh) {
            v4u ga[2][2], gb[2][2];
#pragma unroll
            for (int mm = 0; mm < 2; ++mm)
#pragma unroll
                for (int bj = 0; bj < 2; ++bj) { const size_t off = (size_t)EPI_ROW(ai, 2 * mh + mm) * DM + col0 + bj * HALF; ga[mm][bj] = *(const v4u*)((const bf16*)(ws + WS_SGA) + off); gb[mm][bj] = *(const v4u*)((const bf16*)(ws + WS_SGB) + off); }
            EPI_FENCE;
#pragma unroll
            for (int mm = 0; mm < 2; ++mm)
#pragma unroll
                for (int bj = 0; bj < 2; ++bj) { const int m = 2 * mh + mm; const v4u a = ga[mm][bj], b = gb[mm][bj]; float r[8];
#pragma unroll
                    for (int e = 0; e < 4; ++e) { r[2 * e] = 2048.f * bflo(b[e]) * __builtin_amdgcn_rcpf(fmaxf(bflo(a[e]), 9.094947e-13f)); r[2 * e + 1] = 2048.f * bfhi(b[e]) * __builtin_amdgcn_rcpf(fmaxf(bfhi(a[e]), 9.094947e-13f)); }
                    f32x4 v0 = acc[ai][bj][m][0], v1 = acc[ai][bj][m][1];
                    v0[0] *= r[0]; v0[1] *= r[1]; v0[2] *= r[2]; v0[3] *= r[3]; v1[0] *= r[4]; v1[1] *= r[5]; v1[2] *= r[6]; v1[3] *= r[7];
                    acc[ai][bj][m][0] = v0; acc[ai][bj][m][1] = v1; }
            EPI_FENCE;
          }
    }
};
struct EpiMerge2 {
    static constexpr bool PERM = true, AFTER_DRAIN = false;
    unsigned char* ws;
    __device__ __forceinline__ void operator()(const f32x4 (&acc)[2][2][4][2], const Unit& u, int wr, int wc, int fr, int fq) const {
        const int col0 = u.pn * 256 + wc * 32 + 8 * fq; bf16* T = (bf16*)(ws + WS_MG);
#pragma unroll
        for (int ai = 0; ai < 2; ++ai) {
            v4u gv[4][2];
#pragma unroll
            for (int m = 0; m < 4; ++m)
#pragma unroll
                for (int bj = 0; bj < 2; ++bj) gv[m][bj] = *(const v4u*)((const bf16*)(ws + WS_SGA) + (size_t)EPI_ROW(ai, m) * DM + col0 + bj * HALF);
            EPI_FENCE;
#pragma unroll
            for (int m = 0; m < 4; ++m) { const size_t off = (size_t)EPI_ROW(ai, m) * DM + col0;
#pragma unroll
                for (int bj = 0; bj < 2; ++bj) { f32x4 v0 = acc[ai][bj][m][0] * 0.00048828125f, v1 = acc[ai][bj][m][1] * 0.00048828125f; const v4u g = gv[m][bj];
                    v0[0] *= fmaxf(bflo(g.x), 9.094947e-13f); v0[1] *= fmaxf(bfhi(g.x), 9.094947e-13f); v0[2] *= fmaxf(bflo(g.y), 9.094947e-13f); v0[3] *= fmaxf(bfhi(g.y), 9.094947e-13f);
                    v1[0] *= fmaxf(bflo(g.z), 9.094947e-13f); v1[1] *= fmaxf(bfhi(g.z), 9.094947e-13f); v1[2] *= fmaxf(bflo(g.w), 9.094947e-13f); v1[3] *= fmaxf(bfhi(g.w), 9.094947e-13f);
                    v4u w; w.x = cvtpk(v0[0], v0[1]); w.y = cvtpk(v0[2], v0[3]); w.z = cvtpk(v1[0], v1[1]); w.w = cvtpk(v1[2], v1[3]);
                    *(v4u*)(T + off + bj * HALF) = w; }
                EPI_FENCE; }
        }
    }
};
template <bool LAST> struct EpiOutX {
    static constexpr bool PERM = true, AFTER_DRAIN = false;
    const float* xp; const float* xs; float* out; unsigned char* ws; const float* gn; int layer;
    __device__ __forceinline__ void operator()(f32x4 (&acc)[2][2][4][2], const Unit& u, int wr, int wc, int fr, int fq) const {
        extern __shared__ __attribute__((aligned(16))) unsigned char lds[];
        LAS float* red = (LAS float*)((LAS unsigned char*)lds + 131072);
        const int col0 = u.pn * 256 + wc * 32 + 8 * fq;
#pragma unroll
        for (int ai = 0; ai < 2; ++ai) {
            f32x4 xv[4][2][2];
#pragma unroll
            for (int m = 0; m < 4; ++m) { const int row = EPI_ROW(ai, m);
                const float* xr = (layer == 0 ? (row < MPROMPT ? xp + (size_t)row * DM : xs + (size_t)(row - MPROMPT) * DM) : out + (size_t)row * DM) + col0;
#pragma unroll
                for (int bj = 0; bj < 2; ++bj)
#pragma unroll
                    for (int n = 0; n < 2; ++n) xv[m][bj][n] = *(const f32x4*)(xr + bj * HALF + n * 4); }
            EPI_FENCE;
#pragma unroll
            for (int m = 0; m < 4; ++m) { float s = 0.f;
#pragma unroll
                for (int bj = 0; bj < 2; ++bj)
#pragma unroll
                    for (int n = 0; n < 2; ++n) { const f32x4 v = xv[m][bj][n] + acc[ai][bj][m][n]; acc[ai][bj][m][n] = v; s += (v[0] * v[0] + v[1] * v[1]) + (v[2] * v[2] + v[3] * v[3]); }
                s = sum_x16(s); s = sum_x32(s);
                if (fq == 0) red[(wr * 128 + ai * 64 + m * 16 + fr) * 4 + wc] = s; }
            EPI_FENCE;
        }
        LDS_WAIT(); __builtin_amdgcn_s_barrier(); asm volatile("" ::: "memory");
        const int t_ = opaque_tid();
        if (t_ < 256) { const int wr_t = t_ >> 7, rl = t_ & 127; const f32x4 pr = *(const LAS f32x4*)(red + (wr_t * 128 + rl) * 4);
            const int row_t = u.pm * BM + (rl >> 6) * HALF + wr_t * 64 + (rl & 63);
            __hip_atomic_store((float*)(ws + WS_SSF) + (size_t)row_t * 8 + u.pn, (pr[0] + pr[1]) + (pr[2] + pr[3]), __ATOMIC_RELAXED, __HIP_MEMORY_SCOPE_AGENT); }
        asm volatile("s_waitcnt vmcnt(0)" ::: "memory");
        __syncthreads();
        if (t_ == 0) { unsigned* cnt = (unsigned*)(ws + WS_CTL) + CW_PANEL + layer * 256 + u.pm;
            __hip_atomic_fetch_add(cnt, 1u, __ATOMIC_RELAXED, __HIP_MEMORY_SCOPE_AGENT);
            unsigned sp = 0; while (__hip_atomic_load(cnt, __ATOMIC_RELAXED, __HIP_MEMORY_SCOPE_AGENT) < 8u && ++sp < (1u << 22)) __builtin_amdgcn_s_sleep(1);
            __builtin_amdgcn_fence(__ATOMIC_ACQUIRE, "agent"); asm volatile("s_waitcnt vmcnt(0)" ::: "memory"); }
        __syncthreads();
        const int t2_ = opaque_tid(), wr2 = t2_ >> 8, fr2 = t2_ & 15, colb = u.pn * 256 + ((t2_ >> 6) & 3) * 32 + 8 * ((t2_ >> 4) & 3);
        f32x4 g[2][2];
#pragma unroll
        for (int bj = 0; bj < 2; ++bj) { g[bj][0] = *(const f32x4*)(gn + colb + bj * HALF); g[bj][1] = *(const f32x4*)(gn + colb + bj * HALF + 4); }
#pragma unroll
        for (int ai = 0; ai < 2; ++ai) { f32x4 sf[4][2];
#pragma unroll
            for (int m = 0; m < 4; ++m) { const float* sp = (const float*)(ws + WS_SSF) + (size_t)(u.pm * BM + ai * HALF + wr2 * 64 + m * 16 + fr2) * 8; sf[m][0] = *(const f32x4*)sp; sf[m][1] = *(const f32x4*)(sp + 4); }
            EPI_FENCE;
#pragma unroll
            for (int m = 0; m < 4; ++m) { const int row = u.pm * BM + ai * HALF + wr2 * 64 + m * 16 + fr2; const f32x4 a = sf[m][0], b = sf[m][1];
                const float rs = 1.0f / sqrtf((((a[0] + a[1]) + (a[2] + a[3])) + ((b[0] + b[1]) + (b[2] + b[3]))) * (1.0f / DM) + EPS);
                float* orow = out + (size_t)row * DM + colb;
#pragma unroll
                for (int bj = 0; bj < 2; ++bj) {
                    const f32x4 y0 = acc[ai][bj][m][0], y1 = acc[ai][bj][m][1]; const f32x4 n0 = y0 * rs * g[bj][0], n1 = y1 * rs * g[bj][1];
                    if constexpr (LAST) { *(f32x4*)(orow + bj * HALF) = n0; *(f32x4*)(orow + bj * HALF + 4) = n1; }
                    else { *(f32x4*)(orow + bj * HALF) = y0; *(f32x4*)(orow + bj * HALF + 4) = y1;
                        v4u w; w.x = cvtpk(n0[0], n0[1]); w.y = cvtpk(n0[2], n0[3]); w.z = cvtpk(n1[0], n1[1]); w.w = cvtpk(n1[2], n1[3]);
                        *(v4u*)((bf16*)(ws + WS_XN) + (size_t)row * DM + colb + bj * HALF) = w;
                        *(u32x2*)(ws + WS_XN8 + (size_t)row * DM + colb + bj * HALF) = (u32x2){pk4_fp8(n0[0], n0[1], n0[2], n0[3]), pk4_fp8(n1[0], n1[1], n1[2], n1[3])}; } }
                EPI_FENCE; } }
    }
};
struct EpiOut {
    static constexpr bool PERM = false, AFTER_DRAIN = false;
    const float* xp; const float* xs; float* out; int layer;
    __device__ __forceinline__ void operator()(const f32x4 (&acc)[2][2][4][2], const Unit& u, int wr, int wc, int fr, int fq) const {
        const int col0 = u.pn * 256 + wc * 32 + 4 * fq;
#pragma unroll
        for (int ai = 0; ai < 2; ++ai) {
            f32x4 xv[4][2][2];
#pragma unroll
            for (int m = 0; m < 4; ++m) { const int row = EPI_ROW(ai, m);
                const float* xr = (layer == 0 ? (row < MPROMPT ? xp + (size_t)row * DM : xs + (size_t)(row - MPROMPT) * DM) : out + (size_t)row * DM) + col0;
#pragma unroll
                for (int bj = 0; bj < 2; ++bj)
#pragma unroll
                    for (int n = 0; n < 2; ++n) xv[m][bj][n] = *(const f32x4*)(xr + bj * HALF + n * 16); }
            EPI_FENCE;
#pragma unroll
            for (int m = 0; m < 4; ++m) { float* orow = out + (size_t)EPI_ROW(ai, m) * DM + col0;
#pragma unroll
                for (int bj = 0; bj < 2; ++bj)
#pragma unroll
                    for (int n = 0; n < 2; ++n) *(f32x4*)(orow + bj * HALF + n * 16) = xv[m][bj][n] + acc[ai][bj][m][n];
                EPI_FENCE; }
        }
    }
};

namespace att8 {
constexpr int NW = 8, QBLK = 32, KVBLK = 64;
constexpr float CL2 = 0.07216878364870322f * 1.4426950408889634f;
constexpr float QSC = CL2 * 8.0f;
constexpr float BIAS = 7.0f, THR = 1.5f;
constexpr int NB = 3, SZ_KN = 64 * 128, SZ_KR = 64 * 64, SZ_VT = 128 * 64;
constexpr int OFF_KN = 0, OFF_KR = OFF_KN + NB * SZ_KN, OFF_VT = OFF_KR + NB * SZ_KR, OFF_WS = OFF_VT + NB * SZ_VT, SHM_ATTN = OFF_WS + NW * 64 * 4;
typedef int v8i __attribute__((ext_vector_type(8)));
__device__ __forceinline__ int crow(int r, int hi) { return (r & 3) + 8 * (r >> 2) + 4 * hi; }
#define SBAR8() __builtin_amdgcn_sched_barrier(0)
__device__ __forceinline__ v8i ld2x16(const char* pa, const char* pb) { const v4u a = *reinterpret_cast<const v4u*>(pa), b = *reinterpret_cast<const v4u*>(pb); return (v8i){(int)a.x, (int)a.y, (int)a.z, (int)a.w, (int)b.x, (int)b.y, (int)b.z, (int)b.w}; }
#define MFMA8S(A, B, Cc) __builtin_amdgcn_mfma_scale_f32_32x32x64_f8f6f4(A, B, Cc, 0, 0, 0, 0x7C7C7C7C, 0, 0x7F7F7F7F)
#define MFMA8(A, B, Cc) __builtin_amdgcn_mfma_scale_f32_32x32x64_f8f6f4(A, B, Cc, 0, 0, 0, 0, 0, 0)

template <int VAR = 0>
__device__ __forceinline__ void attn_unit(const bf16* __restrict__ Qn, const bf16* __restrict__ Qr, const unsigned char* __restrict__ K8, const unsigned char* __restrict__ KR8,
                                          const unsigned char* __restrict__ V8T, bf16* __restrict__ Ob, int seq, const f32x2* __restrict__ rope, int qpos0, char* lds) {
  const int tid = opaque_tid(), wid = tid >> 6, lane = tid & 63, r32 = lane & 31, hi = lane >> 5;
  const int wv = __builtin_amdgcn_readfirstlane(wid);
  float* ws = (float*)(lds + OFF_WS) + wid * 64; float* li_l = ws; float* al_l = ws + 32;
  v8i qf[3];
  { const bf16* Qw = Qn + (long)(wid * QBLK + r32) * NQ;
#pragma unroll
    for (int ks = 0; ks < 2; ++ks) {
#pragma unroll
      for (int c = 0; c < 4; ++c) { const v4u raw = *reinterpret_cast<const v4u*>(Qw + 64 * ks + 32 * hi + 8 * c);
        qf[ks][2 * c] = (int)pk4_fp8(bflo(raw.x) * QSC, bfhi(raw.x) * QSC, bflo(raw.y) * QSC, bfhi(raw.y) * QSC);
        qf[ks][2 * c + 1] = (int)pk4_fp8(bflo(raw.z) * QSC, bfhi(raw.z) * QSC, bflo(raw.w) * QSC, bfhi(raw.w) * QSC); } }
    const bf16* Rw = Qr + (long)(wid * QBLK + r32) * NQ + 32 * hi;
    const f32x2* rp = rope + (qpos0 + wid * QBLK + r32) * 32 + 16 * hi;
#pragma unroll
    for (int c = 0; c < 4; ++c) { const v4u raw = *reinterpret_cast<const v4u*>(Rw + 8 * c);
      const f32x4 cs01 = *(const f32x4*)(rp + 4 * c), cs23 = *(const f32x4*)(rp + 4 * c + 2);
      float a0, a1, a2, a3, a4, a5, a6, a7;
      { const float x1 = bflo(raw.x), x2 = bfhi(raw.x); a0 = x1 * cs01[0] - x2 * cs01[1]; a1 = x2 * cs01[0] + x1 * cs01[1]; }
      { const float x1 = bflo(raw.y), x2 = bfhi(raw.y); a2 = x1 * cs01[2] - x2 * cs01[3]; a3 = x2 * cs01[2] + x1 * cs01[3]; }
      { const float x1 = bflo(raw.z), x2 = bfhi(raw.z); a4 = x1 * cs23[0] - x2 * cs23[1]; a5 = x2 * cs23[0] + x1 * cs23[1]; }
      { const float x1 = bflo(raw.w), x2 = bfhi(raw.w); a6 = x1 * cs23[2] - x2 * cs23[3]; a7 = x2 * cs23[2] + x1 * cs23[3]; }
      qf[2][2 * c] = (int)pk4_fp8(a0 * QSC, a1 * QSC, a2 * QSC, a3 * QSC); qf[2][2 * c + 1] = (int)pk4_fp8(a4 * QSC, a5 * QSC, a6 * QSC, a7 * QSC); } }
  const int dk_key = 8 * wv + (lane >> 3), dr_key = 16 * (wv & 3) + (lane >> 2), dv_d = 16 * wv + (lane >> 2);
  const unsigned char* gk = K8 + (long)dk_key * 1024 + (((lane & 7) ^ ((dk_key >> 1) & 7)) << 4);
  const unsigned char* gr = KR8 + (long)dr_key * 64 + (((lane & 3) ^ ((dr_key >> 2) & 3)) << 4);
  const unsigned char* gv = V8T + (long)dv_d * 64 + (((lane & 3) ^ ((dv_d >> 2) & 3)) << 4);
  LAS unsigned char* ldsa = (LAS unsigned char*)lds;
#define DMA8(tk, bk, tv, bv) do { if constexpr (VAR & 8) break; \
    __builtin_amdgcn_global_load_lds((const unsigned*)(gk + (long)(tk) * (KVBLK * 1024)), (LAS unsigned*)(ldsa + OFF_KN + (bk) * SZ_KN + wv * 1024), 16, 0, 0); \
    __builtin_amdgcn_global_load_lds((const unsigned*)(gr + (long)(tk) * (KVBLK * 64)), (LAS unsigned*)(ldsa + OFF_KR + (bk) * SZ_KR + (wv & 3) * 1024), 16, 0, 0); \
    __builtin_amdgcn_global_load_lds((const unsigned*)(gv + (long)(tv) * (KVBLK * 1024)), (LAS unsigned*)(ldsa + OFF_VT + (bv) * SZ_VT + wv * 1024), 16, 0, 0); } while (0)
#define TBAR8() do { if constexpr (!(VAR & 8)) asm volatile("s_waitcnt vmcnt(3)" ::: "memory"); if constexpr (VAR & 16) break; asm volatile("s_waitcnt lgkmcnt(0)" ::: "memory"); __builtin_amdgcn_s_barrier(); asm volatile("" ::: "memory"); } while (0)
  const int g8 = (r32 >> 1) & 7, g4 = (r32 >> 2) & 3;
  const int kn0 = r32 * 128 + (((2 * hi) ^ g8) << 4), kn1 = r32 * 128 + (((2 * hi + 1) ^ g8) << 4);
  const int rv0 = r32 * 64 + (((2 * hi) ^ g4) << 4), rv1 = r32 * 64 + (((2 * hi + 1) ^ g4) << 4);
  float nm = BIAS, l_reg = 0.f;
  const f32x16 zero16 = {}; f32x16 o[4] = {};
  f32x16 nmv;
  _Pragma("unroll") for (int r = 0; r < 16; ++r) nmv[r] = nm; asm volatile("" : "+v"(nmv));
  const int NT = seq / KVBLK;
#define EXPR8(P, ra, rb) do { if constexpr (VAR & 2) break; _Pragma("unroll") for (int r = (ra); r < (rb); ++r) P[r] = __builtin_amdgcn_exp2f(P[r]); } while (0)
#define QKM8(A, B, Cc) ((VAR & 1) ? ({ f32x16 t_ = Cc; asm volatile("" : "+v"(t_) : "v"(A)); t_; }) : MFMA8S(A, B, Cc))
#define PVM8(A, B, Cc) ((VAR & 4) ? ({ f32x16 t_ = Cc; asm volatile("" : "+v"(t_) : "v"(B)); t_; }) : MFMA8(A, B, Cc))
#define CVT8(P, PK, base) _Pragma("unroll") for (int q = 0; q < 4; ++q) { int w_ = __builtin_amdgcn_cvt_pk_fp8_f32(P[4 * q], P[4 * q + 1], 0, false); w_ = __builtin_amdgcn_cvt_pk_fp8_f32(P[4 * q + 2], P[4 * q + 3], w_, true); PK[(base) + q] = w_; }
#define TRIP8(KB, VB, PKIN, PKOUT, DO_PV, FIRST, HOOK) do { \
    const char* kn_ = lds + OFF_KN + (KB) * SZ_KN; const char* kr_ = lds + OFF_KR + (KB) * SZ_KR; const char* vt_ = lds + OFF_VT + (VB) * SZ_VT; \
    v8i f0 = ld2x16(kn_ + kn0, kn_ + kn1), f1 = ld2x16(kn_ + (kn0 ^ 64), kn_ + (kn1 ^ 64)), f2 = ld2x16(kr_ + rv0, kr_ + rv1); SBAR8(); \
    HOOK; SBAR8();                                                              \
    p0 = QKM8(f0, qf[0], nmv); f0 = ld2x16(kn_ + kn0 + 4096, kn_ + kn1 + 4096); SBAR8(); \
    p0 = QKM8(f1, qf[1], p0); f1 = ld2x16(kn_ + (kn0 ^ 64) + 4096, kn_ + (kn1 ^ 64) + 4096); SBAR8(); \
    p0 = QKM8(f2, qf[2], p0); f2 = ld2x16(kr_ + rv0 + 2048, kr_ + rv1 + 2048); SBAR8(); \
    p1 = QKM8(f0, qf[0], nmv); if constexpr (DO_PV) f0 = ld2x16(vt_ + rv0, vt_ + rv1); SBAR8(); \
    float mx0 = p0[0]; _Pragma("unroll") for (int r = 1; r < 16; ++r) mx0 = fmaxf(mx0, p0[r]); \
    EXPR8(p0, 0, 4); SBAR8(); \
    p1 = QKM8(f1, qf[1], p1); if constexpr (DO_PV) f1 = ld2x16(vt_ + rv0 + 2048, vt_ + rv1 + 2048); SBAR8(); \
    EXPR8(p0, 4, 10); SBAR8(); \
    p1 = QKM8(f2, qf[2], p1); if constexpr (DO_PV) f2 = ld2x16(vt_ + rv0 + 4096, vt_ + rv1 + 4096); SBAR8(); \
    EXPR8(p0, 10, 16); SBAR8(); \
    if constexpr (DO_PV) { o[0] = PVM8(PKIN, f0, o[0]); f0 = ld2x16(vt_ + rv0 + 6144, vt_ + rv1 + 6144); } SBAR8(); \
    f32x2 ps2 = {p0[0], p0[1]}; _Pragma("unroll") for (int r = 2; r < 16; r += 2) ps2 += (f32x2){p0[r], p0[r + 1]}; \
    if constexpr (!(FIRST)) { CVT8(p0, PKOUT, 0); } SBAR8(); \
    float mx1 = p1[0]; _Pragma("unroll") for (int r = 1; r < 16; ++r) mx1 = fmaxf(mx1, p1[r]); \
    EXPR8(p1, 0, 4); SBAR8(); \
    if constexpr (DO_PV) o[1] = PVM8(PKIN, f1, o[1]); SBAR8(); \
    EXPR8(p1, 4, 10); SBAR8(); \
    if constexpr (DO_PV) o[2] = PVM8(PKIN, f2, o[2]); SBAR8(); \
    EXPR8(p1, 10, 16); SBAR8(); \
    if constexpr (DO_PV) o[3] = PVM8(PKIN, f0, o[3]); SBAR8(); \
    float mx = fmaxf(mx0, mx1); \
    if ((FIRST) || !__all(mx <= BIAS + THR)) {                                  \
      { auto rr = __builtin_amdgcn_permlane32_swap(__float_as_uint(mx), __float_as_uint(mx), false, false); mx = fmaxf(__uint_as_float(rr[0]), __uint_as_float(rr[1])); } \
      const float delta = (FIRST) ? (mx - BIAS) : fmaxf(mx - BIAS, 0.f); \
      const float alpha = __builtin_amdgcn_exp2f(-delta); \
      nm -= delta; l_reg *= alpha; ps2 *= alpha; \
      _Pragma("unroll") for (int r = 0; r < 16; ++r) nmv[r] = nm; asm volatile("" : "+v"(nmv)); \
      _Pragma("unroll") for (int r = 0; r < 16; ++r) { p0[r] *= alpha; p1[r] *= alpha; } \
      CVT8(p0, PKOUT, 0); \
      if constexpr (!(FIRST)) { if (hi == 0) al_l[r32] = alpha; asm volatile("s_waitcnt lgkmcnt(0)" ::: "memory"); \
        _Pragma("unroll") for (int d = 0; d < 4; ++d) _Pragma("unroll") for (int r = 0; r < 16; ++r) o[d][r] *= al_l[crow(r, hi)]; } \
    } \
    _Pragma("unroll") for (int r = 0; r < 16; r += 2) ps2 += (f32x2){p1[r], p1[r + 1]}; \
    CVT8(p1, PKOUT, 4); \
    l_reg += ps2.x + ps2.y; } while (0)
  f32x16 p0, p1; v8i pkp, pkq;
#define TCL(t) ((t) < NT ? (t) : NT - 1)
  asm volatile("s_waitcnt vmcnt(0)" ::: "memory");
  DMA8(0, 0, 0, 0); DMA8(1, 1, 0, 0);
  TBAR8();
  TRIP8(0, 0, pkq, pkp, false, true, DMA8(2, 2, 1, 1));
  TBAR8();
#define STEP8(jj, M, PIN, POUT) do { TRIP8((M), ((M) + 2) % 3, PIN, POUT, true, false, DMA8(TCL((jj) + 2), ((M) + 2) % 3, TCL((jj) + 1), ((M) + 1) % 3)); TBAR8(); } while (0)
  constexpr int vb = 0;
  { int j = 1;
    for (; j + 5 < NT; j += 6) {
      STEP8(j, 1, pkp, pkq); STEP8(j + 1, 2, pkq, pkp); STEP8(j + 2, 0, pkp, pkq); STEP8(j + 3, 1, pkq, pkp); STEP8(j + 4, 2, pkp, pkq); STEP8(j + 5, 0, pkq, pkp);
    }
    STEP8(j, 1, pkp, pkq); STEP8(j + 1, 2, pkq, pkp); STEP8(j + 2, 0, pkp, pkq);
  }
  { const char* vt_ = lds + OFF_VT + vb * SZ_VT;
    const v8i v0_ = ld2x16(vt_ + rv0, vt_ + rv1), v1_ = ld2x16(vt_ + rv0 + 2048, vt_ + rv1 + 2048), v2_ = ld2x16(vt_ + rv0 + 4096, vt_ + rv1 + 4096), v3_ = ld2x16(vt_ + rv0 + 6144, vt_ + rv1 + 6144);
    o[0] = PVM8(pkq, v0_, o[0]); o[1] = PVM8(pkq, v1_, o[1]); o[2] = PVM8(pkq, v2_, o[2]); o[3] = PVM8(pkq, v3_, o[3]); }
#undef TCL
  { auto rr = __builtin_amdgcn_permlane32_swap(__float_as_uint(l_reg), __float_as_uint(l_reg), false, false); l_reg = __uint_as_float(rr[0]) + __uint_as_float(rr[1]); }
  if (hi == 0) li_l[r32] = l_reg; asm volatile("s_waitcnt lgkmcnt(0)" ::: "memory");
  float rli[16];
#pragma unroll
  for (int r = 0; r < 16; ++r) rli[r] = __builtin_amdgcn_rcpf(li_l[crow(r, hi)]);
  bf16* Ow = Ob + (long)(wid * QBLK) * 1024;
#pragma unroll
  for (int r = 0; r < 16; ++r) { const int orow = crow(r, hi);
#pragma unroll
    for (int d0 = 0; d0 < 4; ++d0) Ow[(long)orow * 1024 + d0 * 32 + r32] = (bf16)(cvtpk(o[d0][r] * rli[r], 0.f) & 0xffffu); }
  asm volatile("s_waitcnt vmcnt(0)" ::: "memory");
  __syncthreads();
#undef DMA8
#undef TBAR8
#undef TRIP8
#undef QKM8
#undef PVM8
#undef EXPR8
#undef CVT8
}
#undef MFMA8
}

namespace ml {
constexpr int PITCH = 288, TILE = 64 * PITCH;
constexpr int OFF_Q = 0, OFF_K = 2 * TILE, OFF_V = 4 * TILE;
constexpr int PPITCH = 144, OFF_P = 6 * TILE;
constexpr int OFF_SC = OFF_P + 64 * PPITCH;
constexpr int OFF_RSP = OFF_SC + 8 * 2 * 5 * 256;
constexpr int OFF_QN = OFF_RSP + 1024;
constexpr int OFF_NBF = OFF_QN + 256;
constexpr int OFF_CH = OFF_NBF + 512;
constexpr int LDS_END = OFF_CH + 5 * 1024;
static_assert(LDS_END <= MISC_OFF, "mLSTM LDS map");
__device__ __forceinline__ int rho(int t) { return (t & ~12) | ((t & 4) << 1) | ((t & 8) >> 1); }
typedef short v4i16_t __attribute__((ext_vector_type(4)));
__device__ __forceinline__ bf16x8 trfrag(LAS const unsigned char* tile, int tbase, int c0, int lane) {
    const int g = lane >> 4, li = lane & 15;
#if ML_FAST_TR
    const int q = li >> 2, p = li & 3;
    const s16x4 lo = __builtin_bit_cast(s16x4, __builtin_amdgcn_ds_read_tr16_b64_v4i16((LAS v4i16_t*)(tile + rho(tbase + 8 * g + q) * PITCH + (c0 + 4 * p) * 2)));
    const s16x4 hi = __builtin_bit_cast(s16x4, __builtin_amdgcn_ds_read_tr16_b64_v4i16((LAS v4i16_t*)(tile + rho(tbase + 8 * g + 4 + q) * PITCH + (c0 + 4 * p) * 2)));
    return (bf16x8){lo[0], lo[1], lo[2], lo[3], hi[0], hi[1], hi[2], hi[3]};
#else
    bf16x8 r;
#pragma unroll
    for (int i = 0; i < 8; ++i) r[i] = *(LAS const short*)(tile + rho(tbase + 8 * g + i) * PITCH + (c0 + li) * 2);
    return r;
#endif
}
__device__ __forceinline__ float logsigmoid(float x) { return fminf(x, 0.f) - log1pf(expf(-fabsf(x))); }

__device__ __forceinline__ void mlstm_item(LAS unsigned char* lds, const bf16* __restrict__ QM, const bf16* __restrict__ KM, const bf16* __restrict__ VM, const float* __restrict__ KRG, const float* __restrict__ BG,
                                           float* SCR, bf16* __restrict__ H, int row0, int S, int dir, int h) {
    const int tid = opaque_tid(), lane = tid & 63, w = __builtin_amdgcn_readfirstlane(tid >> 6), g = lane >> 4, li = lane & 15;
    const int NC = S / 64, hc = h * 128;
    const int srow = tid >> 3, scol = (tid & 7) * 16;
    LAS float* sc = (LAS float*)(lds + OFF_SC) + w * 640;
    LAS float* RSP = (LAS float*)(lds + OFF_RSP); LAS float* QNl = (LAS float*)(lds + OFF_QN);
#define ML_ROW(c, t) (dir ? (row0 + S - 1 - (64 * (c) + (t))) : (row0 + 64 * (c) + (t)))
    float* scr = SCR + ((size_t)(dir * 8 + h) * MTOK + row0) * 5;
    LAS float* CHG = (LAS float*)(lds + OFF_CH); LAS float* CHU = CHG + 256; LAS float* CHM = CHG + 512; LAS float* CHAO = CHG + 768; LAS float* CHAN = CHG + 1024;
    for (int c = w; c < NC; c += 8) {
        const float* gp = KRG + (size_t)ML_ROW(c, lane) * 96 + 64;
        const float li_ = gp[dir * 8 + h] + BG[dir * 8 + h], lf = logsigmoid(gp[16 + dir * 8 + h] + BG[16 + dir * 8 + h]);
        float bsum = lf;
#pragma unroll
        for (int o = 1; o < 64; o <<= 1) { const float v = __int_as_float(__builtin_amdgcn_ds_bpermute(((lane - o) & 63) << 2, __float_as_int(bsum))); if (lane >= o) bsum += v; }
        const float uu = li_ - bsum; float pm = uu;
#pragma unroll
        for (int o = 1; o < 64; o <<= 1) { const float v = __int_as_float(__builtin_amdgcn_ds_bpermute(((lane - o) & 63) << 2, __float_as_int(pm))); if (lane >= o) pm = fmaxf(pm, v); }
        float* sp = scr + (size_t)c * 320 + lane;
        sp[0] = uu; sp[64] = pm; sp[128] = bsum;
        if (lane == 63) { CHG[c] = bsum; CHU[c] = pm; }
    }
    __syncthreads();
    if (w == 0) {
        float m = 0.f;
        for (int c = 0; c < NC; ++c) { const float gch = CHG[c], um = CHU[c]; const float m_loc = gch + um, m_new = fmaxf(gch + m, m_loc);
            if (lane == 0) { CHM[c] = m; CHAO[c] = expf(gch + m - m_new); CHAN[c] = expf(m_loc - m_new); }
            m = m_new; }
    }
    __syncthreads();
    for (int c = w; c < NC; c += 8) {
        float* sp = scr + (size_t)c * 320 + lane;
        const float uu = sp[0], pm = sp[64], bsum = sp[128]; const float mp = CHM[c], um = CHU[c], an = CHAN[c];
        const float Mj = fmaxf(mp, pm);
        sp[64] = Mj; sp[128] = expf(uu - um) * an; sp[192] = expf(mp - Mj); sp[256] = expf(-(bsum + Mj));
    }
    asm volatile("s_waitcnt vmcnt(0)" ::: "memory");
    __syncthreads();
    f32x4 X[8]; f32x4 nst = {0.f, 0.f, 0.f, 0.f};
#pragma unroll
    for (int d = 0; d < 8; ++d) X[d] = (f32x4){0.f, 0.f, 0.f, 0.f};
    v4u stq[2], stk[2], stv[2]; float scv[5];
#define ML_LOAD(c) do { const size_t go = (size_t)ML_ROW(c, srow) * 1024 + hc + scol; \
        stq[0] = *(const v4u*)(QM + go); stq[1] = *(const v4u*)(QM + go + 8); stk[0] = *(const v4u*)(KM + go); stk[1] = *(const v4u*)(KM + go + 8); \
        stv[0] = *(const v4u*)(VM + go); stv[1] = *(const v4u*)(VM + go + 8); \
        _Pragma("unroll") for (int k_ = 0; k_ < 5; ++k_) scv[k_] = __hip_atomic_load(scr + (size_t)(c) * 320 + k_ * 64 + lane, __ATOMIC_RELAXED, __HIP_MEMORY_SCOPE_AGENT); } while (0)
#define ML_WRITE(b) do { const int lo_ = rho(srow) * PITCH + scol * 2; \
        *(LAS v4u*)(lds + OFF_Q + (b) * TILE + lo_) = stq[0]; *(LAS v4u*)(lds + OFF_Q + (b) * TILE + lo_ + 16) = stq[1]; \
        *(LAS v4u*)(lds + OFF_K + (b) * TILE + lo_) = stk[0]; *(LAS v4u*)(lds + OFF_K + (b) * TILE + lo_ + 16) = stk[1]; \
        *(LAS v4u*)(lds + OFF_V + (b) * TILE + lo_) = stv[0]; *(LAS v4u*)(lds + OFF_V + (b) * TILE + lo_ + 16) = stv[1]; \
        _Pragma("unroll") for (int k_ = 0; k_ < 5; ++k_) sc[((b) * 5 + k_) * 64 + lane] = scv[k_]; } while (0)
    ML_LOAD(0); ML_WRITE(0);
    if (tid < 64) ((LAS unsigned*)(lds + OFF_NBF))[tid] = 0u;
    for (int c = 0; c < NC; ++c) {
        const int b = c & 1;
        LAS const unsigned char* Qt = lds + OFF_Q + b * TILE; LAS const unsigned char* Kt = lds + OFF_K + b * TILE; LAS const unsigned char* Vt = lds + OFF_V + b * TILE;
        LAS const float* scb = sc + b * 320;
        { const int cn = (c + 1 < NC) ? c + 1 : c; ML_LOAD(cn); }
        const float a_old = CHAO[c];
        __syncthreads();
        {
            bf16x8 ka[2][4], qb_[2][4], na[4], nq[4];
#pragma unroll
            for (int tt = 0; tt < 2; ++tt) { const int tile = w * 2 + tt, lb = tile & 3, jb = tile >> 2;
#pragma unroll
                for (int ks = 0; ks < 4; ++ks) { ka[tt][ks] = *(LAS const bf16x8*)(Kt + rho(16 * lb + li) * PITCH + (32 * ks + 8 * g) * 2);
                    qb_[tt][ks] = *(LAS const bf16x8*)(Qt + rho(16 * jb + li) * PITCH + (32 * ks + 8 * g) * 2); } }
            { LAS const unsigned char* nb = lds + OFF_NBF + b * 256;
#pragma unroll
              for (int ks = 0; ks < 4; ++ks) { na[ks] = *(LAS const bf16x8*)(nb + (32 * ks + 8 * g) * 2); if (li != 0) na[ks] = (bf16x8){0, 0, 0, 0, 0, 0, 0, 0};
                  nq[ks] = *(LAS const bf16x8*)(Qt + rho(16 * (w & 3) + li) * PITCH + (32 * ks + 8 * g) * 2); } }
#pragma unroll
            for (int tt = 0; tt < 2; ++tt) {
                const int tile = w * 2 + tt, lb = tile & 3, jb = tile >> 2;
                const int j = 16 * jb + li, l0 = 16 * lb + 4 * g;
                f32x4 s = {0.f, 0.f, 0.f, 0.f};
#pragma unroll
                for (int ks = 0; ks < 4; ++ks) s = __builtin_amdgcn_mfma_f32_16x16x32_bf16(ka[tt][ks], qb_[tt][ks], s, 0, 0, 0);
                const f32x4 u4 = *(LAS const f32x4*)(scb + l0); const float Mj = scb[64 + j];
                float p[4]; float rs = 0.f;
#pragma unroll
                for (int r = 0; r < 4; ++r) { p[r] = (l0 + r <= j) ? s[r] * __expf(u4[r] - Mj) : 0.f; rs += p[r]; }
                *(LAS u32x2*)(lds + OFF_P + j * PPITCH + l0 * 2) = (u32x2){cvtpk(p[0], p[1]), cvtpk(p[2], p[3])};
                rs = sum_x16(rs); rs = sum_x32(rs);
                if (g == 0) RSP[j * 4 + lb] = rs;
            }
            { f32x4 s = {0.f, 0.f, 0.f, 0.f};
#pragma unroll
              for (int ks = 0; ks < 4; ++ks) s = __builtin_amdgcn_mfma_f32_16x16x32_bf16(na[ks], nq[ks], s, 0, 0, 0);
              if (g == 0) QNl[16 * (w & 3) + li] = s[0]; }
        }
        f32x4 Y[4];
        {
            bf16x8 ca[4];
#pragma unroll
            for (int ks = 0; ks < 4; ++ks) { v4u t; t.x = cvtpk(X[2 * ks][0], X[2 * ks][1]); t.y = cvtpk(X[2 * ks][2], X[2 * ks][3]); t.z = cvtpk(X[2 * ks + 1][0], X[2 * ks + 1][1]); t.w = cvtpk(X[2 * ks + 1][2], X[2 * ks + 1][3]);
                ca[ks] = __builtin_bit_cast(bf16x8, t); }
#pragma unroll
            for (int tb = 0; tb < 4; ++tb) {
                LAS const unsigned char* qrow = Qt + rho(16 * tb + li) * PITCH;
                v4u qq[4];
#pragma unroll
                for (int ks = 0; ks < 4; ++ks) { const u32x2 q0 = *(LAS const u32x2*)(qrow + (32 * ks + 4 * g) * 2), q1 = *(LAS const u32x2*)(qrow + (32 * ks + 16 + 4 * g) * 2); qq[ks] = (v4u){q0.x, q0.y, q1.x, q1.y}; }
                f32x4 y = {0.f, 0.f, 0.f, 0.f};
#pragma unroll
                for (int ks = 0; ks < 4; ++ks) y = __builtin_amdgcn_mfma_f32_16x16x32_bf16(ca[ks], __builtin_bit_cast(bf16x8, qq[ks]), y, 0, 0, 0);
                Y[tb] = y;
            }
        }
        __syncthreads();
        bf16x8 vf[2];
        vf[0] = trfrag(Vt, 0, 16 * w, lane); vf[1] = trfrag(Vt, 32, 16 * w, lane);
        {
            bf16x8 pb[4][2]; f32x4 rp[4]; float wi[4], qn[4], cl[4];
#pragma unroll
            for (int tb = 0; tb < 4; ++tb) { const int t = 16 * tb + li;
                pb[tb][0] = *(LAS const bf16x8*)(lds + OFF_P + t * PPITCH + (8 * g) * 2); pb[tb][1] = *(LAS const bf16x8*)(lds + OFF_P + t * PPITCH + (32 + 8 * g) * 2);
                rp[tb] = *(LAS const f32x4*)(RSP + t * 4); wi[tb] = scb[192 + t]; qn[tb] = QNl[t]; cl[tb] = scb[256 + t]; }
#pragma unroll
            for (int tb = 0; tb < 4; ++tb) {
                const int t = 16 * tb + li;
                f32x4 y = Y[tb] * wi[tb];
                y = __builtin_amdgcn_mfma_f32_16x16x32_bf16(vf[0], pb[tb][0], y, 0, 0, 0);
                y = __builtin_amdgcn_mfma_f32_16x16x32_bf16(vf[1], pb[tb][1], y, 0, 0, 0);
                const float den = (rp[tb][0] + rp[tb][1]) + (rp[tb][2] + rp[tb][3]) + wi[tb] * qn[tb];
                const float inv = __builtin_amdgcn_rcpf(fmaxf(fabsf(den), cl[tb]));
                const u32x2 o = {cvtpk(y[0] * inv, y[1] * inv), cvtpk(y[2] * inv, y[3] * inv)};
                *(u32x2*)(H + (size_t)ML_ROW(c, t) * 1024 + hc + 16 * w + 4 * g) = o;
            }
        }
        {
            bf16x8 vw[2]; bf16x8 wb[2];
#pragma unroll
            for (int ks = 0; ks < 2; ++ks) {
                const f32x4 w0 = *(LAS const f32x4*)(scb + 128 + 32 * ks + 8 * g), w1 = *(LAS const f32x4*)(scb + 128 + 32 * ks + 8 * g + 4);
                float wv[8] = {w0[0], w0[1], w0[2], w0[3], w1[0], w1[1], w1[2], w1[3]};
                const v4u vraw = __builtin_bit_cast(v4u, vf[ks]); v4u t, tw;
#pragma unroll
                for (int e = 0; e < 4; ++e) { t[e] = cvtpk(bflo(vraw[e]) * wv[2 * e], bfhi(vraw[e]) * wv[2 * e + 1]); tw[e] = (li == 0) ? cvtpk(wv[2 * e], wv[2 * e + 1]) : 0u; }
                vw[ks] = __builtin_bit_cast(bf16x8, t); wb[ks] = __builtin_bit_cast(bf16x8, tw);
            }
            bf16x8 kf[8][2], kn[2];
#pragma unroll
            for (int d = 0; d < 8; ++d) { kf[d][0] = trfrag(Kt, 0, 16 * d, lane); kf[d][1] = trfrag(Kt, 32, 16 * d, lane); }
            kn[0] = trfrag(Kt, 0, 16 * w, lane); kn[1] = trfrag(Kt, 32, 16 * w, lane);
#pragma unroll
            for (int d = 0; d < 8; ++d) {
                f32x4 x = X[d] * a_old;
                x = __builtin_amdgcn_mfma_f32_16x16x32_bf16(kf[d][0], vw[0], x, 0, 0, 0);
                x = __builtin_amdgcn_mfma_f32_16x16x32_bf16(kf[d][1], vw[1], x, 0, 0, 0);
                X[d] = x;
            }
            nst = nst * a_old;
            nst = __builtin_amdgcn_mfma_f32_16x16x32_bf16(kn[0], wb[0], nst, 0, 0, 0);
            nst = __builtin_amdgcn_mfma_f32_16x16x32_bf16(kn[1], wb[1], nst, 0, 0, 0);
            if (li == 0) *(LAS u32x2*)(lds + OFF_NBF + (b ^ 1) * 256 + (16 * w + 4 * g) * 2) = (u32x2){cvtpk(nst[0], nst[1]), cvtpk(nst[2], nst[3])};
        }
        ML_WRITE(b ^ 1);
    }
    __syncthreads();
#undef ML_ROW
#undef ML_LOAD
#undef ML_WRITE
}
}

constexpr int Q_ML_P = 4, Q_ML_S = 16, Q_AT_P = 128, Q_AT_S = 128, QLEN = Q_ML_P + Q_ML_S + Q_AT_P + Q_AT_S;
template <int AVAR = 0>
__device__ __forceinline__ void p_mixer(Frame& F, const float* bgl, int lq, unsigned xcc, bool ml_only = false, bool att_only = false) {
    unsigned char* ws = F.ws;
    int qsel = (int)(xcc & 7u), tried = 0;
    for (;;) {
        if (F.tid == 0) {
            int item = -1, qq = qsel, tr = tried;
            while (tr < 8) {
                const unsigned idx = __hip_atomic_fetch_add(F.ctl + CW_QUEUE + (lq * 8 + qq) * 64, 1u, __ATOMIC_RELAXED, __HIP_MEMORY_SCOPE_AGENT);
                if (idx < (unsigned)QLEN) { item = qq * 1024 + (int)idx; break; }
                qq = (qq + 1) & 7; ++tr;
            }
            F.MISC[0] = (unsigned)item; F.MISC[1] = (unsigned)qq; F.MISC[2] = (unsigned)tr;
        }
        __syncthreads();
        const int item = (int)F.MISC[0]; qsel = (int)F.MISC[1]; tried = (int)F.MISC[2];
        __syncthreads();
        if (item < 0) break;
        const int h = item >> 10, i = item & 1023;
#ifndef NO_ML
        if (i < Q_ML_P + Q_ML_S) {
            if (att_only) continue;
            int row0, S, dir;
            if (i < Q_ML_P) { row0 = (i >> 1) * SEQ_P; S = SEQ_P; dir = i & 1; }
            else { const int k = i - Q_ML_P; row0 = MPROMPT + (k >> 1) * SEQ_S; S = SEQ_S; dir = k & 1; }
            ml::mlstm_item(F.lds, (const bf16*)(ws + WS_QM), (const bf16*)(ws + WS_KM), (const bf16*)(ws + WS_VM), (const float*)(ws + WS_KRG), bgl,
                           (float*)(ws + WS_SCR), (bf16*)(ws + (dir ? WS_HBW : WS_HFW)), row0, S, dir, h);
        } else
#endif
#ifndef NO_ATT
        {
            int row0, S, qb;
            if (i < Q_ML_P + Q_ML_S + Q_AT_P) { const int k = i - (Q_ML_P + Q_ML_S); row0 = (k >> 6) * SEQ_P; S = SEQ_P; qb = k & 63; }
            else { const int k = i - (Q_ML_P + Q_ML_S + Q_AT_P); row0 = MPROMPT + (k >> 4) * SEQ_S; S = SEQ_S; qb = k & 15; }
            const size_t qrow = (size_t)(row0 + 256 * qb);
            if (ml_only) continue;
            att8::attn_unit<AVAR>((const bf16*)(ws + WS_Q) + qrow * NQ + h * 128, (const bf16*)(ws + WS_Q) + qrow * NQ + 1024 + h * 64,
                            ws + WS_K8 + (size_t)row0 * 1024 + h * 128, ws + WS_KR + (size_t)row0 * 64, ws + WS_V8T + ((size_t)(row0 >> 6) * 1024 + h * 128) * 64,
                            (bf16*)(ws + WS_CQKV) + qrow * 1024 + h * 128, S, (const f32x2*)(ws + WS_ROPE), 256 * qb, (char*)F.lds);
        }
#else
        {}
#endif
    }
}


constexpr int NPH = 1 + DEPTH * 10 + 1;
__global__ void __launch_bounds__(NWAVES * 64, 2) trunk_fwd(Args args) {
    extern __shared__ __attribute__((aligned(16))) unsigned char lds[];
    Frame F;
    F.lds = (LAS unsigned char*)lds; F.MISC = (volatile LAS unsigned*)(F.lds + MISC_OFF);
    F.tid = threadIdx.x; F.lane = F.tid & 63; F.wave = __builtin_amdgcn_readfirstlane(F.tid >> 6);
    F.G = gridDim.x; { const int bx = blockIdx.x; F.vcu = (F.G % 8 == 0) ? (bx % 8) * (F.G / 8) + bx / 8 : bx; }
    F.ws = args.ws; F.ctl = (gu32*)(args.ws + WS_CTL); F.out = args.out;
    for (int u = F.tid; u < (LDS_BYTES - MISC_OFF) / 4; u += NWAVES * 64) ((LAS unsigned*)(F.lds + MISC_OFF))[u] = 0u;
    __syncthreads();
    XcdBarrier bar; bar.bar = (unsigned*)(F.ctl + CW_BAR); bar.x = xb_xcc_id(); bar.st = F.MISC + 8;
#if !MK_PER_PHASE
    bar = xcd_barrier_post((unsigned*)(F.ctl + CW_BAR), F.MISC + 8);
#endif
    const unsigned xcc = bar.x;
    const int lo = args.ph_lo, hi = args.ph_hi;
#define IN(k) (lo <= (k) && (k) < hi)
#if MK_PER_PHASE
#define SEAM(k) do { } while (0)
#else
#define SEAM(k) do { if (IN(k) && IN((k) + 1)) xcd_barrier(bar); } while (0)
#endif
    unsigned char* ws = args.ws;
    if (IN(0)) { p_prologue(F, args); }
#if MK_PER_PHASE
    SEAM(0);
#endif
    for (int layer = 0; layer < DEPTH; ++layer) {
        const int p0 = 1 + layer * 10;
        asm volatile("" : "+s"(ws));
        F.ws = ws;
        const unsigned char* wl = ws + WS_W + (size_t)layer * LW;
        if (layer == 0 || F.G != 256) { if (IN(p0 + 0)) { p_norm(F, args, layer); } SEAM(p0 + 0); }
        if (IN(p0 + 1)) {
            { pg8::Gemm g{(const pg8::bf16_t*)(ws + WS_XN8), (const pg8::bf16_t*)(wl + W_P1A), MTOK, NP1A, DM / 2, DM / 2, DM / 2, SC_ONE, SC_M6}; pg8::StaticOrder S; S.init(MTOK, NP1A, F.G, (int)blockIdx.x);
              EpiP1a E{ws, WS_CQKV}; pg8::gemm_phase<EpiP1a, pg8::StaticOrder, true, true, true, SC_ONE, SC_M6>(F.lds, g, S, E);
            }
            { pg8::Gemm g{(const pg8::bf16_t*)(ws + WS_XN), (const pg8::bf16_t*)(wl + W_P1B), MTOK, NP1B, DM, DM, DM, SC_ONE, SC_ONE}; pg8::StaticOrder S; S.init(MTOK, NP1B, F.G, (int)blockIdx.x);
              EpiP1b E{ws}; pg8::gemm_phase<EpiP1b, pg8::StaticOrder, true, true>(F.lds, g, S, E); }
        } SEAM(p0 + 1);
        if (IN(p0 + 2)) {
            { pg8::Gemm g{(const pg8::bf16_t*)(ws + WS_CQKV), (const pg8::bf16_t*)(wl + W_UQ), MTOK, NQ, 256, 512, 256, SC_ONE, SC_M5}; pg8::StaticOrder S; S.init(MTOK, NQ, F.G, (int)blockIdx.x);
              EpiQ E{ws}; pg8::gemm_phase<EpiQ, pg8::StaticOrder, true, true, true, SC_ONE, SC_M5>(F.lds, g, S, E); }
            { pg8::Gemm g{(const pg8::bf16_t*)(ws + WS_CQKV + 512), (const pg8::bf16_t*)(wl + W_UKV), MTOK, 1024, 256, 512, 256, SC_ONE, SC_M5}; pg8::StaticOrder S; S.init(MTOK, 1024, F.G, (int)blockIdx.x);
              EpiK8 E{ws}; pg8::gemm_phase<EpiK8, pg8::StaticOrder, true, true, true, SC_ONE, SC_M5>(F.lds, g, S, E); }
            { pg8::Gemm g{(const pg8::bf16_t*)(wl + W_UKV + (size_t)1024 * 512), (const pg8::bf16_t*)(ws + WS_CQKV + 512), 1024, MTOK, 256, 256, 512, SC_M5, SC_ONE}; pg8::StaticOrder S; S.init(1024, MTOK, F.G, (int)blockIdx.x);
              EpiVT E{ws}; pg8::gemm_phase<EpiVT, pg8::StaticOrder, true, true, true, SC_M5, SC_ONE>(F.lds, g, S, E); }
        } SEAM(p0 + 2);
        if (IN(p0 + 3)) { p_mixer(F, args.in[IN_B_GATES] + layer * 32, layer, xcc); }
        SEAM(p0 + 3);
        if (IN(p0 + 4)) {
            { pg8::Gemm g{(const pg8::bf16_t*)(ws + WS_XN8), (const pg8::bf16_t*)(wl + W_P2A), MTOK, NP2A, DM / 2, DM / 2, DM / 2, SC_ONE, SC_M6}; pg8::StaticOrder S; S.init(MTOK, NP2A, F.G, (int)blockIdx.x);
              EpiP2a E{ws, WS_SGA}; pg8::gemm_phase<EpiP2a, pg8::StaticOrder, true, true, true, SC_ONE, SC_M6>(F.lds, g, S, E);
            }
            { pg8::Gemm g{(const pg8::bf16_t*)(ws + WS_XN), (const pg8::bf16_t*)(wl + W_P2B), MTOK, NP2B, DM, DM, DM, SC_ONE, SC_ONE}; pg8::StaticOrder S; S.init(MTOK, NP2B, F.G, (int)blockIdx.x);
              EpiP2b E{ws, layer}; pg8::gemm_phase<EpiP2b, pg8::StaticOrder, true, true>(F.lds, g, S, E); }
        } SEAM(p0 + 4);
        if (IN(p0 + 5)) {
            pg8::Gemm g1{(const pg8::bf16_t*)(ws + WS_HFW), (const pg8::bf16_t*)(wl + W_OB), MTOK, DM, 1024, 1024, 1024, 0x7F7F7F7F, 0x7F7F7F7F};
            pg8::Gemm g2{(const pg8::bf16_t*)(ws + WS_YA8), (const pg8::bf16_t*)(wl + W_OA), MTOK, DM, 512, 512, 512, SC_M6, SC_M5};
            pg8::StaticOrder S; S.init(MTOK, DM, F.G, (int)blockIdx.x);
            MidMerge Mm{ws}; EpiMerge2 E{ws}; pg8::gemm_chain<EpiMerge2, MidMerge, pg8::StaticOrder>(F.lds, g1, g2, S, Mm, E);
        } SEAM(p0 + 5);
        if (IN(p0 + 8)) {
            pg8::Gemm g{(const pg8::bf16_t*)(ws + WS_MG), (const pg8::bf16_t*)(wl + W_OUT), MTOK, DM, DM, DM, DM, 0x7F7F7F7F, 0x7F7F7F7F}; pg8::StaticOrder S; S.init(MTOK, DM, F.G, (int)blockIdx.x);
            if (F.G == 256) { S.wgm = 4;
                if (layer + 1 == DEPTH) { EpiOutX<true> E{args.in[IN_XP], args.in[IN_XS], F.out, ws, args.in[IN_NORM_F], layer}; pg8::gemm_phase<EpiOutX<true>, pg8::StaticOrder, true, true>(F.lds, g, S, E); }
                else { EpiOutX<false> E{args.in[IN_XP], args.in[IN_XS], F.out, ws, args.in[IN_NORM_IN] + (layer + 1) * DM, layer}; pg8::gemm_phase<EpiOutX<false>, pg8::StaticOrder, true, true>(F.lds, g, S, E); }
            } else { EpiOut E{args.in[IN_XP], args.in[IN_XS], F.out, layer}; pg8::gemm_phase<EpiOut, pg8::StaticOrder, true, true>(F.lds, g, S, E); }
        } if (layer + 1 < DEPTH || F.G != 256) SEAM(p0 + 8);
    }
    if (IN(NPH - 1) && F.G != 256) { p_final(F, args); }
#undef IN
#undef SEAM
}

extern "C" void kernel_launch(void* const* d_in, const int* in_sizes, int n_in, void* d_out, int out_size, void* d_ws, size_t ws_size, hipStream_t stream) {
    static int grid = 0;
    if (grid == 0) {
        if (n_in != 14 || in_sizes[0] != MPROMPT * DM || in_sizes[1] != MPROMPT * DM || out_size != MTOK * DM || ws_size < WS_END) {
            fprintf(stderr, "kernel_launch: shape mismatch (n_in %d, in0 %d, out %d, ws %zu, need %zu); nothing launched\n", n_in, n_in > 0 ? in_sizes[0] : -1, out_size, ws_size, (size_t)WS_END); grid = -1; return; }
        int dev = 0, cus = 0, per_cu = 0;
        if (hipGetDevice(&dev) != hipSuccess || hipDeviceGetAttribute(&cus, hipDeviceAttributeMultiprocessorCount, dev) != hipSuccess) { grid = -1; return; }
        if (hipFuncSetAttribute((const void*)trunk_fwd, hipFuncAttributeMaxDynamicSharedMemorySize, LDS_BYTES) != hipSuccess) { fprintf(stderr, "kernel_launch: hipFuncSetAttribute failed\n"); grid = -1; return; }
        if (hipOccupancyMaxActiveBlocksPerMultiprocessor(&per_cu, (const void*)trunk_fwd, NWAVES * 64, LDS_BYTES) != hipSuccess || per_cu < 1)
            fprintf(stderr, "kernel_launch: note: occupancy query reports %d workgroups per CU\n", per_cu);
        (void)hipGetLastError();
        grid = cus;
    }
    if (grid < 0) return;
    if (hipMemsetAsync((char*)d_ws + WS_CTL, 0, CTL_ZERO_BYTES, stream) != hipSuccess) return;
    Args a{};
    for (int i = 0; i < 14; ++i) a.in[i] = (const float*)d_in[i];
    a.out = (float*)d_out; a.ws = (unsigned char*)d_ws;
#if MK_PER_PHASE
    for (int p = 0; p < NPH; ++p) {
        if (p >= 1 && p < NPH - 1 && (((p - 1) % 10) == 9 || ((p - 1) % 10) == 6)) continue;
        a.ph_lo = p; a.ph_hi = p + 1;
        hipLaunchKernelGGL(trunk_fwd, dim3(grid), dim3(NWAVES * 64), LDS_BYTES, stream, a);
    }
#else
    a.ph_lo = 0; a.ph_hi = NPH;
    hipLaunchKernelGGL(trunk_fwd, dim3(grid), dim3(NWAVES * 64), LDS_BYTES, stream, a);
#endif
    const hipError_t le = hipPeekAtLastError();
    if (le != hipSuccess) fprintf(stderr, "kernel_launch: launch failed: %s\n", hipGetErrorName(le));
}
```
